# Optimizing an MI355X kernel written in HIP

```python
import math
import jax, jax.numpy as jnp
from jax import lax
import numpy as np

D_MODEL = 1024
BATCH = 8
SEQ = 8192
DEPTH = 1

GM_GROUPS = 4
GM_DG = 128
GM_WIDTH = GM_GROUPS * GM_DG
CHUNK = 128
DA_HEADS = 4
DA_DH = 64
DA_VDIM = 2 * DA_DH
DA_QK = DA_HEADS * 2 * DA_DH
DA_WIDTH = DA_HEADS * DA_VDIM
ROT_DIM = DA_DH // 4
ROPE_THETA = 500000.0
Q_BLOCK = 128
N_BRANCH = 2
SPLIT_SIZES = (GM_WIDTH, GM_WIDTH, DA_QK, DA_QK, DA_WIDTH, N_BRANCH * D_MODEL)
IN_COLS = sum(SPLIT_SIZES)
SPLIT_IDX = tuple(int(i) for i in np.cumsum(SPLIT_SIZES)[:-1])
N_GROUPS = 4
EXPERTS_PER_GROUP = 8
N_EXPERTS = N_GROUPS * EXPERTS_PER_GROUP
TOP_K = 2
D_EXPERT = 512
MOE_BLOCK = 128
EPS = 1e-6
POS_OFFSET_MAX = 4096

kernel_name = "hybrid_gmlp_diffattn_hmoe"


def lambda_init(layer):
    return 0.8 - 0.6 * math.exp(-0.3 * layer)


def rmsnorm(x, g):
    xf = x.astype(jnp.float32)
    var = jnp.mean(xf * xf, axis=-1, keepdims=True)
    return (xf * lax.rsqrt(var + EPS) * g.astype(jnp.float32)).astype(x.dtype)


def layernorm(x, g, b):
    xf = x.astype(jnp.float32)
    mu = jnp.mean(xf, axis=-1, keepdims=True)
    xc = xf - mu
    var = jnp.mean(xc * xc, axis=-1, keepdims=True)
    return (xc * lax.rsqrt(var + EPS) * g.astype(jnp.float32) + b.astype(jnp.float32)).astype(x.dtype)


def partial_rope(x, pos):
    half = ROT_DIM // 2
    inv_freq = ROPE_THETA ** (-jnp.arange(half, dtype=jnp.float32) / half)
    ang = pos.astype(jnp.float32)[..., None] * inv_freq
    cos = jnp.cos(ang)[:, :, None, None, :]
    sin = jnp.sin(ang)[:, :, None, None, :]
    xr = x[..., :ROT_DIM].astype(jnp.float32)
    x1, x2 = xr[..., :half], xr[..., half:]
    rot = jnp.concatenate([x1 * cos - x2 * sin, x2 * cos + x1 * sin], axis=-1).astype(x.dtype)
    return jnp.concatenate([rot, x[..., ROT_DIM:]], axis=-1)


def gmlp_mixer(u, v, ln_g, ln_b, w_s, b_s):
    B, S, _ = u.shape
    nc = S // CHUNK
    u = u.reshape(B, nc, CHUNK, GM_GROUPS, GM_DG)
    v = layernorm(v.reshape(B, nc, CHUNK, GM_GROUPS, GM_DG), ln_g, ln_b)
    causal = jnp.tril(jnp.ones((CHUNK, CHUNK), dtype=bool))
    w = jnp.where(causal[None], w_s, 0.0).astype(v.dtype)
    sv = jnp.einsum('gts,bnsgd->bntgd', w, v) + b_s.T[:, :, None].astype(v.dtype)
    return (u * sv).reshape(B, S, GM_WIDTH)


def diff_attention(q, k, v, pos, lam_q1, lam_k1, lam_q2, lam_k2, subln_g, lam_init):
    B, S = q.shape[0], q.shape[1]
    q = partial_rope(q, pos)
    k = partial_rope(k, pos)
    lam = (jnp.exp(jnp.sum(lam_q1.astype(jnp.float32) * lam_k1.astype(jnp.float32)))
           - jnp.exp(jnp.sum(lam_q2.astype(jnp.float32) * lam_k2.astype(jnp.float32)))
           + lam_init)
    scale = DA_DH ** -0.5
    nb = S // Q_BLOCK
    qb = q.reshape(B, nb, Q_BLOCK, DA_HEADS, 2, DA_DH).transpose(1, 0, 2, 3, 4, 5)
    key_idx = jnp.arange(S)

    def block(args):
        qi, bi = args
        s = jnp.einsum('bqhmd,bkhmd->bhmqk', qi, k).astype(jnp.float32) * scale
        q_idx = bi * Q_BLOCK + jnp.arange(Q_BLOCK)
        mask = key_idx[None, :] <= q_idx[:, None]
        p = jax.nn.softmax(jnp.where(mask, s, -jnp.inf), axis=-1)
        a = p[:, :, 0] - lam * p[:, :, 1]
        return jnp.einsum('bhqk,bkhd->bqhd', a.astype(v.dtype), v)

    o = lax.map(block, (qb, jnp.arange(nb)))
    o = o.transpose(1, 0, 2, 3, 4).reshape(B, S, DA_HEADS, DA_VDIM)
    o = rmsnorm(o, subln_g) * (1.0 - lam_init)
    return o.reshape(B, S, DA_WIDTH)


def hier_moe(h, w_rg, b_rg, w_re, b_re, w1, w3, w2):
    B, S, D = h.shape
    T = B * S
    A = T * TOP_K
    hf = h.reshape(T, D)
    g_logits = (hf @ w_rg).astype(jnp.float32) + b_rg.astype(jnp.float32)
    g_prob = jax.nn.softmax(g_logits, axis=-1)
    grp = jnp.argmax(g_logits, axis=-1)
    g_w = jnp.take_along_axis(g_prob, grp[:, None], axis=1)
    e_logits = ((hf @ w_re).astype(jnp.float32) + b_re.astype(jnp.float32)).reshape(T, N_GROUPS, EXPERTS_PER_GROUP)
    e_logits = jnp.take_along_axis(e_logits, grp[:, None, None], axis=1)[:, 0]
    top_v, top_i = lax.top_k(e_logits, TOP_K)
    e_w = jax.nn.softmax(top_v, axis=-1) * g_w
    eid = (grp[:, None] * EXPERTS_PER_GROUP + top_i).reshape(A).astype(jnp.int32)
    wts = e_w.reshape(A)
    tok = jnp.arange(A, dtype=jnp.int32) // TOP_K
    order = jnp.argsort(eid)
    s_eid, s_tok, s_w = eid[order], tok[order], wts[order]
    counts = jax.ops.segment_sum(jnp.ones((A,), jnp.int32), eid, num_segments=N_EXPERTS)
    starts = jnp.cumsum(counts) - counts
    p_counts = (counts + MOE_BLOCK - 1) // MOE_BLOCK * MOE_BLOCK
    p_ends = jnp.cumsum(p_counts)
    p_starts = p_ends - p_counts
    dest = p_starts[s_eid] + (jnp.arange(A, dtype=jnp.int32) - starts[s_eid])
    P = (A + N_EXPERTS * (MOE_BLOCK - 1) + MOE_BLOCK - 1) // MOE_BLOCK * MOE_BLOCK
    nblk = P // MOE_BLOCK
    buf_tok = jnp.zeros((P,), jnp.int32).at[dest].set(s_tok)
    buf_w = jnp.zeros((P,), jnp.float32).at[dest].set(s_w)
    blk_e = jnp.clip(jnp.searchsorted(p_ends, jnp.arange(nblk, dtype=jnp.int32) * MOE_BLOCK, side='right'),
                     0, N_EXPERTS - 1)
    xs = hf[buf_tok].reshape(nblk, MOE_BLOCK, D)

    def expert_block(args):
        xb, e = args
        return (jax.nn.silu(xb @ w1[e]) * (xb @ w3[e])) @ w2[e]

    ys = lax.map(expert_block, (xs, blk_e)).reshape(P, D)
    ys = ys * buf_w[:, None].astype(ys.dtype)
    return jax.ops.segment_sum(ys, buf_tok, num_segments=T).reshape(B, S, D)


def setup_inputs(seed: int = 0) -> dict:
    key = jax.random.key(seed)
    ks = jax.random.split(key, 32)
    f32 = jnp.float32
    nrm = lambda k, shape, s: jax.random.normal(k, shape, f32) * s
    L, D = DEPTH, D_MODEL
    offset = jax.random.randint(ks[1], (BATCH, 1), 0, POS_OFFSET_MAX, dtype=jnp.int32)
    positions = offset + jnp.arange(SEQ, dtype=jnp.int32)[None, :]
    return {
        "x": nrm(ks[0], (BATCH, SEQ, D), 1.0),
        "positions": positions,
        "norm_mix_g": 1.0 + nrm(ks[2], (L, D), 0.02),
        "w_in": nrm(ks[3], (L, D, IN_COLS), D ** -0.5),
        "gm_ln_g": 1.0 + nrm(ks[4], (L, GM_GROUPS, GM_DG), 0.02),
        "gm_ln_b": nrm(ks[5], (L, GM_GROUPS, GM_DG), 0.02),
        "gm_w_s": nrm(ks[6], (L, GM_GROUPS, CHUNK, CHUNK), 0.5 * CHUNK ** -0.5),
        "gm_b_s": 1.0 + nrm(ks[7], (L, GM_GROUPS, CHUNK), 0.02),
        "lam_q1": nrm(ks[8], (L, DA_DH), 0.1),
        "lam_k1": nrm(ks[9], (L, DA_DH), 0.1),
        "lam_q2": nrm(ks[10], (L, DA_DH), 0.1),
        "lam_k2": nrm(ks[11], (L, DA_DH), 0.1),
        "da_subln_g": 1.0 + nrm(ks[12], (L, DA_VDIM), 0.02),
        "w_br_a": nrm(ks[13], (L, GM_WIDTH, D), GM_WIDTH ** -0.5),
        "w_br_b": nrm(ks[14], (L, DA_WIDTH, D), DA_WIDTH ** -0.5),
        "w_out": nrm(ks[15], (L, D, D), D ** -0.5),
        "norm_ffn_g": 1.0 + nrm(ks[16], (L, D), 0.02),
        "w_router_group": nrm(ks[17], (L, D, N_GROUPS), D ** -0.5),
        "b_router_group": nrm(ks[18], (L, N_GROUPS), 0.01),
        "w_router_expert": nrm(ks[19], (L, D, N_EXPERTS), D ** -0.5),
        "b_router_expert": nrm(ks[20], (L, N_EXPERTS), 0.01),
        "w_exp_gate": nrm(ks[21], (L, N_EXPERTS, D, D_EXPERT), D ** -0.5),
        "w_exp_up": nrm(ks[22], (L, N_EXPERTS, D, D_EXPERT), D ** -0.5),
        "w_exp_down": nrm(ks[23], (L, N_EXPERTS, D_EXPERT, D), D_EXPERT ** -0.5),
        "final_norm_g": 1.0 + nrm(ks[24], (D,), 0.02),
    }


def reference(x, positions, norm_mix_g, w_in, gm_ln_g, gm_ln_b, gm_w_s, gm_b_s,
              lam_q1, lam_k1, lam_q2, lam_k2, da_subln_g, w_br_a, w_br_b, w_out,
              norm_ffn_g, w_router_group, b_router_group, w_router_expert, b_router_expert,
              w_exp_gate, w_exp_up, w_exp_down, final_norm_g):
    B, S, D = x.shape
    for l in range(DEPTH):
        h = rmsnorm(x, norm_mix_g[l])
        z = h @ w_in[l]
        z_u, z_v, z_q, z_k, z_va, z_g = jnp.split(z, SPLIT_IDX, axis=-1)
        y_a = gmlp_mixer(jax.nn.gelu(z_u), jax.nn.gelu(z_v), gm_ln_g[l], gm_ln_b[l], gm_w_s[l], gm_b_s[l])
        q = z_q.reshape(B, S, DA_HEADS, 2, DA_DH)
        k = z_k.reshape(B, S, DA_HEADS, 2, DA_DH)
        va = z_va.reshape(B, S, DA_HEADS, DA_VDIM)
        y_b = diff_attention(q, k, va, positions, lam_q1[l], lam_k1[l], lam_q2[l], lam_k2[l],
                             da_subln_g[l], lambda_init(l))
        gates = jax.nn.sigmoid(z_g.astype(jnp.float32)).astype(x.dtype).reshape(B, S, N_BRANCH, D)
        merged = gates[:, :, 0] * (y_a @ w_br_a[l]) + gates[:, :, 1] * (y_b @ w_br_b[l])
        x = x + merged @ w_out[l]
        h2 = rmsnorm(x, norm_ffn_g[l])
        x = x + hier_moe(h2, w_router_group[l], b_router_group[l], w_router_expert[l], b_router_expert[l],
                         w_exp_gate[l], w_exp_up[l], w_exp_down[l])
    return rmsnorm(x, final_norm_g)
```

```cpp
#include <hip/hip_runtime.h>
#include <cstdio>
#include <cstdint>

#ifndef LEVEL
#define LEVEL 3
#endif

#define LAS __attribute__((address_space(3)))
#define GAS __attribute__((address_space(1)))
typedef unsigned short bf16_t;
typedef short bf16x8 __attribute__((ext_vector_type(8)));
typedef short s16x4 __attribute__((ext_vector_type(4)));
typedef float f32x2 __attribute__((ext_vector_type(2)));
typedef float f32x4 __attribute__((ext_vector_type(4)));
typedef float f32x16 __attribute__((ext_vector_type(16)));
typedef unsigned u32x2 __attribute__((ext_vector_type(2)));
typedef unsigned u32x4 __attribute__((ext_vector_type(4)));

constexpr int D = 1024, BATCH = 8, SEQ = 8192, T = BATCH * SEQ;
constexpr int IN_COLS = 4608;
constexpr int NEXP = 32, DEXP = 512;
constexpr int LISTCAP = T;
constexpr float EPS = 1e-6f;
constexpr float LOG2E = 1.4426950408889634f;
constexpr float C2 = 0.125f * LOG2E;
constexpr int NWAVES = 8, NTHREADS = 512;

constexpr size_t MiB = 1u << 20;
constexpr size_t WS_CTL = 0, CTL_ZERO_BYTES = 1 * MiB;
constexpr size_t WS_WIN = 2 * MiB;
constexpr size_t WS_WBR = 12 * MiB;
constexpr size_t WS_WO = 14 * MiB;
constexpr size_t WS_W13 = 16 * MiB;
constexpr size_t WS_W2 = 80 * MiB;
constexpr size_t WS_CS = 113 * MiB;
constexpr size_t WS_SSQ = 117 * MiB;
constexpr size_t WS_RSTD = 121 * MiB;
constexpr size_t WS_WTS = 122 * MiB;
constexpr size_t WS_LIST = 123 * MiB;
constexpr size_t WS_PARK = 131 * MiB;
constexpr size_t WS_RA = 164 * MiB;
constexpr size_t WS_RB = 292 * MiB;
constexpr size_t WS_RC = 420 * MiB;
constexpr size_t WS_RD = 548 * MiB;
constexpr size_t WS_RE = 612 * MiB;
constexpr size_t WS_END = 868 * MiB;
constexpr int CW_TMO = 0;
constexpr int CW_BAR = 4096;
constexpr int CW_CNT = 8192;

constexpr int RING_BYTES = 147456;
constexpr int LDSCTL_OFF = RING_BYTES;
constexpr int LDS_BYTES = RING_BYTES + 1024;

#define RLX_AGENT __ATOMIC_RELAXED, __HIP_MEMORY_SCOPE_AGENT
#define LDS_WAIT() asm volatile("s_waitcnt lgkmcnt(0)" ::: "memory")
#define VM_WAIT() asm volatile("s_waitcnt vmcnt(0)" ::: "memory")

__device__ __forceinline__ unsigned cvt_pk_bf16(float lo, float hi) { unsigned r; asm volatile("v_cvt_pk_bf16_f32 %0, %1, %2" : "=v"(r) : "v"(lo), "v"(hi)); return r; }
__device__ __forceinline__ float bf_lo(unsigned w) { return __uint_as_float(w << 16); }
__device__ __forceinline__ float bf_hi(unsigned w) { return __uint_as_float(w & 0xffff0000u); }
__device__ __forceinline__ float fast_exp2(float x) { return __builtin_amdgcn_exp2f(x); }
__device__ __forceinline__ float fast_rcp(float x) { return __builtin_amdgcn_rcpf(x); }
__device__ __forceinline__ float sigmoidf_(float x) { return fast_rcp(1.0f + fast_exp2(-LOG2E * x)); }
__device__ __forceinline__ float gelu_tanh(float x) {
    const float u = x * (0.7978845608028654f + 0.0356774081363001f * x * x);
    return x * fast_rcp(1.0f + fast_exp2(-2.0f * LOG2E * u));
}
__device__ __forceinline__ float wave_sum(float v) {
#pragma unroll
    for (int o = 1; o < 64; o <<= 1) v += __shfl_xor(v, o);
    return v;
}

namespace pg8 {
constexpr int BM = 256, BK = 64, HALF = 128, HTB = HALF * BK * 2, STAGE_BYTES = 8 * HTB, NXCD = 8, WGM = 8;
__host__ __device__ __forceinline__ int lds_byte(int r, int c) { const int st = (r >> 4) * 2 + (c >> 5), rr = r & 15, cc = c & 31, ob = rr * 64 + cc * 2; return st * 1024 + (ob ^ (((ob >> 9) & 1) << 5)); }
__host__ __device__ __forceinline__ void stage_rc(int b, int& R, int& C) { const int st = b / 1024, sb = b % 1024, swz = sb ^ (((sb >> 9) & 1) << 5); R = (st >> 1) * 16 + swz / 64; C = (st & 1) * 32 + (swz % 64) / 2; }
__host__ __device__ __forceinline__ int perm32(int rho) { const int n = rho >> 4, i = rho & 15; return 8 * (i >> 2) + 4 * n + (i & 3); }

struct Unit { int pm, pn, e, lbase, nv; };

struct DenseProb {
    const char* A; const char* Bt; int K; int nM, nN, nwg, G, c;
    __device__ __forceinline__ void init(const void* A_, const void* Bt_, int M, int N, int K_, int G_, int c_) { A = (const char*)A_; Bt = (const char*)Bt_; K = K_; nM = M / BM; nN = N / BM; nwg = nM * nN; G = G_; c = c_; }
    __device__ __forceinline__ bool next(int i, Unit& u) const {
        const long L = (long)i * G + c; if (L >= nwg) return false;
        int wgid = (int)L; { const int q = nwg / NXCD, r = nwg % NXCD, xcd = wgid % NXCD, off = wgid / NXCD; wgid = (xcd < r ? xcd * (q + 1) : r * (q + 1) + (xcd - r) * q) + off; }
        const int nig = WGM * nN, gid = wgid / nig, fm = gid * WGM, gsz = (nM - fm) < WGM ? (nM - fm) : WGM;
        u.pm = fm + ((wgid % nig) % gsz); u.pn = (wgid % nig) / gsz; u.e = 0; u.lbase = 0; u.nv = 256; return true;
    }
    __device__ __forceinline__ void a_offs(const Unit& u, const int (&R)[2], const int (&C)[2], unsigned (&o)[2][2]) const {
#pragma unroll
        for (int h = 0; h < 2; ++h)
#pragma unroll
            for (int i = 0; i < 2; ++i) o[h][i] = (unsigned)((u.pm * BM + h * HALF + R[i]) * K + C[i]) * 2u;
    }
    __device__ __forceinline__ const char* b_tile(const Unit& u) const { return Bt + (size_t)u.pn * BM * K * 2; }
};

struct MoeOrder {
    const LAS int* bstart; const LAS int* cnt; int nblk, nwg, G, c;
    __device__ __forceinline__ void init(const LAS int* bs, const LAS int* cn, int G_, int c_) { bstart = bs; cnt = cn; nblk = bs[NEXP]; nwg = nblk * 4; G = G_; c = c_; }
    __device__ __forceinline__ bool next(int i, Unit& u) const {
        const long L = (long)i * G + c; if (L >= nwg) return false;
        int wgid = (int)L; { const int q = nwg / NXCD, r = nwg % NXCD, xcd = wgid % NXCD, off = wgid / NXCD; wgid = (xcd < r ? xcd * (q + 1) : r * (q + 1) + (xcd - r) * q) + off; }
        const int gid = wgid / 32, fm = gid * 8, gsz = (nblk - fm) < 8 ? (nblk - fm) : 8, w = wgid - gid * 32;
        const int blk = fm + (w % gsz); u.pn = w / gsz; u.pm = blk;
        int e = 0;
        while (e < NEXP - 1 && blk >= bstart[e + 1]) ++e;
        const int rb = blk - bstart[e]; u.e = e; u.lbase = e * LISTCAP + rb * 256; const int rem = cnt[e] - rb * 256; u.nv = rem < 256 ? rem : 256; return true;
    }
};
struct MoeUpProb : MoeOrder {
    const char* A; const char* Bt; int K; const int* list;
    __device__ __forceinline__ void a_offs(const Unit& u, const int (&R)[2], const int (&C)[2], unsigned (&o)[2][2]) const {
#pragma unroll
        for (int h = 0; h < 2; ++h)
#pragma unroll
            for (int i = 0; i < 2; ++i) { const int r = h * HALF + R[i]; const int tok = (r < u.nv) ? (list[u.lbase + r] >> 1) : 0; o[h][i] = (unsigned)(tok * K + C[i]) * 2u; }
    }
    __device__ __forceinline__ const char* b_tile(const Unit& u) const { return Bt + ((size_t)u.e * 1024 + (size_t)u.pn * BM) * K * 2; }
};
struct MoeDownProb : MoeOrder {
    const char* A; const char* Bt; int K;
    __device__ __forceinline__ void a_offs(const Unit& u, const int (&R)[2], const int (&C)[2], unsigned (&o)[2][2]) const {
#pragma unroll
        for (int h = 0; h < 2; ++h)
#pragma unroll
            for (int i = 0; i < 2; ++i) o[h][i] = (unsigned)((u.pm * BM + h * HALF + R[i]) * K + C[i]) * 2u;
    }
    __device__ __forceinline__ const char* b_tile(const Unit& u) const { return Bt + ((size_t)u.e * 1024 + (size_t)u.pn * BM) * K * 2; }
};

struct NoHook { static constexpr int AT = -1; __device__ __forceinline__ void operator()(f32x4 (&)[2][2][4][2], const Unit&, int, int, int, int) const {} };

template <class Prob, class Epi, class Hook>
__device__ __forceinline__ void gemm_core(LAS unsigned char* lds, const Prob& P, const Epi& E, const Hook& HK) {
    const int tid = threadIdx.x, wid = __builtin_amdgcn_readfirstlane(tid >> 6), lane = tid & 63, wr = wid >> 2, wc = wid & 3, fr = lane & 15, fq = lane >> 4;
    const int K = P.K, nt = K / BK;
    int R[2], C[2]; unsigned voffB[2];
#pragma unroll
    for (int i = 0; i < 2; ++i) { stage_rc(tid * 16 + i * 8192, R[i], C[i]); const int Rb = (R[i] & ~31) + perm32(R[i] & 31); voffB[i] = (unsigned)(Rb * K + C[i]) * 2u; }
    const size_t kstep = (size_t)(BK * 2);
    const size_t hstep = (size_t)HALF * K * 2;
    const unsigned ldsw = (unsigned)wid * 1024u;
    const int aoff = lds_byte(wr * 64 + fr, fq * 8), boff = lds_byte(wc * 32 + fr, fq * 8);
#define PG8_SA(b, h) (((b) * 2 + (h)) * HTB)
#define PG8_SB(b, h) ((4 + (b) * 2 + (h)) * HTB)
#define PG8_STAGE_B(bufoff, gbase) do { _Pragma("unroll") for (int _i = 0; _i < 2; ++_i) \
        __builtin_amdgcn_global_load_lds((const unsigned*)((const char*)(gbase) + voffB[_i]), (LAS unsigned*)(lds + (bufoff) + ldsw + _i * 8192), 16, 0, 0); } while (0)
#define PG8_STAGE_A(bufoff, kb, va) do { _Pragma("unroll") for (int _i = 0; _i < 2; ++_i) \
        __builtin_amdgcn_global_load_lds((const unsigned*)(P.A + (kb) + (va)[_i]), (LAS unsigned*)(lds + (bufoff) + ldsw + _i * 8192), 16, 0, 0); } while (0)
#define PG8_LDA(dst, b, h) do { _Pragma("unroll") for (int m = 0; m < 4; ++m) _Pragma("unroll") for (int k = 0; k < 2; ++k) dst[m][k] = *(const LAS bf16x8*)(lds + PG8_SA(b, h) + aoff + m * 2048 + k * 1024); } while (0)
#define PG8_LDB(dst, b, h) do { _Pragma("unroll") for (int n = 0; n < 2; ++n) _Pragma("unroll") for (int k = 0; k < 2; ++k) dst[n][k] = *(const LAS bf16x8*)(lds + PG8_SB(b, h) + boff + n * 2048 + k * 1024); } while (0)
#define PG8_MMA(ai, bj, At, Bt) do { __builtin_amdgcn_s_setprio(1); _Pragma("unroll") for (int m = 0; m < 4; ++m) _Pragma("unroll") for (int n = 0; n < 2; ++n) _Pragma("unroll") for (int k = 0; k < 2; ++k) \
        acc[ai][bj][m][n] = __builtin_amdgcn_mfma_f32_16x16x32_bf16(Bt[n][k], At[m][k], acc[ai][bj][m][n], 0, 0, 0); __builtin_amdgcn_s_setprio(0); } while (0)
#define PG8_WAIT_V(n) asm volatile("s_waitcnt vmcnt(" #n ")" ::: "memory")
#define PG8_WAIT_L(n) asm volatile("s_waitcnt lgkmcnt(" #n ")" ::: "memory")
#define PG8_BAR __builtin_amdgcn_s_barrier()
#define PG8_SCHED __builtin_amdgcn_sched_barrier(0)
    Unit cur, nxt; int ui = 0;
    if (!P.next(0, cur)) return;
    f32x4 acc[2][2][4][2];
#pragma unroll
    for (int a = 0; a < 2; ++a)
#pragma unroll
        for (int b = 0; b < 2; ++b)
#pragma unroll
            for (int m = 0; m < 4; ++m)
#pragma unroll
                for (int n = 0; n < 2; ++n) acc[a][b][m][n] = (f32x4){0.f, 0.f, 0.f, 0.f};
    bf16x8 At[4][2], B0[2][2], B1[2][2];
    unsigned cvA[2][2], nvA[2][2];
    P.a_offs(cur, R, C, cvA);
    const char* cB = P.b_tile(cur);
    PG8_STAGE_B(PG8_SB(0, 0), cB); PG8_STAGE_B(PG8_SB(0, 1), cB + hstep); PG8_STAGE_A(PG8_SA(0, 0), 0, cvA[0]); PG8_STAGE_A(PG8_SA(0, 1), 0, cvA[1]);
    if (wr == 1) PG8_BAR;
    PG8_WAIT_V(2); PG8_BAR;
    PG8_STAGE_B(PG8_SB(1, 0), cB + kstep); PG8_STAGE_A(PG8_SA(1, 0), kstep, cvA[0]); PG8_STAGE_B(PG8_SB(1, 1), cB + hstep + kstep);
    PG8_WAIT_V(6); PG8_BAR;
    for (;;) {
        const bool has_next = P.next(ui + 1, nxt);
        if (has_next) P.a_offs(nxt, R, C, nvA);
        else {
#pragma unroll
            for (int h = 0; h < 2; ++h)
#pragma unroll
                for (int i = 0; i < 2; ++i) nvA[h][i] = cvA[h][i];
        }
        const char* nB = has_next ? P.b_tile(nxt) : cB;
        for (int t = 0; t < nt; t += 2) {
            if (Hook::AT >= 0 && t == Hook::AT) HK(acc, cur, wr, wc, fr, fq);
            const bool last = (t == nt - 2);
            const size_t k1 = (size_t)(t + 1) * kstep;
            const size_t k2 = last ? 0 : (size_t)(t + 2) * kstep, k3 = k2 + kstep;
            const char* b2 = last ? nB : cB + (size_t)(t + 2) * kstep; const char* b3 = b2 + kstep;
            unsigned v2[2][2];
#pragma unroll
            for (int h = 0; h < 2; ++h)
#pragma unroll
                for (int i = 0; i < 2; ++i) v2[h][i] = last ? nvA[h][i] : cvA[h][i];
            PG8_LDB(B0, 0, 0); PG8_LDB(B1, 0, 1); PG8_SCHED; PG8_LDA(At, 0, 0); PG8_STAGE_A(PG8_SA(1, 1), k1, cvA[1]);
            PG8_WAIT_V(8); PG8_WAIT_L(0); PG8_BAR; PG8_MMA(0, 0, At, B0); PG8_MMA(0, 1, At, B1); PG8_BAR; PG8_SCHED;
            PG8_LDA(At, 0, 1); PG8_STAGE_B(PG8_SB(0, 0), b2); PG8_STAGE_B(PG8_SB(0, 1), b2 + hstep); PG8_STAGE_A(PG8_SA(0, 0), k2, v2[0]);
            PG8_WAIT_V(8); PG8_WAIT_L(0); PG8_BAR; PG8_MMA(1, 0, At, B0); PG8_MMA(1, 1, At, B1); PG8_BAR; PG8_SCHED;
            PG8_LDB(B0, 1, 0); PG8_LDB(B1, 1, 1); PG8_SCHED; PG8_LDA(At, 1, 0); PG8_STAGE_A(PG8_SA(0, 1), k2, v2[1]);
            PG8_WAIT_V(8); PG8_WAIT_L(0); PG8_BAR; PG8_MMA(0, 0, At, B0); PG8_MMA(0, 1, At, B1); PG8_BAR; PG8_SCHED;
            PG8_LDA(At, 1, 1); PG8_STAGE_B(PG8_SB(1, 0), b3); PG8_STAGE_B(PG8_SB(1, 1), b3 + hstep); PG8_STAGE_A(PG8_SA(1, 0), k3, v2[0]);
            PG8_WAIT_V(8); PG8_WAIT_L(0); PG8_BAR; PG8_MMA(1, 0, At, B0); PG8_MMA(1, 1, At, B1); PG8_BAR; PG8_SCHED;
        }
        if (wr == 0) PG8_BAR;
        E(acc, cur, wr, wc, fr, fq);
        if (!has_next) break;
#pragma unroll
        for (int a = 0; a < 2; ++a)
#pragma unroll
            for (int b = 0; b < 2; ++b)
#pragma unroll
                for (int m = 0; m < 4; ++m)
#pragma unroll
                    for (int n = 0; n < 2; ++n) acc[a][b][m][n] = (f32x4){0.f, 0.f, 0.f, 0.f};
        cur = nxt; cB = nB; ++ui;
#pragma unroll
        for (int h = 0; h < 2; ++h)
#pragma unroll
            for (int i = 0; i < 2; ++i) cvA[h][i] = nvA[h][i];
        if (wr == 1) PG8_BAR;
    }
    PG8_WAIT_V(0);
    PG8_BAR;
#undef PG8_SA
#undef PG8_SB
#undef PG8_STAGE_A
#undef PG8_STAGE_B
#undef PG8_LDA
#undef PG8_LDB
#undef PG8_MMA
#undef PG8_WAIT_V
#undef PG8_WAIT_L
#undef PG8_BAR
#undef PG8_SCHED
}

__device__ __forceinline__ u32x4 pack8(const f32x4& v0, const f32x4& v1) { u32x4 w; w.x = cvt_pk_bf16(v0[0], v0[1]); w.y = cvt_pk_bf16(v0[2], v0[3]); w.z = cvt_pk_bf16(v1[0], v1[1]); w.w = cvt_pk_bf16(v1[2], v1[3]); return w; }

struct EpiInProj {
    bf16_t *UV, *Q, *Kb, *Vb, *G; const float* cs;
    __device__ __forceinline__ void operator()(f32x4 (&acc)[2][2][4][2], const Unit& u, int wr, int wc, int fr, int fq) const {
        const int pn = u.pn, cl0 = wc * 32 + 8 * fq; int row0 = u.pm * BM + wr * 64 + fr; asm volatile("" : "+v"(row0));
        if (pn < 4) {
#pragma unroll
            for (int ai = 0; ai < 2; ++ai)
#pragma unroll
                for (int m = 0; m < 4; ++m) { bf16_t* rowp = UV + (size_t)(row0 + ai * HALF + m * 16) * 1024 + pn * 256 + cl0;
#pragma unroll
                    for (int bj = 0; bj < 2; ++bj) { f32x4 v0 = acc[ai][bj][m][0], v1 = acc[ai][bj][m][1];
#pragma unroll
                        for (int e = 0; e < 4; ++e) { v0[e] = gelu_tanh(v0[e]); v1[e] = gelu_tanh(v1[e]); }
                        *(u32x4*)(rowp + bj * HALF) = pack8(v0, v1); } }
        } else if (pn < 8) {
            bf16_t* dst = (pn < 6) ? Q : Kb; const float sc = (pn < 6) ? C2 : 1.0f; const int colb = (pn & 1) * 256 + cl0;
            const bool rot_wave = (wc & 1) == 0;
            const float sgn = (fq == 0) ? -1.0f : 1.0f; const bool rot_lane = fq < 2;
#pragma unroll
            for (int ai = 0; ai < 2; ++ai)
#pragma unroll
                for (int m = 0; m < 4; ++m) { const int row = row0 + ai * HALF + m * 16; bf16_t* rowp = dst + (size_t)row * 512 + colb;
                    f32x4 c0 = (f32x4){1.f, 1.f, 1.f, 1.f}, c1 = c0, s0 = (f32x4){0.f, 0.f, 0.f, 0.f}, s1 = s0;
                    if (rot_wave) { const f32x4* cp = (const f32x4*)(cs + (size_t)row * 16); c0 = cp[0]; c1 = cp[1]; s0 = cp[2]; s1 = cp[3]; }
#pragma unroll
                    for (int bj = 0; bj < 2; ++bj) { f32x4 v0 = acc[ai][bj][m][0], v1 = acc[ai][bj][m][1];
                        if (rot_wave) {
                            f32x4 p0, p1;
#pragma unroll
                            for (int e = 0; e < 4; ++e) { p0[e] = __shfl_xor(v0[e], 16); p1[e] = __shfl_xor(v1[e], 16); }
                            if (rot_lane) {
#pragma unroll
                                for (int e = 0; e < 4; ++e) { v0[e] = v0[e] * c0[e] + sgn * p0[e] * s0[e]; v1[e] = v1[e] * c1[e] + sgn * p1[e] * s1[e]; }
                            }
                        }
                        v0 = v0 * sc; v1 = v1 * sc;
                        *(u32x4*)(rowp + bj * HALF) = pack8(v0, v1); } }
        } else if (pn < 10) {
#pragma unroll
            for (int ai = 0; ai < 2; ++ai)
#pragma unroll
                for (int m = 0; m < 4; ++m) { bf16_t* rowp = Vb + (size_t)(row0 + ai * HALF + m * 16) * 512 + (pn - 8) * 256 + cl0;
#pragma unroll
                    for (int bj = 0; bj < 2; ++bj) *(u32x4*)(rowp + bj * HALF) = pack8(acc[ai][bj][m][0], acc[ai][bj][m][1]); }
        } else {
#pragma unroll
            for (int ai = 0; ai < 2; ++ai)
#pragma unroll
                for (int m = 0; m < 4; ++m) { bf16_t* rowp = G + (size_t)(row0 + ai * HALF + m * 16) * 2048 + (pn - 10) * 256 + cl0;
#pragma unroll
                    for (int bj = 0; bj < 2; ++bj) { f32x4 v0 = acc[ai][bj][m][0], v1 = acc[ai][bj][m][1];
#pragma unroll
                        for (int e = 0; e < 4; ++e) { v0[e] = sigmoidf_(v0[e]); v1[e] = sigmoidf_(v1[e]); }
                        *(u32x4*)(rowp + bj * HALF) = pack8(v0, v1); } }
        }
    }
};

__device__ __forceinline__ void unpack8(const u32x4& w, f32x4& a, f32x4& b) { a = (f32x4){bf_lo(w.x), bf_hi(w.x), bf_lo(w.y), bf_hi(w.y)}; b = (f32x4){bf_lo(w.z), bf_hi(w.z), bf_lo(w.w), bf_hi(w.w)}; }
struct HookMerge {
    static constexpr int AT = 8;
    const bf16_t* G;
    __device__ __forceinline__ void operator()(f32x4 (&acc)[2][2][4][2], const Unit& u, int wr, int wc, int fr, int fq) const {
        const int col0 = u.pn * BM + wc * 32 + 8 * fq; int row0 = u.pm * BM + wr * 64 + fr; asm volatile("" : "+v"(row0));
#pragma unroll
        for (int ai = 0; ai < 2; ++ai)
#pragma unroll
            for (int m = 0; m < 4; ++m) { const bf16_t* gp = G + (size_t)(row0 + ai * HALF + m * 16) * 2048 + col0;
#pragma unroll
                for (int bj = 0; bj < 2; ++bj) { const u32x4 w0 = *(const u32x4*)(gp + bj * HALF), w1 = *(const u32x4*)(gp + 1024 + bj * HALF);
                    f32x4 a0, a1, b0, b1; unpack8(w0, a0, a1); unpack8(w1, b0, b1);
#pragma unroll
                    for (int e = 0; e < 4; ++e) { acc[ai][bj][m][0][e] *= a0[e] * fast_rcp(fmaxf(b0[e], 1e-30f)); acc[ai][bj][m][1][e] *= a1[e] * fast_rcp(fmaxf(b1[e], 1e-30f)); } }
                asm volatile("" : "+v"(acc[ai][0][m][0]), "+v"(acc[ai][0][m][1]), "+v"(acc[ai][1][m][0]), "+v"(acc[ai][1][m][1]));
                asm volatile("" ::: "memory"); }
    }
};
struct EpiMerge {
    const bf16_t* G; bf16_t* MG;
    __device__ __forceinline__ void operator()(f32x4 (&acc)[2][2][4][2], const Unit& u, int wr, int wc, int fr, int fq) const {
        const int col0 = u.pn * BM + wc * 32 + 8 * fq; int row0 = u.pm * BM + wr * 64 + fr; asm volatile("" : "+v"(row0));
#pragma unroll
        for (int ai = 0; ai < 2; ++ai)
#pragma unroll
            for (int m = 0; m < 4; ++m) { const size_t row = (size_t)(row0 + ai * HALF + m * 16); const bf16_t* gp = G + row * 2048 + 1024 + col0; bf16_t* op = MG + row * 1024 + col0;
#pragma unroll
                for (int bj = 0; bj < 2; ++bj) { const u32x4 w1 = *(const u32x4*)(gp + bj * HALF); f32x4 b0, b1; unpack8(w1, b0, b1);
                    *(u32x4*)(op + bj * HALF) = pack8(acc[ai][bj][m][0] * b0, acc[ai][bj][m][1] * b1); } }
    }
};

struct EpiX1 {
    const float* X; float* X1; bf16_t* XB; float* ssq;
    __device__ __forceinline__ void operator()(f32x4 (&acc)[2][2][4][2], const Unit& u, int wr, int wc, int fr, int fq) const {
        const int col0 = u.pn * BM + wc * 32 + 8 * fq; int row0 = u.pm * BM + wr * 64 + fr; asm volatile("" : "+v"(row0));
#pragma unroll
        for (int ai = 0; ai < 2; ++ai)
#pragma unroll
            for (int m = 0; m < 4; ++m) { const size_t row = (size_t)(row0 + ai * HALF + m * 16); const float* xp = X + row * 1024 + col0; float* op = X1 + row * 1024 + col0; bf16_t* bp = XB + row * 1024 + col0;
                float s = 0.f;
#pragma unroll
                for (int bj = 0; bj < 2; ++bj) { const f32x4 x0 = *(const f32x4*)(xp + bj * HALF), x1 = *(const f32x4*)(xp + bj * HALF + 4);
                    const f32x4 v0 = acc[ai][bj][m][0] + x0, v1 = acc[ai][bj][m][1] + x1;
                    *(f32x4*)(op + bj * HALF) = v0; *(f32x4*)(op + bj * HALF + 4) = v1; *(u32x4*)(bp + bj * HALF) = pack8(v0, v1);
                    s += (v0[0] * v0[0] + v0[1] * v0[1]) + (v0[2] * v0[2] + v0[3] * v0[3]) + (v1[0] * v1[0] + v1[1] * v1[1]) + (v1[2] * v1[2] + v1[3] * v1[3]); }
                s += __shfl_xor(s, 16); s += __shfl_xor(s, 32);
                if (fq == 0) ssq[row * 16 + u.pn * 4 + wc] = s; }
    }
};

struct EpiMoeUp {
    const int* list; const float* rstd; bf16_t* H;
    __device__ __forceinline__ void operator()(f32x4 (&acc)[2][2][4][2], const Unit& u, int wr, int wc, int fr, int fq) const {
        const int col0 = u.pn * 128 + wc * 32 + 8 * fq; int r0 = wr * 64 + fr; asm volatile("" : "+v"(r0));
#pragma unroll
        for (int ai = 0; ai < 2; ++ai)
#pragma unroll
            for (int m = 0; m < 4; ++m) { const int r = r0 + ai * HALF + m * 16; const int tok = (r < u.nv) ? (list[u.lbase + r] >> 1) : 0; const float rs = rstd[tok];
                f32x4 g0 = acc[ai][0][m][0] * rs, g1 = acc[ai][0][m][1] * rs, u0 = acc[ai][1][m][0] * rs, u1 = acc[ai][1][m][1] * rs;
#pragma unroll
                for (int e = 0; e < 4; ++e) { g0[e] = g0[e] * sigmoidf_(g0[e]) * u0[e]; g1[e] = g1[e] * sigmoidf_(g1[e]) * u1[e]; }
                *(u32x4*)(H + (size_t)(u.pm * BM + r) * 512 + col0) = pack8(g0, g1); }
    }
};
struct EpiMoeDown {
    const int* list; const float* wts; bf16_t* YB;
    __device__ __forceinline__ void operator()(f32x4 (&acc)[2][2][4][2], const Unit& u, int wr, int wc, int fr, int fq) const {
        const int col0 = u.pn * BM + wc * 32 + 8 * fq; int r0 = wr * 64 + fr; asm volatile("" : "+v"(r0));
#pragma unroll
        for (int ai = 0; ai < 2; ++ai)
#pragma unroll
            for (int m = 0; m < 4; ++m) { const int r = r0 + ai * HALF + m * 16;
                if (r < u.nv) { const int dest = list[u.lbase + r]; const float w = wts[dest]; bf16_t* op = YB + (size_t)dest * 1024 + col0;
#pragma unroll
                    for (int bj = 0; bj < 2; ++bj) *(u32x4*)(op + bj * HALF) = pack8(acc[ai][bj][m][0] * w, acc[ai][bj][m][1] * w); } }
    }
};
}

namespace att {
constexpr int QB = 256, KVB = 64, QP = 512  ;
constexpr int KSLOT = 8192, VSLOT = 16384, NS = 3;
constexpr int L_K = 0, L_V = NS * KSLOT, L_WS = L_V + NS * VSLOT, L_OST = L_WS + NWAVES * 256, L_END = L_OST + NWAVES * 8192;
static_assert(L_END <= RING_BYTES, "attention LDS");
constexpr int THR = 8;
__device__ __forceinline__ int crow(int r, int hi) { return (r & 3) + 8 * (r >> 2) + 4 * hi; }
__device__ __forceinline__ void glds16(const void* gsrc, unsigned lds_dst) { unsigned keep;
    asm volatile("s_mov_b32 %0, m0\n\ts_mov_b32 m0, %2\n\ts_nop 0\n\tglobal_load_lds_dwordx4 %1, off\n\ts_mov_b32 m0, %0" : "=&s"(keep) : "v"(gsrc), "s"(lds_dst) : "memory"); }
#define ATT_WAIT_BAR(N) asm volatile("s_waitcnt vmcnt(" #N ") lgkmcnt(0)\n\ts_barrier" ::: "memory")
#define MX3(a, b, c) __builtin_fmaxf(__builtin_fmaxf((a), (b)), (c))
__device__ __forceinline__ float rowmax(const f32x16& p0, const f32x16& p1) {
    float a = MX3(p0[0], p0[1], p1[0]), b = MX3(p0[2], p0[3], p1[1]); a = MX3(a, p1[2], p1[3]);
#pragma unroll
    for (int r = 4; r < 16; r += 4) { a = MX3(a, p0[r], p0[r + 1]); b = MX3(b, p0[r + 2], p0[r + 3]); a = MX3(a, p1[r], p1[r + 1]); b = MX3(b, p1[r + 2], p1[r + 3]); }
    const float m = __builtin_fmaxf(a, b); auto rr = __builtin_amdgcn_permlane32_swap(__float_as_uint(m), __float_as_uint(m), false, false);
    return __builtin_fmaxf(__uint_as_float(rr[0]), __uint_as_float(rr[1])); }
__device__ __forceinline__ void cmask(f32x16& p0, f32x16& p1, int jb, int qrel, int hi) {
    const int kb = 64 * jb + 4 * hi;
#pragma unroll
    for (int r = 0; r < 16; ++r) { const int kv = kb + (r & 3) + 8 * (r >> 2); if (kv > qrel) p0[r] = -INFINITY; if (kv + 32 > qrel) p1[r] = -INFINITY; } }
__device__ __forceinline__ void qkt(f32x16& p0, f32x16& p1, const LAS char* Kslot, const bf16x8* qr, const f32x16& negm, int r32, int hi) {
    const LAS char* kb = Kslot + hi * 1024 + r32 * 16;
#pragma unroll
    for (int d0 = 0; d0 < 4; ++d0) {
        const bf16x8 b0 = *(const LAS bf16x8*)(kb + d0 * 2048);
        const bf16x8 b1 = *(const LAS bf16x8*)(kb + d0 * 2048 + 512);
        if (d0 == 0) { p0 = __builtin_amdgcn_mfma_f32_32x32x16_bf16(b0, qr[0], negm, 0, 0, 0); p1 = __builtin_amdgcn_mfma_f32_32x32x16_bf16(b1, qr[0], negm, 0, 0, 0); }
        else { p0 = __builtin_amdgcn_mfma_f32_32x32x16_bf16(b0, qr[d0], p0, 0, 0, 0); p1 = __builtin_amdgcn_mfma_f32_32x32x16_bf16(b1, qr[d0], p1, 0, 0, 0); } }
}
__device__ __forceinline__ void pv(f32x16* o, int vb, bf16x8 pa0, bf16x8 pa1, bf16x8 pa2, bf16x8 pa3) {
#pragma unroll
    for (int d0 = 0; d0 < 4; ++d0) { s16x4 lo[4], hi[4];
#pragma unroll
        for (int ks = 0; ks < 4; ++ks) {
            asm volatile("ds_read_b64_tr_b16 %0,%1 offset:%c2" : "=&v"(lo[ks]) : "v"(vb), "i"(d0 * 4096 + ks * 1024) : "memory");
            asm volatile("ds_read_b64_tr_b16 %0,%1 offset:%c2" : "=&v"(hi[ks]) : "v"(vb), "i"(d0 * 4096 + ks * 1024 + 512) : "memory"); }
        asm volatile("s_waitcnt lgkmcnt(0)" ::: "memory"); __builtin_amdgcn_sched_barrier(0);
#define PK(k) (bf16x8){lo[k][0], lo[k][1], lo[k][2], lo[k][3], hi[k][0], hi[k][1], hi[k][2], hi[k][3]}
        o[d0] = __builtin_amdgcn_mfma_f32_32x32x16_bf16(pa0, PK(0), o[d0], 0, 0, 0);
        o[d0] = __builtin_amdgcn_mfma_f32_32x32x16_bf16(pa1, PK(1), o[d0], 0, 0, 0);
        o[d0] = __builtin_amdgcn_mfma_f32_32x32x16_bf16(pa2, PK(2), o[d0], 0, 0, 0);
        o[d0] = __builtin_amdgcn_mfma_f32_32x32x16_bf16(pa3, PK(3), o[d0], 0, 0, 0);
#undef PK
    }
}
__device__ __forceinline__ void attn_pass(f32x16 (&o)[4], int b, int hm, int h, int qb, const bf16_t* Q, const bf16_t* __restrict__ K, const bf16_t* __restrict__ V, LAS char* shm) {
    const int tid = threadIdx.x, lane = tid & 63, r32 = lane & 31, hi = lane >> 5; const int wid = __builtin_amdgcn_readfirstlane(tid >> 6);
    const long rowbase = (long)b * SEQ; const int q0 = qb * QB, NT = (q0 + QB) / KVB;
    const bf16_t* Qw = Q + (rowbase + q0 + wid * 32) * QP + hm * 64;
    const bf16_t* Kh = K + rowbase * QP + hm * 64; const bf16_t* Vh = V + rowbase * QP + h * 128;
    const unsigned lds0 = (unsigned)(uintptr_t)shm;
    LAS float* wsf = (LAS float*)(shm + L_WS) + wid * 64;
    const bf16_t* ksrc = Kh + (long)lane * QP + wid * 8;
    const bf16_t* vsrc0 = Vh + (long)(16 * (wid & 3) + (lane >> 2)) * QP + (wid >> 2) * 32 + (lane & 3) * 8;
    const bf16_t* vsrc1 = vsrc0 + 64;
    const unsigned kdst = lds0 + L_K + wid * 1024, vdst0 = lds0 + L_V + wid * 1024, vdst1 = vdst0 + 8192;
#define ATT_DMA(t, s) do { const long go_ = (long)(t) * KVB * QP; const unsigned s_ = (unsigned)(s); \
        glds16(ksrc + go_, (unsigned)__builtin_amdgcn_readfirstlane(kdst + s_ * KSLOT)); \
        glds16(vsrc0 + go_, (unsigned)__builtin_amdgcn_readfirstlane(vdst0 + s_ * VSLOT)); \
        glds16(vsrc1 + go_, (unsigned)__builtin_amdgcn_readfirstlane(vdst1 + s_ * VSLOT)); } while (0)
    const int vb0 = (int)(lds0 + L_V) + ((lane >> 4) & 1) * 32 + (lane & 3) * 8 + (4 * hi + ((lane & 15) >> 2)) * 64;
    ATT_DMA(0, 0);
    if (NT > 1) ATT_DMA(1, 1);
    bf16x8 qr[4];
#pragma unroll
    for (int d0 = 0; d0 < 4; ++d0) qr[d0] = *(const bf16x8*)(Qw + (long)r32 * QP + d0 * 16 + hi * 8);
    float mhat = 0.f, l_reg = 0.f;
#pragma unroll
    for (int d0 = 0; d0 < 4; ++d0) o[d0] = f32x16{};
    f32x16 negm = f32x16{};
    const int qrel = wid * 32 + r32;
    asm volatile("" : "+v"(qr[0]), "+v"(qr[1]), "+v"(qr[2]), "+v"(qr[3]));
    asm volatile("s_waitcnt vmcnt(0) lgkmcnt(0)\n\ts_barrier" ::: "memory");
    int slot = 0;
    for (int t = 0; t < NT; ++t) {
        if (t + 2 < NT) { const int s2 = (slot == 0) ? 2 : slot - 1; ATT_DMA(t + 2, s2); }
        f32x16 p0, p1;
        qkt(p0, p1, shm + L_K + slot * KSLOT, qr, negm, r32, hi);
        if (t >= NT - 4) cmask(p0, p1, t - (NT - 4), qrel, hi);
        const float rm = rowmax(p0, p1);
        if (__builtin_expect(t == 0 || __any(rm > (float)THR), 0)) {
            const float dl = (t == 0) ? rm : __builtin_fmaxf(rm, 0.f); mhat += dl;
#pragma unroll
            for (int r = 0; r < 16; ++r) { asm volatile("v_sub_f32 %0, %0, %1" : "+v"(p0[r]) : "v"(dl)); asm volatile("v_sub_f32 %0, %0, %1" : "+v"(p1[r]) : "v"(dl)); }
#pragma unroll
            for (int r = 0; r < 16; ++r) negm[r] = -mhat;
            const float f = (t == 0) ? 1.0f : fast_exp2(-dl); l_reg *= f; if (hi == 0) wsf[r32] = f;
            asm volatile("s_waitcnt lgkmcnt(0)" ::: "memory");
#pragma unroll
            for (int r = 0; r < 16; ++r) { const float fr_ = wsf[crow(r, hi)];
#pragma unroll
                for (int d0 = 0; d0 < 4; ++d0) asm volatile("v_mul_f32 %0, %0, %1" : "+v"(o[d0][r]) : "v"(fr_)); }
        }
        float sacc = 0.f;
#pragma unroll
        for (int r = 0; r < 16; ++r) { p0[r] = fast_exp2(p0[r]); p1[r] = fast_exp2(p1[r]); sacc += p0[r] + p1[r]; }
        l_reg += sacc;
        u32x4 pw0, pw1, pw2, pw3;
        pw0 = (u32x4){cvt_pk_bf16(p0[0], p0[1]), cvt_pk_bf16(p0[2], p0[3]), cvt_pk_bf16(p0[4], p0[5]), cvt_pk_bf16(p0[6], p0[7])};
        pw1 = (u32x4){cvt_pk_bf16(p0[8], p0[9]), cvt_pk_bf16(p0[10], p0[11]), cvt_pk_bf16(p0[12], p0[13]), cvt_pk_bf16(p0[14], p0[15])};
        pw2 = (u32x4){cvt_pk_bf16(p1[0], p1[1]), cvt_pk_bf16(p1[2], p1[3]), cvt_pk_bf16(p1[4], p1[5]), cvt_pk_bf16(p1[6], p1[7])};
        pw3 = (u32x4){cvt_pk_bf16(p1[8], p1[9]), cvt_pk_bf16(p1[10], p1[11]), cvt_pk_bf16(p1[12], p1[13]), cvt_pk_bf16(p1[14], p1[15])};
        pv(o, vb0 + slot * VSLOT, __builtin_bit_cast(bf16x8, pw0), __builtin_bit_cast(bf16x8, pw1), __builtin_bit_cast(bf16x8, pw2), __builtin_bit_cast(bf16x8, pw3));
        if (t + 2 < NT) { ATT_WAIT_BAR(3); } else { ATT_WAIT_BAR(0); }
        slot = (slot == 2) ? 0 : slot + 1;
    }
    { auto rr = __builtin_amdgcn_permlane32_swap(__float_as_uint(l_reg), __float_as_uint(l_reg), false, false); l_reg = __uint_as_float(rr[0]) + __uint_as_float(rr[1]); }
    if (hi == 0) wsf[32 + r32] = l_reg;
    asm volatile("s_waitcnt lgkmcnt(0)" ::: "memory");
#pragma unroll
    for (int r = 0; r < 16; ++r) { const float rl = fast_rcp(wsf[32 + crow(r, hi)]);
#pragma unroll
        for (int d0 = 0; d0 < 4; ++d0) o[d0][r] *= rl; }
    asm volatile("s_waitcnt lgkmcnt(0)" ::: "memory");
#undef ATT_DMA
}

__device__ __forceinline__ void attn_unit(int b, int h, int qb, const bf16_t* Q, const bf16_t* K, const bf16_t* V, bf16_t* YAB, float* park, float lam, const float* subg, LAS char* shm) {
    const int tid = threadIdx.x, lane = tid & 63, r32 = lane & 31, hi = lane >> 5; const int wid = __builtin_amdgcn_readfirstlane(tid >> 6);
    for (int m = 0; m < 2; ++m) {
        f32x16 o[4];
        attn_pass(o, b, 2 * h + m, h, qb, Q, K, V, shm);
        int lo_ = lane; asm volatile("" : "+v"(lo_));
        f32x4* pk = (f32x4*)park + (size_t)wid * 1024 + lo_;
        if (m == 0) {
#pragma unroll
            for (int d0 = 0; d0 < 4; ++d0)
#pragma unroll
                for (int j = 0; j < 4; ++j) pk[(d0 * 4 + j) * 64] = (f32x4){o[d0][4 * j], o[d0][4 * j + 1], o[d0][4 * j + 2], o[d0][4 * j + 3]};
        } else {
            float ss[16];
#pragma unroll
            for (int r = 0; r < 16; ++r) ss[r] = 0.f;
#pragma unroll
            for (int d0 = 0; d0 < 4; ++d0)
#pragma unroll
                for (int j = 0; j < 4; ++j) { const f32x4 a = pk[(d0 * 4 + j) * 64];
#pragma unroll
                    for (int e = 0; e < 4; ++e) { const float v = a[e] - lam * o[d0][4 * j + e]; o[d0][4 * j + e] = v; ss[4 * j + e] += v * v; } }
#pragma unroll
            for (int r = 0; r < 16; ++r) { float s = ss[r]; s += __shfl_xor(s, 1); s += __shfl_xor(s, 2); s += __shfl_xor(s, 4); s += __shfl_xor(s, 8); s += __shfl_xor(s, 16); ss[r] = 0.8f / sqrtf(s * (1.0f / 128.0f) + EPS); }
            float gd[4];
#pragma unroll
            for (int d0 = 0; d0 < 4; ++d0) gd[d0] = subg[d0 * 32 + r32];
            LAS bf16_t* stg = (LAS bf16_t*)(shm + L_OST) + wid * 4096;
#pragma unroll
            for (int r = 0; r < 16; ++r) { const int orow = crow(r, hi);
#pragma unroll
                for (int d0 = 0; d0 < 4; ++d0) { const float y = o[d0][r] * ss[r] * gd[d0]; stg[orow * 128 + d0 * 32 + r32] = (bf16_t)(cvt_pk_bf16(y, 0.f) & 0xffffu); } }
            asm volatile("s_waitcnt lgkmcnt(0)" ::: "memory");
            bf16_t* Ow = YAB + ((long)b * SEQ + qb * QB + wid * 32) * 1024 + 512 + h * 128;
#pragma unroll
            for (int i = 0; i < 8; ++i) { const int row = i * 4 + (lo_ >> 4), ch = lo_ & 15; const u32x4 v = *(const LAS u32x4*)(stg + row * 128 + ch * 8); *(u32x4*)(Ow + (long)row * 1024 + ch * 8) = v; }
        }
        asm volatile("s_waitcnt lgkmcnt(0)\n\ts_barrier" ::: "memory");
    }
}
#undef ATT_WAIT_BAR
#undef MX3
}

#define XB_TMO      128
#define XB_XCNT(j)  (256  + 64 * (j))
#define XB_XSUB(j)  (1280 + 64 * (j))
#define XB_XGEN(j)  (2304 + 64 * (j))
#define XB_TOP      3328
#define XB_TOPGEN   3392
#define XCD_BAR_WORDS 3456
#define XB_SPIN_CAP (1u << 18)
__device__ __forceinline__ unsigned xb_ld(unsigned* p)              { return __hip_atomic_load(p, __ATOMIC_RELAXED, __HIP_MEMORY_SCOPE_AGENT); }
__device__ __forceinline__ unsigned xb_add(unsigned* p, unsigned v) { return __hip_atomic_fetch_add(p, v, __ATOMIC_RELAXED, __HIP_MEMORY_SCOPE_AGENT); }
__device__ __forceinline__ unsigned xb_xcc_id() { return (unsigned)__builtin_amdgcn_s_getreg((3 << 11) | 20) & 0xFu; }
#define XB_SPIN(cond, bar) do { unsigned _sp = 0; while (cond) { __builtin_amdgcn_s_sleep(1); \
    if ((++_sp & 255u) == 0u) { if (xb_ld(&(bar)[XB_TMO])) break; if (_sp > XB_SPIN_CAP) { atomicAdd(&(bar)[XB_TMO], 1u); break; } } } } while (0)
struct XcdBarrier { unsigned* bar; unsigned x; volatile LAS unsigned* st; };
__device__ __forceinline__ XcdBarrier xcd_barrier_post(unsigned* bar, volatile LAS unsigned* st) {
    XcdBarrier b; b.bar = bar; b.x = xb_xcc_id(); b.st = st;
    if (threadIdx.x == 0) (void)xb_add(&bar[XB_XCNT(b.x)], 1u);
    return b;
}
__device__ __forceinline__ void xcd_barrier_complete(unsigned* bar, unsigned x, unsigned& nloc, unsigned& nx) {
    const unsigned G = gridDim.x * gridDim.y * gridDim.z;
    unsigned sum, cnt, mine, sp = 0u;
    for (;;) {
        sum = 0u; cnt = 0u; mine = 0u;
#pragma unroll
        for (unsigned j = 0; j < 16; ++j) { const unsigned c = xb_ld(&bar[XB_XCNT(j)]); sum += c; cnt += (c > 0u) ? 1u : 0u; mine = (j == x) ? c : mine; }
        if (sum == G) break;
        __builtin_amdgcn_s_sleep(1);
        if ((++sp & 255u) == 0u) { if (xb_ld(&bar[XB_TMO])) break; if (sp > XB_SPIN_CAP) { atomicAdd(&bar[XB_TMO], 1u); break; } }
    }
    nloc = mine > 0u ? mine : 1u; nx = cnt > 0u ? cnt : 1u;
}
__device__ __forceinline__ void xcd_barrier(const XcdBarrier& b) {
    asm volatile("s_waitcnt vmcnt(0)" ::: "memory");
    __syncthreads();
    if (threadIdx.x == 0) {
        unsigned* bar = b.bar;
        __builtin_amdgcn_s_waitcnt(0);
        unsigned nloc = b.st[0], nx = b.st[1];
        if (nloc == 0u) { xcd_barrier_complete(bar, b.x, nloc, nx); b.st[0] = nloc; b.st[1] = nx; }
        const unsigned old = xb_add(&bar[XB_XSUB(b.x)], 1u);
        const unsigned gen = old / nloc;
        if (old + 1u == (gen + 1u) * nloc) {
            __builtin_amdgcn_fence(__ATOMIC_RELEASE, "agent");
            asm volatile("s_waitcnt vmcnt(0)" ::: "memory");
            const unsigned og = xb_add(&bar[XB_TOP], 1u);
            const unsigned tg = og / nx;
            if (og + 1u == (tg + 1u) * nx) xb_add(&bar[XB_TOPGEN], 1u);
            else XB_SPIN(xb_ld(&bar[XB_TOPGEN]) == tg, bar);
            __builtin_amdgcn_fence(__ATOMIC_ACQUIRE, "agent");
            xb_add(&bar[XB_XGEN(b.x)], 1u);
            asm volatile("s_waitcnt vmcnt(0)" ::: "memory");
        } else {
            XB_SPIN(xb_ld(&bar[XB_XGEN(b.x)]) == gen, bar);
            __builtin_amdgcn_fence(__ATOMIC_ACQUIRE, "agent");
            asm volatile("s_waitcnt vmcnt(0)" ::: "memory");
        }
    }
    __syncthreads();
}

#define GRID_BAR() xcd_barrier(bar)

struct Args {
    const float* x; const int* pos; const float* norm_mix_g; const float* w_in; const float* gm_ln_g; const float* gm_ln_b; const float* gm_w_s; const float* gm_b_s;
    const float* lam_q1; const float* lam_k1; const float* lam_q2; const float* lam_k2; const float* subln_g; const float* w_br_a; const float* w_br_b; const float* w_out;
    const float* norm_ffn_g; const float* w_rg; const float* b_rg; const float* w_re; const float* b_re; const float* w_gate; const float* w_up; const float* w_down; const float* final_g;
    float* out; unsigned char* ws;
};

__device__ __forceinline__ void transpose_item(const float* W, int ldw, int k0, int n0, bf16_t* WT, int ldt, int drow0, int dk0, const float* gk, LAS float* scr, int lane) {
#pragma unroll 8
    for (int i = 0; i < 32; ++i) { const int kk = 2 * i + (lane >> 5); float v = W[(size_t)(k0 + kk) * ldw + n0 + (lane & 31)]; if (gk) v *= gk[k0 + kk]; scr[kk * 33 + (lane & 31)] = v; }
    LDS_WAIT(); asm volatile("" ::: "memory");
    const int c = lane & 7;
#pragma unroll
    for (int j = 0; j < 4; ++j) { const int n = (lane >> 3) + 8 * j; const LAS float* s = scr + (8 * c) * 33 + n;
        u32x4 o; o.x = cvt_pk_bf16(s[0 * 33], s[1 * 33]); o.y = cvt_pk_bf16(s[2 * 33], s[3 * 33]); o.z = cvt_pk_bf16(s[4 * 33], s[5 * 33]); o.w = cvt_pk_bf16(s[6 * 33], s[7 * 33]);
        *(u32x4*)(WT + (size_t)(drow0 + n) * ldt + dk0 + k0 + 8 * c) = o; }
    LDS_WAIT(); asm volatile("" ::: "memory");
}
__device__ __forceinline__ void rms_row_to_bf16(const float* xrow, const float* g, bf16_t* orow, int lane) {
    const f32x4* xr = (const f32x4*)xrow + lane; const f32x4* gr = (const f32x4*)g + lane;
    f32x4 v[4]; float s = 0.f;
#pragma unroll
    for (int j = 0; j < 4; ++j) { v[j] = xr[64 * j]; s += (v[j].x * v[j].x + v[j].y * v[j].y) + (v[j].z * v[j].z + v[j].w * v[j].w); }
    const float rstd = 1.f / sqrtf(wave_sum(s) * (1.f / D) + EPS);
    u32x2* o8 = (u32x2*)orow + lane;
#pragma unroll
    for (int j = 0; j < 4; ++j) { const f32x4 gg = gr[64 * j]; u32x2 w; w.x = cvt_pk_bf16(v[j].x * rstd * gg.x, v[j].y * rstd * gg.y); w.y = cvt_pk_bf16(v[j].z * rstd * gg.z, v[j].w * rstd * gg.w); o8[64 * j] = w; }
}

__global__ void __launch_bounds__(NTHREADS, 2) fwd_kernel(Args a) {
    extern __shared__ __attribute__((aligned(16))) unsigned char lds_raw[];
    LAS unsigned char* lds = (LAS unsigned char*)lds_raw;
    volatile LAS unsigned* LCTL = (volatile LAS unsigned*)(lds + LDSCTL_OFF);
    const int tid = threadIdx.x, lane = tid & 63, wave = __builtin_amdgcn_readfirstlane(tid >> 6);
    const int G = gridDim.x, bx = blockIdx.x;
    const int vcu = (G % 8 == 0) ? (bx % 8) * (G / 8) + bx / 8 : bx;
    unsigned char* ws = a.ws;
    unsigned* ctl = (unsigned*)(ws + WS_CTL);
    for (int u = tid; u < (LDS_BYTES - LDSCTL_OFF) / 4; u += NTHREADS) LCTL[u] = 0u;
    __syncthreads();
    XcdBarrier bar = xcd_barrier_post(ctl + CW_BAR, LCTL);
    const int gw = vcu * NWAVES + wave, NGW = G * NWAVES;

    bf16_t* WIN = (bf16_t*)(ws + WS_WIN); bf16_t* WBR = (bf16_t*)(ws + WS_WBR); bf16_t* WO = (bf16_t*)(ws + WS_WO); bf16_t* W13 = (bf16_t*)(ws + WS_W13); bf16_t* W2 = (bf16_t*)(ws + WS_W2);
    float* CS = (float*)(ws + WS_CS); float* SSQ = (float*)(ws + WS_SSQ); float* RSTD = (float*)(ws + WS_RSTD); float* WTS = (float*)(ws + WS_WTS);
    int* LIST = (int*)(ws + WS_LIST); float* PARK = (float*)(ws + WS_PARK);
    bf16_t* XN = (bf16_t*)(ws + WS_RA); bf16_t* YAB = (bf16_t*)(ws + WS_RA); bf16_t* YB = (bf16_t*)(ws + WS_RA);
    bf16_t* UV = (bf16_t*)(ws + WS_RB); bf16_t* MG = (bf16_t*)(ws + WS_RB);
    bf16_t* Qb = (bf16_t*)(ws + WS_RC); bf16_t* Kb = Qb + (size_t)T * 512; bf16_t* XB = (bf16_t*)(ws + WS_RC);
    bf16_t* Vb = (bf16_t*)(ws + WS_RD);
    bf16_t* Gb = (bf16_t*)(ws + WS_RE); bf16_t* Hb = (bf16_t*)(ws + WS_RE);
    float* X1 = a.out;

    {
        LAS float* scr = (LAS float*)(lds + wave * 16384);
#if LEVEL >= 1
        constexpr int I_IN = 16 * 144, I_BA = 8 * 32, I_BB = 8 * 32, I_O = 16 * 32;
#if LEVEL >= 3
        constexpr int I_G = 32 * 256, I_U = 32 * 256, I_D = 32 * 256;
#else
        constexpr int I_G = 0, I_U = 0, I_D = 0;
#endif
        constexpr int NITEMS = I_IN + I_BA + I_BB + I_O + I_G + I_U + I_D;
        for (int it = gw; it < NITEMS; it += NGW) {
            int r = it;
            if (r < I_IN) { const int kb = r / 144, nb = r % 144; transpose_item(a.w_in, IN_COLS, 64 * kb, 32 * nb, WIN, 1024, 32 * nb, 0, nullptr, scr, lane); continue; } r -= I_IN;
            if (r < I_BA) { const int kb = r / 32, nb = r % 32; transpose_item(a.w_br_a, 1024, 64 * kb, 32 * nb, WBR, 1024, 32 * nb, 0, nullptr, scr, lane); continue; } r -= I_BA;
            if (r < I_BB) { const int kb = r / 32, nb = r % 32; transpose_item(a.w_br_b, 1024, 64 * kb, 32 * nb, WBR, 1024, 32 * nb, 512, nullptr, scr, lane); continue; } r -= I_BB;
            if (r < I_O) { const int kb = r / 32, nb = r % 32; transpose_item(a.w_out, 1024, 64 * kb, 32 * nb, WO, 1024, 32 * nb, 0, nullptr, scr, lane); continue; } r -= I_O;
            if (r < I_G + I_U) { const int up = r >= I_G; if (up) r -= I_G; const int e = r / 256, q = r % 256, kb = q / 16, nb = q % 16;
                const int n0 = 32 * nb, drow = e * 1024 + (n0 >> 7) * 256 + up * 128 + (n0 & 127);
                transpose_item((up ? a.w_up : a.w_gate) + (size_t)e * 1024 * 512, 512, 64 * kb, n0, W13, 1024, drow, 0, a.norm_ffn_g, scr, lane); continue; } r -= I_G + I_U;
            { const int e = r / 256, q = r % 256, kb = q / 32, nb = q % 32;
                transpose_item(a.w_down + (size_t)e * 512 * 1024, 1024, 64 * kb, 32 * nb, W2, 512, e * 1024 + 32 * nb, 0, nullptr, scr, lane); }
        }
        for (int i = bx * NTHREADS + tid; i < T * 8; i += G * NTHREADS) { const int t = i >> 3, j = i & 7;
            const double invf = exp2(-(double)j * (18.931568569324174 / 8.0));
            const double ang = (double)a.pos[t] * invf; const double kk = rint(ang * 0.15915494309189535); const float rr = (float)(ang - kk * 6.283185307179586);
            CS[t * 16 + j] = cosf(rr); CS[t * 16 + 8 + j] = sinf(rr); }
        for (int m = gw; m < T; m += NGW) rms_row_to_bf16(a.x + (size_t)m * D, a.norm_mix_g, XN + (size_t)m * D, lane);
#endif
    }
    GRID_BAR();

#if LEVEL >= 1 && !defined(NO_P1)
    {
        pg8::DenseProb P; P.init(XN, WIN, T, IN_COLS, 1024, G, bx);
        pg8::EpiInProj E{UV, Qb, Kb, Vb, Gb, CS};
        pg8::gemm_core(lds, P, E, pg8::NoHook{});
    }
#endif
    GRID_BAR();

#if LEVEL >= 1 && !defined(NO_P2A)
    {
        LAS bf16_t* VT = (LAS bf16_t*)lds;
        LAS float* STAT = (LAS float*)(lds + 36864);
        (void)STAT;
        const int r32 = lane & 31, hi = lane >> 5;
        for (int un = vcu; un < 2048; un += G) {
            const int ch = un >> 2, g = un & 3; const size_t row0 = (size_t)ch * 128;
            {
                const int s = tid >> 2, qd = tid & 3;
                const u32x4* vp = (const u32x4*)(UV + (row0 + s) * 1024 + 512 + g * 128 + qd * 32);
                float v[32]; float sm = 0.f;
#pragma unroll
                for (int j = 0; j < 4; ++j) { const u32x4 w = vp[j]; f32x4 x0, x1; pg8::unpack8(w, x0, x1);
#pragma unroll
                    for (int e = 0; e < 4; ++e) { v[8 * j + e] = x0[e]; v[8 * j + 4 + e] = x1[e]; sm += x0[e] + x1[e]; } }
                sm += __shfl_xor(sm, 1); sm += __shfl_xor(sm, 2);
                const float mu = sm * (1.0f / 128.0f); float sq = 0.f;
#pragma unroll
                for (int i = 0; i < 32; ++i) { v[i] -= mu; sq += v[i] * v[i]; }
                sq += __shfl_xor(sq, 1); sq += __shfl_xor(sq, 2);
                const float rstd = 1.0f / sqrtf(sq * (1.0f / 128.0f) + EPS);
                const float* lg = a.gm_ln_g + g * 128 + qd * 32; const float* lb = a.gm_ln_b + g * 128 + qd * 32;
#pragma unroll
                for (int i = 0; i < 32; ++i) { const float y = v[i] * rstd * lg[i] + lb[i]; VT[(qd * 32 + i) * 136 + s] = (bf16_t)(cvt_pk_bf16(y, 0.f) & 0xffffu); }
            }
            LDS_WAIT(); __syncthreads();
            {
                const int tb = wave >> 1, db0 = 2 * (wave & 1);
                f32x16 c0 = f32x16{}, c1 = f32x16{};
                const float* wrow = a.gm_w_s + ((size_t)g * 128 + tb * 32 + r32) * 128;
                const int trow = tb * 32 + r32;
                for (int ks = 0; ks <= 2 * tb + 1; ++ks) {
                    const int s0 = 16 * ks + 8 * hi;
                    const f32x4 wa = *(const f32x4*)(wrow + s0), wb = *(const f32x4*)(wrow + s0 + 4);
                    float w8[8] = {wa[0], wa[1], wa[2], wa[3], wb[0], wb[1], wb[2], wb[3]};
#pragma unroll
                    for (int j = 0; j < 8; ++j) if (s0 + j > trow) w8[j] = 0.f;
                    u32x4 aw; aw.x = cvt_pk_bf16(w8[0], w8[1]); aw.y = cvt_pk_bf16(w8[2], w8[3]); aw.z = cvt_pk_bf16(w8[4], w8[5]); aw.w = cvt_pk_bf16(w8[6], w8[7]);
                    const bf16x8 af = __builtin_bit_cast(bf16x8, aw);
                    const bf16x8 b0 = *(const LAS bf16x8*)(VT + ((db0 + 0) * 32 + r32) * 136 + s0);
                    const bf16x8 b1 = *(const LAS bf16x8*)(VT + ((db0 + 1) * 32 + r32) * 136 + s0);
                    c0 = __builtin_amdgcn_mfma_f32_32x32x16_bf16(af, b0, c0, 0, 0, 0);
                    c1 = __builtin_amdgcn_mfma_f32_32x32x16_bf16(af, b1, c1, 0, 0, 0);
                }
#pragma unroll
                for (int r = 0; r < 16; ++r) { const int t = tb * 32 + att::crow(r, hi); const float bs = a.gm_b_s[g * 128 + t];
                    const size_t ro = (row0 + t) * 1024 + g * 128 + db0 * 32 + r32;
                    const float u0 = __uint_as_float((unsigned)UV[ro] << 16), u1 = __uint_as_float((unsigned)UV[ro + 32] << 16);
                    YAB[ro] = (bf16_t)(cvt_pk_bf16(u0 * (c0[r] + bs), 0.f) & 0xffffu); YAB[ro + 32] = (bf16_t)(cvt_pk_bf16(u1 * (c1[r] + bs), 0.f) & 0xffffu); }
            }
            LDS_WAIT(); __syncthreads();
        }
    }
#endif
#if LEVEL >= 2
    {
        float lam;
        { const float p1 = wave_sum(a.lam_q1[lane] * a.lam_k1[lane]), p2 = wave_sum(a.lam_q2[lane] * a.lam_k2[lane]); lam = expf(p1) - expf(p2) + 0.2f; }
        const int bh = vcu >> 3, s = vcu & 7, b = bh >> 2, h = bh & 3;
        float* park = PARK + (size_t)bx * 32768;
        if (G == 256) {
            for (int i = 0; i < 4; ++i) { const int qb = (i == 0) ? s : (i == 1) ? 15 - s : (i == 2) ? 16 + s : 31 - s;
                att::attn_unit(b, h, qb, Qb, Kb, Vb, YAB, park, lam, a.subln_g, (LAS char*)lds); }
        }
    }
#elif LEVEL >= 1
    {
        for (int i = bx * NTHREADS + tid; i < T * 64; i += G * NTHREADS) { const int row = i >> 6, c = i & 63; *(u32x4*)(YAB + (size_t)row * 1024 + 512 + c * 8) = (u32x4){0u, 0u, 0u, 0u}; }
    }
#endif
    GRID_BAR();

#if LEVEL >= 1 && !defined(NO_P3)
    {
        pg8::DenseProb P; P.init(YAB, WBR, T, 1024, 1024, G, bx);
        pg8::EpiMerge E{Gb, MG};
        pg8::gemm_core(lds, P, E, pg8::HookMerge{Gb});
    }
#endif
    GRID_BAR();
#if LEVEL >= 1 && !defined(NO_P4)
    {
        pg8::DenseProb P; P.init(MG, WO, T, 1024, 1024, G, bx);
        pg8::EpiX1 E{a.x, X1, XB, SSQ};
        pg8::gemm_core(lds, P, E, pg8::NoHook{});
    }
#endif
    GRID_BAR();

#if LEVEL >= 3
    {
        LAS float* XS = (LAS float*)(lds + wave * 8704);
        LAS float* PART = (LAS float*)(lds + 69632);
        volatile LAS int* LCNT = (volatile LAS int*)(LCTL + 96); volatile LAS int* LBASE = (volatile LAS int*)(LCTL + 128);
        for (int tb = vcu; tb < T / 256; tb += G) {
            const int tg = wave & 3, kh = wave >> 2; const size_t tok0 = (size_t)tb * 256 + tg * 64;
            float acc[36];
#pragma unroll
            for (int n = 0; n < 36; ++n) acc[n] = 0.f;
            for (int kc = 0; kc < 16; ++kc) {
                const int k0 = kh * 512 + kc * 32;
                const f32x4 gv = *(const f32x4*)(a.norm_ffn_g + k0 + (lane & 7) * 4);
#pragma unroll
                for (int i = 0; i < 8; ++i) { const int row = i * 8 + (lane >> 3), pc = lane & 7; const f32x4 v = *(const f32x4*)(X1 + (tok0 + row) * 1024 + k0 + pc * 4) * gv;
                    LAS float* d = XS + row * 33 + pc * 4; d[0] = v[0]; d[1] = v[1]; d[2] = v[2]; d[3] = v[3]; }
                LDS_WAIT(); asm volatile("" ::: "memory");
                const float* wg = a.w_rg + (size_t)k0 * 4; const float* we = a.w_re + (size_t)k0 * 32;
                for (int k = 0; k < 32; ++k) { const float xv = XS[lane * 33 + k];
#pragma unroll
                    for (int n = 0; n < 4; ++n) acc[n] = __builtin_fmaf(xv, wg[k * 4 + n], acc[n]);
#pragma unroll
                    for (int n = 0; n < 32; ++n) acc[4 + n] = __builtin_fmaf(xv, we[k * 32 + n], acc[4 + n]); }
                LDS_WAIT(); asm volatile("" ::: "memory");
            }
            const int tl = tg * 64 + lane;
#pragma unroll
            for (int n = 0; n < 36; ++n) PART[(kh * 256 + tl) * 37 + n] = acc[n];
            if (tid < 32) LCNT[tid] = 0;
            LDS_WAIT(); __syncthreads();
            int eid0 = 0, eid1 = 0, rk0 = 0, rk1 = 0; float w0 = 0.f, w1 = 0.f; const size_t tok = (size_t)tb * 256 + tid;
            if (tid < 256) {
                float ssq = 0.f;
#pragma unroll
                for (int j = 0; j < 16; ++j) ssq += SSQ[tok * 16 + j];
                const float rstd = 1.0f / sqrtf(ssq * (1.0f / 1024.0f) + EPS);
                RSTD[tok] = rstd;
                const LAS float* p0 = PART + tid * 37; const LAS float* p1 = PART + (256 + tid) * 37;
                float gl[4]; int grp = 0;
#pragma unroll
                for (int j = 0; j < 4; ++j) gl[j] = (p0[j] + p1[j]) * rstd + a.b_rg[j];
                float gmx = gl[0];
#pragma unroll
                for (int j = 1; j < 4; ++j) if (gl[j] > gmx) { gmx = gl[j]; grp = j; }
                float gs = 0.f;
#pragma unroll
                for (int j = 0; j < 4; ++j) gs += expf(gl[j] - gmx);
                const float gwt = 1.0f / gs;
                float el[8];
#pragma unroll
                for (int j = 0; j < 8; ++j) el[j] = (p0[4 + grp * 8 + j] + p1[4 + grp * 8 + j]) * rstd + a.b_re[grp * 8 + j];
                int i0 = 0; float v0 = el[0];
#pragma unroll
                for (int j = 1; j < 8; ++j) if (el[j] > v0) { v0 = el[j]; i0 = j; }
                int i1 = -1; float v1 = -INFINITY;
#pragma unroll
                for (int j = 0; j < 8; ++j) if (j != i0 && el[j] > v1) { v1 = el[j]; i1 = j; }
                const float e1 = expf(v1 - v0); w0 = gwt / (1.0f + e1); w1 = gwt * e1 / (1.0f + e1);
                eid0 = grp * 8 + i0; eid1 = grp * 8 + i1;
                rk0 = atomicAdd((int*)(LCNT + eid0), 1); rk1 = atomicAdd((int*)(LCNT + eid1), 1);
            }
            LDS_WAIT(); __syncthreads();
            if (tid < 32) LBASE[tid] = (int)__hip_atomic_fetch_add(ctl + CW_CNT + tid, (unsigned)LCNT[tid], RLX_AGENT);
            LDS_WAIT(); __syncthreads();
            if (tid < 256) {
                LIST[eid0 * LISTCAP + LBASE[eid0] + rk0] = (int)(tok * 2); LIST[eid1 * LISTCAP + LBASE[eid1] + rk1] = (int)(tok * 2 + 1);
                WTS[tok * 2] = w0; WTS[tok * 2 + 1] = w1;
            }
            LDS_WAIT(); __syncthreads();
        }
    }
#endif
    GRID_BAR();
#if LEVEL >= 3
    {
        volatile LAS int* BST = (volatile LAS int*)(LCTL + 16); volatile LAS int* CNT = (volatile LAS int*)(LCTL + 64);
        if (tid == 0) { int accb = 0; for (int e = 0; e < NEXP; ++e) { const int c = (int)__hip_atomic_load(ctl + CW_CNT + e, RLX_AGENT); CNT[e] = c; BST[e] = accb; accb += (c + 255) >> 8; } BST[NEXP] = accb; }
        LDS_WAIT(); __syncthreads();
    }
    {
        pg8::MoeUpProb P; P.init((const LAS int*)(LCTL + 16), (const LAS int*)(LCTL + 64), G, bx); P.A = (const char*)XB; P.Bt = (const char*)W13; P.K = 1024; P.list = LIST;
        pg8::EpiMoeUp E{LIST, RSTD, Hb};
        pg8::gemm_core(lds, P, E, pg8::NoHook{});
    }
#endif
    GRID_BAR();
#if LEVEL >= 3
    {
        pg8::MoeDownProb P; P.init((const LAS int*)(LCTL + 16), (const LAS int*)(LCTL + 64), G, bx); P.A = (const char*)Hb; P.Bt = (const char*)W2; P.K = 512;
        pg8::EpiMoeDown E{LIST, WTS, YB};
        pg8::gemm_core(lds, P, E, pg8::NoHook{});
    }
#endif
    GRID_BAR();

    {
        const bool tmo = (__hip_atomic_load(ctl + CW_BAR + XB_TMO, RLX_AGENT) != 0u);
        for (int m = gw; m < T; m += NGW) {
#if LEVEL >= 1
            const f32x4* xr = (const f32x4*)(X1 + (size_t)m * D) + lane;
#else
            const f32x4* xr = (const f32x4*)(a.x + (size_t)m * D) + lane;
#endif
            const f32x4* gr = (const f32x4*)a.final_g + lane;
            f32x4 v[4]; float s = 0.f;
#pragma unroll
            for (int j = 0; j < 4; ++j) { v[j] = xr[64 * j];
#if LEVEL >= 3
                const u32x2 y0 = *((const u32x2*)(YB + (size_t)(2 * m) * D) + lane + 64 * j), y1 = *((const u32x2*)(YB + (size_t)(2 * m + 1) * D) + lane + 64 * j);
                v[j].x += bf_lo(y0.x) + bf_lo(y1.x); v[j].y += bf_hi(y0.x) + bf_hi(y1.x); v[j].z += bf_lo(y0.y) + bf_lo(y1.y); v[j].w += bf_hi(y0.y) + bf_hi(y1.y);
#endif
                s += (v[j].x * v[j].x + v[j].y * v[j].y) + (v[j].z * v[j].z + v[j].w * v[j].w); }
            float rstd = 1.f / sqrtf(wave_sum(s) * (1.f / D) + EPS);
            if (tmo) rstd = __builtin_nanf("");
            f32x4* o = (f32x4*)(a.out + (size_t)m * D) + lane;
#pragma unroll
            for (int j = 0; j < 4; ++j) o[64 * j] = v[j] * rstd * gr[64 * j];
        }
    }
}

extern "C" void kernel_launch(void* const* d_in, const int* in_sizes, int n_in, void* d_out, int out_size, void* d_ws, size_t ws_size, hipStream_t stream) {
    static int grid = 0;
    if (grid == 0) {
        if (n_in != 25 || in_sizes[0] != T * D || out_size != T * D || ws_size < WS_END) { fprintf(stderr, "kernel_launch: unexpected shapes (n_in %d, in0 %d, out %d, ws %zu); nothing launched\n", n_in, n_in > 0 ? in_sizes[0] : -1, out_size, ws_size); grid = -1; return; }
        int dev = 0, cus = 0, per_cu = 0;
        if (hipGetDevice(&dev) != hipSuccess || hipDeviceGetAttribute(&cus, hipDeviceAttributeMultiprocessorCount, dev) != hipSuccess) { grid = -1; return; }
        if (hipFuncSetAttribute((const void*)fwd_kernel, hipFuncAttributeMaxDynamicSharedMemorySize, LDS_BYTES) != hipSuccess) { fprintf(stderr, "kernel_launch: hipFuncSetAttribute failed\n"); grid = -1; return; }
        if (hipOccupancyMaxActiveBlocksPerMultiprocessor(&per_cu, (const void*)fwd_kernel, NTHREADS, LDS_BYTES) != hipSuccess || per_cu < 1) fprintf(stderr, "kernel_launch: occupancy query reports %d\n", per_cu);
        (void)hipGetLastError();
        grid = cus;
        if (grid != 256) fprintf(stderr, "kernel_launch: %d CUs (built for 256)\n", grid);
    }
    if (grid < 0) return;
    if (hipMemsetAsync((char*)d_ws + WS_CTL, 0, CTL_ZERO_BYTES, stream) != hipSuccess) return;
    Args a{};
    a.x = (const float*)d_in[0]; a.pos = (const int*)d_in[1]; a.norm_mix_g = (const float*)d_in[2]; a.w_in = (const float*)d_in[3]; a.gm_ln_g = (const float*)d_in[4]; a.gm_ln_b = (const float*)d_in[5];
    a.gm_w_s = (const float*)d_in[6]; a.gm_b_s = (const float*)d_in[7]; a.lam_q1 = (const float*)d_in[8]; a.lam_k1 = (const float*)d_in[9]; a.lam_q2 = (const float*)d_in[10]; a.lam_k2 = (const float*)d_in[11];
    a.subln_g = (const float*)d_in[12]; a.w_br_a = (const float*)d_in[13]; a.w_br_b = (const float*)d_in[14]; a.w_out = (const float*)d_in[15]; a.norm_ffn_g = (const float*)d_in[16];
    a.w_rg = (const float*)d_in[17]; a.b_rg = (const float*)d_in[18]; a.w_re = (const float*)d_in[19]; a.b_re = (const float*)d_in[20]; a.w_gate = (const float*)d_in[21]; a.w_up = (const float*)d_in[22];
    a.w_down = (const float*)d_in[23]; a.final_g = (const float*)d_in[24];
    a.out = (float*)d_out; a.ws = (unsigned char*)d_ws;
    hipLaunchKernelGGL(fwd_kernel, dim3(grid), dim3(NTHREADS), LDS_BYTES, stream, a);
    const hipError_t le = hipPeekAtLastError();
    if (le != hipSuccess) fprintf(stderr, "kernel_launch: launch failed: %s\n", hipGetErrorName(le));
}
```

```cpp
#include <hip/hip_runtime.h>
#include <cstdio>
#include <cstdint>

#ifndef LEVEL
#define LEVEL 3
#endif

#ifndef PROBE_PHASE
#define PROBE_PHASE -1
#endif
#define REPS(p) ((PROBE_PHASE == (p)) ? 2 : 1)
#define LAS __attribute__((address_space(3)))
#define GAS __attribute__((address_space(1)))
typedef unsigned short bf16_t;
typedef short bf16x8 __attribute__((ext_vector_type(8)));
typedef short s16x4 __attribute__((ext_vector_type(4)));
typedef float f32x2 __attribute__((ext_vector_type(2)));
typedef float f32x4 __attribute__((ext_vector_type(4)));
typedef float f32x16 __attribute__((ext_vector_type(16)));
typedef unsigned u32x2 __attribute__((ext_vector_type(2)));
typedef unsigned u32x4 __attribute__((ext_vector_type(4)));
typedef int i32x8 __attribute__((ext_vector_type(8)));
typedef short s16x16 __attribute__((ext_vector_type(16)));

constexpr int D = 1024, BATCH = 8, SEQ = 8192, T = BATCH * SEQ;
constexpr int IN_COLS = 4608;
constexpr int NEXP = 32, DEXP = 512;
constexpr int LISTCAP = T;
constexpr float EPS = 1e-6f;
constexpr float LOG2E = 1.4426950408889634f;
constexpr float C2 = 0.125f * LOG2E;
constexpr int NWAVES = 8, NTHREADS = 512;

constexpr size_t MiB = 1u << 20;
constexpr size_t WS_CTL = 0, CTL_ZERO_BYTES = 1 * MiB;
constexpr size_t WS_WIN = 2 * MiB;
constexpr size_t WS_WBR = 12 * MiB;
constexpr size_t WS_WO = 14 * MiB;
constexpr size_t WS_W13 = 16 * MiB;
constexpr size_t WS_W2 = 80 * MiB;
constexpr size_t WS_WRH = 112 * MiB;
constexpr size_t WS_WRL = 112 * MiB + 131072;
constexpr size_t WS_CS = 113 * MiB;
constexpr size_t WS_SSQ = 117 * MiB;
constexpr size_t WS_RSTD = 121 * MiB;
constexpr size_t WS_WTS = 122 * MiB;
constexpr size_t WS_LIST = 123 * MiB;
constexpr size_t WS_PARK = 131 * MiB;
constexpr size_t WS_RA = 164 * MiB;
constexpr size_t WS_RB = 292 * MiB;
constexpr size_t WS_RC = 420 * MiB;
constexpr size_t WS_RD = 548 * MiB;
constexpr size_t WS_RE = 612 * MiB;
constexpr size_t WS_END = 868 * MiB;
constexpr int CW_TMO = 0;
constexpr int CW_BAR = 4096;
constexpr int CW_CNT = 8192;

constexpr int RING_BYTES = 147456;
constexpr int LDSCTL_OFF = RING_BYTES;
constexpr int LDS_BYTES = RING_BYTES + 1024;

#define RLX_AGENT __ATOMIC_RELAXED, __HIP_MEMORY_SCOPE_AGENT
#define LDS_WAIT() asm volatile("s_waitcnt lgkmcnt(0)" ::: "memory")
#define VM_WAIT() asm volatile("s_waitcnt vmcnt(0)" ::: "memory")

__device__ __forceinline__ unsigned cvt_pk_bf16(float lo, float hi) { unsigned r; asm("v_cvt_pk_bf16_f32 %0, %1, %2" : "=v"(r) : "v"(lo), "v"(hi)); return r; }
__device__ __forceinline__ unsigned cvt_pk4_fp8(float a, float b, float c, float d) { int w; asm("v_cvt_pk_fp8_f32 %0, %1, %2" : "=v"(w) : "v"(a), "v"(b)); w = __builtin_amdgcn_cvt_pk_fp8_f32(c, d, w, true); return (unsigned)w; }
__device__ __forceinline__ unsigned cvt_pk4_u8(float a, float b, float c, float d) { unsigned w = 0; w = __builtin_amdgcn_cvt_pk_u8_f32(a, 0, w); w = __builtin_amdgcn_cvt_pk_u8_f32(b, 1, w); w = __builtin_amdgcn_cvt_pk_u8_f32(c, 2, w); w = __builtin_amdgcn_cvt_pk_u8_f32(d, 3, w); return w; }
__device__ __forceinline__ f32x4 u8x4_to_f32(unsigned w) { return (f32x4){(float)(w & 0xffu), (float)((w >> 8) & 0xffu), (float)((w >> 16) & 0xffu), (float)(w >> 24)}; }
__device__ __forceinline__ f32x4 fp8x4_to_f32(unsigned w) { const f32x2 lo = __builtin_amdgcn_cvt_pk_f32_fp8((int)w, false), hi = __builtin_amdgcn_cvt_pk_f32_fp8((int)w, true); return (f32x4){lo[0], lo[1], hi[0], hi[1]}; }
__device__ __forceinline__ float bf_lo(unsigned w) { return __uint_as_float(w << 16); }
__device__ __forceinline__ float bf_hi(unsigned w) { return __uint_as_float(w & 0xffff0000u); }
__device__ __forceinline__ float fast_exp2(float x) { return __builtin_amdgcn_exp2f(x); }
__device__ __forceinline__ float fast_rcp(float x) { return __builtin_amdgcn_rcpf(x); }
__device__ __forceinline__ float sigmoidf_(float x) { return fast_rcp(1.0f + fast_exp2(-LOG2E * x)); }
__device__ __forceinline__ float gelu_tanh(float x) {
    const float u = x * (0.7978845608028654f + 0.0356774081363001f * x * x);
    return x * fast_rcp(1.0f + fast_exp2(-2.0f * LOG2E * u));
}
__device__ __forceinline__ int opaque_tid() { int t = threadIdx.x; asm volatile("" : "+v"(t)); return t; }
__device__ __forceinline__ float wave_sum(float v) {
#pragma unroll
    for (int o = 1; o < 64; o <<= 1) v += __shfl_xor(v, o);
    return v;
}

namespace pg8 {
constexpr int BM = 256, BK = 64, HALF = 128, HTB = HALF * BK * 2, STAGE_BYTES = 8 * HTB, NXCD = 8, WGM = 8;
__host__ __device__ __forceinline__ int lds_byte(int r, int c) { const int st = (r >> 4) * 2 + (c >> 5), rr = r & 15, cc = c & 31, ob = rr * 64 + cc * 2; return st * 1024 + (ob ^ (((ob >> 9) & 1) << 5)); }
__host__ __device__ __forceinline__ void stage_rc(int b, int& R, int& C) { const int st = b / 1024, sb = b % 1024, swz = sb ^ (((sb >> 9) & 1) << 5); R = (st >> 1) * 16 + swz / 64; C = (st & 1) * 32 + (swz % 64) / 2; }
__host__ __device__ __forceinline__ int perm32(int rho) { const int n = rho >> 4, i = rho & 15; return 8 * (i >> 2) + 4 * n + (i & 3); }

struct Unit { int pm, pn, e, lbase, nv; };

struct DenseProb {
    static constexpr bool GATHER = false;
    const char* A; const char* Bt; int pitch  ; int nM, nN, nwg, G, c;
    __device__ __forceinline__ void init(const void* A_, const void* Bt_, int M, int N, int K_, int G_, int c_) { A = (const char*)A_; Bt = (const char*)Bt_; pitch = K_ * 2; nM = M / BM; nN = N / BM; nwg = nM * nN; G = G_; c = c_; }
    __device__ __forceinline__ bool next(int i, Unit& u) const {
        const long L = (long)i * G + c; if (L >= nwg) return false;
        int wgid = (int)L; { const int q = nwg / NXCD, r = nwg % NXCD, xcd = wgid % NXCD, off = wgid / NXCD; wgid = (xcd < r ? xcd * (q + 1) : r * (q + 1) + (xcd - r) * q) + off; }
        const int nig = WGM * nN, gid = wgid / nig, fm = gid * WGM, gsz = (nM - fm) < WGM ? (nM - fm) : WGM;
        u.pm = fm + ((wgid % nig) % gsz); u.pn = (wgid % nig) / gsz; u.e = 0; u.lbase = 0; u.nv = 256; return true;
    }
    __device__ __forceinline__ void a_offs(const Unit& u, const int (&R)[2], const int (&C)[2], unsigned (&o)[2][2]) const {
#pragma unroll
        for (int h = 0; h < 2; ++h)
#pragma unroll
            for (int i = 0; i < 2; ++i) o[h][i] = (unsigned)((u.pm * BM + h * HALF + R[i]) * pitch + C[i] * 2);
    }
    __device__ __forceinline__ const char* b_tile(const Unit& u) const { return Bt + (size_t)u.pn * BM * pitch; }
    __device__ __forceinline__ const char* a_tile(const Unit& u) const { return A + (size_t)u.pm * BM * pitch; }
};

struct PanelProb : DenseProb {
    __device__ __forceinline__ bool next(int i, Unit& u) const { if (i >= nN || c >= nM) return false; u.pm = c; u.pn = i; u.e = 0; u.lbase = 0; u.nv = 256; return true; }
};
struct MoeOrder {
    const LAS int* bstart; const LAS int* cnt; int nblk, nwg, G, c;
    __device__ __forceinline__ void init(const LAS int* bs, const LAS int* cn, int G_, int c_) { bstart = bs; cnt = cn; nblk = bs[NEXP]; nwg = nblk * 4; G = G_; c = c_; }
    __device__ __forceinline__ bool next(int i, Unit& u) const {
        const long L = (long)i * G + c; if (L >= nwg) return false;
        int wgid = (int)L; { const int q = nwg / NXCD, r = nwg % NXCD, xcd = wgid % NXCD, off = wgid / NXCD; wgid = (xcd < r ? xcd * (q + 1) : r * (q + 1) + (xcd - r) * q) + off; }
        const int gid = wgid / 32, fm = gid * 8, gsz = (nblk - fm) < 8 ? (nblk - fm) : 8, w = wgid - gid * 32;
        const int blk = fm + (w % gsz); u.pn = w / gsz; u.pm = blk;
        int e = 0;
        while (e < NEXP - 1 && blk >= bstart[e + 1]) ++e;
        const int rb = blk - bstart[e]; u.e = e; u.lbase = e * LISTCAP + rb * 256; const int rem = cnt[e] - rb * 256; u.nv = rem < 256 ? rem : 256; return true;
    }
};
struct MoeUpProb : MoeOrder {
    static constexpr bool GATHER = true;
    const char* A; const char* Bt; int pitch; const int* list;
    __device__ __forceinline__ const char* a_tile(const Unit&) const { return A; }
    __device__ __forceinline__ void a_offs(const Unit& u, const int (&R)[2], const int (&C)[2], unsigned (&o)[2][2]) const {
#pragma unroll
        for (int h = 0; h < 2; ++h)
#pragma unroll
            for (int i = 0; i < 2; ++i) { const int r = h * HALF + R[i]; const int tok = (r < u.nv) ? (int)((unsigned)list[u.lbase + r] >> 16) : 0; o[h][i] = (unsigned)(tok * pitch + C[i] * 2); }
    }
    __device__ __forceinline__ const char* b_tile(const Unit& u) const { return Bt + ((size_t)u.e * 1024 + (size_t)u.pn * BM) * pitch; }
};
struct MoeDownProb : MoeOrder {
    static constexpr bool GATHER = false;
    const char* A; const char* Bt; int pitch;
    __device__ __forceinline__ const char* a_tile(const Unit& u) const { return A + (size_t)u.pm * BM * pitch; }
    __device__ __forceinline__ void a_offs(const Unit& u, const int (&R)[2], const int (&C)[2], unsigned (&o)[2][2]) const {
#pragma unroll
        for (int h = 0; h < 2; ++h)
#pragma unroll
            for (int i = 0; i < 2; ++i) o[h][i] = (unsigned)((u.pm * BM + h * HALF + R[i]) * pitch + C[i] * 2);
    }
    __device__ __forceinline__ const char* b_tile(const Unit& u) const { return Bt + ((size_t)u.e * 1024 + (size_t)u.pn * BM) * pitch; }
};

struct EpiNull { __device__ __forceinline__ void prefetch(const Unit&, int, int, int, int) const {}
    __device__ __forceinline__ void operator()(f32x4 (&acc)[2][2][4][2], const Unit&, int, int, int, int) const {
#pragma unroll
    for (int a = 0; a < 2; ++a)
#pragma unroll
        for (int b = 0; b < 2; ++b)
#pragma unroll
            for (int m = 0; m < 4; ++m) asm volatile("" :: "v"(acc[a][b][m][0]), "v"(acc[a][b][m][1])); } };
struct DenseProbSame : DenseProb {
    __device__ __forceinline__ void a_offs(const Unit&, const int (&R)[2], const int (&C)[2], unsigned (&o)[2][2]) const { Unit z{0, 0, 0, 0, 256}; DenseProb::a_offs(z, R, C, o); }
    __device__ __forceinline__ const char* b_tile(const Unit&) const { return Bt; }
};
struct NoHook { static constexpr int AT = -1; __device__ __forceinline__ void operator()(f32x4 (&)[2][2][4][2], const Unit&, int, int, int, int) const {} };

template <bool FP8, class Prob, class Epi, class Hook, int PM = 0>
__device__ __forceinline__ void gemm_core(LAS unsigned char* lds, const Prob& P, const Epi& E, const Hook& HK) {
    const int tid = opaque_tid(), wid = __builtin_amdgcn_readfirstlane(tid >> 6), lane = tid & 63, wr = wid >> 2, wc = wid & 3, fr = lane & 15, fq = lane >> 4;
    const int pitch = P.pitch, nt = pitch / (BK * 2);
    int R[2], C[2]; unsigned voffB[2], voffA[2];
#pragma unroll
    for (int i = 0; i < 2; ++i) { stage_rc(tid * 16 + i * 8192, R[i], C[i]); const int Rb = (R[i] & ~31) + perm32(R[i] & 31); voffB[i] = (unsigned)(Rb * pitch + C[i] * 2); voffA[i] = (unsigned)(R[i] * pitch + C[i] * 2); }
    const size_t kstep = (size_t)(BK * 2);
    const size_t hstep = (size_t)HALF * pitch;
    const unsigned ldsw = (unsigned)wid * 1024u;
    const int aoff = lds_byte(wr * 64 + fr, fq * 8), boff = lds_byte(wc * 32 + fr, fq * 8);
#define PG8_SA(b, h) (((b) * 2 + (h)) * HTB)
#define PG8_SB(b, h) ((4 + (b) * 2 + (h)) * HTB)
#define PG8_STAGE_B(bufoff, gbase) do { if constexpr (PM != 1) _Pragma("unroll") for (int _i = 0; _i < 2; ++_i) \
        __builtin_amdgcn_global_load_lds((const unsigned*)((const char*)(gbase) + voffB[_i]), (LAS unsigned*)(lds + (bufoff) + ldsw + _i * 8192), 16, 0, 0); } while (0)
#define PG8_STAGE_AG(bufoff, kb, va) do { if constexpr (PM != 1) _Pragma("unroll") for (int _i = 0; _i < 2; ++_i) \
        __builtin_amdgcn_global_load_lds((const unsigned*)(P.A + (kb) + (va)[_i]), (LAS unsigned*)(lds + (bufoff) + ldsw + _i * 8192), 16, 0, 0); } while (0)
#define PG8_STAGE_AD(bufoff, ubase) do { if constexpr (PM != 1) _Pragma("unroll") for (int _i = 0; _i < 2; ++_i) \
        __builtin_amdgcn_global_load_lds((const unsigned*)((const char*)(ubase) + voffA[_i]), (LAS unsigned*)(lds + (bufoff) + ldsw + _i * 8192), 16, 0, 0); } while (0)
#define PG8_STAGE_AC(bufoff, kb, h) do { if constexpr (Prob::GATHER) { PG8_STAGE_AG(bufoff, kb, cvA[h]); } else { PG8_STAGE_AD(bufoff, cA + (h) * hstep + (kb)); } } while (0)
#define PG8_STAGE_AN(bufoff, kb, h) do { if constexpr (Prob::GATHER) { PG8_STAGE_AG(bufoff, kb, v2[h]); } else { PG8_STAGE_AD(bufoff, (last ? nA : cA) + (h) * hstep + (kb)); } } while (0)
#define PG8_LDA(dst, b, h) do { _Pragma("unroll") for (int m = 0; m < 4; ++m) _Pragma("unroll") for (int k = 0; k < 2; ++k) { if constexpr (PM == 3) asm volatile("" : "=v"(dst[m][k])); else dst[m][k] = *(const LAS bf16x8*)(lds + PG8_SA(b, h) + aoff + m * 2048 + k * 1024); } } while (0)
#define PG8_LDB(dst, b, h) do { _Pragma("unroll") for (int n = 0; n < 2; ++n) _Pragma("unroll") for (int k = 0; k < 2; ++k) { if constexpr (PM == 3) asm volatile("" : "=v"(dst[n][k])); else dst[n][k] = *(const LAS bf16x8*)(lds + PG8_SB(b, h) + boff + n * 2048 + k * 1024); } } while (0)
#define PG8_CAT(x) __builtin_bit_cast(i32x8, __builtin_shufflevector((x)[0], (x)[1], 0, 1, 2, 3, 4, 5, 6, 7, 8, 9, 10, 11, 12, 13, 14, 15))
#define PG8_MMA(ai, bj, At, Bt) do { __builtin_amdgcn_s_setprio(1); \
        if constexpr (PM == 2) { _Pragma("unroll") for (int m = 0; m < 4; ++m) asm volatile("" :: "v"(At[m][0]), "v"(At[m][1])); _Pragma("unroll") for (int n = 0; n < 2; ++n) asm volatile("" :: "v"(Bt[n][0]), "v"(Bt[n][1])); } \
        else if constexpr (FP8) { _Pragma("unroll") for (int m = 0; m < 4; ++m) _Pragma("unroll") for (int n = 0; n < 2; ++n) \
            { const i32x8 bq_ = PG8_CAT(Bt[n]), aq_ = PG8_CAT(At[m]); \
              asm volatile("v_mfma_scale_f32_16x16x128_f8f6f4 %0, %1, %2, %0, %3, %3 op_sel_hi:[0,0,0]" : "+v"(acc[ai][bj][m][n]) : "v"(bq_), "v"(aq_), "v"(sc8)); } } \
        else { _Pragma("unroll") for (int m = 0; m < 4; ++m) _Pragma("unroll") for (int n = 0; n < 2; ++n) _Pragma("unroll") for (int k = 0; k < 2; ++k) \
            acc[ai][bj][m][n] = __builtin_amdgcn_mfma_f32_16x16x32_bf16(Bt[n][k], At[m][k], acc[ai][bj][m][n], 0, 0, 0); } \
        __builtin_amdgcn_s_setprio(0); } while (0)
#define PG8_WAIT_V(n) asm volatile("s_waitcnt vmcnt(" #n ")" ::: "memory")
#define PG8_WAIT_L(n) asm volatile("s_waitcnt lgkmcnt(" #n ")" ::: "memory")
#define PG8_BAR __builtin_amdgcn_s_barrier()
#define PG8_SCHED __builtin_amdgcn_sched_barrier(0)
    Unit cur, nxt; int ui = 0;
    if (!P.next(0, cur)) return;
    int sc8 = 0x7f7f7f7f; asm volatile("" : "+v"(sc8));
    f32x4 acc[2][2][4][2];
#pragma unroll
    for (int a = 0; a < 2; ++a)
#pragma unroll
        for (int b = 0; b < 2; ++b)
#pragma unroll
            for (int m = 0; m < 4; ++m)
#pragma unroll
                for (int n = 0; n < 2; ++n) acc[a][b][m][n] = (f32x4){0.f, 0.f, 0.f, 0.f};
    bf16x8 At[4][2], B0[2][2], B1[2][2];
    unsigned cvA[2][2], nvA[2][2];
    if constexpr (Prob::GATHER) P.a_offs(cur, R, C, cvA);
    const char* cA = P.a_tile(cur);
    const char* cB = P.b_tile(cur);
    PG8_STAGE_B(PG8_SB(0, 0), cB); PG8_STAGE_B(PG8_SB(0, 1), cB + hstep); PG8_STAGE_AC(PG8_SA(0, 0), 0, 0); PG8_STAGE_AC(PG8_SA(0, 1), 0, 1);
    if (wr == 1) PG8_BAR;
    PG8_WAIT_V(2); PG8_BAR;
    PG8_STAGE_B(PG8_SB(1, 0), cB + kstep); PG8_STAGE_AC(PG8_SA(1, 0), kstep, 0); PG8_STAGE_B(PG8_SB(1, 1), cB + hstep + kstep);
    PG8_WAIT_V(6); PG8_BAR;
    for (;;) {
        E.prefetch(cur, wr, wc, fr, fq);
        const bool has_next = P.next(ui + 1, nxt);
        if constexpr (Prob::GATHER) {
            if (has_next) P.a_offs(nxt, R, C, nvA);
            else {
#pragma unroll
                for (int h = 0; h < 2; ++h)
#pragma unroll
                    for (int i = 0; i < 2; ++i) nvA[h][i] = cvA[h][i];
            }
        }
        const char* nA = has_next ? P.a_tile(nxt) : cA;
        const char* nB = has_next ? P.b_tile(nxt) : cB;
        for (int t = 0; t < (PM == 4 ? 0 : nt); t += 2) {
            if (Hook::AT >= 0 && t == Hook::AT) HK(acc, cur, wr, wc, fr, fq);
            const bool last = (t == nt - 2);
            const size_t k1 = (size_t)(t + 1) * kstep;
            const size_t k2 = last ? 0 : (size_t)(t + 2) * kstep, k3 = k2 + kstep;
            const char* b2 = last ? nB : cB + (size_t)(t + 2) * kstep; const char* b3 = b2 + kstep;
            unsigned v2[2][2];
            if constexpr (Prob::GATHER) {
#pragma unroll
                for (int h = 0; h < 2; ++h)
#pragma unroll
                    for (int i = 0; i < 2; ++i) v2[h][i] = last ? nvA[h][i] : cvA[h][i];
            }
            PG8_LDB(B0, 0, 0); PG8_LDB(B1, 0, 1); PG8_SCHED; PG8_LDA(At, 0, 0); PG8_STAGE_AC(PG8_SA(1, 1), k1, 1);
            PG8_WAIT_V(8); PG8_WAIT_L(0); PG8_BAR; PG8_MMA(0, 0, At, B0); PG8_MMA(0, 1, At, B1); PG8_BAR; PG8_SCHED;
            PG8_LDA(At, 0, 1); PG8_STAGE_B(PG8_SB(0, 0), b2); PG8_STAGE_B(PG8_SB(0, 1), b2 + hstep); PG8_STAGE_AN(PG8_SA(0, 0), k2, 0);
            PG8_WAIT_V(8); PG8_WAIT_L(0); PG8_BAR; PG8_MMA(1, 0, At, B0); PG8_MMA(1, 1, At, B1); PG8_BAR; PG8_SCHED;
            PG8_LDB(B0, 1, 0); PG8_LDB(B1, 1, 1); PG8_SCHED; PG8_LDA(At, 1, 0); PG8_STAGE_AN(PG8_SA(0, 1), k2, 1);
            PG8_WAIT_V(8); PG8_WAIT_L(0); PG8_BAR; PG8_MMA(0, 0, At, B0); PG8_MMA(0, 1, At, B1); PG8_BAR; PG8_SCHED;
            PG8_LDA(At, 1, 1); PG8_STAGE_B(PG8_SB(1, 0), b3); PG8_STAGE_B(PG8_SB(1, 1), b3 + hstep); PG8_STAGE_AN(PG8_SA(1, 0), k3, 0);
            PG8_WAIT_V(8); PG8_WAIT_L(0); PG8_BAR; PG8_MMA(1, 0, At, B0); PG8_MMA(1, 1, At, B1); PG8_BAR; PG8_SCHED;
        }
        if (wr == 0) PG8_BAR;
        if constexpr (FP8) asm volatile("s_nop 15\n\ts_nop 7" ::: "memory");
        E(acc, cur, wr, wc, fr, fq);
        if (!has_next) break;
#pragma unroll
        for (int a = 0; a < 2; ++a)
#pragma unroll
            for (int b = 0; b < 2; ++b)
#pragma unroll
                for (int m = 0; m < 4; ++m)
#pragma unroll
                    for (int n = 0; n < 2; ++n) acc[a][b][m][n] = (f32x4){0.f, 0.f, 0.f, 0.f};
        cur = nxt; cA = nA; cB = nB; ++ui;
        if constexpr (Prob::GATHER) {
#pragma unroll
            for (int h = 0; h < 2; ++h)
#pragma unroll
                for (int i = 0; i < 2; ++i) cvA[h][i] = nvA[h][i];
        }
        if (wr == 1) PG8_BAR;
    }
    PG8_WAIT_V(0);
    PG8_BAR;
#undef PG8_SA
#undef PG8_SB
#undef PG8_STAGE_AG
#undef PG8_STAGE_AD
#undef PG8_STAGE_AC
#undef PG8_STAGE_AN
#undef PG8_STAGE_B
#undef PG8_LDA
#undef PG8_LDB
#undef PG8_MMA
#undef PG8_CAT
#undef PG8_WAIT_V
#undef PG8_WAIT_L
#undef PG8_BAR
#undef PG8_SCHED
}

__device__ __forceinline__ u32x4 pack8(const f32x4& v0, const f32x4& v1) { u32x4 w; w.x = cvt_pk_bf16(v0[0], v0[1]); w.y = cvt_pk_bf16(v0[2], v0[3]); w.z = cvt_pk_bf16(v1[0], v1[1]); w.w = cvt_pk_bf16(v1[2], v1[3]); return w; }

struct EpiStoreOnly {
    bf16_t* O;
    __device__ __forceinline__ void prefetch(const Unit&, int, int, int, int) const {}
    __device__ __forceinline__ void operator()(f32x4 (&acc)[2][2][4][2], const Unit& u, int wr, int wc, int fr, int fq) const {
        const int cl0 = wc * 32 + 8 * fq; int row0 = u.pm * BM + wr * 64 + fr; asm volatile("" : "+v"(row0));
#pragma unroll
        for (int ai = 0; ai < 2; ++ai)
#pragma unroll
            for (int m = 0; m < 4; ++m) { bf16_t* rowp = O + (size_t)(row0 + ai * HALF + m * 16) * 256 + cl0;
#pragma unroll
                for (int bj = 0; bj < 2; ++bj) *(u32x4*)(rowp + bj * HALF) = pack8(acc[ai][bj][m][0], acc[ai][bj][m][1]); }
    }
};
#define EPI_ST(val, ptr) do { if constexpr (MODE == 1) { auto v_ = (val); asm volatile("" :: "v"(v_)); } else *(ptr) = (val); } while (0)
template <int MODE> struct EpiInProjT {
    bf16_t *UV, *Q, *Kb, *Vb; unsigned char* G8; const float* cs; unsigned char *Q8, *K8;
    __device__ __forceinline__ void prefetch(const Unit&, int, int, int, int) const {}
    __device__ __forceinline__ void operator()(f32x4 (&acc)[2][2][4][2], const Unit& u, int wr, int wc, int fr, int fq) const {
        constexpr bool NOMATH = (MODE == 2);
        const int pn = u.pn, cl0 = wc * 64 + 8 * fq; int row0 = u.pm * BM + wr * 64 + fr; asm volatile("" : "+v"(row0));
        if (pn < 4) {
#pragma unroll
            for (int ai = 0; ai < 2; ++ai)
#pragma unroll
                for (int m = 0; m < 4; ++m) { bf16_t* rowp = UV + (size_t)(row0 + ai * HALF + m * 16) * 1024 + pn * 256 + cl0;
#pragma unroll
                    for (int bj = 0; bj < 2; ++bj) { f32x4 v0 = acc[ai][bj][m][0], v1 = acc[ai][bj][m][1];
#pragma unroll
                        for (int e = 0; e < 4; ++e) { if constexpr (!NOMATH) { v0[e] = gelu_tanh(v0[e]); v1[e] = gelu_tanh(v1[e]); } }
                        EPI_ST(pack8(v0, v1), (u32x4*)(rowp + bj * 32)); } }
        } else if (pn < 8) {
            bf16_t* dst = (pn < 6) ? Q : Kb; const float sc = (pn < 6) ? C2 : 1.0f; const int colb = (pn & 1) * 256 + cl0;
            const float sgn = (fq == 0) ? -1.0f : 1.0f; const bool rot_lane = fq < 2;
#pragma unroll
            for (int ai = 0; ai < 2; ++ai) {
                f32x4 cs4[4][4];
#pragma unroll
                for (int m = 0; m < 4; ++m) { const f32x4* cp = (const f32x4*)(cs + (size_t)(row0 + ai * HALF + m * 16) * 16);
#pragma unroll
                    for (int j = 0; j < 4; ++j) cs4[m][j] = cp[j]; }
#pragma unroll
                for (int m = 0; m < 4; ++m) { const int row = row0 + ai * HALF + m * 16; bf16_t* rowp = dst + (size_t)row * 512 + colb;
#pragma unroll
                    for (int bj = 0; bj < 2; ++bj) { f32x4 v0 = acc[ai][bj][m][0], v1 = acc[ai][bj][m][1];
                        if (!NOMATH && bj == 0) {
                            f32x4 p0, p1;
#pragma unroll
                            for (int e = 0; e < 4; ++e) { p0[e] = __shfl_xor(v0[e], 16); p1[e] = __shfl_xor(v1[e], 16); }
                            if (rot_lane) {
#pragma unroll
                                for (int e = 0; e < 4; ++e) { v0[e] = v0[e] * cs4[m][0][e] + sgn * p0[e] * cs4[m][2][e]; v1[e] = v1[e] * cs4[m][1][e] + sgn * p1[e] * cs4[m][3][e]; }
                            }
                        }
                        if ((wc & 1) == 0) { v0 = v0 * sc; v1 = v1 * sc; EPI_ST(pack8(v0, v1), (u32x4*)(rowp + bj * 32)); }
                        else { const float s8 = (pn < 6) ? sc * 8.0f : 1.0f; v0 = v0 * s8; v1 = v1 * s8;
                            u32x2 q8; q8.x = cvt_pk4_fp8(v0[0], v0[1], v0[2], v0[3]); q8.y = cvt_pk4_fp8(v1[0], v1[1], v1[2], v1[3]);
                            EPI_ST(q8, (u32x2*)(((pn < 6) ? Q8 : K8) + (size_t)row * 256 + ((pn & 1) * 2 + (wc >> 1)) * 64 + bj * 32 + 8 * fq)); } } }
            }
        } else if (pn < 10) {
#pragma unroll
            for (int ai = 0; ai < 2; ++ai)
#pragma unroll
                for (int m = 0; m < 4; ++m) { bf16_t* rowp = Vb + (size_t)(row0 + ai * HALF + m * 16) * 512 + (pn - 8) * 256 + cl0;
#pragma unroll
                    for (int bj = 0; bj < 2; ++bj) EPI_ST(pack8(acc[ai][bj][m][0], acc[ai][bj][m][1]), (u32x4*)(rowp + bj * 32)); }
        } else {
            int gc = (pn - 10) * 256 + wc * 64 + 16 * fq; asm volatile("" : "+v"(gc));
#pragma unroll
            for (int ai = 0; ai < 2; ++ai)
#pragma unroll
                for (int m = 0; m < 4; ++m) { unsigned char* rowp = G8 + (size_t)(row0 + ai * HALF + m * 16) * 2048 + gc; u32x4 qq;
#pragma unroll
                    for (int bj = 0; bj < 2; ++bj) { f32x4 v0 = acc[ai][bj][m][0], v1 = acc[ai][bj][m][1];
#pragma unroll
                        for (int e = 0; e < 4; ++e) { if constexpr (!NOMATH) { v0[e] = 255.0f * fast_rcp(1.0f + fast_exp2(v0[e])); v1[e] = 255.0f * fast_rcp(1.0f + fast_exp2(v1[e])); } }
                        const unsigned qa = cvt_pk4_u8(v0[0], v0[1], v0[2], v0[3]), qb = cvt_pk4_u8(v1[0], v1[1], v1[2], v1[3]);
                        if (bj == 0) { qq.x = qa; qq.y = qb; } else { qq.z = qa; qq.w = qb; } }
                    EPI_ST(qq, (u32x4*)rowp); }
        }
    }
};

#undef EPI_ST
using EpiInProj = EpiInProjT<0>;
__device__ __forceinline__ void unpack8(const u32x4& w, f32x4& a, f32x4& b) { a = (f32x4){bf_lo(w.x), bf_hi(w.x), bf_lo(w.y), bf_hi(w.y)}; b = (f32x4){bf_lo(w.z), bf_hi(w.z), bf_lo(w.w), bf_hi(w.w)}; }
struct HookMerge {
    static constexpr int AT = 8;
    const unsigned char* G8;
    __device__ __forceinline__ void operator()(f32x4 (&acc)[2][2][4][2], const Unit& u, int wr, int wc, int fr, int fq) const {
        const int col0 = u.pn * BM + wc * 64 + 8 * fq; int row0 = u.pm * BM + wr * 64 + fr; asm volatile("" : "+v"(row0));
        u32x2 w0[2][4][2], w1[2][4][2];
#pragma unroll
        for (int ai = 0; ai < 2; ++ai)
#pragma unroll
            for (int m = 0; m < 4; ++m) { const unsigned char* gp = G8 + (size_t)(row0 + ai * HALF + m * 16) * 2048 + col0;
#pragma unroll
                for (int bj = 0; bj < 2; ++bj) { w0[ai][m][bj] = *(const u32x2*)(gp + bj * 32); w1[ai][m][bj] = *(const u32x2*)(gp + 1024 + bj * 32); } }
#pragma unroll
        for (int ai = 0; ai < 2; ++ai)
#pragma unroll
            for (int m = 0; m < 4; ++m)
#pragma unroll
                for (int bj = 0; bj < 2; ++bj) { const f32x4 a0 = u8x4_to_f32(w0[ai][m][bj].x), a1 = u8x4_to_f32(w0[ai][m][bj].y), b0 = u8x4_to_f32(w1[ai][m][bj].x), b1 = u8x4_to_f32(w1[ai][m][bj].y);
#pragma unroll
                    for (int e = 0; e < 4; ++e) { acc[ai][bj][m][0][e] *= a0[e] * fast_rcp(fmaxf(b0[e], 0.5f)); acc[ai][bj][m][1][e] *= a1[e] * fast_rcp(fmaxf(b1[e], 0.5f)); } }
    }
};
struct EpiMerge {
    const unsigned char* G8; bf16_t* MG;
    __device__ __forceinline__ void prefetch(const Unit&, int, int, int, int) const {}
    __device__ __forceinline__ void operator()(f32x4 (&acc)[2][2][4][2], const Unit& u, int wr, int wc, int fr, int fq) const {
        const int col0 = u.pn * BM + wc * 64 + 8 * fq; int row0 = u.pm * BM + wr * 64 + fr; asm volatile("" : "+v"(row0));
        u32x2 w1[2][4][2];
#pragma unroll
        for (int ai = 0; ai < 2; ++ai)
#pragma unroll
            for (int m = 0; m < 4; ++m) { const unsigned char* gp = G8 + (size_t)(row0 + ai * HALF + m * 16) * 2048 + 1024 + col0;
#pragma unroll
                for (int bj = 0; bj < 2; ++bj) w1[ai][m][bj] = *(const u32x2*)(gp + bj * 32); }
        const float s255 = 1.0f / 255.0f;
#pragma unroll
        for (int ai = 0; ai < 2; ++ai)
#pragma unroll
            for (int m = 0; m < 4; ++m) { bf16_t* op = MG + (size_t)(row0 + ai * HALF + m * 16) * 1024 + col0;
#pragma unroll
                for (int bj = 0; bj < 2; ++bj) { f32x4 b0 = u8x4_to_f32(w1[ai][m][bj].x), b1 = u8x4_to_f32(w1[ai][m][bj].y);
#pragma unroll
                    for (int e = 0; e < 4; ++e) { b0[e] = fmaxf(b0[e], 0.5f) * s255; b1[e] = fmaxf(b1[e], 0.5f) * s255; }
                    *(u32x4*)(op + bj * 32) = pack8(acc[ai][bj][m][0] * b0, acc[ai][bj][m][1] * b1); } }
    }
};

struct EpiX1 {
    const float* X; bf16_t* XB; unsigned char* XB8; float* ssq;
    __device__ __forceinline__ void prefetch(const Unit&, int, int, int, int) const {}
    __device__ __forceinline__ void operator()(f32x4 (&acc)[2][2][4][2], const Unit& u, int wr, int wc, int fr, int fq) const {
        const int col0 = u.pn * BM + wc * 64 + 8 * fq; int row0 = u.pm * BM + wr * 64 + fr; asm volatile("" : "+v"(row0));
#pragma unroll
        for (int ai = 0; ai < 2; ++ai) {
            f32x4 xv[4][2][2];
#pragma unroll
            for (int m = 0; m < 4; ++m) { const float* xp = X + (size_t)(row0 + ai * HALF + m * 16) * 1024 + col0;
#pragma unroll
                for (int bj = 0; bj < 2; ++bj) { xv[m][bj][0] = *(const f32x4*)(xp + bj * 32); xv[m][bj][1] = *(const f32x4*)(xp + bj * 32 + 4); } }
#pragma unroll
            for (int m = 0; m < 4; ++m) { const size_t row = (size_t)(row0 + ai * HALF + m * 16); bf16_t* bp = XB + row * 1024 + col0;
                float s = 0.f;
#pragma unroll
                for (int bj = 0; bj < 2; ++bj) { const f32x4 v0 = acc[ai][bj][m][0] + xv[m][bj][0], v1 = acc[ai][bj][m][1] + xv[m][bj][1];
                    *(u32x4*)(bp + bj * 32) = pack8(v0, v1);
                    { u32x2 q8; q8.x = cvt_pk4_fp8(v0[0], v0[1], v0[2], v0[3]); q8.y = cvt_pk4_fp8(v1[0], v1[1], v1[2], v1[3]); *(u32x2*)(XB8 + row * 1024 + col0 + bj * 32) = q8; }
                    s += (v0[0] * v0[0] + v0[1] * v0[1]) + (v0[2] * v0[2] + v0[3] * v0[3]) + (v1[0] * v1[0] + v1[1] * v1[1]) + (v1[2] * v1[2] + v1[3] * v1[3]); }
                s += __shfl_xor(s, 16); s += __shfl_xor(s, 32);
                if (fq == 0) ssq[row * 16 + u.pn * 4 + wc] = s; }
        }
    }
};

struct EpiMoeUp {
    const int* list; const float* rstd; unsigned char* H8;
    mutable float rs[2][4];
    __device__ __forceinline__ void prefetch(const Unit& u, int wr, int wc, int fr, int fq) const {
        int r0 = wr * 64 + fr; asm volatile("" : "+v"(r0));
        int tok[2][4];
#pragma unroll
        for (int ai = 0; ai < 2; ++ai)
#pragma unroll
            for (int m = 0; m < 4; ++m) { const int r = r0 + ai * HALF + m * 16; tok[ai][m] = (r < u.nv) ? (int)((unsigned)list[u.lbase + r] >> 16) : 0; }
#pragma unroll
        for (int ai = 0; ai < 2; ++ai)
#pragma unroll
            for (int m = 0; m < 4; ++m) rs[ai][m] = rstd[tok[ai][m]] * 0.015625f;
    }
    __device__ __forceinline__ void operator()(f32x4 (&acc)[2][2][4][2], const Unit& u, int wr, int wc, int fr, int fq) const {
        const int col0 = u.pn * 128 + wc * 32 + 8 * fq; int r0 = wr * 64 + fr; asm volatile("" : "+v"(r0));
#pragma unroll
        for (int ai = 0; ai < 2; ++ai)
#pragma unroll
            for (int m = 0; m < 4; ++m) { const int r = r0 + ai * HALF + m * 16; const float rsv = rs[ai][m];
                f32x4 g0 = acc[ai][0][m][0] * rsv, g1 = acc[ai][0][m][1] * rsv, u0 = acc[ai][1][m][0] * rsv, u1 = acc[ai][1][m][1] * rsv;
#pragma unroll
                for (int e = 0; e < 4; ++e) { g0[e] = g0[e] * sigmoidf_(g0[e]) * (u0[e] * 8.f); g1[e] = g1[e] * sigmoidf_(g1[e]) * (u1[e] * 8.f); }
                u32x2 q8; q8.x = cvt_pk4_fp8(g0[0], g0[1], g0[2], g0[3]); q8.y = cvt_pk4_fp8(g1[0], g1[1], g1[2], g1[3]);
                *(u32x2*)(H8 + (size_t)(u.pm * BM + r) * 512 + col0) = q8; }
    }
};
struct EpiMoeDown {
    const int* list; unsigned char* YB8;
    mutable unsigned lw[2][4];
    __device__ __forceinline__ void prefetch(const Unit& u, int wr, int wc, int fr, int fq) const {
        int r0 = wr * 64 + fr; asm volatile("" : "+v"(r0));
#pragma unroll
        for (int ai = 0; ai < 2; ++ai)
#pragma unroll
            for (int m = 0; m < 4; ++m) { const int r = r0 + ai * HALF + m * 16; lw[ai][m] = (r < u.nv) ? (unsigned)list[u.lbase + r] : 0xffffffffu; }
    }
    __device__ __forceinline__ void operator()(f32x4 (&acc)[2][2][4][2], const Unit& u, int wr, int wc, int fr, int fq) const {
        const int col0 = u.pn * BM + wc * 64 + 16 * fq;
#pragma unroll
        for (int ai = 0; ai < 2; ++ai)
#pragma unroll
            for (int m = 0; m < 4; ++m) { const unsigned word = lw[ai][m];
                if (word != 0xffffffffu) { const float w = __uint_as_float((word & 0x7fffu) << 16) * 0.0625f;
                    unsigned char* op = YB8 + (size_t)(word >> 15) * 1024 + col0; u32x4 q;
                    { const f32x4 y0 = acc[ai][0][m][0] * w, y1 = acc[ai][0][m][1] * w; q.x = cvt_pk4_fp8(y0[0], y0[1], y0[2], y0[3]); q.y = cvt_pk4_fp8(y1[0], y1[1], y1[2], y1[3]); }
                    { const f32x4 y0 = acc[ai][1][m][0] * w, y1 = acc[ai][1][m][1] * w; q.z = cvt_pk4_fp8(y0[0], y0[1], y0[2], y0[3]); q.w = cvt_pk4_fp8(y1[0], y1[1], y1[2], y1[3]); }
                    *(u32x4*)op = q; } }
    }
};
}


namespace att {
constexpr int QB = 256, KVB = 64, QP = 512  ;
#if PROBE_PHASE == 52
#define ATT_REF_OFF 0.0f
#else
#define ATT_REF_OFF 0.0f
#endif
constexpr int KSLOT = 8192, VSLOT = 8192, NSLOT = 3;
constexpr int L_K = 0, L_V = NSLOT * KSLOT, L_WS = L_V + NSLOT * VSLOT, L_OST = L_WS + NWAVES * 256, L_END = L_OST + NWAVES * 8192;
static_assert(L_END <= RING_BYTES, "attention LDS");
#if PROBE_PHASE == 40
#define ATT_RESC_THR 0.f
#define ATT_RESC_MIN 0.001f
#define ATT_RESC_LO -2.f
#else
#define ATT_RESC_THR 512.f
#define ATT_RESC_MIN 64.f
#define ATT_RESC_LO 0.f
#endif
__device__ __forceinline__ int crow(int r, int hi) { return (r & 3) + 8 * (r >> 2) + 4 * hi; }
__device__ __forceinline__ void glds16(const void* gsrc, unsigned lds_dst) { unsigned keep;
    asm volatile("s_mov_b32 %0, m0\n\ts_mov_b32 m0, %2\n\ts_nop 0\n\tglobal_load_lds_dwordx4 %1, off\n\ts_mov_b32 m0, %0" : "=&s"(keep) : "v"(gsrc), "s"(lds_dst) : "memory"); }
#define ATT_WAIT_BAR(N) asm volatile("s_waitcnt vmcnt(" #N ") lgkmcnt(0)\n\ts_barrier" ::: "memory")
#define MX3(a, b, c) __builtin_fmaxf(__builtin_fmaxf((a), (b)), (c))
#define ATT_SBAR() __builtin_amdgcn_sched_barrier(0)
#define ATT_MFMA(a, b, c) __builtin_amdgcn_mfma_f32_32x32x16_bf16(a, b, c, 0, 0, 0)
__device__ __forceinline__ float rowmax(const f32x16& p0, const f32x16& p1) {
    float a = MX3(p0[0], p0[1], p1[0]), b = MX3(p0[2], p0[3], p1[1]); a = MX3(a, p1[2], p1[3]);
#pragma unroll
    for (int r = 4; r < 16; r += 4) { a = MX3(a, p0[r], p0[r + 1]); b = MX3(b, p0[r + 2], p0[r + 3]); a = MX3(a, p1[r], p1[r + 1]); b = MX3(b, p1[r + 2], p1[r + 3]); }
    const float m = __builtin_fmaxf(a, b); auto rr = __builtin_amdgcn_permlane32_swap(__float_as_uint(m), __float_as_uint(m), false, false);
    return __builtin_fmaxf(__uint_as_float(rr[0]), __uint_as_float(rr[1])); }
__device__ __forceinline__ void cmask(f32x16& p0, f32x16& p1, int jb, int qrel, int hi) {
    const int kb = 64 * jb + 4 * hi;
#pragma unroll
    for (int r = 0; r < 16; ++r) { const int kv = kb + (r & 3) + 8 * (r >> 2); if (kv > qrel) p0[r] = -INFINITY; if (kv + 32 > qrel) p1[r] = -INFINITY; } }
typedef int i32x4 __attribute__((ext_vector_type(4)));
__device__ __forceinline__ void kload2(bf16x8* kf, const LAS char* kp, int j) { kf[2 * j] = *(const LAS bf16x8*)(kp + j * 2048); kf[2 * j + 1] = *(const LAS bf16x8*)(kp + j * 2048 + 512); }
__device__ __forceinline__ i32x8 frag32(const LAS char* row, int c0) {
    const i32x4 lo = *(const LAS i32x4*)(row + c0 * 16), hi = *(const LAS i32x4*)(row + (c0 ^ 1) * 16);
    return __builtin_shufflevector(lo, hi, 0, 1, 2, 3, 4, 5, 6, 7); }
#define MFMA8_PV(O, A, B) asm volatile("v_mfma_scale_f32_32x32x64_f8f6f4 %0, %1, %2, %0, %3, %3 op_sel_hi:[0,0,0]" : "+v"(O) : "v"(A), "v"(B), "v"(sc_1))
template <int MODE> __device__ __forceinline__ void attn_pass(f32x16 (&o)[4], int b, int hm, int h, int qb, const bf16_t* Q, const bf16_t* __restrict__ K, const unsigned char* __restrict__ V8T, LAS char* shm) {
    const int tid = opaque_tid(), lane = tid & 63, r32 = lane & 31, hi = lane >> 5; const int wid = __builtin_amdgcn_readfirstlane(tid >> 6);
    const long rowbase = (long)b * SEQ; const int q0 = qb * QB, NT = (q0 + QB) / KVB;
    const bf16_t* Qw = Q + (rowbase + q0 + wid * 32) * QP + hm * 64;
    const bf16_t* Kh = K + rowbase * QP + hm * 64;
    const unsigned lds0 = (unsigned)(uintptr_t)shm;
    LAS float* wsf = (LAS float*)(shm + L_WS) + wid * 64;
    const bf16_t* ksrc = Kh + (long)lane * QP + wid * 8;
    const unsigned char* vsrc = V8T + ((size_t)(b * 4 + h) * (SEQ / KVB)) * VSLOT + wid * 1024 + lane * 16;
    const unsigned kdst = lds0 + L_K + wid * 1024, vdst = lds0 + L_V + wid * 1024;
#define DMA_K(t, s) glds16(ksrc + (long)(t) * KVB * QP, (unsigned)__builtin_amdgcn_readfirstlane(kdst + (unsigned)(s) * KSLOT))
#define DMA_V(t, s) glds16(vsrc + (long)(t) * VSLOT, (unsigned)__builtin_amdgcn_readfirstlane(vdst + (unsigned)(s) * VSLOT))
    const LAS char* kp0 = shm + L_K + hi * 1024 + r32 * 16;
    const LAS char* vp0 = shm + L_V + r32 * 64;  const int vc0 = (2 * hi) ^ ((r32 >> 2) & 3);
    DMA_K(0, 0); DMA_V(0, 0); DMA_K(1, 1);
    bf16x8 qr[4];
#pragma unroll
    for (int d0 = 0; d0 < 4; ++d0) qr[d0] = *(const bf16x8*)(Qw + (long)r32 * QP + d0 * 16 + hi * 8);
    float mhat = 0.f, l_reg = 0.f;
    float zf = 0.f; asm volatile("" : "+v"(zf));
    int sc_1 = 0x7f7f7f7f; asm volatile("" : "+v"(sc_1));
    f32x16 negm;
#pragma unroll
    for (int r = 0; r < 16; ++r) { negm[r] = zf;
#pragma unroll
        for (int d0 = 0; d0 < 4; ++d0) o[d0][r] = zf; }
    asm volatile("" : "+v"(negm));
    const int qrel = wid * 32 + r32;
    asm volatile("" : "+v"(qr[0]), "+v"(qr[1]), "+v"(qr[2]), "+v"(qr[3]));
    LAS bf16x8* qlds = (LAS bf16x8*)(shm + L_OST + wid * 8192) + lane;
#pragma unroll
    for (int d0 = 0; d0 < 4; ++d0) qlds[d0 * 64] = qr[d0];
    DMA_K(2, 2);
    ATT_WAIT_BAR(1);
    bool resc = false;
#define CMASK(P0, P1, t) do { const int jb_ = (t) - (NT - 4); if (jb_ >= 0) cmask(P0, P1, jb_, qrel, hi); } while (0)
#define RESC() do { if (resc) { asm volatile("s_waitcnt lgkmcnt(0)\n\ts_nop 15\n\ts_nop 15\n\ts_nop 7" ::: "memory"); \
        _Pragma("unroll") for (int r = 0; r < 16; ++r) { const float fr_ = wsf[crow(r, hi)]; _Pragma("unroll") for (int d_ = 0; d_ < 4; ++d_) asm volatile("v_mul_f32 %0, %0, %1" : "+v"(o[d_][r]) : "v"(fr_)); } } } while (0)
    f32x16 pA0, pA1, pB0, pB1;
    int sl_prev = 0, sl_cur = 0, sl_next = 1;
#define ROT() do { sl_prev = sl_cur; sl_cur = sl_next; sl_next = (sl_next == NSLOT - 1) ? 0 : sl_next + 1; } while (0)
    bf16x8 kf[8];
#pragma unroll
    for (int j = 0; j < 4; ++j) kload2(kf, kp0, j);
    pA0 = ATT_MFMA(kf[0], qr[0], negm); pA1 = ATT_MFMA(kf[1], qr[0], negm);
#pragma unroll
    for (int d0 = 1; d0 < 4; ++d0) { pA0 = ATT_MFMA(kf[2 * d0], qr[d0], pA0); pA1 = ATT_MFMA(kf[2 * d0 + 1], qr[d0], pA1); }
    CMASK(pA0, pA1, 0);
    { const float rm = rowmax(pA0, pA1) - ATT_REF_OFF; mhat = rm;
#pragma unroll
      for (int r = 0; r < 16; ++r) { pA0[r] -= rm; pA1[r] -= rm; negm[r] = -rm; }
      asm volatile("" : "+v"(negm));
#pragma unroll
      for (int r = 0; r < 16; ++r) { pA0[r] = fast_exp2(pA0[r]); pA1[r] = fast_exp2(pA1[r]); } }
    ATT_WAIT_BAR(0);
    DMA_K(3, 0); DMA_V(1, 1);
    ROT();
#pragma unroll
    for (int j = 0; j < 4; ++j) kload2(kf, kp0 + sl_cur * KSLOT, j);
    ATT_WAIT_BAR(2);
    i32x8 vf[4], pf;
#define PK4(P, B) cvt_pk4_fp8(P[B], P[(B) + 1], P[(B) + 2], P[(B) + 3])
#define PIN(x) asm volatile("" : "+v"(x))
#define GAPA(MF, P, B, W) do { MF; sacc += P[B]; sacc += P[(B) + 1]; sacc += P[(B) + 2]; sacc += P[(B) + 3]; PIN(sacc); pf[W] = PK4(P, B); PIN(pf); ATT_SBAR(); } while (0)
#define EXP8(X, B) do { X[B] = fast_exp2(X[B]); X[(B) + 1] = fast_exp2(X[(B) + 1]); X[(B) + 2] = fast_exp2(X[(B) + 2]); X[(B) + 3] = fast_exp2(X[(B) + 3]); \
        X[(B) + 4] = fast_exp2(X[(B) + 4]); X[(B) + 5] = fast_exp2(X[(B) + 5]); X[(B) + 6] = fast_exp2(X[(B) + 6]); X[(B) + 7] = fast_exp2(X[(B) + 7]); PIN(X); } while (0)
#define STEP(C0, C1, P0, P1, t, GK, GV, GL) do { ATT_SBAR(); \
    const LAS char* vp_ = vp0 + sl_prev * VSLOT; \
    float sacc = 0.f; \
    bf16x8 qa_ = qlds[0], qb_ = qlds[64]; ATT_SBAR(); \
    GAPA(C0 = ATT_MFMA(kf[0], qa_, negm), P0, 0, 0); \
    GAPA(C1 = ATT_MFMA(kf[1], qa_, negm), P0, 4, 1); \
    qa_ = qlds[128]; ATT_SBAR(); \
    GAPA(C0 = ATT_MFMA(kf[2], qb_, C0), P0, 8, 2); \
    GAPA(C1 = ATT_MFMA(kf[3], qb_, C1), P0, 12, 3); \
    qb_ = qlds[192]; ATT_SBAR(); \
    vf[0] = frag32(vp_, vc0); ATT_SBAR(); GAPA(C0 = ATT_MFMA(kf[4], qa_, C0), P1, 0, 4); \
    vf[1] = frag32(vp_ + 32 * 64, vc0); ATT_SBAR(); GAPA(C1 = ATT_MFMA(kf[5], qa_, C1), P1, 4, 5); \
    vf[2] = frag32(vp_ + 64 * 64, vc0); ATT_SBAR(); GAPA(C0 = ATT_MFMA(kf[6], qb_, C0), P1, 8, 6); \
    vf[3] = frag32(vp_ + 96 * 64, vc0); ATT_SBAR(); GAPA(C1 = ATT_MFMA(kf[7], qb_, C1), P1, 12, 7); \
    l_reg += sacc; \
    if (GK) { DMA_K((t) + 3, sl_cur); } if (GV) { DMA_V((t) + 1, sl_next); } \
    CMASK(C0, C1, t); \
    {   \
      float st_; { auto rr = __builtin_amdgcn_permlane32_swap(__float_as_uint(sacc), __float_as_uint(sacc), false, false); st_ = __uint_as_float(rr[0]) + __uint_as_float(rr[1]); } \
      resc = false; \
      if (__builtin_expect(__any(st_ > ATT_RESC_THR), 0)) { const float dl = (st_ > ATT_RESC_MIN) ? __builtin_fmaxf(__builtin_floorf(__builtin_amdgcn_logf(st_)) - 6.f, ATT_RESC_LO) : 0.f; mhat += dl; \
        _Pragma("unroll") for (int r = 0; r < 16; ++r) { asm volatile("v_sub_f32 %0, %0, %1" : "+v"(C0[r]) : "v"(dl)); asm volatile("v_sub_f32 %0, %0, %1" : "+v"(C1[r]) : "v"(dl)); } \
        _Pragma("unroll") for (int r = 0; r < 16; ++r) negm[r] = -mhat; asm volatile("" : "+v"(negm)); \
        const float f = fast_exp2(-dl); l_reg *= f; if (hi == 0) wsf[r32] = f; resc = true; } } \
    ATT_SBAR(); \
    MFMA8_PV(o[0], pf, vf[0]); EXP8(C0, 0); if (GL) { kload2(kf, kp0 + sl_next * KSLOT, 0); } ATT_SBAR(); \
    MFMA8_PV(o[1], pf, vf[1]); EXP8(C0, 8); if (GL) { kload2(kf, kp0 + sl_next * KSLOT, 1); } ATT_SBAR(); \
    MFMA8_PV(o[2], pf, vf[2]); EXP8(C1, 0); if (GL) { kload2(kf, kp0 + sl_next * KSLOT, 2); } ATT_SBAR(); \
    MFMA8_PV(o[3], pf, vf[3]); EXP8(C1, 8); if (GL) { kload2(kf, kp0 + sl_next * KSLOT, 3); } ATT_SBAR(); \
    } while (0)
    int t = 1;
#undef CMASK
#define CMASK(P0, P1, t) do {} while (0)
    for (; t + 5 < NT; t += 2) {
        STEP(pB0, pB1, pA0, pA1, t, true, true, true);       if (MODE == 3) { asm volatile("s_waitcnt lgkmcnt(0)" ::: "memory"); } else { ATT_WAIT_BAR(2); } RESC(); ROT();
        STEP(pA0, pA1, pB0, pB1, t + 1, true, true, true);   if (MODE == 3) { asm volatile("s_waitcnt lgkmcnt(0)" ::: "memory"); } else { ATT_WAIT_BAR(2); } RESC(); ROT();
    }
#undef CMASK
#define CMASK(P0, P1, t) do { const int jb_ = (t) - (NT - 4); if (jb_ >= 0) cmask(P0, P1, jb_, qrel, hi); } while (0)
#define ENDW(tt) do { if ((tt) + 3 < NT) { ATT_WAIT_BAR(2); } else if ((tt) + 2 < NT) { ATT_WAIT_BAR(1); } else { ATT_WAIT_BAR(0); } } while (0)
    for (; t + 1 < NT; t += 2) {
        STEP(pB0, pB1, pA0, pA1, t, (t + 3 < NT), (t + 1 < NT), (t + 1 < NT));       ENDW(t);     RESC(); ROT();
        STEP(pA0, pA1, pB0, pB1, t + 1, (t + 4 < NT), (t + 2 < NT), (t + 2 < NT));   ENDW(t + 1); RESC(); ROT();
    }
    STEP(pB0, pB1, pA0, pA1, NT - 1, false, false, false); RESC();
    { float sacc = 0.f;
#pragma unroll
      for (int r = 0; r < 16; ++r) sacc += pB0[r] + pB1[r];
      l_reg += sacc;
      pf[0] = PK4(pB0, 0); pf[1] = PK4(pB0, 4); pf[2] = PK4(pB0, 8); pf[3] = PK4(pB0, 12); pf[4] = PK4(pB1, 0); pf[5] = PK4(pB1, 4); pf[6] = PK4(pB1, 8); pf[7] = PK4(pB1, 12);
      const LAS char* vp_ = vp0 + sl_cur * VSLOT;
      vf[0] = frag32(vp_, vc0); vf[1] = frag32(vp_ + 32 * 64, vc0); vf[2] = frag32(vp_ + 64 * 64, vc0); vf[3] = frag32(vp_ + 96 * 64, vc0);
      asm volatile("s_nop 3" : "+v"(pf));
      MFMA8_PV(o[0], pf, vf[0]); MFMA8_PV(o[1], pf, vf[1]); MFMA8_PV(o[2], pf, vf[2]); MFMA8_PV(o[3], pf, vf[3]);
      asm volatile("s_nop 15\n\ts_nop 15\n\ts_nop 7" : "+v"(o[0]), "+v"(o[1]), "+v"(o[2]), "+v"(o[3])); }
#undef PK4
#undef PIN
#undef GAPA
#undef EXP8
#undef STEP
#undef ENDW
#undef CMASK
#undef RESC
#undef ROT
    { auto rr = __builtin_amdgcn_permlane32_swap(__float_as_uint(l_reg), __float_as_uint(l_reg), false, false); l_reg = __uint_as_float(rr[0]) + __uint_as_float(rr[1]); }
    if (hi == 0) wsf[32 + r32] = l_reg;
    asm volatile("s_waitcnt lgkmcnt(0)" ::: "memory");
#pragma unroll
    for (int r = 0; r < 16; ++r) { const float rl = fast_rcp(wsf[32 + crow(r, hi)]);
#pragma unroll
        for (int d0 = 0; d0 < 4; ++d0) o[d0][r] *= rl; }
    asm volatile("s_waitcnt lgkmcnt(0)" ::: "memory");
#undef DMA_K
#undef DMA_V
}

constexpr int KSLOT8 = 4096, QP8 = 256  ;
constexpr int L_V8 = NSLOT * KSLOT8, L_WS8 = L_V8 + NSLOT * VSLOT;
static_assert(L_WS8 + NWAVES * 256 <= L_OST, "fp8 pass LDS");
#define MFMA8_QK(C, A, B) asm volatile("v_mfma_scale_f32_32x32x64_f8f6f4 %0, %1, %2, %3, %4, %5 op_sel_hi:[0,0,0]" : "=&v"(C) : "v"(A), "v"(B), "v"(negm), "v"(sc_k), "v"(sc_q))
#define MFMA8_PV8(O, A, B) asm volatile("v_mfma_scale_f32_32x32x64_f8f6f4 %0, %1, %2, %0, %3, %3 op_sel_hi:[0,0,0]" : "+v"(O) : "v"(A), "v"(B), "v"(sc_k))
template <int MODE> __device__ __forceinline__ void attn_pass8(f32x16 (&o)[4], int b, int hm, int h, int qb, const unsigned char* Q8, const unsigned char* __restrict__ K8, const unsigned char* __restrict__ V8T, LAS char* shm) {
    const int tid = opaque_tid(), lane = tid & 63, r32 = lane & 31, hi = lane >> 5; const int wid = __builtin_amdgcn_readfirstlane(tid >> 6);
    const long rowbase = (long)b * SEQ; const int q0 = qb * QB, NT = (q0 + QB) / KVB;
    const unsigned lds0 = (unsigned)(uintptr_t)shm;
    LAS float* wsf = (LAS float*)(shm + L_WS8) + wid * 64;
    const int kkey = (wid & 3) * 16 + (lane >> 2);
    const unsigned char* ksrc = K8 + (rowbase + kkey) * QP8 + h * 64 + (((lane & 3) ^ ((kkey >> 2) & 3)) * 16);
    const unsigned char* vsrc = V8T + ((size_t)(b * 4 + h) * (SEQ / KVB)) * VSLOT + wid * 1024 + lane * 16;
    const unsigned kdst = lds0 + L_K + (wid & 3) * 1024, vdst = lds0 + L_V8 + wid * 1024;
#define DMA_K(t, s) glds16(ksrc + (long)(t) * KVB * QP8, (unsigned)__builtin_amdgcn_readfirstlane(kdst + (unsigned)(s) * KSLOT8))
#define DMA_V(t, s) glds16(vsrc + (long)(t) * VSLOT, (unsigned)__builtin_amdgcn_readfirstlane(vdst + (unsigned)(s) * VSLOT))
    const int sw = (r32 >> 2) & 3;
    const LAS char* kp0 = shm + L_K + r32 * 64;  const int kc0 = (2 * hi) ^ sw;
    const LAS char* vp0 = shm + L_V8 + r32 * 64;  const int vc0 = (2 * hi) ^ sw;
    DMA_K(0, 0); DMA_V(0, 0); DMA_K(1, 1);
    i32x8 qf;
    { const unsigned char* qp = Q8 + (rowbase + q0 + wid * 32 + r32) * QP8 + h * 64 + hi * 32; const i32x4 lo = *(const i32x4*)qp, hi4 = *(const i32x4*)(qp + 16); qf = __builtin_shufflevector(lo, hi4, 0, 1, 2, 3, 4, 5, 6, 7); }
    float mhat = 0.f;
    f32x16 ol;
    float zf = 0.f; asm volatile("" : "+v"(zf));
    int sc_k = 0x7f7f7f7f, sc_q = 0x7c7c7c7c; asm volatile("" : "+v"(sc_k), "+v"(sc_q));
    f32x16 negm;
#pragma unroll
    for (int r = 0; r < 16; ++r) { negm[r] = zf;
#pragma unroll
        for (int d0 = 0; d0 < 4; ++d0) o[d0][r] = zf;
        ol[r] = zf; }
    i32x8 ones8; { int o1 = 0x38383838; asm volatile("" : "+v"(o1)); ones8 = (i32x8){o1, o1, o1, o1, o1, o1, o1, o1}; }
    asm volatile("" : "+v"(negm));
    const int qrel = wid * 32 + r32;
    asm volatile("" : "+v"(qf));
    DMA_K(2, 2);
    ATT_WAIT_BAR(1);
    bool resc = false;
#define CMASK(P0, P1, t) do { const int jb_ = (t) - (NT - 4); if (jb_ >= 0) cmask(P0, P1, jb_, qrel, hi); } while (0)
#define RESC() do { if (resc) { asm volatile("s_waitcnt lgkmcnt(0)\n\ts_nop 15\n\ts_nop 7" ::: "memory"); \
        _Pragma("unroll") for (int r = 0; r < 16; ++r) { const float fr_ = wsf[crow(r, hi)]; _Pragma("unroll") for (int d_ = 0; d_ < 4; ++d_) asm volatile("v_mul_f32 %0, %0, %1" : "+v"(o[d_][r]) : "v"(fr_)); asm volatile("v_mul_f32 %0, %0, %1" : "+v"(ol[r]) : "v"(fr_)); } } } while (0)
    f32x16 pA0, pA1, pB0, pB1;
    int sl_prev = 0, sl_cur = 0, sl_next = 1;
#define ROT() do { sl_prev = sl_cur; sl_cur = sl_next; sl_next = (sl_next == NSLOT - 1) ? 0 : sl_next + 1; } while (0)
    i32x8 kf0, kf1;
    kf0 = frag32(kp0, kc0); kf1 = frag32(kp0 + 32 * 64, kc0);
    MFMA8_QK(pA0, kf0, qf); MFMA8_QK(pA1, kf1, qf);
    asm volatile("s_nop 15\n\ts_nop 15\n\ts_nop 7" : "+v"(pA0), "+v"(pA1));
    CMASK(pA0, pA1, 0);
    { const float rm = rowmax(pA0, pA1) - ATT_REF_OFF; mhat = rm;
#pragma unroll
      for (int r = 0; r < 16; ++r) { pA0[r] -= rm; pA1[r] -= rm; negm[r] = -rm; }
      asm volatile("" : "+v"(negm));
#pragma unroll
      for (int r = 0; r < 16; ++r) { pA0[r] = fast_exp2(pA0[r]); pA1[r] = fast_exp2(pA1[r]); } }
    ATT_WAIT_BAR(0);
    DMA_K(3, 0); DMA_V(1, 1);
    ROT();
    kf0 = frag32(kp0 + sl_cur * KSLOT8, kc0); kf1 = frag32(kp0 + sl_cur * KSLOT8 + 32 * 64, kc0);
    ATT_WAIT_BAR(2);
    i32x8 vf[4], pf;
#define PK4(P, B) cvt_pk4_fp8(P[B], P[(B) + 1], P[(B) + 2], P[(B) + 3])
#define PIN(x) asm volatile("" : "+v"(x))
#define SUM8(P, B) do { sacc += P[B]; sacc += P[(B) + 1]; sacc += P[(B) + 2]; sacc += P[(B) + 3]; sacc += P[(B) + 4]; sacc += P[(B) + 5]; sacc += P[(B) + 6]; sacc += P[(B) + 7]; PIN(sacc); } while (0)
#define EXP8(X, B) do { X[B] = fast_exp2(X[B]); X[(B) + 1] = fast_exp2(X[(B) + 1]); X[(B) + 2] = fast_exp2(X[(B) + 2]); X[(B) + 3] = fast_exp2(X[(B) + 3]); \
        X[(B) + 4] = fast_exp2(X[(B) + 4]); X[(B) + 5] = fast_exp2(X[(B) + 5]); X[(B) + 6] = fast_exp2(X[(B) + 6]); X[(B) + 7] = fast_exp2(X[(B) + 7]); PIN(X); } while (0)
#define STEP(C0, C1, P0, P1, t, GK, GV, GL) do { ATT_SBAR(); \
    const LAS char* vp_ = vp0 + sl_prev * VSLOT; \
    const bool det_ = (((t) & 3) == 1);            \
    float sacc = 0.f; \
    MFMA8_QK(C0, kf0, qf); \
    if (det_) { SUM8(P0, 0); SUM8(P0, 8); } \
    pf[0] = PK4(P0, 0); pf[1] = PK4(P0, 4); pf[2] = PK4(P0, 8); pf[3] = PK4(P0, 12); PIN(pf); \
    vf[0] = frag32(vp_, vc0); vf[1] = frag32(vp_ + 32 * 64, vc0); ATT_SBAR(); \
    MFMA8_QK(C1, kf1, qf); \
    if (det_) { SUM8(P1, 0); SUM8(P1, 8); } \
    pf[4] = PK4(P1, 0); pf[5] = PK4(P1, 4); pf[6] = PK4(P1, 8); pf[7] = PK4(P1, 12); PIN(pf); \
    vf[2] = frag32(vp_ + 64 * 64, vc0); vf[3] = frag32(vp_ + 96 * 64, vc0); ATT_SBAR(); \
    if (GK) { DMA_K((t) + 3, sl_cur); } if (GV) { DMA_V((t) + 1, sl_next); } \
    {   \
      float st_; { auto rr = __builtin_amdgcn_permlane32_swap(__float_as_uint(sacc), __float_as_uint(sacc), false, false); st_ = __uint_as_float(rr[0]) + __uint_as_float(rr[1]); } \
      resc = false; \
      if (__builtin_expect(det_ && __any(st_ > ATT_RESC_THR), 0)) { const float dl = (st_ > ATT_RESC_MIN) ? __builtin_fmaxf(__builtin_floorf(__builtin_amdgcn_logf(st_)) - 6.f, ATT_RESC_LO) : 0.f; mhat += dl; \
        asm volatile("s_nop 15\n\ts_nop 15" ::: "memory"); \
        _Pragma("unroll") for (int r = 0; r < 16; ++r) { asm volatile("v_sub_f32 %0, %0, %1" : "+v"(C0[r]) : "v"(dl)); asm volatile("v_sub_f32 %0, %0, %1" : "+v"(C1[r]) : "v"(dl)); } \
        _Pragma("unroll") for (int r = 0; r < 16; ++r) negm[r] = -mhat; asm volatile("" : "+v"(negm)); \
        const float f = fast_exp2(-dl); if (hi == 0) wsf[r32] = f; resc = true; } } \
    asm volatile("s_nop 7" : "+v"(C0), "+v"(C1)); CMASK(C0, C1, t); \
    ATT_SBAR(); \
    MFMA8_PV8(o[0], pf, vf[0]); EXP8(C0, 0); if (GL) kf0 = frag32(kp0 + sl_next * KSLOT8, kc0); ATT_SBAR(); \
    MFMA8_PV8(o[1], pf, vf[1]); EXP8(C0, 8); ATT_SBAR(); \
    MFMA8_PV8(o[2], pf, vf[2]); EXP8(C1, 0); if (GL) kf1 = frag32(kp0 + sl_next * KSLOT8 + 32 * 64, kc0); ATT_SBAR(); \
    MFMA8_PV8(o[3], pf, vf[3]); EXP8(C1, 8); ATT_SBAR(); \
    MFMA8_PV8(ol, pf, ones8); ATT_SBAR(); \
    } while (0)
    int t = 1;
#undef CMASK
#define CMASK(P0, P1, t) do {} while (0)
    for (; t + 5 < NT; t += 2) {
        STEP(pB0, pB1, pA0, pA1, t, true, true, true);       ATT_WAIT_BAR(2); RESC(); ROT();
        STEP(pA0, pA1, pB0, pB1, t + 1, true, true, true);   ATT_WAIT_BAR(2); RESC(); ROT();
    }
#undef CMASK
#define CMASK(P0, P1, t) do { const int jb_ = (t) - (NT - 4); if (jb_ >= 0) cmask(P0, P1, jb_, qrel, hi); } while (0)
#define ENDW(tt) do { if ((tt) + 3 < NT) { ATT_WAIT_BAR(2); } else if ((tt) + 2 < NT) { ATT_WAIT_BAR(1); } else { ATT_WAIT_BAR(0); } } while (0)
    for (; t + 1 < NT; t += 2) {
        STEP(pB0, pB1, pA0, pA1, t, (t + 3 < NT), (t + 1 < NT), (t + 1 < NT));       ENDW(t);     RESC(); ROT();
        STEP(pA0, pA1, pB0, pB1, t + 1, (t + 4 < NT), (t + 2 < NT), (t + 2 < NT));   ENDW(t + 1); RESC(); ROT();
    }
    STEP(pB0, pB1, pA0, pA1, NT - 1, false, false, false); RESC();
    {
      pf[0] = PK4(pB0, 0); pf[1] = PK4(pB0, 4); pf[2] = PK4(pB0, 8); pf[3] = PK4(pB0, 12); pf[4] = PK4(pB1, 0); pf[5] = PK4(pB1, 4); pf[6] = PK4(pB1, 8); pf[7] = PK4(pB1, 12);
      const LAS char* vp_ = vp0 + sl_cur * VSLOT;
      vf[0] = frag32(vp_, vc0); vf[1] = frag32(vp_ + 32 * 64, vc0); vf[2] = frag32(vp_ + 64 * 64, vc0); vf[3] = frag32(vp_ + 96 * 64, vc0);
      asm volatile("s_nop 3" : "+v"(pf));
      MFMA8_PV8(o[0], pf, vf[0]); MFMA8_PV8(o[1], pf, vf[1]); MFMA8_PV8(o[2], pf, vf[2]); MFMA8_PV8(o[3], pf, vf[3]); MFMA8_PV8(ol, pf, ones8);
      asm volatile("s_nop 15\n\ts_nop 15\n\ts_nop 7" : "+v"(o[0]), "+v"(o[1]), "+v"(o[2]), "+v"(o[3]), "+v"(ol)); }
#undef PK4
#undef PIN
#undef SUM8
#undef EXP8
#undef STEP
#undef ENDW
#undef CMASK
#undef RESC
#undef ROT
#pragma unroll
    for (int r = 0; r < 16; ++r) { const float rl = fast_rcp(ol[r]);
#pragma unroll
        for (int d0 = 0; d0 < 4; ++d0) o[d0][r] *= rl; }
#undef DMA_K
#undef DMA_V
}

template <int MODE> __device__ __forceinline__ void attn_unit(int b, int h, int qb, const bf16_t* Q, const bf16_t* K, const unsigned char* Q8, const unsigned char* K8, const unsigned char* V, bf16_t* YAB, float* park, float lam, const float* subg, LAS char* shm) {
    const int tid = opaque_tid(), lane = tid & 63, r32 = lane & 31, hi = lane >> 5; const int wid = __builtin_amdgcn_readfirstlane(tid >> 6);
    for (int m = 0; m < 2; ++m) {
        f32x16 o[4];
        if (m == 0) attn_pass<MODE>(o, b, 2 * h, h, qb, Q, K, V, shm);
        else attn_pass8<MODE>(o, b, 2 * h + 1, h, qb, Q8, K8, V, shm);
        int lo_ = lane; asm volatile("" : "+v"(lo_));
        f32x4* pk = (f32x4*)park + (size_t)wid * 1024 + lo_;
        if (m == 0) {
#pragma unroll
            for (int d0 = 0; d0 < 4; ++d0)
#pragma unroll
                for (int j = 0; j < 4; ++j) pk[(d0 * 4 + j) * 64] = (f32x4){o[d0][4 * j], o[d0][4 * j + 1], o[d0][4 * j + 2], o[d0][4 * j + 3]};
        } else {
            float ss[16];
#pragma unroll
            for (int r = 0; r < 16; ++r) ss[r] = 0.f;
#pragma unroll
            for (int d0 = 0; d0 < 4; ++d0)
#pragma unroll
                for (int j = 0; j < 4; ++j) { const f32x4 a = pk[(d0 * 4 + j) * 64];
#pragma unroll
                    for (int e = 0; e < 4; ++e) { const float v = a[e] - lam * o[d0][4 * j + e]; o[d0][4 * j + e] = v; ss[4 * j + e] += v * v; } }
#pragma unroll
            for (int r = 0; r < 16; ++r) { float s = ss[r]; s += __shfl_xor(s, 1); s += __shfl_xor(s, 2); s += __shfl_xor(s, 4); s += __shfl_xor(s, 8); s += __shfl_xor(s, 16); ss[r] = 0.8f / sqrtf(s * (1.0f / 128.0f) + EPS); }
            float gd[4];
#pragma unroll
            for (int d0 = 0; d0 < 4; ++d0) gd[d0] = subg[d0 * 32 + r32];
            LAS bf16_t* stg = (LAS bf16_t*)(shm + L_OST) + wid * 4096;
#pragma unroll
            for (int r = 0; r < 16; ++r) { const int orow = crow(r, hi);
#pragma unroll
                for (int d0 = 0; d0 < 4; ++d0) { float y = o[d0][r] * ss[r] * gd[d0];
#if PROBE_PHASE == 51
                    if (!(__builtin_fabsf(y) < 1e30f)) y = 0.f;
#endif
                    stg[orow * 128 + d0 * 32 + r32] = (bf16_t)(cvt_pk_bf16(y, 0.f) & 0xffffu); } }
            asm volatile("s_waitcnt lgkmcnt(0)" ::: "memory");
            bf16_t* Ow = YAB + ((long)b * SEQ + qb * QB + wid * 32) * 1024 + 512 + h * 128;
#pragma unroll
            for (int i = 0; i < 8; ++i) { const int row = i * 4 + (lo_ >> 4), ch = lo_ & 15; const u32x4 v = *(const LAS u32x4*)(stg + row * 128 + ch * 8); *(u32x4*)(Ow + (long)row * 1024 + ch * 8) = v; }
        }
        asm volatile("s_waitcnt lgkmcnt(0)\n\ts_barrier" ::: "memory");
    }
}
#undef ATT_WAIT_BAR
#undef MX3
#undef ATT_SBAR
#undef ATT_MFMA
#undef MFMA8_PV
#undef MFMA8_QK
#undef MFMA8_PV8
}

#define XB_TMO      128
#define XB_XCNT(j)  (256  + 64 * (j))
#define XB_XSUB(j)  (1280 + 64 * (j))
#define XB_XGEN(j)  (2304 + 64 * (j))
#define XB_TOP      3328
#define XB_TOPGEN   3392
#define XCD_BAR_WORDS 3456
#define XB_SPIN_CAP (1u << 18)
__device__ __forceinline__ unsigned xb_ld(unsigned* p)              { return __hip_atomic_load(p, __ATOMIC_RELAXED, __HIP_MEMORY_SCOPE_AGENT); }
__device__ __forceinline__ unsigned xb_add(unsigned* p, unsigned v) { return __hip_atomic_fetch_add(p, v, __ATOMIC_RELAXED, __HIP_MEMORY_SCOPE_AGENT); }
__device__ __forceinline__ unsigned xb_xcc_id() { return (unsigned)__builtin_amdgcn_s_getreg((3 << 11) | 20) & 0xFu; }
#define XB_SPIN(cond, bar) do { unsigned _sp = 0; while (cond) { __builtin_amdgcn_s_sleep(1); \
    if ((++_sp & 255u) == 0u) { if (xb_ld(&(bar)[XB_TMO])) break; if (_sp > XB_SPIN_CAP) { atomicAdd(&(bar)[XB_TMO], 1u); break; } } } } while (0)
struct XcdBarrier { unsigned* bar; unsigned x; volatile LAS unsigned* st; };
__device__ __forceinline__ XcdBarrier xcd_barrier_post(unsigned* bar, volatile LAS unsigned* st) {
    XcdBarrier b; b.bar = bar; b.x = xb_xcc_id(); b.st = st;
    if (threadIdx.x == 0) (void)xb_add(&bar[XB_XCNT(b.x)], 1u);
    return b;
}
__device__ __forceinline__ void xcd_barrier_complete(unsigned* bar, unsigned x, unsigned& nloc, unsigned& nx) {
    const unsigned G = gridDim.x * gridDim.y * gridDim.z;
    unsigned sum, cnt, mine, sp = 0u;
    for (;;) {
        sum = 0u; cnt = 0u; mine = 0u;
#pragma unroll
        for (unsigned j = 0; j < 16; ++j) { const unsigned c = xb_ld(&bar[XB_XCNT(j)]); sum += c; cnt += (c > 0u) ? 1u : 0u; mine = (j == x) ? c : mine; }
        if (sum == G) break;
        __builtin_amdgcn_s_sleep(1);
        if ((++sp & 255u) == 0u) { if (xb_ld(&bar[XB_TMO])) break; if (sp > XB_SPIN_CAP) { atomicAdd(&bar[XB_TMO], 1u); break; } }
    }
    nloc = mine > 0u ? mine : 1u; nx = cnt > 0u ? cnt : 1u;
}
__device__ __forceinline__ void xcd_barrier(const XcdBarrier& b) {
    asm volatile("s_waitcnt vmcnt(0)" ::: "memory");
    __syncthreads();
    if (threadIdx.x == 0) {
        unsigned* bar = b.bar;
        __builtin_amdgcn_s_waitcnt(0);
        unsigned nloc = b.st[0], nx = b.st[1];
        if (nloc == 0u) { xcd_barrier_complete(bar, b.x, nloc, nx); b.st[0] = nloc; b.st[1] = nx; }
        const unsigned old = xb_add(&bar[XB_XSUB(b.x)], 1u);
        const unsigned gen = old / nloc;
        if (old + 1u == (gen + 1u) * nloc) {
            __builtin_amdgcn_fence(__ATOMIC_RELEASE, "agent");
            asm volatile("s_waitcnt vmcnt(0)" ::: "memory");
            const unsigned og = xb_add(&bar[XB_TOP], 1u);
            const unsigned tg = og / nx;
            if (og + 1u == (tg + 1u) * nx) xb_add(&bar[XB_TOPGEN], 1u);
            else XB_SPIN(xb_ld(&bar[XB_TOPGEN]) == tg, bar);
            __builtin_amdgcn_fence(__ATOMIC_ACQUIRE, "agent");
            xb_add(&bar[XB_XGEN(b.x)], 1u);
            asm volatile("s_waitcnt vmcnt(0)" ::: "memory");
        } else {
            XB_SPIN(xb_ld(&bar[XB_XGEN(b.x)]) == gen, bar);
            __builtin_amdgcn_fence(__ATOMIC_ACQUIRE, "agent");
            asm volatile("s_waitcnt vmcnt(0)" ::: "memory");
        }
    }
    __syncthreads();
}

#define GRID_BAR() xcd_barrier(bar)

__device__ __forceinline__ void phase_stagger(int cls, unsigned ticks) {
    const unsigned long long t0 = __builtin_amdgcn_s_memrealtime(); const unsigned long long want = (unsigned long long)cls * ticks;
    while (__builtin_amdgcn_s_memrealtime() - t0 < want) __builtin_amdgcn_s_sleep(8);
}

struct Args {
    const float* x; const int* pos; const float* norm_mix_g; const float* w_in; const float* gm_ln_g; const float* gm_ln_b; const float* gm_w_s; const float* gm_b_s;
    const float* lam_q1; const float* lam_k1; const float* lam_q2; const float* lam_k2; const float* subln_g; const float* w_br_a; const float* w_br_b; const float* w_out;
    const float* norm_ffn_g; const float* w_rg; const float* b_rg; const float* w_re; const float* b_re; const float* w_gate; const float* w_up; const float* w_down; const float* final_g;
    float* out; unsigned char* ws;
};

__device__ __forceinline__ int wrow_map(int rmode, int n) { return rmode == 0 ? n : rmode == 1 ? ((n >> 5) * 128 + (n & 31)) : (((n >> 3) & 1) * 128 + (n >> 4) * 8 + (n & 7)); }
__device__ __forceinline__ void transpose_item(const float* W, int ldw, int k0, int n0, bf16_t* WT, int ldt, int drow0, int dk0, const float* gk, LAS float* scr, int lane, float sc = 1.0f, int rmode = 0) {
    f32x4 v[16];
    const int kr = lane >> 4, nc = (lane & 15) * 4;
#pragma unroll
    for (int i = 0; i < 16; ++i) v[i] = *(const f32x4*)(W + (size_t)(k0 + 4 * i + kr) * ldw + n0 + nc);
    if (gk) {
#pragma unroll
        for (int i = 0; i < 16; ++i) v[i] = v[i] * gk[k0 + 4 * i + kr];
    }
    if (sc != 1.0f) {
#pragma unroll
        for (int i = 0; i < 16; ++i) v[i] = v[i] * sc;
    }
#pragma unroll
    for (int i = 0; i < 16; ++i) { LAS float* d = scr + (4 * i + kr) * 65 + nc; d[0] = v[i][0]; d[1] = v[i][1]; d[2] = v[i][2]; d[3] = v[i][3]; }
    LDS_WAIT(); asm volatile("" ::: "memory");
    const int c = lane & 7;
#pragma unroll
    for (int j = 0; j < 8; ++j) { const int n = (lane >> 3) + 8 * j; const LAS float* s = scr + (8 * c) * 65 + n;
        u32x4 o; o.x = cvt_pk_bf16(s[0 * 65], s[1 * 65]); o.y = cvt_pk_bf16(s[2 * 65], s[3 * 65]); o.z = cvt_pk_bf16(s[4 * 65], s[5 * 65]); o.w = cvt_pk_bf16(s[6 * 65], s[7 * 65]);
        *(u32x4*)(WT + (size_t)(drow0 + wrow_map(rmode, n)) * ldt + dk0 + k0 + 8 * c) = o; }
    LDS_WAIT(); asm volatile("" ::: "memory");
}
__device__ __forceinline__ void transpose_item8(const float* W, int ldw, int k0, int n0, unsigned char* WT, int ldt, int drow0, const float* gk, float sc, LAS float* scr, int lane, int rmode = 0) {
    f32x4 v[16];
    const int kr = lane >> 4, nc = (lane & 15) * 4;
#pragma unroll
    for (int i = 0; i < 16; ++i) v[i] = *(const f32x4*)(W + (size_t)(k0 + 4 * i + kr) * ldw + n0 + nc);
#pragma unroll
    for (int i = 0; i < 16; ++i) v[i] = v[i] * (gk ? gk[k0 + 4 * i + kr] * sc : sc);
#pragma unroll
    for (int i = 0; i < 16; ++i) { LAS float* d = scr + (4 * i + kr) * 65 + nc; d[0] = v[i][0]; d[1] = v[i][1]; d[2] = v[i][2]; d[3] = v[i][3]; }
    LDS_WAIT(); asm volatile("" ::: "memory");
    const int c = lane & 7;
#pragma unroll
    for (int j = 0; j < 8; ++j) { const int n = (lane >> 3) + 8 * j; const LAS float* s = scr + (8 * c) * 65 + n;
        u32x2 o; o.x = cvt_pk4_fp8(s[0 * 65], s[1 * 65], s[2 * 65], s[3 * 65]); o.y = cvt_pk4_fp8(s[4 * 65], s[5 * 65], s[6 * 65], s[7 * 65]);
        *(u32x2*)(WT + (size_t)(drow0 + wrow_map(rmode, n)) * ldt + k0 + 8 * c) = o; }
    LDS_WAIT(); asm volatile("" ::: "memory");
}
__device__ __forceinline__ void expert_item(int r, const float* w_gate, const float* w_up, const float* w_down, const float* gffn, unsigned char* W13, unsigned char* W2, LAS float* scr, int lane) {
    constexpr int I_G = 32 * 128;
    if (r < 2 * I_G) { const int up = r >= I_G; if (up) r -= I_G; const int e = r / 128, q = r % 128, kb = q / 8, nb = q % 8;
        const int n0 = 64 * nb, drow = e * 1024 + (n0 >> 7) * 256 + up * 128 + (n0 & 127);
        transpose_item8((up ? w_up : w_gate) + (size_t)e * 1024 * 512, 512, 64 * kb, n0, W13, 1024, drow, gffn, 64.f, scr, lane); return; }
    r -= 2 * I_G;
    { const int e = r / 128, q = r % 128, kb = q / 16, nb = q % 16;
        transpose_item8(w_down + (size_t)e * 512 * 1024, 1024, 64 * kb, 64 * nb, W2, 512, e * 1024 + (nb >> 2) * 256 + (nb & 3) * 32, nullptr, 32.f, scr, lane, 2); }
}
__device__ __forceinline__ void rms_row_to_bf16(const float* xrow, const float* g, bf16_t* orow, int lane) {
    const f32x4* xr = (const f32x4*)xrow + lane; const f32x4* gr = (const f32x4*)g + lane;
    f32x4 v[4]; float s = 0.f;
#pragma unroll
    for (int j = 0; j < 4; ++j) { v[j] = xr[64 * j]; s += (v[j].x * v[j].x + v[j].y * v[j].y) + (v[j].z * v[j].z + v[j].w * v[j].w); }
    const float rstd = 1.f / sqrtf(wave_sum(s) * (1.f / D) + EPS);
    u32x2* o8 = (u32x2*)orow + lane;
#pragma unroll
    for (int j = 0; j < 4; ++j) { const f32x4 gg = gr[64 * j]; u32x2 w; w.x = cvt_pk_bf16(v[j].x * rstd * gg.x, v[j].y * rstd * gg.y); w.y = cvt_pk_bf16(v[j].z * rstd * gg.z, v[j].w * rstd * gg.w); o8[64 * j] = w; }
}

__global__ void __launch_bounds__(NTHREADS, 2) fwd_kernel(Args a) {
    extern __shared__ __attribute__((aligned(16))) unsigned char lds_raw[];
    LAS unsigned char* lds = (LAS unsigned char*)lds_raw;
    volatile LAS unsigned* LCTL = (volatile LAS unsigned*)(lds + LDSCTL_OFF);
    const int tid0 = threadIdx.x;
    const int G = gridDim.x, bx = blockIdx.x;
    const int vcu = (G % 8 == 0) ? (bx % 8) * (G / 8) + bx / 8 : bx;
    unsigned char* ws = a.ws;
    unsigned* ctl = (unsigned*)(ws + WS_CTL);
    __builtin_amdgcn_s_setreg((23 << 6) | 1, 1);
    for (int u = tid0; u < (LDS_BYTES - LDSCTL_OFF) / 4; u += NTHREADS) LCTL[u] = 0u;
    __syncthreads();
    XcdBarrier bar = xcd_barrier_post(ctl + CW_BAR, LCTL);
    const int NGW = G * NWAVES;
#define PHASE_IDS() const int tid = opaque_tid(), lane = tid & 63, wave = __builtin_amdgcn_readfirstlane(tid >> 6), gw = vcu * NWAVES + wave; (void)lane; (void)gw

    bf16_t* WIN = (bf16_t*)(ws + WS_WIN); bf16_t* WBR = (bf16_t*)(ws + WS_WBR); bf16_t* WO = (bf16_t*)(ws + WS_WO); unsigned char* W13 = ws + WS_W13; unsigned char* W2 = ws + WS_W2;
    bf16_t* WRH = (bf16_t*)(ws + WS_WRH); bf16_t* WRL = (bf16_t*)(ws + WS_WRL); float* CS = (float*)(ws + WS_CS); float* SSQ = (float*)(ws + WS_SSQ); float* RSTD = (float*)(ws + WS_RSTD); float* WTS = (float*)(ws + WS_WTS);
    int* LIST = (int*)(ws + WS_LIST);
    float* PARK = (float*)(ws + WS_PARK);
    bf16_t* XN = (bf16_t*)(ws + WS_RA); bf16_t* YAB = (bf16_t*)(ws + WS_RA); unsigned char* YB8 = ws + WS_RA;
    bf16_t* UV = (bf16_t*)(ws + WS_RB); bf16_t* MG = (bf16_t*)(ws + WS_RB);
    bf16_t* Qb = (bf16_t*)(ws + WS_RC); bf16_t* Kb = Qb + (size_t)T * 512; bf16_t* XB = (bf16_t*)(ws + WS_RC); unsigned char* V8T = ws + WS_RE + 128 * MiB; unsigned char* Q8 = V8T + 32 * MiB; unsigned char* K8 = Q8 + 16 * MiB;
    bf16_t* Vb = (bf16_t*)(ws + WS_RD);
    unsigned char* G8 = ws + WS_RE; unsigned char* H8 = ws + WS_RE; unsigned char* XB8 = ws + WS_RD;

    for (int rep = 0; rep < REPS(0); ++rep) {
        PHASE_IDS();
        LAS float* scr = (LAS float*)(lds + wave * 16896);
#if LEVEL >= 1
        constexpr int I_IN = 16 * 72, I_BA = 8 * 16, I_BB = 8 * 16, I_O = 16 * 16;
        constexpr int NITEMS = I_IN + I_BA + I_BB + I_O;
        for (int it = gw; it < NITEMS; it += NGW) {
            int r = it;
            if (r < I_IN) { const int kb = r / 72, nb = r % 72; transpose_item(a.w_in, IN_COLS, 64 * kb, 64 * nb, WIN, 1024, (nb >> 2) * 256 + (nb & 3) * 32, 0, nullptr, scr, lane, (64 * nb >= 2560) ? -LOG2E : 1.0f, (64 * nb >= 2560) ? 2 : 1); continue; } r -= I_IN;
            if (r < I_BA) { const int kb = r / 16, nb = r % 16; transpose_item(a.w_br_a, 1024, 64 * kb, 64 * nb, WBR, 1024, (nb >> 2) * 256 + (nb & 3) * 32, 0, nullptr, scr, lane, 1.0f, 1); continue; } r -= I_BA;
            if (r < I_BB) { const int kb = r / 16, nb = r % 16; transpose_item(a.w_br_b, 1024, 64 * kb, 64 * nb, WBR, 1024, (nb >> 2) * 256 + (nb & 3) * 32, 512, nullptr, scr, lane, 1.0f, 1); continue; } r -= I_BB;
            { const int kb = r / 16, nb = r % 16; transpose_item(a.w_out, 1024, 64 * kb, 64 * nb, WO, 1024, (nb >> 2) * 256 + (nb & 3) * 32, 0, nullptr, scr, lane, 1.0f, 1); }
        }
#if LEVEL >= 3
        for (int i = bx * NTHREADS + tid; i < 64 * 1024; i += G * NTHREADS) { const int n = i >> 10, k = i & 1023; float v = 0.f; if (n < 4) v = a.w_rg[k * 4 + n]; else if (n < 36) v = a.w_re[k * 32 + (n - 4)];
            v *= a.norm_ffn_g[k]; const unsigned h = cvt_pk_bf16(v, 0.f) & 0xffffu; const float r = v - __uint_as_float(h << 16); WRH[i] = (bf16_t)h; WRL[i] = (bf16_t)(cvt_pk_bf16(r, 0.f) & 0xffffu); }
#endif
        for (int i = bx * NTHREADS + tid; i < T * 8; i += G * NTHREADS) { const int t = i >> 3, j = i & 7;
            const double invf = exp2(-(double)j * (18.931568569324174 / 8.0));
            const double ang = (double)a.pos[t] * invf; const double kk = rint(ang * 0.15915494309189535); const float rr = (float)(ang - kk * 6.283185307179586);
            CS[t * 16 + j] = cosf(rr); CS[t * 16 + 8 + j] = sinf(rr); }
        for (int m = gw; m < T; m += NGW) rms_row_to_bf16(a.x + (size_t)m * D, a.norm_mix_g, XN + (size_t)m * D, lane);
#endif
    }
    GRID_BAR();

#if LEVEL >= 1 && !defined(NO_P1)
#if PROBE_PHASE == 66 || PROBE_PHASE == 67
    {
        pg8::DenseProb P; P.init(XN, WIN, T, IN_COLS, 1024, G, bx);
        pg8::EpiInProjT<PROBE_PHASE - 65> E{UV, Qb, Kb, Vb, G8, CS, Q8, K8};
        pg8::gemm_core<false, pg8::DenseProb, pg8::EpiInProjT<PROBE_PHASE - 65>, pg8::NoHook, 4>(lds, P, E, pg8::NoHook{});
    }
#endif
#if PROBE_PHASE == 64
    {
        pg8::DenseProb P; P.init(XN, WIN, T, IN_COLS, 1024, G, bx);
        pg8::EpiInProj E{UV, Qb, Kb, Vb, G8, CS, Q8, K8};
        pg8::gemm_core<false, pg8::DenseProb, pg8::EpiInProj, pg8::NoHook, 4>(lds, P, E, pg8::NoHook{});
    }
#endif
    for (int rep = 0; rep < REPS(1); ++rep) {
#ifdef STAG1
        phase_stagger(((bx >> 3) & 7) >> 1, STAG1);
#endif
        pg8::DenseProb P; P.init(XN, WIN, T, IN_COLS, 1024, G, bx);
        pg8::EpiInProj E{UV, Qb, Kb, Vb, G8, CS, Q8, K8};
        pg8::gemm_core<false>(lds, P, E, pg8::NoHook{});
    }
#if PROBE_PHASE == 11
    {
        pg8::DenseProb P; P.init(XN, WIN, T, IN_COLS, 1024, G, bx);
        pg8::gemm_core<false>(lds, P, pg8::EpiNull{}, pg8::NoHook{});
    }
#endif
#if PROBE_PHASE >= 61 && PROBE_PHASE <= 63
    {
        pg8::DenseProb P; P.init(XN, WIN, T, IN_COLS, 1024, G, bx);
        pg8::gemm_core<false, pg8::DenseProb, pg8::EpiNull, pg8::NoHook, PROBE_PHASE - 60>(lds, P, pg8::EpiNull{}, pg8::NoHook{});
    }
#endif
#if PROBE_PHASE == 31
    {
        pg8::DenseProb P; P.init(XN, WIN, T, IN_COLS, 1024, G, bx);
        pg8::gemm_core<false>(lds, P, pg8::EpiStoreOnly{(bf16_t*)(ws + WS_END)}, pg8::NoHook{});
    }
#endif
#if PROBE_PHASE == 12
    {
        pg8::DenseProbSame P; P.init(XN, WIN, T, IN_COLS, 1024, G, bx);
        pg8::gemm_core<false>(lds, P, pg8::EpiNull{}, pg8::NoHook{});
    }
#endif
#endif
    GRID_BAR();

#if LEVEL >= 1 && !defined(NO_P2A)
    for (int rep = 0; rep < REPS(2); ++rep) {
        PHASE_IDS();
        LAS bf16_t* VT = (LAS bf16_t*)lds;
        LAS float* SV = (LAS float*)(lds + 36864);
        const int r32 = lane & 31, hi = lane >> 5;
        for (int un = vcu; un < 2048; un += G) {
            const int ch = un >> 2, g = un & 3; const size_t row0 = (size_t)ch * 128;
            {
                const int s = tid >> 2, qd = tid & 3;
                const u32x4* vp = (const u32x4*)(UV + (row0 + s) * 1024 + 512 + g * 128 + qd * 32);
                float v[32]; float sm = 0.f;
#pragma unroll
                for (int j = 0; j < 4; ++j) { const u32x4 w = vp[j]; f32x4 x0, x1; pg8::unpack8(w, x0, x1);
#pragma unroll
                    for (int e = 0; e < 4; ++e) { v[8 * j + e] = x0[e]; v[8 * j + 4 + e] = x1[e]; sm += x0[e] + x1[e]; } }
                sm += __shfl_xor(sm, 1); sm += __shfl_xor(sm, 2);
                const float mu = sm * (1.0f / 128.0f); float sq = 0.f;
#pragma unroll
                for (int i = 0; i < 32; ++i) { v[i] -= mu; sq += v[i] * v[i]; }
                sq += __shfl_xor(sq, 1); sq += __shfl_xor(sq, 2);
                const float rstd = 1.0f / sqrtf(sq * (1.0f / 128.0f) + EPS);
                const float* lg = a.gm_ln_g + g * 128 + qd * 32; const float* lb = a.gm_ln_b + g * 128 + qd * 32;
#pragma unroll
                for (int i = 0; i < 32; ++i) { const float y = v[i] * rstd * lg[i] + lb[i]; VT[(qd * 32 + i) * 136 + s] = (bf16_t)(cvt_pk_bf16(y, 0.f) & 0xffffu); }
            }
            LDS_WAIT(); __syncthreads();
            {
                const int tb = wave >> 1, db0 = 2 * (wave & 1);
                f32x16 c0 = f32x16{}, c1 = f32x16{};
                const float* wrow = a.gm_w_s + ((size_t)g * 128 + tb * 32 + r32) * 128;
                const int trow = tb * 32 + r32;
                for (int ks = 0; ks <= 2 * tb + 1; ++ks) {
                    const int s0 = 16 * ks + 8 * hi;
                    const f32x4 wa = *(const f32x4*)(wrow + s0), wb = *(const f32x4*)(wrow + s0 + 4);
                    float w8[8] = {wa[0], wa[1], wa[2], wa[3], wb[0], wb[1], wb[2], wb[3]};
#pragma unroll
                    for (int j = 0; j < 8; ++j) if (s0 + j > trow) w8[j] = 0.f;
                    u32x4 aw; aw.x = cvt_pk_bf16(w8[0], w8[1]); aw.y = cvt_pk_bf16(w8[2], w8[3]); aw.z = cvt_pk_bf16(w8[4], w8[5]); aw.w = cvt_pk_bf16(w8[6], w8[7]);
                    const bf16x8 af = __builtin_bit_cast(bf16x8, aw);
                    const bf16x8 b0 = *(const LAS bf16x8*)(VT + ((db0 + 0) * 32 + r32) * 136 + s0);
                    const bf16x8 b1 = *(const LAS bf16x8*)(VT + ((db0 + 1) * 32 + r32) * 136 + s0);
                    c0 = __builtin_amdgcn_mfma_f32_32x32x16_bf16(af, b0, c0, 0, 0, 0);
                    c1 = __builtin_amdgcn_mfma_f32_32x32x16_bf16(af, b1, c1, 0, 0, 0);
                }
#pragma unroll
                for (int r = 0; r < 16; ++r) { const int t = tb * 32 + att::crow(r, hi); const float bs = a.gm_b_s[g * 128 + t];
                    SV[t * 132 + db0 * 32 + r32] = c0[r] + bs; SV[t * 132 + db0 * 32 + 32 + r32] = c1[r] + bs; }
            }
            LDS_WAIT(); __syncthreads();
            {
#pragma unroll
                for (int i = 0; i < 4; ++i) { const int t = i * 32 + (tid >> 4), dc = (tid & 15) * 8;
                    const size_t ro = (row0 + t) * 1024 + g * 128 + dc;
                    const u32x4 uw = *(const u32x4*)(UV + ro); f32x4 u0, u1; pg8::unpack8(uw, u0, u1);
                    const f32x4 s0 = *(const LAS f32x4*)(SV + t * 132 + dc), s1 = *(const LAS f32x4*)(SV + t * 132 + dc + 4);
                    *(u32x4*)(YAB + ro) = pg8::pack8(u0 * s0, u1 * s1); }
            }
            LDS_WAIT(); __syncthreads();
        }
    }
#endif
#if LEVEL >= 2
    {
        PHASE_IDS();
        LAS unsigned char* TB = (LAS unsigned char*)lds + wave * 8192;
        for (int tl = gw; tl < BATCH * 4 * (SEQ / 64); tl += NGW) {
            const int bh = tl >> 7, tt = tl & 127, b = bh >> 2, h = bh & 3;
            const bf16_t* vsrc = Vb + ((size_t)b * SEQ + tt * 64) * 512 + h * 128;
            u32x4 w[16];
#pragma unroll
            for (int i = 0; i < 16; ++i) w[i] = *(const u32x4*)(vsrc + (size_t)(i * 4 + (lane >> 4)) * 512 + (lane & 15) * 8);
#pragma unroll
            for (int i = 0; i < 16; ++i) { const int key = i * 4 + (lane >> 4), kk = key & 31, khi = (kk >> 2) & 1, j = (kk & 3) + 4 * (kk >> 3) + 16 * (key >> 5), cc = khi * 2 + (j >> 4);
                f32x4 x0, x1; pg8::unpack8(w[i], x0, x1); const unsigned q0_ = cvt_pk4_fp8(x0[0], x0[1], x0[2], x0[3]), q1_ = cvt_pk4_fp8(x1[0], x1[1], x1[2], x1[3]);
#pragma unroll
                for (int e = 0; e < 8; ++e) { const int d = (lane & 15) * 8 + e; const unsigned byte = ((e < 4 ? q0_ : q1_) >> (8 * (e & 3))) & 0xffu;
                    TB[d * 64 + ((cc ^ ((d >> 2) & 3)) * 16) + (j & 15)] = (unsigned char)byte; } }
            LDS_WAIT(); asm volatile("" ::: "memory");
            unsigned char* dst = V8T + (size_t)tl * 8192;
#pragma unroll
            for (int i = 0; i < 8; ++i) *(u32x4*)(dst + (i * 64 + lane) * 16) = *(const LAS u32x4*)(TB + (i * 64 + lane) * 16);
            LDS_WAIT(); asm volatile("" ::: "memory");
        }
    }
    GRID_BAR();
#endif
#if LEVEL >= 2 && !defined(NO_P2B)
    {
        PHASE_IDS();
        float lam;
        { const float p1 = wave_sum(a.lam_q1[lane] * a.lam_k1[lane]), p2 = wave_sum(a.lam_q2[lane] * a.lam_k2[lane]); lam = expf(p1) - expf(p2) + 0.2f; }
        const int bh = vcu >> 3, s = vcu & 7, b = bh >> 2, h = bh & 3;
        float* park = PARK + (size_t)bx * 32768;
        if (G == 256) {
            for (int ii = 0; ii < 4 * REPS(3); ++ii) { const int i = ii & 3; const int qb = (i == 0) ? s : (i == 1) ? 15 - s : (i == 2) ? 16 + s : 31 - s;
                att::attn_unit<0>(b, h, qb, Qb, Kb, Q8, K8, V8T, YAB, park, lam, a.subln_g, (LAS char*)lds);
#if LEVEL >= 3
                if (ii < 4) {
                    LAS float* scr = (LAS float*)(lds + wave * 16896);
                    for (int k = wave; k < 12; k += NWAVES) expert_item((bx * 4 + ii) * 12 + k, a.w_gate, a.w_up, a.w_down, a.norm_ffn_g, W13, W2, scr, lane);
                    LDS_WAIT(); __syncthreads();
                }
#endif
            }
#if PROBE_PHASE == 13 || PROBE_PHASE == 14 || PROBE_PHASE == 15 || PROBE_PHASE == 16
            for (int i = 0; i < 4; ++i) { const int qb = (i == 0) ? s : (i == 1) ? 15 - s : (i == 2) ? 16 + s : 31 - s;
                att::attn_unit<PROBE_PHASE - 13>(0, 0, qb, Qb, Kb, Q8, K8, V8T, (bf16_t*)(ws + WS_END), park, lam, a.subln_g, (LAS char*)lds); }
#endif
        }
    }
#elif LEVEL >= 1
    {
        PHASE_IDS();
        for (int i = bx * NTHREADS + tid; i < T * 64; i += G * NTHREADS) { const int row = i >> 6, c = i & 63; *(u32x4*)(YAB + (size_t)row * 1024 + 512 + c * 8) = (u32x4){0u, 0u, 0u, 0u}; }
    }
#endif
    GRID_BAR();

#if LEVEL >= 1 && !defined(NO_P3)
    for (int rep = 0; rep < REPS(4); ++rep) {
        pg8::PanelProb P; P.init(YAB, WBR, T, 1024, 1024, G, bx);
        pg8::EpiMerge E{G8, MG};
        pg8::gemm_core<false>(lds, P, E, pg8::HookMerge{G8});
    }
#endif
    asm volatile("s_waitcnt vmcnt(0)" ::: "memory"); __syncthreads();
#if LEVEL >= 1 && !defined(NO_P4)
    for (int rep = 0; rep < REPS(5); ++rep) {
        pg8::PanelProb P; P.init(MG, WO, T, 1024, 1024, G, bx);
        pg8::EpiX1 E{a.x, XB, XB8, SSQ};
        pg8::gemm_core<false>(lds, P, E, pg8::NoHook{});
    }
#endif
    asm volatile("s_waitcnt vmcnt(0)" ::: "memory"); __syncthreads();

#if LEVEL >= 3 && !defined(NO_P5)
    {
        PHASE_IDS();
        LAS float* LG = (LAS float*)lds;
        volatile LAS int* LCNT = (volatile LAS int*)(LCTL + 96); volatile LAS int* LBASE = (volatile LAS int*)(LCTL + 128);
        const int r32 = lane & 31, hi = lane >> 5;
        for (int tb = bx; tb < T / 256; tb += G) {
            const size_t tok0 = (size_t)tb * 256 + wave * 32;
            const bf16_t* xa = XB + (tok0 + r32) * 1024 + hi * 8;
            const bf16_t* wh0 = WRH + (size_t)r32 * 1024 + hi * 8; const bf16_t* wh1 = wh0 + 32 * 1024;
            const bf16_t* wl0 = WRL + (size_t)r32 * 1024 + hi * 8; const bf16_t* wl1 = wl0 + 32 * 1024;
            f32x16 c0 = f32x16{}, c1 = f32x16{};
#pragma unroll 4
            for (int ks = 0; ks < 64; ++ks) {
                const bf16x8 av = *(const bf16x8*)(xa + ks * 16);
                const bf16x8 h0 = *(const bf16x8*)(wh0 + ks * 16), h1 = *(const bf16x8*)(wh1 + ks * 16), l0 = *(const bf16x8*)(wl0 + ks * 16), l1 = *(const bf16x8*)(wl1 + ks * 16);
                c0 = __builtin_amdgcn_mfma_f32_32x32x16_bf16(av, h0, c0, 0, 0, 0); c1 = __builtin_amdgcn_mfma_f32_32x32x16_bf16(av, h1, c1, 0, 0, 0);
                c0 = __builtin_amdgcn_mfma_f32_32x32x16_bf16(av, l0, c0, 0, 0, 0); c1 = __builtin_amdgcn_mfma_f32_32x32x16_bf16(av, l1, c1, 0, 0, 0);
            }
#pragma unroll
            for (int r = 0; r < 16; ++r) { const int tl = wave * 32 + att::crow(r, hi); LG[tl * 37 + r32] = c0[r]; if (r32 < 4) LG[tl * 37 + 32 + r32] = c1[r]; }
            if (tid < 32) LCNT[tid] = 0;
            LDS_WAIT(); __syncthreads();
            int eid0 = 0, eid1 = 0, rk0 = 0, rk1 = 0; float w0 = 0.f, w1 = 0.f; const size_t tok = (size_t)tb * 256 + tid;
            if (tid < 256) {
                float ssq = 0.f;
#pragma unroll
                for (int j = 0; j < 16; ++j) ssq += SSQ[tok * 16 + j];
                const float rstd = 1.0f / sqrtf(ssq * (1.0f / 1024.0f) + EPS);
                RSTD[tok] = rstd;
                const LAS float* p0 = LG + tid * 37;
                float gl[4]; int grp = 0;
#pragma unroll
                for (int j = 0; j < 4; ++j) gl[j] = p0[j] * rstd + a.b_rg[j];
                float gmx = gl[0];
#pragma unroll
                for (int j = 1; j < 4; ++j) if (gl[j] > gmx) { gmx = gl[j]; grp = j; }
                float gs = 0.f;
#pragma unroll
                for (int j = 0; j < 4; ++j) gs += expf(gl[j] - gmx);
                const float gwt = 1.0f / gs;
                float el[8];
#pragma unroll
                for (int j = 0; j < 8; ++j) el[j] = p0[4 + grp * 8 + j] * rstd + a.b_re[grp * 8 + j];
                int i0 = 0; float v0 = el[0];
#pragma unroll
                for (int j = 1; j < 8; ++j) if (el[j] > v0) { v0 = el[j]; i0 = j; }
                int i1 = -1; float v1 = -INFINITY;
#pragma unroll
                for (int j = 0; j < 8; ++j) if (j != i0 && el[j] > v1) { v1 = el[j]; i1 = j; }
                const float e1 = expf(v1 - v0); w0 = gwt / (1.0f + e1); w1 = gwt * e1 / (1.0f + e1);
                eid0 = grp * 8 + i0; eid1 = grp * 8 + i1;
                rk0 = atomicAdd((int*)(LCNT + eid0), 1); rk1 = atomicAdd((int*)(LCNT + eid1), 1);
            }
            LDS_WAIT(); __syncthreads();
            if (tid < 32) LBASE[tid] = (int)__hip_atomic_fetch_add(ctl + CW_CNT + tid, (unsigned)LCNT[tid], RLX_AGENT);
            LDS_WAIT(); __syncthreads();
            if (tid < 256) {
                const int s0_ = eid0 * LISTCAP + LBASE[eid0] + rk0, s1_ = eid1 * LISTCAP + LBASE[eid1] + rk1;
                LIST[s0_] = (int)(((unsigned)(tok * 2) << 15) | (cvt_pk_bf16(w0, 0.f) & 0x7fffu)); LIST[s1_] = (int)(((unsigned)(tok * 2 + 1) << 15) | (cvt_pk_bf16(w1, 0.f) & 0x7fffu));
            }
            LDS_WAIT(); __syncthreads();
        }
    }
#endif
    GRID_BAR();
#if LEVEL >= 3
    {
        PHASE_IDS();
        volatile LAS int* BST = (volatile LAS int*)(LCTL + 16); volatile LAS int* CNT = (volatile LAS int*)(LCTL + 64);
        if (tid == 0) { int accb = 0; for (int e = 0; e < NEXP; ++e) { const int c = (int)__hip_atomic_load(ctl + CW_CNT + e, RLX_AGENT); CNT[e] = c; BST[e] = accb; accb += (c + 255) >> 8; } BST[NEXP] = accb; }
        LDS_WAIT(); __syncthreads();
    }
#if !defined(NO_P6)
    for (int rep = 0; rep < REPS(6); ++rep) {
        pg8::MoeUpProb P; P.init((const LAS int*)(LCTL + 16), (const LAS int*)(LCTL + 64), G, bx); P.A = (const char*)XB8; P.Bt = (const char*)W13; P.pitch = 1024; P.list = LIST;
        pg8::EpiMoeUp E{LIST, RSTD, H8, {}};
        pg8::gemm_core<true>(lds, P, E, pg8::NoHook{});
    }
#endif
#endif
    GRID_BAR();
#if LEVEL >= 3 && !defined(NO_P7)
    for (int rep = 0; rep < REPS(7); ++rep) {
        pg8::MoeDownProb P; P.init((const LAS int*)(LCTL + 16), (const LAS int*)(LCTL + 64), G, bx); P.A = (const char*)H8; P.Bt = (const char*)W2; P.pitch = 512;
        pg8::EpiMoeDown E{LIST, YB8, {}};
        pg8::gemm_core<true>(lds, P, E, pg8::NoHook{});
    }
#endif
    GRID_BAR();

    {
        PHASE_IDS();
        const bool tmo = (__hip_atomic_load(ctl + CW_BAR + XB_TMO, RLX_AGENT) != 0u);
        for (int m = gw; m < T; m += NGW) {
            const f32x4* gr = (const f32x4*)a.final_g + lane;
            f32x4 v[4]; float s = 0.f;
#pragma unroll
            for (int j = 0; j < 4; ++j) {
#if LEVEL >= 1
                { const u32x2 xw = *((const u32x2*)(XB + (size_t)m * D) + lane + 64 * j); v[j] = (f32x4){bf_lo(xw.x), bf_hi(xw.x), bf_lo(xw.y), bf_hi(xw.y)}; }
#else
                v[j] = ((const f32x4*)(a.x + (size_t)m * D) + lane)[64 * j];
#endif
#if LEVEL >= 3
                const unsigned y0 = *((const unsigned*)(YB8 + (size_t)(2 * m) * D) + lane + 64 * j), y1 = *((const unsigned*)(YB8 + (size_t)(2 * m + 1) * D) + lane + 64 * j);
                v[j] = v[j] + (fp8x4_to_f32(y0) + fp8x4_to_f32(y1)) * 0.0625f;
#endif
                s += (v[j].x * v[j].x + v[j].y * v[j].y) + (v[j].z * v[j].z + v[j].w * v[j].w); }
            float rstd = 1.f / sqrtf(wave_sum(s) * (1.f / D) + EPS);
            if (tmo) rstd = __builtin_nanf("");
            f32x4* o = (f32x4*)(a.out + (size_t)m * D) + lane;
#pragma unroll
            for (int j = 0; j < 4; ++j) { f32x4 ov = v[j] * rstd * gr[64 * j];
#if PROBE_PHASE == 50
#pragma unroll
                for (int e = 0; e < 4; ++e) if (!(__builtin_fabsf(ov[e]) < 1e30f)) ov[e] = 0.f;
#endif
                o[64 * j] = ov; }
        }
    }
}

extern "C" void kernel_launch(void* const* d_in, const int* in_sizes, int n_in, void* d_out, int out_size, void* d_ws, size_t ws_size, hipStream_t stream) {
    static int grid = 0;
    if (grid == 0) {
        if (n_in != 25 || in_sizes[0] != T * D || out_size != T * D || ws_size < WS_END + 64 * MiB) { fprintf(stderr, "kernel_launch: unexpected shapes (n_in %d, in0 %d, out %d, ws %zu); nothing launched\n", n_in, n_in > 0 ? in_sizes[0] : -1, out_size, ws_size); grid = -1; return; }
        int dev = 0, cus = 0, per_cu = 0;
        if (hipGetDevice(&dev) != hipSuccess || hipDeviceGetAttribute(&cus, hipDeviceAttributeMultiprocessorCount, dev) != hipSuccess) { grid = -1; return; }
        if (hipFuncSetAttribute((const void*)fwd_kernel, hipFuncAttributeMaxDynamicSharedMemorySize, LDS_BYTES) != hipSuccess) { fprintf(stderr, "kernel_launch: hipFuncSetAttribute failed\n"); grid = -1; return; }
        if (hipOccupancyMaxActiveBlocksPerMultiprocessor(&per_cu, (const void*)fwd_kernel, NTHREADS, LDS_BYTES) != hipSuccess || per_cu < 1) fprintf(stderr, "kernel_launch: occupancy query reports %d\n", per_cu);
        (void)hipGetLastError();
        grid = cus;
        if (grid != 256) fprintf(stderr, "kernel_launch: %d CUs (built for 256)\n", grid);
    }
    if (grid < 0) return;
    if (hipMemsetAsync((char*)d_ws + WS_CTL, 0, CTL_ZERO_BYTES, stream) != hipSuccess) return;
    Args a{};
    a.x = (const float*)d_in[0]; a.pos = (const int*)d_in[1]; a.norm_mix_g = (const float*)d_in[2]; a.w_in = (const float*)d_in[3]; a.gm_ln_g = (const float*)d_in[4]; a.gm_ln_b = (const float*)d_in[5];
    a.gm_w_s = (const float*)d_in[6]; a.gm_b_s = (const float*)d_in[7]; a.lam_q1 = (const float*)d_in[8]; a.lam_k1 = (const float*)d_in[9]; a.lam_q2 = (const float*)d_in[10]; a.lam_k2 = (const float*)d_in[11];
    a.subln_g = (const float*)d_in[12]; a.w_br_a = (const float*)d_in[13]; a.w_br_b = (const float*)d_in[14]; a.w_out = (const float*)d_in[15]; a.norm_ffn_g = (const float*)d_in[16];
    a.w_rg = (const float*)d_in[17]; a.b_rg = (const float*)d_in[18]; a.w_re = (const float*)d_in[19]; a.b_re = (const float*)d_in[20]; a.w_gate = (const float*)d_in[21]; a.w_up = (const float*)d_in[22];
    a.w_down = (const float*)d_in[23]; a.final_g = (const float*)d_in[24];
    a.out = (float*)d_out; a.ws = (unsigned char*)d_ws;
    hipLaunchKernelGGL(fwd_kernel, dim3(grid), dim3(NTHREADS), LDS_BYTES, stream, a);
    const hipError_t le = hipPeekAtLastError();
    if (le != hipSuccess) fprintf(stderr, "kernel_launch: launch failed: %s\n", hipGetErrorName(le));
}
```

```cpp
#include <hip/hip_runtime.h>
#include <cstdio>
#include <cstdint>

#ifndef LEVEL
#define LEVEL 3
#endif

#ifndef PROBE_PHASE
#define PROBE_PHASE -1
#endif
#define REPS(p) ((PROBE_PHASE == (p)) ? 2 : 1)
#define LAS __attribute__((address_space(3)))
#define GAS __attribute__((address_space(1)))
typedef unsigned short bf16_t;
typedef short bf16x8 __attribute__((ext_vector_type(8)));
typedef short s16x4 __attribute__((ext_vector_type(4)));
typedef float f32x2 __attribute__((ext_vector_type(2)));
typedef float f32x4 __attribute__((ext_vector_type(4)));
typedef float f32x16 __attribute__((ext_vector_type(16)));
typedef unsigned u32x2 __attribute__((ext_vector_type(2)));
typedef unsigned u32x4 __attribute__((ext_vector_type(4)));
typedef int i32x8 __attribute__((ext_vector_type(8)));
typedef short s16x16 __attribute__((ext_vector_type(16)));

constexpr int D = 1024, BATCH = 8, SEQ = 8192, T = BATCH * SEQ;
constexpr int IN_COLS = 4608;
constexpr int NEXP = 32, DEXP = 512;
constexpr int LISTCAP = T;
constexpr float EPS = 1e-6f;
constexpr float LOG2E = 1.4426950408889634f;
constexpr float C2 = 0.125f * LOG2E;
constexpr int NWAVES = 8, NTHREADS = 512;

constexpr size_t MiB = 1u << 20;
constexpr size_t WS_CTL = 0, CTL_ZERO_BYTES = 1 * MiB;
constexpr size_t WS_WIN = 2 * MiB;
constexpr size_t WS_WBR = 12 * MiB;
constexpr size_t WS_WO = 14 * MiB;
constexpr size_t WS_W13 = 16 * MiB;
constexpr size_t WS_W2 = 80 * MiB;
constexpr size_t WS_WRH = 112 * MiB;
constexpr size_t WS_WRL = 112 * MiB + 131072;
constexpr size_t WS_CS = 113 * MiB;
constexpr size_t WS_SSQ = 117 * MiB;
constexpr size_t WS_RSTD = 121 * MiB;
constexpr size_t WS_WTS = 122 * MiB;
constexpr size_t WS_LIST = 123 * MiB;
constexpr size_t WS_PARK = 131 * MiB;
constexpr size_t WS_RA = 164 * MiB;
constexpr size_t WS_RB = 292 * MiB;
constexpr size_t WS_RC = 420 * MiB;
constexpr size_t WS_RD = 548 * MiB;
constexpr size_t WS_RE = 612 * MiB;
constexpr size_t WS_END = 868 * MiB;
constexpr int CW_TMO = 0;
constexpr int CW_BAR = 4096;
constexpr int CW_CNT = 8192;

constexpr int RING_BYTES = 147456;
constexpr int LDSCTL_OFF = RING_BYTES;
constexpr int LDS_BYTES = RING_BYTES + 1024;

#define RLX_AGENT __ATOMIC_RELAXED, __HIP_MEMORY_SCOPE_AGENT
#define LDS_WAIT() asm volatile("s_waitcnt lgkmcnt(0)" ::: "memory")
#define VM_WAIT() asm volatile("s_waitcnt vmcnt(0)" ::: "memory")

__device__ __forceinline__ unsigned cvt_pk_bf16(float lo, float hi) { unsigned r; asm("v_cvt_pk_bf16_f32 %0, %1, %2" : "=v"(r) : "v"(lo), "v"(hi)); return r; }
__device__ __forceinline__ unsigned cvt_pk4_fp8(float a, float b, float c, float d) { int w; asm("v_cvt_pk_fp8_f32 %0, %1, %2" : "=v"(w) : "v"(a), "v"(b)); w = __builtin_amdgcn_cvt_pk_fp8_f32(c, d, w, true); return (unsigned)w; }
__device__ __forceinline__ unsigned cvt_pk4_u8(float a, float b, float c, float d) { unsigned w = 0; w = __builtin_amdgcn_cvt_pk_u8_f32(a, 0, w); w = __builtin_amdgcn_cvt_pk_u8_f32(b, 1, w); w = __builtin_amdgcn_cvt_pk_u8_f32(c, 2, w); w = __builtin_amdgcn_cvt_pk_u8_f32(d, 3, w); return w; }
__device__ __forceinline__ f32x4 u8x4_to_f32(unsigned w) { return (f32x4){(float)(w & 0xffu), (float)((w >> 8) & 0xffu), (float)((w >> 16) & 0xffu), (float)(w >> 24)}; }
__device__ __forceinline__ f32x4 fp8x4_to_f32(unsigned w) { const f32x2 lo = __builtin_amdgcn_cvt_pk_f32_fp8((int)w, false), hi = __builtin_amdgcn_cvt_pk_f32_fp8((int)w, true); return (f32x4){lo[0], lo[1], hi[0], hi[1]}; }
__device__ __forceinline__ float bf_lo(unsigned w) { return __uint_as_float(w << 16); }
__device__ __forceinline__ float bf_hi(unsigned w) { return __uint_as_float(w & 0xffff0000u); }
__device__ __forceinline__ float fast_exp2(float x) { return __builtin_amdgcn_exp2f(x); }
__device__ __forceinline__ float fast_rcp(float x) { return __builtin_amdgcn_rcpf(x); }
__device__ __forceinline__ float sigmoidf_(float x) { return fast_rcp(1.0f + fast_exp2(-LOG2E * x)); }
__device__ __forceinline__ float gelu_tanh(float x) {
    const float u = x * (0.7978845608028654f + 0.0356774081363001f * x * x);
    return x * fast_rcp(1.0f + fast_exp2(-2.0f * LOG2E * u));
}
__device__ __forceinline__ int opaque_tid() { int t = threadIdx.x; asm volatile("" : "+v"(t)); return t; }
__device__ __forceinline__ float wave_sum(float v) {
#pragma unroll
    for (int o = 1; o < 64; o <<= 1) v += __shfl_xor(v, o);
    return v;
}

namespace pg8 {
constexpr int BM = 256, BK = 64, HALF = 128, HTB = HALF * BK * 2, STAGE_BYTES = 8 * HTB, NXCD = 8, WGM = 8;
__host__ __device__ __forceinline__ int lds_byte(int r, int c) { const int st = (r >> 4) * 2 + (c >> 5), rr = r & 15, cc = c & 31, ob = rr * 64 + cc * 2; return st * 1024 + (ob ^ (((ob >> 9) & 1) << 5)); }
__host__ __device__ __forceinline__ void stage_rc(int b, int& R, int& C) { const int st = b / 1024, sb = b % 1024, swz = sb ^ (((sb >> 9) & 1) << 5); R = (st >> 1) * 16 + swz / 64; C = (st & 1) * 32 + (swz % 64) / 2; }
__host__ __device__ __forceinline__ int perm32(int rho) { const int n = rho >> 4, i = rho & 15; return 8 * (i >> 2) + 4 * n + (i & 3); }

struct Unit { int pm, pn, e, lbase, nv; };

struct DenseProb {
    static constexpr bool GATHER = false;
    const char* A; const char* Bt; int pitch  ; int nM, nN, nwg, G, c;
    __device__ __forceinline__ void init(const void* A_, const void* Bt_, int M, int N, int K_, int G_, int c_) { A = (const char*)A_; Bt = (const char*)Bt_; pitch = K_ * 2; nM = M / BM; nN = N / BM; nwg = nM * nN; G = G_; c = c_; }
    __device__ __forceinline__ bool next(int i, Unit& u) const {
        const long L = (long)i * G + c; if (L >= nwg) return false;
        int wgid = (int)L; { const int q = nwg / NXCD, r = nwg % NXCD, xcd = wgid % NXCD, off = wgid / NXCD; wgid = (xcd < r ? xcd * (q + 1) : r * (q + 1) + (xcd - r) * q) + off; }
        const int nig = WGM * nN, gid = wgid / nig, fm = gid * WGM, gsz = (nM - fm) < WGM ? (nM - fm) : WGM;
        u.pm = fm + ((wgid % nig) % gsz); u.pn = (wgid % nig) / gsz; u.e = 0; u.lbase = 0; u.nv = 256; return true;
    }
    __device__ __forceinline__ void a_offs(const Unit& u, const int (&R)[2], const int (&C)[2], unsigned (&o)[2][2]) const {
#pragma unroll
        for (int h = 0; h < 2; ++h)
#pragma unroll
            for (int i = 0; i < 2; ++i) o[h][i] = (unsigned)((u.pm * BM + h * HALF + R[i]) * pitch + C[i] * 2);
    }
    __device__ __forceinline__ const char* b_tile(const Unit& u) const { return Bt + (size_t)u.pn * BM * pitch; }
    __device__ __forceinline__ const char* a_tile(const Unit& u) const { return A + (size_t)u.pm * BM * pitch; }
};

struct PanelProb : DenseProb {
    __device__ __forceinline__ bool next(int i, Unit& u) const { if (i >= nN || c >= nM) return false; u.pm = c; u.pn = i; u.e = 0; u.lbase = 0; u.nv = 256; return true; }
};
struct MoeOrder {
    const LAS int* bstart; const LAS int* cnt; int nblk, nwg, G, c;
    __device__ __forceinline__ void init(const LAS int* bs, const LAS int* cn, int G_, int c_) { bstart = bs; cnt = cn; nblk = bs[NEXP]; nwg = nblk * 4; G = G_; c = c_; }
    __device__ __forceinline__ bool next(int i, Unit& u) const {
        const long L = (long)i * G + c; if (L >= nwg) return false;
        int wgid = (int)L; { const int q = nwg / NXCD, r = nwg % NXCD, xcd = wgid % NXCD, off = wgid / NXCD; wgid = (xcd < r ? xcd * (q + 1) : r * (q + 1) + (xcd - r) * q) + off; }
        const int gid = wgid / 32, fm = gid * 8, gsz = (nblk - fm) < 8 ? (nblk - fm) : 8, w = wgid - gid * 32;
        const int blk = fm + (w % gsz); u.pn = w / gsz; u.pm = blk;
        int e = 0;
        while (e < NEXP - 1 && blk >= bstart[e + 1]) ++e;
        const int rb = blk - bstart[e]; u.e = e; u.lbase = e * LISTCAP + rb * 256; const int rem = cnt[e] - rb * 256; u.nv = rem < 256 ? rem : 256; return true;
    }
};
struct MoeUpProb : MoeOrder {
    static constexpr bool GATHER = true;
    const char* A; const char* Bt; int pitch; const int* list;
    __device__ __forceinline__ const char* a_tile(const Unit&) const { return A; }
    __device__ __forceinline__ void a_offs(const Unit& u, const int (&R)[2], const int (&C)[2], unsigned (&o)[2][2]) const {
#pragma unroll
        for (int h = 0; h < 2; ++h)
#pragma unroll
            for (int i = 0; i < 2; ++i) { const int r = h * HALF + R[i]; const int tok = (r < u.nv) ? (int)((unsigned)list[u.lbase + r] >> 16) : 0; o[h][i] = (unsigned)(tok * pitch + C[i] * 2); }
    }
    __device__ __forceinline__ const char* b_tile(const Unit& u) const { return Bt + ((size_t)u.e * 1024 + (size_t)u.pn * BM) * pitch; }
};
struct MoeDownProb : MoeOrder {
    static constexpr bool GATHER = false;
    const char* A; const char* Bt; int pitch;
    __device__ __forceinline__ const char* a_tile(const Unit& u) const { return A + (size_t)u.pm * BM * pitch; }
    __device__ __forceinline__ void a_offs(const Unit& u, const int (&R)[2], const int (&C)[2], unsigned (&o)[2][2]) const {
#pragma unroll
        for (int h = 0; h < 2; ++h)
#pragma unroll
            for (int i = 0; i < 2; ++i) o[h][i] = (unsigned)((u.pm * BM + h * HALF + R[i]) * pitch + C[i] * 2);
    }
    __device__ __forceinline__ const char* b_tile(const Unit& u) const { return Bt + ((size_t)u.e * 1024 + (size_t)u.pn * BM) * pitch; }
};

struct EpiNull { __device__ __forceinline__ void prefetch(const Unit&, int, int, int, int) const {}
    __device__ __forceinline__ void operator()(f32x4 (&acc)[2][2][4][2], const Unit&, int, int, int, int) const {
#pragma unroll
    for (int a = 0; a < 2; ++a)
#pragma unroll
        for (int b = 0; b < 2; ++b)
#pragma unroll
            for (int m = 0; m < 4; ++m) asm volatile("" :: "v"(acc[a][b][m][0]), "v"(acc[a][b][m][1])); } };
struct DenseProbSame : DenseProb {
    __device__ __forceinline__ void a_offs(const Unit&, const int (&R)[2], const int (&C)[2], unsigned (&o)[2][2]) const { Unit z{0, 0, 0, 0, 256}; DenseProb::a_offs(z, R, C, o); }
    __device__ __forceinline__ const char* b_tile(const Unit&) const { return Bt; }
};
struct NoHook { static constexpr int AT = -1; __device__ __forceinline__ void operator()(f32x4 (&)[2][2][4][2], const Unit&, int, int, int, int) const {} };

template <bool FP8, class Prob, class Epi, class Hook, int PM = 0>
__device__ __forceinline__ void gemm_core(LAS unsigned char* lds, const Prob& P, const Epi& E, const Hook& HK) {
    const int tid = opaque_tid(), wid = __builtin_amdgcn_readfirstlane(tid >> 6), lane = tid & 63, wr = wid >> 2, wc = wid & 3, fr = lane & 15, fq = lane >> 4;
    const int pitch = P.pitch, nt = pitch / (BK * 2);
    int R[2], C[2]; unsigned voffB[2], voffA[2];
#pragma unroll
    for (int i = 0; i < 2; ++i) { stage_rc(tid * 16 + i * 8192, R[i], C[i]); const int Rb = (R[i] & ~31) + perm32(R[i] & 31); voffB[i] = (unsigned)(Rb * pitch + C[i] * 2); voffA[i] = (unsigned)(R[i] * pitch + C[i] * 2); }
    const size_t kstep = (size_t)(BK * 2);
    const size_t hstep = (size_t)HALF * pitch;
    const unsigned ldsw = (unsigned)wid * 1024u;
    const int aoff = lds_byte(wr * 64 + fr, fq * 8), boff = lds_byte(wc * 32 + fr, fq * 8);
#define PG8_SA(b, h) (((b) * 2 + (h)) * HTB)
#define PG8_SB(b, h) ((4 + (b) * 2 + (h)) * HTB)
#define PG8_STAGE_B(bufoff, gbase) do { if constexpr (PM != 1) _Pragma("unroll") for (int _i = 0; _i < 2; ++_i) \
        __builtin_amdgcn_global_load_lds((const unsigned*)((const char*)(gbase) + voffB[_i]), (LAS unsigned*)(lds + (bufoff) + ldsw + _i * 8192), 16, 0, 0); } while (0)
#define PG8_STAGE_AG(bufoff, kb, va) do { if constexpr (PM != 1) _Pragma("unroll") for (int _i = 0; _i < 2; ++_i) \
        __builtin_amdgcn_global_load_lds((const unsigned*)(P.A + (kb) + (va)[_i]), (LAS unsigned*)(lds + (bufoff) + ldsw + _i * 8192), 16, 0, 0); } while (0)
#define PG8_STAGE_AD(bufoff, ubase) do { if constexpr (PM != 1) _Pragma("unroll") for (int _i = 0; _i < 2; ++_i) \
        __builtin_amdgcn_global_load_lds((const unsigned*)((const char*)(ubase) + voffA[_i]), (LAS unsigned*)(lds + (bufoff) + ldsw + _i * 8192), 16, 0, 0); } while (0)
#define PG8_STAGE_AC(bufoff, kb, h) do { if constexpr (Prob::GATHER) { PG8_STAGE_AG(bufoff, kb, cvA[h]); } else { PG8_STAGE_AD(bufoff, cA + (h) * hstep + (kb)); } } while (0)
#define PG8_STAGE_AN(bufoff, kb, h) do { if constexpr (Prob::GATHER) { PG8_STAGE_AG(bufoff, kb, v2[h]); } else { PG8_STAGE_AD(bufoff, (last ? nA : cA) + (h) * hstep + (kb)); } } while (0)
#define PG8_LDA(dst, b, h) do { _Pragma("unroll") for (int m = 0; m < 4; ++m) _Pragma("unroll") for (int k = 0; k < 2; ++k) { if constexpr (PM == 3) asm volatile("" : "=v"(dst[m][k])); else dst[m][k] = *(const LAS bf16x8*)(lds + PG8_SA(b, h) + aoff + m * 2048 + k * 1024); } } while (0)
#define PG8_LDB(dst, b, h) do { _Pragma("unroll") for (int n = 0; n < 2; ++n) _Pragma("unroll") for (int k = 0; k < 2; ++k) { if constexpr (PM == 3) asm volatile("" : "=v"(dst[n][k])); else dst[n][k] = *(const LAS bf16x8*)(lds + PG8_SB(b, h) + boff + n * 2048 + k * 1024); } } while (0)
#define PG8_CAT(x) __builtin_bit_cast(i32x8, __builtin_shufflevector((x)[0], (x)[1], 0, 1, 2, 3, 4, 5, 6, 7, 8, 9, 10, 11, 12, 13, 14, 15))
#define PG8_MMA(ai, bj, At, Bt) do { __builtin_amdgcn_s_setprio(1); \
        if constexpr (PM == 2) { _Pragma("unroll") for (int m = 0; m < 4; ++m) asm volatile("" :: "v"(At[m][0]), "v"(At[m][1])); _Pragma("unroll") for (int n = 0; n < 2; ++n) asm volatile("" :: "v"(Bt[n][0]), "v"(Bt[n][1])); } \
        else if constexpr (FP8) { _Pragma("unroll") for (int m = 0; m < 4; ++m) _Pragma("unroll") for (int n = 0; n < 2; ++n) \
            { const i32x8 bq_ = PG8_CAT(Bt[n]), aq_ = PG8_CAT(At[m]); \
              asm volatile("v_mfma_scale_f32_16x16x128_f8f6f4 %0, %1, %2, %0, %3, %3 op_sel_hi:[0,0,0]" : "+v"(acc[ai][bj][m][n]) : "v"(bq_), "v"(aq_), "v"(sc8)); } } \
        else { _Pragma("unroll") for (int m = 0; m < 4; ++m) _Pragma("unroll") for (int n = 0; n < 2; ++n) _Pragma("unroll") for (int k = 0; k < 2; ++k) \
            acc[ai][bj][m][n] = __builtin_amdgcn_mfma_f32_16x16x32_bf16(Bt[n][k], At[m][k], acc[ai][bj][m][n], 0, 0, 0); } \
        __builtin_amdgcn_s_setprio(0); } while (0)
#define PG8_WAIT_V(n) asm volatile("s_waitcnt vmcnt(" #n ")" ::: "memory")
#define PG8_WAIT_L(n) asm volatile("s_waitcnt lgkmcnt(" #n ")" ::: "memory")
#define PG8_BAR __builtin_amdgcn_s_barrier()
#define PG8_SCHED __builtin_amdgcn_sched_barrier(0)
    Unit cur, nxt; int ui = 0;
    if (!P.next(0, cur)) return;
    int sc8 = 0x7f7f7f7f; asm volatile("" : "+v"(sc8));
    f32x4 acc[2][2][4][2];
#pragma unroll
    for (int a = 0; a < 2; ++a)
#pragma unroll
        for (int b = 0; b < 2; ++b)
#pragma unroll
            for (int m = 0; m < 4; ++m)
#pragma unroll
                for (int n = 0; n < 2; ++n) acc[a][b][m][n] = (f32x4){0.f, 0.f, 0.f, 0.f};
    bf16x8 At[4][2], B0[2][2], B1[2][2];
    unsigned cvA[2][2], nvA[2][2];
    if constexpr (Prob::GATHER) P.a_offs(cur, R, C, cvA);
    const char* cA = P.a_tile(cur);
    const char* cB = P.b_tile(cur);
    PG8_STAGE_B(PG8_SB(0, 0), cB); PG8_STAGE_B(PG8_SB(0, 1), cB + hstep); PG8_STAGE_AC(PG8_SA(0, 0), 0, 0); PG8_STAGE_AC(PG8_SA(0, 1), 0, 1);
    if (wr == 1) PG8_BAR;
    PG8_WAIT_V(2); PG8_BAR;
    PG8_STAGE_B(PG8_SB(1, 0), cB + kstep); PG8_STAGE_AC(PG8_SA(1, 0), kstep, 0); PG8_STAGE_B(PG8_SB(1, 1), cB + hstep + kstep);
    PG8_WAIT_V(6); PG8_BAR;
    for (;;) {
        E.prefetch(cur, wr, wc, fr, fq);
        const bool has_next = P.next(ui + 1, nxt);
        if constexpr (Prob::GATHER) {
            if (has_next) P.a_offs(nxt, R, C, nvA);
            else {
#pragma unroll
                for (int h = 0; h < 2; ++h)
#pragma unroll
                    for (int i = 0; i < 2; ++i) nvA[h][i] = cvA[h][i];
            }
        }
        const char* nA = has_next ? P.a_tile(nxt) : cA;
        const char* nB = has_next ? P.b_tile(nxt) : cB;
        for (int t = 0; t < (PM == 4 ? 0 : nt); t += 2) {
            if (Hook::AT >= 0 && t == Hook::AT) HK(acc, cur, wr, wc, fr, fq);
            const bool last = (t == nt - 2);
            const size_t k1 = (size_t)(t + 1) * kstep;
            const size_t k2 = last ? 0 : (size_t)(t + 2) * kstep, k3 = k2 + kstep;
            const char* b2 = last ? nB : cB + (size_t)(t + 2) * kstep; const char* b3 = b2 + kstep;
            unsigned v2[2][2];
            if constexpr (Prob::GATHER) {
#pragma unroll
                for (int h = 0; h < 2; ++h)
#pragma unroll
                    for (int i = 0; i < 2; ++i) v2[h][i] = last ? nvA[h][i] : cvA[h][i];
            }
            PG8_LDB(B0, 0, 0); PG8_LDB(B1, 0, 1); PG8_SCHED; PG8_LDA(At, 0, 0); PG8_STAGE_AC(PG8_SA(1, 1), k1, 1);
            PG8_WAIT_V(8); PG8_WAIT_L(0); PG8_BAR; PG8_MMA(0, 0, At, B0); PG8_MMA(0, 1, At, B1); PG8_BAR; PG8_SCHED;
            PG8_LDA(At, 0, 1); PG8_STAGE_B(PG8_SB(0, 0), b2); PG8_STAGE_B(PG8_SB(0, 1), b2 + hstep); PG8_STAGE_AN(PG8_SA(0, 0), k2, 0);
            PG8_WAIT_V(8); PG8_WAIT_L(0); PG8_BAR; PG8_MMA(1, 0, At, B0); PG8_MMA(1, 1, At, B1); PG8_BAR; PG8_SCHED;
            PG8_LDB(B0, 1, 0); PG8_LDB(B1, 1, 1); PG8_SCHED; PG8_LDA(At, 1, 0); PG8_STAGE_AN(PG8_SA(0, 1), k2, 1);
            PG8_WAIT_V(8); PG8_WAIT_L(0); PG8_BAR; PG8_MMA(0, 0, At, B0); PG8_MMA(0, 1, At, B1); PG8_BAR; PG8_SCHED;
            PG8_LDA(At, 1, 1); PG8_STAGE_B(PG8_SB(1, 0), b3); PG8_STAGE_B(PG8_SB(1, 1), b3 + hstep); PG8_STAGE_AN(PG8_SA(1, 0), k3, 0);
            PG8_WAIT_V(8); PG8_WAIT_L(0); PG8_BAR; PG8_MMA(1, 0, At, B0); PG8_MMA(1, 1, At, B1); PG8_BAR; PG8_SCHED;
        }
        if (wr == 0) PG8_BAR;
        if constexpr (FP8) asm volatile("s_nop 15\n\ts_nop 7" ::: "memory");
        E(acc, cur, wr, wc, fr, fq);
        if (!has_next) break;
#pragma unroll
        for (int a = 0; a < 2; ++a)
#pragma unroll
            for (int b = 0; b < 2; ++b)
#pragma unroll
                for (int m = 0; m < 4; ++m)
#pragma unroll
                    for (int n = 0; n < 2; ++n) acc[a][b][m][n] = (f32x4){0.f, 0.f, 0.f, 0.f};
        cur = nxt; cA = nA; cB = nB; ++ui;
        if constexpr (Prob::GATHER) {
#pragma unroll
            for (int h = 0; h < 2; ++h)
#pragma unroll
                for (int i = 0; i < 2; ++i) cvA[h][i] = nvA[h][i];
        }
        if (wr == 1) PG8_BAR;
    }
    PG8_WAIT_V(0);
    PG8_BAR;
#undef PG8_SA
#undef PG8_SB
#undef PG8_STAGE_AG
#undef PG8_STAGE_AD
#undef PG8_STAGE_AC
#undef PG8_STAGE_AN
#undef PG8_STAGE_B
#undef PG8_LDA
#undef PG8_LDB
#undef PG8_MMA
#undef PG8_CAT
#undef PG8_WAIT_V
#undef PG8_WAIT_L
#undef PG8_BAR
#undef PG8_SCHED
}

__device__ __forceinline__ void pair_store16(unsigned char* p, size_t r8, const u32x4& A, const u32x4& B) {
    u32x4 s1, s2;
    s1.x = __builtin_amdgcn_update_dpp(A.x, B.x, 0x128, 0xf, 0xc, false); s1.y = __builtin_amdgcn_update_dpp(A.y, B.y, 0x128, 0xf, 0xc, false);
    s1.z = __builtin_amdgcn_update_dpp(A.z, B.z, 0x128, 0xf, 0xc, false); s1.w = __builtin_amdgcn_update_dpp(A.w, B.w, 0x128, 0xf, 0xc, false);
    s2.x = __builtin_amdgcn_update_dpp(B.x, A.x, 0x128, 0xf, 0x3, false); s2.y = __builtin_amdgcn_update_dpp(B.y, A.y, 0x128, 0xf, 0x3, false);
    s2.z = __builtin_amdgcn_update_dpp(B.z, A.z, 0x128, 0xf, 0x3, false); s2.w = __builtin_amdgcn_update_dpp(B.w, A.w, 0x128, 0xf, 0x3, false);
    *(u32x4*)p = s1; *(u32x4*)(p + r8) = s2;
}
__device__ __forceinline__ u32x4 pack8(const f32x4& v0, const f32x4& v1) { u32x4 w; w.x = cvt_pk_bf16(v0[0], v0[1]); w.y = cvt_pk_bf16(v0[2], v0[3]); w.z = cvt_pk_bf16(v1[0], v1[1]); w.w = cvt_pk_bf16(v1[2], v1[3]); return w; }

struct EpiStoreOnly {
    bf16_t* O;
    __device__ __forceinline__ void prefetch(const Unit&, int, int, int, int) const {}
    __device__ __forceinline__ void operator()(f32x4 (&acc)[2][2][4][2], const Unit& u, int wr, int wc, int fr, int fq) const {
        const int cl0 = wc * 32 + 8 * fq; int row0 = u.pm * BM + wr * 64 + fr; asm volatile("" : "+v"(row0));
#pragma unroll
        for (int ai = 0; ai < 2; ++ai)
#pragma unroll
            for (int m = 0; m < 4; ++m) { bf16_t* rowp = O + (size_t)(row0 + ai * HALF + m * 16) * 256 + cl0;
#pragma unroll
                for (int bj = 0; bj < 2; ++bj) *(u32x4*)(rowp + bj * HALF) = pack8(acc[ai][bj][m][0], acc[ai][bj][m][1]); }
    }
};
#define EPI_ST(val, ptr) do { if constexpr (MODE == 1) { auto v_ = (val); asm volatile("" :: "v"(v_)); } else *(ptr) = (val); } while (0)
template <int MODE> struct EpiInProjT {
    bf16_t *UV, *Q, *Kb, *Vb; unsigned char* G8; const float* cs; unsigned char *Q8, *K8;
    __device__ __forceinline__ void prefetch(const Unit&, int, int, int, int) const {}
    template <class PT> __device__ __forceinline__ void st_pair(PT* p, int pitch, const u32x4& A, const u32x4& B) const {
        if constexpr (MODE == 1) { asm volatile("" :: "v"(A), "v"(B)); } else pair_store16((unsigned char*)p, (size_t)8 * pitch * sizeof(PT), A, B); }
    __device__ __forceinline__ void operator()(f32x4 (&acc)[2][2][4][2], const Unit& u, int wr, int wc, int fr, int fq) const {
        constexpr bool NOMATH = (MODE == 2);
        const int pn = u.pn; int row0 = u.pm * BM + wr * 64 + fr; asm volatile("" : "+v"(row0));
        int prow0 = row0 - (fr & 8), pcl = wc * 64 + 8 * fq + 4 * (fr & 8);
        asm volatile("" : "+v"(prow0), "+v"(pcl));
        if (pn < 4) {
#pragma unroll
            for (int ai = 0; ai < 2; ++ai)
#pragma unroll
                for (int m = 0; m < 4; ++m) { u32x4 w[2];
#pragma unroll
                    for (int bj = 0; bj < 2; ++bj) { f32x4 v0 = acc[ai][bj][m][0], v1 = acc[ai][bj][m][1];
#pragma unroll
                        for (int e = 0; e < 4; ++e) { if constexpr (!NOMATH) { v0[e] = gelu_tanh(v0[e]); v1[e] = gelu_tanh(v1[e]); } }
                        w[bj] = pack8(v0, v1); }
                    st_pair(UV + (size_t)(prow0 + ai * HALF + m * 16) * 1024 + pn * 256 + pcl, 1024, w[0], w[1]); }
        } else if (pn < 8) {
            bf16_t* dst = (pn < 6) ? Q : Kb; const float sc = (pn < 6) ? C2 : 1.0f;
            const float sgn = (fq == 0) ? -1.0f : 1.0f; const bool rot_lane = fq < 2;
#pragma unroll
            for (int ai = 0; ai < 2; ++ai) {
                f32x4 cs4[4][4];
#pragma unroll
                for (int m = 0; m < 4; ++m) { const f32x4* cp = (const f32x4*)(cs + (size_t)(row0 + ai * HALF + m * 16) * 16);
#pragma unroll
                    for (int j = 0; j < 4; ++j) cs4[m][j] = cp[j]; }
#pragma unroll
                for (int m = 0; m < 4; ++m) { const int row = row0 + ai * HALF + m * 16; f32x4 v[2][2];
#pragma unroll
                    for (int bj = 0; bj < 2; ++bj) { v[bj][0] = acc[ai][bj][m][0]; v[bj][1] = acc[ai][bj][m][1]; }
                    if constexpr (!NOMATH) {
                        f32x4 p0, p1;
#pragma unroll
                        for (int e = 0; e < 4; ++e) { p0[e] = __shfl_xor(v[0][0][e], 16); p1[e] = __shfl_xor(v[0][1][e], 16); }
                        if (rot_lane) {
#pragma unroll
                            for (int e = 0; e < 4; ++e) { v[0][0][e] = v[0][0][e] * cs4[m][0][e] + sgn * p0[e] * cs4[m][2][e]; v[0][1][e] = v[0][1][e] * cs4[m][1][e] + sgn * p1[e] * cs4[m][3][e]; }
                        }
                    }
                    if ((wc & 1) == 0) {
                        st_pair(dst + (size_t)(prow0 + ai * HALF + m * 16) * 512 + (pn & 1) * 256 + pcl, 512, pack8(v[0][0] * sc, v[0][1] * sc), pack8(v[1][0] * sc, v[1][1] * sc));
                    } else {
                        const float s8 = (pn < 6) ? sc * 8.0f : 1.0f;
#pragma unroll
                        for (int bj = 0; bj < 2; ++bj) { const f32x4 v0 = v[bj][0] * s8, v1 = v[bj][1] * s8;
                            u32x2 q8; q8.x = cvt_pk4_fp8(v0[0], v0[1], v0[2], v0[3]); q8.y = cvt_pk4_fp8(v1[0], v1[1], v1[2], v1[3]);
                            EPI_ST(q8, (u32x2*)(((pn < 6) ? Q8 : K8) + (size_t)row * 256 + ((pn & 1) * 2 + (wc >> 1)) * 64 + bj * 32 + 8 * fq)); } } }
            }
        } else if (pn < 10) {
#pragma unroll
            for (int ai = 0; ai < 2; ++ai)
#pragma unroll
                for (int m = 0; m < 4; ++m)
                    st_pair(Vb + (size_t)(prow0 + ai * HALF + m * 16) * 512 + (pn - 8) * 256 + pcl, 512, pack8(acc[ai][0][m][0], acc[ai][0][m][1]), pack8(acc[ai][1][m][0], acc[ai][1][m][1]));
        } else {
            int gl = (fq * 16 + fr) * 16; asm volatile("" : "+v"(gl));
            unsigned char* gb = G8 + (size_t)((u.pm * 8 + (pn - 10)) * 8 + wr * 4 + wc) * 8192 + gl;
#pragma unroll
            for (int ai = 0; ai < 2; ++ai)
#pragma unroll
                for (int m = 0; m < 4; ++m) { u32x4 qq;
#pragma unroll
                    for (int bj = 0; bj < 2; ++bj) { f32x4 v0 = acc[ai][bj][m][0], v1 = acc[ai][bj][m][1];
#pragma unroll
                        for (int e = 0; e < 4; ++e) { if constexpr (!NOMATH) { v0[e] = 255.0f * fast_rcp(1.0f + fast_exp2(v0[e])); v1[e] = 255.0f * fast_rcp(1.0f + fast_exp2(v1[e])); } }
                        const unsigned qa = cvt_pk4_u8(v0[0], v0[1], v0[2], v0[3]), qb = cvt_pk4_u8(v1[0], v1[1], v1[2], v1[3]);
                        if (bj == 0) { qq.x = qa; qq.y = qb; } else { qq.z = qa; qq.w = qb; } }
                    EPI_ST(qq, (u32x4*)(gb + (ai * 4 + m) * 1024)); }
        }
    }
};

#undef EPI_ST
using EpiInProj = EpiInProjT<0>;
__device__ __forceinline__ void unpack8(const u32x4& w, f32x4& a, f32x4& b) { a = (f32x4){bf_lo(w.x), bf_hi(w.x), bf_lo(w.y), bf_hi(w.y)}; b = (f32x4){bf_lo(w.z), bf_hi(w.z), bf_lo(w.w), bf_hi(w.w)}; }
struct HookMerge {
    static constexpr int AT = 8;
    const unsigned char* G8;
    __device__ __forceinline__ void operator()(f32x4 (&acc)[2][2][4][2], const Unit& u, int wr, int wc, int fr, int fq) const {
        const unsigned char* gp = G8 + (size_t)((u.pm * 8 + u.pn) * 8 + wr * 4 + wc) * 8192 + ((fq >> 1) * 16 + fr) * 16 + 8 * (fq & 1); asm volatile("" : "+v"(gp));
        u32x2 w0[2][4][2], w1[2][4][2];
#pragma unroll
        for (int ai = 0; ai < 2; ++ai)
#pragma unroll
            for (int m = 0; m < 4; ++m)
#pragma unroll
                for (int bj = 0; bj < 2; ++bj) { w0[ai][m][bj] = *(const u32x2*)(gp + (ai * 4 + m) * 1024 + bj * 512); w1[ai][m][bj] = *(const u32x2*)(gp + 4 * 65536 + (ai * 4 + m) * 1024 + bj * 512); }
#pragma unroll
        for (int ai = 0; ai < 2; ++ai)
#pragma unroll
            for (int m = 0; m < 4; ++m)
#pragma unroll
                for (int bj = 0; bj < 2; ++bj) { const f32x4 a0 = u8x4_to_f32(w0[ai][m][bj].x), a1 = u8x4_to_f32(w0[ai][m][bj].y), b0 = u8x4_to_f32(w1[ai][m][bj].x), b1 = u8x4_to_f32(w1[ai][m][bj].y);
#pragma unroll
                    for (int e = 0; e < 4; ++e) { acc[ai][bj][m][0][e] *= a0[e] * fast_rcp(fmaxf(b0[e], 0.5f)); acc[ai][bj][m][1][e] *= a1[e] * fast_rcp(fmaxf(b1[e], 0.5f)); } }
    }
};
struct EpiMerge {
    const unsigned char* G8; bf16_t* MG;
    __device__ __forceinline__ void prefetch(const Unit&, int, int, int, int) const {}
    __device__ __forceinline__ void operator()(f32x4 (&acc)[2][2][4][2], const Unit& u, int wr, int wc, int fr, int fq) const {
        const unsigned char* gp = G8 + (size_t)((u.pm * 8 + u.pn + 4) * 8 + wr * 4 + wc) * 8192 + ((fq >> 1) * 16 + fr) * 16 + 8 * (fq & 1); asm volatile("" : "+v"(gp));
        int prow0 = u.pm * BM + wr * 64 + (fr & 7), pcol = u.pn * BM + wc * 64 + 8 * fq + 4 * (fr & 8); asm volatile("" : "+v"(prow0), "+v"(pcol));
        u32x2 w1[2][4][2];
#pragma unroll
        for (int ai = 0; ai < 2; ++ai)
#pragma unroll
            for (int m = 0; m < 4; ++m)
#pragma unroll
                for (int bj = 0; bj < 2; ++bj) w1[ai][m][bj] = *(const u32x2*)(gp + (ai * 4 + m) * 1024 + bj * 512);
        const float s255 = 1.0f / 255.0f;
#pragma unroll
        for (int ai = 0; ai < 2; ++ai)
#pragma unroll
            for (int m = 0; m < 4; ++m) { u32x4 w[2];
#pragma unroll
                for (int bj = 0; bj < 2; ++bj) { f32x4 b0 = u8x4_to_f32(w1[ai][m][bj].x), b1 = u8x4_to_f32(w1[ai][m][bj].y);
#pragma unroll
                    for (int e = 0; e < 4; ++e) { b0[e] = fmaxf(b0[e], 0.5f) * s255; b1[e] = fmaxf(b1[e], 0.5f) * s255; }
                    w[bj] = pack8(acc[ai][bj][m][0] * b0, acc[ai][bj][m][1] * b1); }
                pair_store16((unsigned char*)(MG + (size_t)(prow0 + ai * HALF + m * 16) * 1024 + pcol), (size_t)8 * 1024 * 2, w[0], w[1]); }
    }
};

struct EpiX1 {
    const float* X; bf16_t* XB; unsigned char* XB8; float* ssq;
    __device__ __forceinline__ void prefetch(const Unit&, int, int, int, int) const {}
    __device__ __forceinline__ void operator()(f32x4 (&acc)[2][2][4][2], const Unit& u, int wr, int wc, int fr, int fq) const {
        const int col0 = u.pn * BM + wc * 64 + 8 * fq; int row0 = u.pm * BM + wr * 64 + fr; asm volatile("" : "+v"(row0));
#pragma unroll
        for (int ai = 0; ai < 2; ++ai) {
            f32x4 xv[4][2][2];
#pragma unroll
            for (int m = 0; m < 4; ++m) { const float* xp = X + (size_t)(row0 + ai * HALF + m * 16) * 1024 + col0;
#pragma unroll
                for (int bj = 0; bj < 2; ++bj) { xv[m][bj][0] = *(const f32x4*)(xp + bj * 32); xv[m][bj][1] = *(const f32x4*)(xp + bj * 32 + 4); } }
#pragma unroll
            for (int m = 0; m < 4; ++m) { const size_t row = (size_t)(row0 + ai * HALF + m * 16); u32x4 wb[2];
                float s = 0.f;
#pragma unroll
                for (int bj = 0; bj < 2; ++bj) { const f32x4 v0 = acc[ai][bj][m][0] + xv[m][bj][0], v1 = acc[ai][bj][m][1] + xv[m][bj][1];
                    wb[bj] = pack8(v0, v1);
                    { u32x2 q8; q8.x = cvt_pk4_fp8(v0[0], v0[1], v0[2], v0[3]); q8.y = cvt_pk4_fp8(v1[0], v1[1], v1[2], v1[3]); *(u32x2*)(XB8 + row * 1024 + col0 + bj * 32) = q8; }
                    s += (v0[0] * v0[0] + v0[1] * v0[1]) + (v0[2] * v0[2] + v0[3] * v0[3]) + (v1[0] * v1[0] + v1[1] * v1[1]) + (v1[2] * v1[2] + v1[3] * v1[3]); }
                pair_store16((unsigned char*)(XB + (row - (fr & 8)) * 1024 + col0 + 4 * (fr & 8)), (size_t)8 * 1024 * 2, wb[0], wb[1]);
                s += __shfl_xor(s, 16); s += __shfl_xor(s, 32);
                if (fq == 0) ssq[row * 16 + u.pn * 4 + wc] = s; }
        }
    }
};

struct EpiMoeUp {
    const int* list; const float* rstd; unsigned char* H8;
    mutable float rs[2][4];
    __device__ __forceinline__ void prefetch(const Unit& u, int wr, int wc, int fr, int fq) const {
        int r0 = wr * 64 + fr; asm volatile("" : "+v"(r0));
        int tok[2][4];
#pragma unroll
        for (int ai = 0; ai < 2; ++ai)
#pragma unroll
            for (int m = 0; m < 4; ++m) { const int r = r0 + ai * HALF + m * 16; tok[ai][m] = (r < u.nv) ? (int)((unsigned)list[u.lbase + r] >> 16) : 0; }
#pragma unroll
        for (int ai = 0; ai < 2; ++ai)
#pragma unroll
            for (int m = 0; m < 4; ++m) rs[ai][m] = rstd[tok[ai][m]] * 0.015625f;
    }
    __device__ __forceinline__ void operator()(f32x4 (&acc)[2][2][4][2], const Unit& u, int wr, int wc, int fr, int fq) const {
        const int col0 = u.pn * 128 + wc * 32 + 8 * fq; int r0 = wr * 64 + fr; asm volatile("" : "+v"(r0));
#pragma unroll
        for (int ai = 0; ai < 2; ++ai)
#pragma unroll
            for (int m = 0; m < 4; ++m) { const int r = r0 + ai * HALF + m * 16; const float rsv = rs[ai][m];
                f32x4 g0 = acc[ai][0][m][0] * rsv, g1 = acc[ai][0][m][1] * rsv, u0 = acc[ai][1][m][0] * rsv, u1 = acc[ai][1][m][1] * rsv;
#pragma unroll
                for (int e = 0; e < 4; ++e) { g0[e] = g0[e] * sigmoidf_(g0[e]) * (u0[e] * 8.f); g1[e] = g1[e] * sigmoidf_(g1[e]) * (u1[e] * 8.f); }
                u32x2 q8; q8.x = cvt_pk4_fp8(g0[0], g0[1], g0[2], g0[3]); q8.y = cvt_pk4_fp8(g1[0], g1[1], g1[2], g1[3]);
                *(u32x2*)(H8 + (size_t)(u.pm * BM + r) * 512 + col0) = q8; }
    }
};
struct EpiMoeDown {
    const int* list; unsigned char* YB8;
    mutable unsigned lw[2][4];
    __device__ __forceinline__ void prefetch(const Unit& u, int wr, int wc, int fr, int fq) const {
        int r0 = wr * 64 + fr; asm volatile("" : "+v"(r0));
#pragma unroll
        for (int ai = 0; ai < 2; ++ai)
#pragma unroll
            for (int m = 0; m < 4; ++m) { const int r = r0 + ai * HALF + m * 16; lw[ai][m] = (r < u.nv) ? (unsigned)list[u.lbase + r] : 0xffffffffu; }
    }
    __device__ __forceinline__ void operator()(f32x4 (&acc)[2][2][4][2], const Unit& u, int wr, int wc, int fr, int fq) const {
        const int col0 = u.pn * BM + wc * 64 + 16 * fq;
#pragma unroll
        for (int ai = 0; ai < 2; ++ai)
#pragma unroll
            for (int m = 0; m < 4; ++m) { const unsigned word = lw[ai][m];
                if (word != 0xffffffffu) { const float w = __uint_as_float((word & 0x7fffu) << 16) * 0.0625f;
                    unsigned char* op = YB8 + (size_t)(word >> 15) * 1024 + col0; u32x4 q;
                    { const f32x4 y0 = acc[ai][0][m][0] * w, y1 = acc[ai][0][m][1] * w; q.x = cvt_pk4_fp8(y0[0], y0[1], y0[2], y0[3]); q.y = cvt_pk4_fp8(y1[0], y1[1], y1[2], y1[3]); }
                    { const f32x4 y0 = acc[ai][1][m][0] * w, y1 = acc[ai][1][m][1] * w; q.z = cvt_pk4_fp8(y0[0], y0[1], y0[2], y0[3]); q.w = cvt_pk4_fp8(y1[0], y1[1], y1[2], y1[3]); }
                    *(u32x4*)op = q; } }
    }
};
}


namespace att {
constexpr int QB = 256, KVB = 64, QP = 512  ;
#if PROBE_PHASE == 52
#define ATT_REF_OFF 0.0f
#else
#define ATT_REF_OFF 0.0f
#endif
constexpr int KSLOT = 8192, VSLOT = 8192, NSLOT = 3;
constexpr int L_K = 0, L_V = NSLOT * KSLOT, L_WS = L_V + NSLOT * VSLOT, L_OST = L_WS + NWAVES * 256, L_END = L_OST + NWAVES * 8192;
static_assert(L_END <= RING_BYTES, "attention LDS");
#if PROBE_PHASE == 40
#define ATT_RESC_THR 0.f
#define ATT_RESC_MIN 0.001f
#define ATT_RESC_LO -2.f
#else
#define ATT_RESC_THR 512.f
#define ATT_RESC_MIN 64.f
#define ATT_RESC_LO 0.f
#endif
__device__ __forceinline__ int crow(int r, int hi) { return (r & 3) + 8 * (r >> 2) + 4 * hi; }
__device__ __forceinline__ void glds16(const void* gsrc, unsigned lds_dst) { unsigned keep;
    asm volatile("s_mov_b32 %0, m0\n\ts_mov_b32 m0, %2\n\ts_nop 0\n\tglobal_load_lds_dwordx4 %1, off\n\ts_mov_b32 m0, %0" : "=&s"(keep) : "v"(gsrc), "s"(lds_dst) : "memory"); }
#define ATT_WAIT_BAR(N) asm volatile("s_waitcnt vmcnt(" #N ") lgkmcnt(0)\n\ts_barrier" ::: "memory")
#define MX3(a, b, c) __builtin_fmaxf(__builtin_fmaxf((a), (b)), (c))
#define ATT_SBAR() __builtin_amdgcn_sched_barrier(0)
#define ATT_MFMA(a, b, c) __builtin_amdgcn_mfma_f32_32x32x16_bf16(a, b, c, 0, 0, 0)
__device__ __forceinline__ float rowmax(const f32x16& p0, const f32x16& p1) {
    float a = MX3(p0[0], p0[1], p1[0]), b = MX3(p0[2], p0[3], p1[1]); a = MX3(a, p1[2], p1[3]);
#pragma unroll
    for (int r = 4; r < 16; r += 4) { a = MX3(a, p0[r], p0[r + 1]); b = MX3(b, p0[r + 2], p0[r + 3]); a = MX3(a, p1[r], p1[r + 1]); b = MX3(b, p1[r + 2], p1[r + 3]); }
    const float m = __builtin_fmaxf(a, b); auto rr = __builtin_amdgcn_permlane32_swap(__float_as_uint(m), __float_as_uint(m), false, false);
    return __builtin_fmaxf(__uint_as_float(rr[0]), __uint_as_float(rr[1])); }
__device__ __forceinline__ void cmask(f32x16& p0, f32x16& p1, int jb, int qrel, int hi) {
    const int kb = 64 * jb + 4 * hi;
#pragma unroll
    for (int r = 0; r < 16; ++r) { const int kv = kb + (r & 3) + 8 * (r >> 2); if (kv > qrel) p0[r] = -INFINITY; if (kv + 32 > qrel) p1[r] = -INFINITY; } }
typedef int i32x4 __attribute__((ext_vector_type(4)));
__device__ __forceinline__ void kload2(bf16x8* kf, const LAS char* kp, int j) { kf[2 * j] = *(const LAS bf16x8*)(kp + j * 2048); kf[2 * j + 1] = *(const LAS bf16x8*)(kp + j * 2048 + 512); }
__device__ __forceinline__ i32x8 frag32(const LAS char* row, int c0) {
    const i32x4 lo = *(const LAS i32x4*)(row + c0 * 16), hi = *(const LAS i32x4*)(row + (c0 ^ 1) * 16);
    return __builtin_shufflevector(lo, hi, 0, 1, 2, 3, 4, 5, 6, 7); }
#define MFMA8_PV(O, A, B) asm volatile("v_mfma_scale_f32_32x32x64_f8f6f4 %0, %1, %2, %0, %3, %3 op_sel_hi:[0,0,0]" : "+v"(O) : "v"(A), "v"(B), "v"(sc_1))
template <int MODE> __device__ __forceinline__ void attn_pass(f32x16 (&o)[4], int b, int hm, int h, int qb, const bf16_t* Q, const bf16_t* __restrict__ K, const unsigned char* __restrict__ V8T, LAS char* shm) {
    const int tid = opaque_tid(), lane = tid & 63, r32 = lane & 31, hi = lane >> 5; const int wid = __builtin_amdgcn_readfirstlane(tid >> 6);
    const long rowbase = (long)b * SEQ; const int q0 = qb * QB, NT = (q0 + QB) / KVB;
    const bf16_t* Qw = Q + (rowbase + q0 + wid * 32) * QP + hm * 64;
    const bf16_t* Kh = K + rowbase * QP + hm * 64;
    const unsigned lds0 = (unsigned)(uintptr_t)shm;
    LAS float* wsf = (LAS float*)(shm + L_WS) + wid * 64;
    const bf16_t* ksrc = Kh + (long)lane * QP + wid * 8;
    const unsigned char* vsrc = V8T + ((size_t)(b * 4 + h) * (SEQ / KVB)) * VSLOT + wid * 1024 + lane * 16;
    const unsigned kdst = lds0 + L_K + wid * 1024, vdst = lds0 + L_V + wid * 1024;
#define DMA_K(t, s) glds16(ksrc + (long)(t) * KVB * QP, (unsigned)__builtin_amdgcn_readfirstlane(kdst + (unsigned)(s) * KSLOT))
#define DMA_V(t, s) glds16(vsrc + (long)(t) * VSLOT, (unsigned)__builtin_amdgcn_readfirstlane(vdst + (unsigned)(s) * VSLOT))
    const LAS char* kp0 = shm + L_K + hi * 1024 + r32 * 16;
    const LAS char* vp0 = shm + L_V + r32 * 64;  const int vc0 = (2 * hi) ^ ((r32 >> 2) & 3);
    DMA_K(0, 0); DMA_V(0, 0); DMA_K(1, 1);
    bf16x8 qr[4];
#pragma unroll
    for (int d0 = 0; d0 < 4; ++d0) qr[d0] = *(const bf16x8*)(Qw + (long)r32 * QP + d0 * 16 + hi * 8);
    float mhat = 0.f, l_reg = 0.f;
    float zf = 0.f; asm volatile("" : "+v"(zf));
    int sc_1 = 0x7f7f7f7f; asm volatile("" : "+v"(sc_1));
    f32x16 negm;
#pragma unroll
    for (int r = 0; r < 16; ++r) { negm[r] = zf;
#pragma unroll
        for (int d0 = 0; d0 < 4; ++d0) o[d0][r] = zf; }
    asm volatile("" : "+v"(negm));
    const int qrel = wid * 32 + r32;
    asm volatile("" : "+v"(qr[0]), "+v"(qr[1]), "+v"(qr[2]), "+v"(qr[3]));
    LAS bf16x8* qlds = (LAS bf16x8*)(shm + L_OST + wid * 8192) + lane;
#pragma unroll
    for (int d0 = 0; d0 < 4; ++d0) qlds[d0 * 64] = qr[d0];
    DMA_K(2, 2);
    ATT_WAIT_BAR(1);
    bool resc = false;
#define CMASK(P0, P1, t) do { const int jb_ = (t) - (NT - 4); if (jb_ >= 0) cmask(P0, P1, jb_, qrel, hi); } while (0)
#define RESC() do { if (resc) { asm volatile("s_waitcnt lgkmcnt(0)\n\ts_nop 15\n\ts_nop 15\n\ts_nop 7" ::: "memory"); \
        _Pragma("unroll") for (int r = 0; r < 16; ++r) { const float fr_ = wsf[crow(r, hi)]; _Pragma("unroll") for (int d_ = 0; d_ < 4; ++d_) asm volatile("v_mul_f32 %0, %0, %1" : "+v"(o[d_][r]) : "v"(fr_)); } } } while (0)
    f32x16 pA0, pA1, pB0, pB1;
    int sl_prev = 0, sl_cur = 0, sl_next = 1;
#define ROT() do { sl_prev = sl_cur; sl_cur = sl_next; sl_next = (sl_next == NSLOT - 1) ? 0 : sl_next + 1; } while (0)
    bf16x8 kf[8];
#pragma unroll
    for (int j = 0; j < 4; ++j) kload2(kf, kp0, j);
    pA0 = ATT_MFMA(kf[0], qr[0], negm); pA1 = ATT_MFMA(kf[1], qr[0], negm);
#pragma unroll
    for (int d0 = 1; d0 < 4; ++d0) { pA0 = ATT_MFMA(kf[2 * d0], qr[d0], pA0); pA1 = ATT_MFMA(kf[2 * d0 + 1], qr[d0], pA1); }
    CMASK(pA0, pA1, 0);
    { const float rm = rowmax(pA0, pA1) - ATT_REF_OFF; mhat = rm;
#pragma unroll
      for (int r = 0; r < 16; ++r) { pA0[r] -= rm; pA1[r] -= rm; negm[r] = -rm; }
      asm volatile("" : "+v"(negm));
#pragma unroll
      for (int r = 0; r < 16; ++r) { pA0[r] = fast_exp2(pA0[r]); pA1[r] = fast_exp2(pA1[r]); } }
    ATT_WAIT_BAR(0);
    DMA_K(3, 0); DMA_V(1, 1);
    ROT();
#pragma unroll
    for (int j = 0; j < 4; ++j) kload2(kf, kp0 + sl_cur * KSLOT, j);
    ATT_WAIT_BAR(2);
    i32x8 vf[4], pf;
#define PK4(P, B) cvt_pk4_fp8(P[B], P[(B) + 1], P[(B) + 2], P[(B) + 3])
#define PIN(x) asm volatile("" : "+v"(x))
#define GAPA(MF, P, B, W) do { MF; sacc += P[B]; sacc += P[(B) + 1]; sacc += P[(B) + 2]; sacc += P[(B) + 3]; PIN(sacc); pf[W] = PK4(P, B); PIN(pf); ATT_SBAR(); } while (0)
#define EXP8(X, B) do { X[B] = fast_exp2(X[B]); X[(B) + 1] = fast_exp2(X[(B) + 1]); X[(B) + 2] = fast_exp2(X[(B) + 2]); X[(B) + 3] = fast_exp2(X[(B) + 3]); \
        X[(B) + 4] = fast_exp2(X[(B) + 4]); X[(B) + 5] = fast_exp2(X[(B) + 5]); X[(B) + 6] = fast_exp2(X[(B) + 6]); X[(B) + 7] = fast_exp2(X[(B) + 7]); PIN(X); } while (0)
#define STEP(C0, C1, P0, P1, t, GK, GV, GL) do { ATT_SBAR(); \
    const LAS char* vp_ = vp0 + sl_prev * VSLOT; \
    float sacc = 0.f; \
    bf16x8 qa_ = qlds[0], qb_ = qlds[64]; ATT_SBAR(); \
    GAPA(C0 = ATT_MFMA(kf[0], qa_, negm), P0, 0, 0); \
    GAPA(C1 = ATT_MFMA(kf[1], qa_, negm), P0, 4, 1); \
    qa_ = qlds[128]; ATT_SBAR(); \
    GAPA(C0 = ATT_MFMA(kf[2], qb_, C0), P0, 8, 2); \
    GAPA(C1 = ATT_MFMA(kf[3], qb_, C1), P0, 12, 3); \
    qb_ = qlds[192]; ATT_SBAR(); \
    vf[0] = frag32(vp_, vc0); ATT_SBAR(); GAPA(C0 = ATT_MFMA(kf[4], qa_, C0), P1, 0, 4); \
    vf[1] = frag32(vp_ + 32 * 64, vc0); ATT_SBAR(); GAPA(C1 = ATT_MFMA(kf[5], qa_, C1), P1, 4, 5); \
    vf[2] = frag32(vp_ + 64 * 64, vc0); ATT_SBAR(); GAPA(C0 = ATT_MFMA(kf[6], qb_, C0), P1, 8, 6); \
    vf[3] = frag32(vp_ + 96 * 64, vc0); ATT_SBAR(); GAPA(C1 = ATT_MFMA(kf[7], qb_, C1), P1, 12, 7); \
    l_reg += sacc; \
    if (GK) { DMA_K((t) + 3, sl_cur); } if (GV) { DMA_V((t) + 1, sl_next); } \
    CMASK(C0, C1, t); \
    {   \
      float st_; { auto rr = __builtin_amdgcn_permlane32_swap(__float_as_uint(sacc), __float_as_uint(sacc), false, false); st_ = __uint_as_float(rr[0]) + __uint_as_float(rr[1]); } \
      resc = false; \
      if (__builtin_expect(__any(st_ > ATT_RESC_THR), 0)) { const float dl = (st_ > ATT_RESC_MIN) ? __builtin_fmaxf(__builtin_floorf(__builtin_amdgcn_logf(st_)) - 6.f, ATT_RESC_LO) : 0.f; mhat += dl; \
        _Pragma("unroll") for (int r = 0; r < 16; ++r) { asm volatile("v_sub_f32 %0, %0, %1" : "+v"(C0[r]) : "v"(dl)); asm volatile("v_sub_f32 %0, %0, %1" : "+v"(C1[r]) : "v"(dl)); } \
        _Pragma("unroll") for (int r = 0; r < 16; ++r) negm[r] = -mhat; asm volatile("" : "+v"(negm)); \
        const float f = fast_exp2(-dl); l_reg *= f; if (hi == 0) wsf[r32] = f; resc = true; } } \
    ATT_SBAR(); \
    MFMA8_PV(o[0], pf, vf[0]); EXP8(C0, 0); if (GL) { kload2(kf, kp0 + sl_next * KSLOT, 0); } ATT_SBAR(); \
    MFMA8_PV(o[1], pf, vf[1]); EXP8(C0, 8); if (GL) { kload2(kf, kp0 + sl_next * KSLOT, 1); } ATT_SBAR(); \
    MFMA8_PV(o[2], pf, vf[2]); EXP8(C1, 0); if (GL) { kload2(kf, kp0 + sl_next * KSLOT, 2); } ATT_SBAR(); \
    MFMA8_PV(o[3], pf, vf[3]); EXP8(C1, 8); if (GL) { kload2(kf, kp0 + sl_next * KSLOT, 3); } ATT_SBAR(); \
    } while (0)
    int t = 1;
#undef CMASK
#define CMASK(P0, P1, t) do {} while (0)
    for (; t + 5 < NT; t += 2) {
        STEP(pB0, pB1, pA0, pA1, t, true, true, true);       if (MODE == 3) { asm volatile("s_waitcnt lgkmcnt(0)" ::: "memory"); } else { ATT_WAIT_BAR(2); } RESC(); ROT();
        STEP(pA0, pA1, pB0, pB1, t + 1, true, true, true);   if (MODE == 3) { asm volatile("s_waitcnt lgkmcnt(0)" ::: "memory"); } else { ATT_WAIT_BAR(2); } RESC(); ROT();
    }
#undef CMASK
#define CMASK(P0, P1, t) do { const int jb_ = (t) - (NT - 4); if (jb_ >= 0) cmask(P0, P1, jb_, qrel, hi); } while (0)
#define ENDW(tt) do { if ((tt) + 3 < NT) { ATT_WAIT_BAR(2); } else if ((tt) + 2 < NT) { ATT_WAIT_BAR(1); } else { ATT_WAIT_BAR(0); } } while (0)
    for (; t + 1 < NT; t += 2) {
        STEP(pB0, pB1, pA0, pA1, t, (t + 3 < NT), (t + 1 < NT), (t + 1 < NT));       ENDW(t);     RESC(); ROT();
        STEP(pA0, pA1, pB0, pB1, t + 1, (t + 4 < NT), (t + 2 < NT), (t + 2 < NT));   ENDW(t + 1); RESC(); ROT();
    }
    STEP(pB0, pB1, pA0, pA1, NT - 1, false, false, false); RESC();
    { float sacc = 0.f;
#pragma unroll
      for (int r = 0; r < 16; ++r) sacc += pB0[r] + pB1[r];
      l_reg += sacc;
      pf[0] = PK4(pB0, 0); pf[1] = PK4(pB0, 4); pf[2] = PK4(pB0, 8); pf[3] = PK4(pB0, 12); pf[4] = PK4(pB1, 0); pf[5] = PK4(pB1, 4); pf[6] = PK4(pB1, 8); pf[7] = PK4(pB1, 12);
      const LAS char* vp_ = vp0 + sl_cur * VSLOT;
      vf[0] = frag32(vp_, vc0); vf[1] = frag32(vp_ + 32 * 64, vc0); vf[2] = frag32(vp_ + 64 * 64, vc0); vf[3] = frag32(vp_ + 96 * 64, vc0);
      asm volatile("s_nop 3" : "+v"(pf));
      MFMA8_PV(o[0], pf, vf[0]); MFMA8_PV(o[1], pf, vf[1]); MFMA8_PV(o[2], pf, vf[2]); MFMA8_PV(o[3], pf, vf[3]);
      asm volatile("s_nop 15\n\ts_nop 15\n\ts_nop 7" : "+v"(o[0]), "+v"(o[1]), "+v"(o[2]), "+v"(o[3])); }
#undef PK4
#undef PIN
#undef GAPA
#undef EXP8
#undef STEP
#undef ENDW
#undef CMASK
#undef RESC
#undef ROT
    { auto rr = __builtin_amdgcn_permlane32_swap(__float_as_uint(l_reg), __float_as_uint(l_reg), false, false); l_reg = __uint_as_float(rr[0]) + __uint_as_float(rr[1]); }
    if (hi == 0) wsf[32 + r32] = l_reg;
    asm volatile("s_waitcnt lgkmcnt(0)" ::: "memory");
#pragma unroll
    for (int r = 0; r < 16; ++r) { const float rl = fast_rcp(wsf[32 + crow(r, hi)]);
#pragma unroll
        for (int d0 = 0; d0 < 4; ++d0) o[d0][r] *= rl; }
    asm volatile("s_waitcnt lgkmcnt(0)" ::: "memory");
#undef DMA_K
#undef DMA_V
}

constexpr int KSLOT8 = 4096, QP8 = 256  ;
constexpr int L_V8 = NSLOT * KSLOT8, L_WS8 = L_V8 + NSLOT * VSLOT;
static_assert(L_WS8 + NWAVES * 256 <= L_OST, "fp8 pass LDS");
#define MFMA8_QK(C, A, B) asm volatile("v_mfma_scale_f32_32x32x64_f8f6f4 %0, %1, %2, %3, %4, %5 op_sel_hi:[0,0,0]" : "=&v"(C) : "v"(A), "v"(B), "v"(negm), "v"(sc_k), "v"(sc_q))
#define MFMA8_PV8(O, A, B) asm volatile("v_mfma_scale_f32_32x32x64_f8f6f4 %0, %1, %2, %0, %3, %3 op_sel_hi:[0,0,0]" : "+v"(O) : "v"(A), "v"(B), "v"(sc_k))
template <int MODE> __device__ __forceinline__ void attn_pass8(f32x16 (&o)[4], int b, int hm, int h, int qb, const unsigned char* Q8, const unsigned char* __restrict__ K8, const unsigned char* __restrict__ V8T, LAS char* shm) {
    const int tid = opaque_tid(), lane = tid & 63, r32 = lane & 31, hi = lane >> 5; const int wid = __builtin_amdgcn_readfirstlane(tid >> 6);
    const long rowbase = (long)b * SEQ; const int q0 = qb * QB, NT = (q0 + QB) / KVB;
    const unsigned lds0 = (unsigned)(uintptr_t)shm;
    LAS float* wsf = (LAS float*)(shm + L_WS8) + wid * 64;
    const int kkey = (wid & 3) * 16 + (lane >> 2);
    const unsigned char* ksrc = K8 + (rowbase + kkey) * QP8 + h * 64 + (((lane & 3) ^ ((kkey >> 2) & 3)) * 16);
    const unsigned char* vsrc = V8T + ((size_t)(b * 4 + h) * (SEQ / KVB)) * VSLOT + wid * 1024 + lane * 16;
    const unsigned kdst = lds0 + L_K + (wid & 3) * 1024, vdst = lds0 + L_V8 + wid * 1024;
#define DMA_K(t, s) glds16(ksrc + (long)(t) * KVB * QP8, (unsigned)__builtin_amdgcn_readfirstlane(kdst + (unsigned)(s) * KSLOT8))
#define DMA_V(t, s) glds16(vsrc + (long)(t) * VSLOT, (unsigned)__builtin_amdgcn_readfirstlane(vdst + (unsigned)(s) * VSLOT))
    const int sw = (r32 >> 2) & 3;
    const LAS char* kp0 = shm + L_K + r32 * 64;  const int kc0 = (2 * hi) ^ sw;
    const LAS char* vp0 = shm + L_V8 + r32 * 64;  const int vc0 = (2 * hi) ^ sw;
    DMA_K(0, 0); DMA_V(0, 0); DMA_K(1, 1);
    i32x8 qf;
    { const unsigned char* qp = Q8 + (rowbase + q0 + wid * 32 + r32) * QP8 + h * 64 + hi * 32; const i32x4 lo = *(const i32x4*)qp, hi4 = *(const i32x4*)(qp + 16); qf = __builtin_shufflevector(lo, hi4, 0, 1, 2, 3, 4, 5, 6, 7); }
    float mhat = 0.f;
    f32x16 ol;
    float zf = 0.f; asm volatile("" : "+v"(zf));
    int sc_k = 0x7f7f7f7f, sc_q = 0x7c7c7c7c; asm volatile("" : "+v"(sc_k), "+v"(sc_q));
    f32x16 negm;
#pragma unroll
    for (int r = 0; r < 16; ++r) { negm[r] = zf;
#pragma unroll
        for (int d0 = 0; d0 < 4; ++d0) o[d0][r] = zf;
        ol[r] = zf; }
    i32x8 ones8; { int o1 = 0x38383838; asm volatile("" : "+v"(o1)); ones8 = (i32x8){o1, o1, o1, o1, o1, o1, o1, o1}; }
    asm volatile("" : "+v"(negm));
    const int qrel = wid * 32 + r32;
    asm volatile("" : "+v"(qf));
    DMA_K(2, 2);
    ATT_WAIT_BAR(1);
    bool resc = false;
#define CMASK(P0, P1, t) do { const int jb_ = (t) - (NT - 4); if (jb_ >= 0) cmask(P0, P1, jb_, qrel, hi); } while (0)
#define RESC() do { if (resc) { asm volatile("s_waitcnt lgkmcnt(0)\n\ts_nop 15\n\ts_nop 7" ::: "memory"); \
        _Pragma("unroll") for (int r = 0; r < 16; ++r) { const float fr_ = wsf[crow(r, hi)]; _Pragma("unroll") for (int d_ = 0; d_ < 4; ++d_) asm volatile("v_mul_f32 %0, %0, %1" : "+v"(o[d_][r]) : "v"(fr_)); asm volatile("v_mul_f32 %0, %0, %1" : "+v"(ol[r]) : "v"(fr_)); } } } while (0)
    f32x16 pA0, pA1, pB0, pB1;
    int sl_prev = 0, sl_cur = 0, sl_next = 1;
#define ROT() do { sl_prev = sl_cur; sl_cur = sl_next; sl_next = (sl_next == NSLOT - 1) ? 0 : sl_next + 1; } while (0)
    i32x8 kf0, kf1;
    kf0 = frag32(kp0, kc0); kf1 = frag32(kp0 + 32 * 64, kc0);
    MFMA8_QK(pA0, kf0, qf); MFMA8_QK(pA1, kf1, qf);
    asm volatile("s_nop 15\n\ts_nop 15\n\ts_nop 7" : "+v"(pA0), "+v"(pA1));
    CMASK(pA0, pA1, 0);
    { const float rm = rowmax(pA0, pA1) - ATT_REF_OFF; mhat = rm;
#pragma unroll
      for (int r = 0; r < 16; ++r) { pA0[r] -= rm; pA1[r] -= rm; negm[r] = -rm; }
      asm volatile("" : "+v"(negm));
#pragma unroll
      for (int r = 0; r < 16; ++r) { pA0[r] = fast_exp2(pA0[r]); pA1[r] = fast_exp2(pA1[r]); } }
    ATT_WAIT_BAR(0);
    DMA_K(3, 0); DMA_V(1, 1);
    ROT();
    kf0 = frag32(kp0 + sl_cur * KSLOT8, kc0); kf1 = frag32(kp0 + sl_cur * KSLOT8 + 32 * 64, kc0);
    ATT_WAIT_BAR(2);
    i32x8 vf[4], pf;
#define PK4(P, B) cvt_pk4_fp8(P[B], P[(B) + 1], P[(B) + 2], P[(B) + 3])
#define PIN(x) asm volatile("" : "+v"(x))
#define SUM8(P, B) do { sacc += P[B]; sacc += P[(B) + 1]; sacc += P[(B) + 2]; sacc += P[(B) + 3]; sacc += P[(B) + 4]; sacc += P[(B) + 5]; sacc += P[(B) + 6]; sacc += P[(B) + 7]; PIN(sacc); } while (0)
#define EXP8(X, B) do { X[B] = fast_exp2(X[B]); X[(B) + 1] = fast_exp2(X[(B) + 1]); X[(B) + 2] = fast_exp2(X[(B) + 2]); X[(B) + 3] = fast_exp2(X[(B) + 3]); \
        X[(B) + 4] = fast_exp2(X[(B) + 4]); X[(B) + 5] = fast_exp2(X[(B) + 5]); X[(B) + 6] = fast_exp2(X[(B) + 6]); X[(B) + 7] = fast_exp2(X[(B) + 7]); PIN(X); } while (0)
#define STEP(C0, C1, P0, P1, t, GK, GV, GL) do { ATT_SBAR(); \
    const LAS char* vp_ = vp0 + sl_prev * VSLOT; \
    const bool det_ = (((t) & 3) == 1);            \
    float sacc = 0.f; \
    MFMA8_QK(C0, kf0, qf); \
    if (det_) { SUM8(P0, 0); SUM8(P0, 8); } \
    pf[0] = PK4(P0, 0); pf[1] = PK4(P0, 4); pf[2] = PK4(P0, 8); pf[3] = PK4(P0, 12); PIN(pf); \
    vf[0] = frag32(vp_, vc0); vf[1] = frag32(vp_ + 32 * 64, vc0); ATT_SBAR(); \
    MFMA8_QK(C1, kf1, qf); \
    if (det_) { SUM8(P1, 0); SUM8(P1, 8); } \
    pf[4] = PK4(P1, 0); pf[5] = PK4(P1, 4); pf[6] = PK4(P1, 8); pf[7] = PK4(P1, 12); PIN(pf); \
    vf[2] = frag32(vp_ + 64 * 64, vc0); vf[3] = frag32(vp_ + 96 * 64, vc0); ATT_SBAR(); \
    if (GK) { DMA_K((t) + 3, sl_cur); } if (GV) { DMA_V((t) + 1, sl_next); } \
    {   \
      float st_; { auto rr = __builtin_amdgcn_permlane32_swap(__float_as_uint(sacc), __float_as_uint(sacc), false, false); st_ = __uint_as_float(rr[0]) + __uint_as_float(rr[1]); } \
      resc = false; \
      if (__builtin_expect(det_ && __any(st_ > ATT_RESC_THR), 0)) { const float dl = (st_ > ATT_RESC_MIN) ? __builtin_fmaxf(__builtin_floorf(__builtin_amdgcn_logf(st_)) - 6.f, ATT_RESC_LO) : 0.f; mhat += dl; \
        asm volatile("s_nop 15\n\ts_nop 15" ::: "memory"); \
        _Pragma("unroll") for (int r = 0; r < 16; ++r) { asm volatile("v_sub_f32 %0, %0, %1" : "+v"(C0[r]) : "v"(dl)); asm volatile("v_sub_f32 %0, %0, %1" : "+v"(C1[r]) : "v"(dl)); } \
        _Pragma("unroll") for (int r = 0; r < 16; ++r) negm[r] = -mhat; asm volatile("" : "+v"(negm)); \
        const float f = fast_exp2(-dl); if (hi == 0) wsf[r32] = f; resc = true; } } \
    asm volatile("s_nop 7" : "+v"(C0), "+v"(C1)); CMASK(C0, C1, t); \
    ATT_SBAR(); \
    MFMA8_PV8(o[0], pf, vf[0]); EXP8(C0, 0); if (GL) kf0 = frag32(kp0 + sl_next * KSLOT8, kc0); ATT_SBAR(); \
    MFMA8_PV8(o[1], pf, vf[1]); EXP8(C0, 8); ATT_SBAR(); \
    MFMA8_PV8(o[2], pf, vf[2]); EXP8(C1, 0); if (GL) kf1 = frag32(kp0 + sl_next * KSLOT8 + 32 * 64, kc0); ATT_SBAR(); \
    MFMA8_PV8(o[3], pf, vf[3]); EXP8(C1, 8); ATT_SBAR(); \
    MFMA8_PV8(ol, pf, ones8); ATT_SBAR(); \
    } while (0)
    int t = 1;
#undef CMASK
#define CMASK(P0, P1, t) do {} while (0)
    for (; t + 5 < NT; t += 2) {
        STEP(pB0, pB1, pA0, pA1, t, true, true, true);       ATT_WAIT_BAR(2); RESC(); ROT();
        STEP(pA0, pA1, pB0, pB1, t + 1, true, true, true);   ATT_WAIT_BAR(2); RESC(); ROT();
    }
#undef CMASK
#define CMASK(P0, P1, t) do { const int jb_ = (t) - (NT - 4); if (jb_ >= 0) cmask(P0, P1, jb_, qrel, hi); } while (0)
#define ENDW(tt) do { if ((tt) + 3 < NT) { ATT_WAIT_BAR(2); } else if ((tt) + 2 < NT) { ATT_WAIT_BAR(1); } else { ATT_WAIT_BAR(0); } } while (0)
    for (; t + 1 < NT; t += 2) {
        STEP(pB0, pB1, pA0, pA1, t, (t + 3 < NT), (t + 1 < NT), (t + 1 < NT));       ENDW(t);     RESC(); ROT();
        STEP(pA0, pA1, pB0, pB1, t + 1, (t + 4 < NT), (t + 2 < NT), (t + 2 < NT));   ENDW(t + 1); RESC(); ROT();
    }
    STEP(pB0, pB1, pA0, pA1, NT - 1, false, false, false); RESC();
    {
      pf[0] = PK4(pB0, 0); pf[1] = PK4(pB0, 4); pf[2] = PK4(pB0, 8); pf[3] = PK4(pB0, 12); pf[4] = PK4(pB1, 0); pf[5] = PK4(pB1, 4); pf[6] = PK4(pB1, 8); pf[7] = PK4(pB1, 12);
      const LAS char* vp_ = vp0 + sl_cur * VSLOT;
      vf[0] = frag32(vp_, vc0); vf[1] = frag32(vp_ + 32 * 64, vc0); vf[2] = frag32(vp_ + 64 * 64, vc0); vf[3] = frag32(vp_ + 96 * 64, vc0);
      asm volatile("s_nop 3" : "+v"(pf));
      MFMA8_PV8(o[0], pf, vf[0]); MFMA8_PV8(o[1], pf, vf[1]); MFMA8_PV8(o[2], pf, vf[2]); MFMA8_PV8(o[3], pf, vf[3]); MFMA8_PV8(ol, pf, ones8);
      asm volatile("s_nop 15\n\ts_nop 15\n\ts_nop 7" : "+v"(o[0]), "+v"(o[1]), "+v"(o[2]), "+v"(o[3]), "+v"(ol)); }
#undef PK4
#undef PIN
#undef SUM8
#undef EXP8
#undef STEP
#undef ENDW
#undef CMASK
#undef RESC
#undef ROT
#pragma unroll
    for (int r = 0; r < 16; ++r) { const float rl = fast_rcp(ol[r]);
#pragma unroll
        for (int d0 = 0; d0 < 4; ++d0) o[d0][r] *= rl; }
#undef DMA_K
#undef DMA_V
}

template <int MODE> __device__ __forceinline__ void attn_unit(int b, int h, int qb, const bf16_t* Q, const bf16_t* K, const unsigned char* Q8, const unsigned char* K8, const unsigned char* V, bf16_t* YAB, float* park, float lam, const float* subg, LAS char* shm) {
    const int tid = opaque_tid(), lane = tid & 63, r32 = lane & 31, hi = lane >> 5; const int wid = __builtin_amdgcn_readfirstlane(tid >> 6);
    for (int m = 0; m < 2; ++m) {
        f32x16 o[4];
        if (m == 0) attn_pass<MODE>(o, b, 2 * h, h, qb, Q, K, V, shm);
        else attn_pass8<MODE>(o, b, 2 * h + 1, h, qb, Q8, K8, V, shm);
        int lo_ = lane; asm volatile("" : "+v"(lo_));
        f32x4* pk = (f32x4*)park + (size_t)wid * 1024 + lo_;
        if (m == 0) {
#pragma unroll
            for (int d0 = 0; d0 < 4; ++d0)
#pragma unroll
                for (int j = 0; j < 4; ++j) pk[(d0 * 4 + j) * 64] = (f32x4){o[d0][4 * j], o[d0][4 * j + 1], o[d0][4 * j + 2], o[d0][4 * j + 3]};
        } else {
            float ss[16];
#pragma unroll
            for (int r = 0; r < 16; ++r) ss[r] = 0.f;
#pragma unroll
            for (int d0 = 0; d0 < 4; ++d0)
#pragma unroll
                for (int j = 0; j < 4; ++j) { const f32x4 a = pk[(d0 * 4 + j) * 64];
#pragma unroll
                    for (int e = 0; e < 4; ++e) { const float v = a[e] - lam * o[d0][4 * j + e]; o[d0][4 * j + e] = v; ss[4 * j + e] += v * v; } }
#pragma unroll
            for (int r = 0; r < 16; ++r) { float s = ss[r]; s += __shfl_xor(s, 1); s += __shfl_xor(s, 2); s += __shfl_xor(s, 4); s += __shfl_xor(s, 8); s += __shfl_xor(s, 16); ss[r] = 0.8f / sqrtf(s * (1.0f / 128.0f) + EPS); }
            float gd[4];
#pragma unroll
            for (int d0 = 0; d0 < 4; ++d0) gd[d0] = subg[d0 * 32 + r32];
            LAS bf16_t* stg = (LAS bf16_t*)(shm + L_OST) + wid * 4096;
#pragma unroll
            for (int r = 0; r < 16; ++r) { const int orow = crow(r, hi);
#pragma unroll
                for (int d0 = 0; d0 < 4; ++d0) { float y = o[d0][r] * ss[r] * gd[d0];
#if PROBE_PHASE == 51
                    if (!(__builtin_fabsf(y) < 1e30f)) y = 0.f;
#endif
                    stg[orow * 128 + d0 * 32 + r32] = (bf16_t)(cvt_pk_bf16(y, 0.f) & 0xffffu); } }
            asm volatile("s_waitcnt lgkmcnt(0)" ::: "memory");
            bf16_t* Ow = YAB + ((long)b * SEQ + qb * QB + wid * 32) * 1024 + 512 + h * 128;
#pragma unroll
            for (int i = 0; i < 8; ++i) { const int row = i * 4 + (lo_ >> 4), ch = lo_ & 15; const u32x4 v = *(const LAS u32x4*)(stg + row * 128 + ch * 8); *(u32x4*)(Ow + (long)row * 1024 + ch * 8) = v; }
        }
        asm volatile("s_waitcnt lgkmcnt(0)\n\ts_barrier" ::: "memory");
    }
}
#undef ATT_WAIT_BAR
#undef MX3
#undef ATT_SBAR
#undef ATT_MFMA
#undef MFMA8_PV
#undef MFMA8_QK
#undef MFMA8_PV8
}

#define XB_TMO      128
#define XB_XCNT(j)  (256  + 64 * (j))
#define XB_XSUB(j)  (1280 + 64 * (j))
#define XB_XGEN(j)  (2304 + 64 * (j))
#define XB_TOP      3328
#define XB_TOPGEN   3392
#define XCD_BAR_WORDS 3456
#define XB_SPIN_CAP (1u << 18)
__device__ __forceinline__ unsigned xb_ld(unsigned* p)              { return __hip_atomic_load(p, __ATOMIC_RELAXED, __HIP_MEMORY_SCOPE_AGENT); }
__device__ __forceinline__ unsigned xb_add(unsigned* p, unsigned v) { return __hip_atomic_fetch_add(p, v, __ATOMIC_RELAXED, __HIP_MEMORY_SCOPE_AGENT); }
__device__ __forceinline__ unsigned xb_xcc_id() { return (unsigned)__builtin_amdgcn_s_getreg((3 << 11) | 20) & 0xFu; }
#define XB_SPIN(cond, bar) do { unsigned _sp = 0; while (cond) { __builtin_amdgcn_s_sleep(1); \
    if ((++_sp & 255u) == 0u) { if (xb_ld(&(bar)[XB_TMO])) break; if (_sp > XB_SPIN_CAP) { atomicAdd(&(bar)[XB_TMO], 1u); break; } } } } while (0)
struct XcdBarrier { unsigned* bar; unsigned x; volatile LAS unsigned* st; };
__device__ __forceinline__ XcdBarrier xcd_barrier_post(unsigned* bar, volatile LAS unsigned* st) {
    XcdBarrier b; b.bar = bar; b.x = xb_xcc_id(); b.st = st;
    if (threadIdx.x == 0) (void)xb_add(&bar[XB_XCNT(b.x)], 1u);
    return b;
}
__device__ __forceinline__ void xcd_barrier_complete(unsigned* bar, unsigned x, unsigned& nloc, unsigned& nx) {
    const unsigned G = gridDim.x * gridDim.y * gridDim.z;
    unsigned sum, cnt, mine, sp = 0u;
    for (;;) {
        sum = 0u; cnt = 0u; mine = 0u;
#pragma unroll
        for (unsigned j = 0; j < 16; ++j) { const unsigned c = xb_ld(&bar[XB_XCNT(j)]); sum += c; cnt += (c > 0u) ? 1u : 0u; mine = (j == x) ? c : mine; }
        if (sum == G) break;
        __builtin_amdgcn_s_sleep(1);
        if ((++sp & 255u) == 0u) { if (xb_ld(&bar[XB_TMO])) break; if (sp > XB_SPIN_CAP) { atomicAdd(&bar[XB_TMO], 1u); break; } }
    }
    nloc = mine > 0u ? mine : 1u; nx = cnt > 0u ? cnt : 1u;
}
__device__ __forceinline__ void xcd_barrier(const XcdBarrier& b) {
    asm volatile("s_waitcnt vmcnt(0)" ::: "memory");
    __syncthreads();
    if (threadIdx.x == 0) {
        unsigned* bar = b.bar;
        __builtin_amdgcn_s_waitcnt(0);
        unsigned nloc = b.st[0], nx = b.st[1];
        if (nloc == 0u) { xcd_barrier_complete(bar, b.x, nloc, nx); b.st[0] = nloc; b.st[1] = nx; }
        const unsigned old = xb_add(&bar[XB_XSUB(b.x)], 1u);
        const unsigned gen = old / nloc;
        if (old + 1u == (gen + 1u) * nloc) {
            __builtin_amdgcn_fence(__ATOMIC_RELEASE, "agent");
            asm volatile("s_waitcnt vmcnt(0)" ::: "memory");
            const unsigned og = xb_add(&bar[XB_TOP], 1u);
            const unsigned tg = og / nx;
            if (og + 1u == (tg + 1u) * nx) xb_add(&bar[XB_TOPGEN], 1u);
            else XB_SPIN(xb_ld(&bar[XB_TOPGEN]) == tg, bar);
            __builtin_amdgcn_fence(__ATOMIC_ACQUIRE, "agent");
            xb_add(&bar[XB_XGEN(b.x)], 1u);
            asm volatile("s_waitcnt vmcnt(0)" ::: "memory");
        } else {
            XB_SPIN(xb_ld(&bar[XB_XGEN(b.x)]) == gen, bar);
            __builtin_amdgcn_fence(__ATOMIC_ACQUIRE, "agent");
            asm volatile("s_waitcnt vmcnt(0)" ::: "memory");
        }
    }
    __syncthreads();
}

#define GRID_BAR() xcd_barrier(bar)

__device__ __forceinline__ void phase_stagger(int cls, unsigned ticks) {
    const unsigned long long t0 = __builtin_amdgcn_s_memrealtime(); const unsigned long long want = (unsigned long long)cls * ticks;
    while (__builtin_amdgcn_s_memrealtime() - t0 < want) __builtin_amdgcn_s_sleep(8);
}

struct Args {
    const float* x; const int* pos; const float* norm_mix_g; const float* w_in; const float* gm_ln_g; const float* gm_ln_b; const float* gm_w_s; const float* gm_b_s;
    const float* lam_q1; const float* lam_k1; const float* lam_q2; const float* lam_k2; const float* subln_g; const float* w_br_a; const float* w_br_b; const float* w_out;
    const float* norm_ffn_g; const float* w_rg; const float* b_rg; const float* w_re; const float* b_re; const float* w_gate; const float* w_up; const float* w_down; const float* final_g;
    float* out; unsigned char* ws;
};

__device__ __forceinline__ int wrow_map(int rmode, int n) { return rmode == 0 ? n : rmode == 1 ? ((n >> 5) * 128 + (n & 31)) : (((n >> 3) & 1) * 128 + (n >> 4) * 8 + (n & 7)); }
__device__ __forceinline__ void transpose_item(const float* W, int ldw, int k0, int n0, bf16_t* WT, int ldt, int drow0, int dk0, const float* gk, LAS float* scr, int lane, float sc = 1.0f, int rmode = 0) {
    f32x4 v[16];
    const int kr = lane >> 4, nc = (lane & 15) * 4;
#pragma unroll
    for (int i = 0; i < 16; ++i) v[i] = *(const f32x4*)(W + (size_t)(k0 + 4 * i + kr) * ldw + n0 + nc);
    if (gk) {
#pragma unroll
        for (int i = 0; i < 16; ++i) v[i] = v[i] * gk[k0 + 4 * i + kr];
    }
    if (sc != 1.0f) {
#pragma unroll
        for (int i = 0; i < 16; ++i) v[i] = v[i] * sc;
    }
#pragma unroll
    for (int i = 0; i < 16; ++i) { LAS float* d = scr + (4 * i + kr) * 65 + nc; d[0] = v[i][0]; d[1] = v[i][1]; d[2] = v[i][2]; d[3] = v[i][3]; }
    LDS_WAIT(); asm volatile("" ::: "memory");
    const int c = lane & 7;
#pragma unroll
    for (int j = 0; j < 8; ++j) { const int n = (lane >> 3) + 8 * j; const LAS float* s = scr + (8 * c) * 65 + n;
        u32x4 o; o.x = cvt_pk_bf16(s[0 * 65], s[1 * 65]); o.y = cvt_pk_bf16(s[2 * 65], s[3 * 65]); o.z = cvt_pk_bf16(s[4 * 65], s[5 * 65]); o.w = cvt_pk_bf16(s[6 * 65], s[7 * 65]);
        *(u32x4*)(WT + (size_t)(drow0 + wrow_map(rmode, n)) * ldt + dk0 + k0 + 8 * c) = o; }
    LDS_WAIT(); asm volatile("" ::: "memory");
}
__device__ __forceinline__ void transpose_item8(const float* W, int ldw, int k0, int n0, unsigned char* WT, int ldt, int drow0, const float* gk, float sc, LAS float* scr, int lane, int rmode = 0) {
    f32x4 v[16];
    const int kr = lane >> 4, nc = (lane & 15) * 4;
#pragma unroll
    for (int i = 0; i < 16; ++i) v[i] = *(const f32x4*)(W + (size_t)(k0 + 4 * i + kr) * ldw + n0 + nc);
#pragma unroll
    for (int i = 0; i < 16; ++i) v[i] = v[i] * (gk ? gk[k0 + 4 * i + kr] * sc : sc);
#pragma unroll
    for (int i = 0; i < 16; ++i) { LAS float* d = scr + (4 * i + kr) * 65 + nc; d[0] = v[i][0]; d[1] = v[i][1]; d[2] = v[i][2]; d[3] = v[i][3]; }
    LDS_WAIT(); asm volatile("" ::: "memory");
    const int c = lane & 7;
#pragma unroll
    for (int j = 0; j < 8; ++j) { const int n = (lane >> 3) + 8 * j; const LAS float* s = scr + (8 * c) * 65 + n;
        u32x2 o; o.x = cvt_pk4_fp8(s[0 * 65], s[1 * 65], s[2 * 65], s[3 * 65]); o.y = cvt_pk4_fp8(s[4 * 65], s[5 * 65], s[6 * 65], s[7 * 65]);
        *(u32x2*)(WT + (size_t)(drow0 + wrow_map(rmode, n)) * ldt + k0 + 8 * c) = o; }
    LDS_WAIT(); asm volatile("" ::: "memory");
}
__device__ __forceinline__ void expert_item(int r, const float* w_gate, const float* w_up, const float* w_down, const float* gffn, unsigned char* W13, unsigned char* W2, LAS float* scr, int lane) {
    constexpr int I_G = 32 * 128;
    if (r < 2 * I_G) { const int up = r >= I_G; if (up) r -= I_G; const int e = r / 128, q = r % 128, kb = q / 8, nb = q % 8;
        const int n0 = 64 * nb, drow = e * 1024 + (n0 >> 7) * 256 + up * 128 + (n0 & 127);
        transpose_item8((up ? w_up : w_gate) + (size_t)e * 1024 * 512, 512, 64 * kb, n0, W13, 1024, drow, gffn, 64.f, scr, lane); return; }
    r -= 2 * I_G;
    { const int e = r / 128, q = r % 128, kb = q / 16, nb = q % 16;
        transpose_item8(w_down + (size_t)e * 512 * 1024, 1024, 64 * kb, 64 * nb, W2, 512, e * 1024 + (nb >> 2) * 256 + (nb & 3) * 32, nullptr, 32.f, scr, lane, 2); }
}
__device__ __forceinline__ void rms_row_to_bf16(const float* xrow, const float* g, bf16_t* orow, int lane) {
    const f32x4* xr = (const f32x4*)xrow + lane; const f32x4* gr = (const f32x4*)g + lane;
    f32x4 v[4]; float s = 0.f;
#pragma unroll
    for (int j = 0; j < 4; ++j) { v[j] = xr[64 * j]; s += (v[j].x * v[j].x + v[j].y * v[j].y) + (v[j].z * v[j].z + v[j].w * v[j].w); }
    const float rstd = 1.f / sqrtf(wave_sum(s) * (1.f / D) + EPS);
    u32x2* o8 = (u32x2*)orow + lane;
#pragma unroll
    for (int j = 0; j < 4; ++j) { const f32x4 gg = gr[64 * j]; u32x2 w; w.x = cvt_pk_bf16(v[j].x * rstd * gg.x, v[j].y * rstd * gg.y); w.y = cvt_pk_bf16(v[j].z * rstd * gg.z, v[j].w * rstd * gg.w); o8[64 * j] = w; }
}

__global__ void __launch_bounds__(NTHREADS, 2) fwd_kernel(Args a) {
    extern __shared__ __attribute__((aligned(16))) unsigned char lds_raw[];
    LAS unsigned char* lds = (LAS unsigned char*)lds_raw;
    volatile LAS unsigned* LCTL = (volatile LAS unsigned*)(lds + LDSCTL_OFF);
    const int tid0 = threadIdx.x;
    const int G = gridDim.x, bx = blockIdx.x;
    const int vcu = (G % 8 == 0) ? (bx % 8) * (G / 8) + bx / 8 : bx;
    unsigned char* ws = a.ws;
    unsigned* ctl = (unsigned*)(ws + WS_CTL);
    __builtin_amdgcn_s_setreg((23 << 6) | 1, 1);
    for (int u = tid0; u < (LDS_BYTES - LDSCTL_OFF) / 4; u += NTHREADS) LCTL[u] = 0u;
    __syncthreads();
    XcdBarrier bar = xcd_barrier_post(ctl + CW_BAR, LCTL);
    const int NGW = G * NWAVES;
#define PHASE_IDS() const int tid = opaque_tid(), lane = tid & 63, wave = __builtin_amdgcn_readfirstlane(tid >> 6), gw = vcu * NWAVES + wave; (void)lane; (void)gw

    bf16_t* WIN = (bf16_t*)(ws + WS_WIN); bf16_t* WBR = (bf16_t*)(ws + WS_WBR); bf16_t* WO = (bf16_t*)(ws + WS_WO); unsigned char* W13 = ws + WS_W13; unsigned char* W2 = ws + WS_W2;
    bf16_t* WRH = (bf16_t*)(ws + WS_WRH); bf16_t* WRL = (bf16_t*)(ws + WS_WRL); float* CS = (float*)(ws + WS_CS); float* SSQ = (float*)(ws + WS_SSQ); float* RSTD = (float*)(ws + WS_RSTD); float* WTS = (float*)(ws + WS_WTS);
    int* LIST = (int*)(ws + WS_LIST);
    float* PARK = (float*)(ws + WS_PARK);
    bf16_t* XN = (bf16_t*)(ws + WS_RA); bf16_t* YAB = (bf16_t*)(ws + WS_RA); unsigned char* YB8 = ws + WS_RA;
    bf16_t* UV = (bf16_t*)(ws + WS_RB); bf16_t* MG = (bf16_t*)(ws + WS_RB);
    bf16_t* Qb = (bf16_t*)(ws + WS_RC); bf16_t* Kb = Qb + (size_t)T * 512; bf16_t* XB = (bf16_t*)(ws + WS_RC); unsigned char* V8T = ws + WS_RE + 128 * MiB; unsigned char* Q8 = V8T + 32 * MiB; unsigned char* K8 = Q8 + 16 * MiB;
    bf16_t* Vb = (bf16_t*)(ws + WS_RD);
    unsigned char* G8 = ws + WS_RE; unsigned char* H8 = ws + WS_RE; unsigned char* XB8 = ws + WS_RD;

    for (int rep = 0; rep < REPS(0); ++rep) {
        PHASE_IDS();
        LAS float* scr = (LAS float*)(lds + wave * 16896);
#if LEVEL >= 1
        constexpr int I_IN = 16 * 72, I_BA = 8 * 16, I_BB = 8 * 16, I_O = 16 * 16;
        constexpr int NITEMS = I_IN + I_BA + I_BB + I_O;
        for (int it = gw; it < NITEMS; it += NGW) {
            int r = it;
            if (r < I_IN) { const int kb = r / 72, nb = r % 72; transpose_item(a.w_in, IN_COLS, 64 * kb, 64 * nb, WIN, 1024, (nb >> 2) * 256 + (nb & 3) * 32, 0, nullptr, scr, lane, (64 * nb >= 2560) ? -LOG2E : 1.0f, (64 * nb >= 2560) ? 2 : 1); continue; } r -= I_IN;
            if (r < I_BA) { const int kb = r / 16, nb = r % 16; transpose_item(a.w_br_a, 1024, 64 * kb, 64 * nb, WBR, 1024, (nb >> 2) * 256 + (nb & 3) * 32, 0, nullptr, scr, lane, 1.0f, 1); continue; } r -= I_BA;
            if (r < I_BB) { const int kb = r / 16, nb = r % 16; transpose_item(a.w_br_b, 1024, 64 * kb, 64 * nb, WBR, 1024, (nb >> 2) * 256 + (nb & 3) * 32, 512, nullptr, scr, lane, 1.0f, 1); continue; } r -= I_BB;
            { const int kb = r / 16, nb = r % 16; transpose_item(a.w_out, 1024, 64 * kb, 64 * nb, WO, 1024, (nb >> 2) * 256 + (nb & 3) * 32, 0, nullptr, scr, lane, 1.0f, 1); }
        }
#if LEVEL >= 3
        for (int i = bx * NTHREADS + tid; i < 64 * 1024; i += G * NTHREADS) { const int n = i >> 10, k = i & 1023; float v = 0.f; if (n < 4) v = a.w_rg[k * 4 + n]; else if (n < 36) v = a.w_re[k * 32 + (n - 4)];
            v *= a.norm_ffn_g[k]; const unsigned h = cvt_pk_bf16(v, 0.f) & 0xffffu; const float r = v - __uint_as_float(h << 16); WRH[i] = (bf16_t)h; WRL[i] = (bf16_t)(cvt_pk_bf16(r, 0.f) & 0xffffu); }
#endif
        for (int i = bx * NTHREADS + tid; i < T * 8; i += G * NTHREADS) { const int t = i >> 3, j = i & 7;
            const double invf = exp2(-(double)j * (18.931568569324174 / 8.0));
            const double ang = (double)a.pos[t] * invf; const double kk = rint(ang * 0.15915494309189535); const float rr = (float)(ang - kk * 6.283185307179586);
            CS[t * 16 + j] = cosf(rr); CS[t * 16 + 8 + j] = sinf(rr); }
        for (int m = gw; m < T; m += NGW) rms_row_to_bf16(a.x + (size_t)m * D, a.norm_mix_g, XN + (size_t)m * D, lane);
#endif
    }
    GRID_BAR();

#if LEVEL >= 1 && !defined(NO_P1)
#if PROBE_PHASE >= 71 && PROBE_PHASE <= 73
    {
        pg8::DenseProb P; P.init(XN, WIN, T, IN_COLS, 1024, G, bx);
        pg8::EpiInProjT<(PROBE_PHASE == 73 ? 4 : PROBE_PHASE - 70)> E{UV, Qb, Kb, Vb, G8, CS, Q8, K8};
        pg8::gemm_core<false>(lds, P, E, pg8::NoHook{});
    }
#endif
#if PROBE_PHASE == 66 || PROBE_PHASE == 67
    {
        pg8::DenseProb P; P.init(XN, WIN, T, IN_COLS, 1024, G, bx);
        pg8::EpiInProjT<PROBE_PHASE - 65> E{UV, Qb, Kb, Vb, G8, CS, Q8, K8};
        pg8::gemm_core<false, pg8::DenseProb, pg8::EpiInProjT<PROBE_PHASE - 65>, pg8::NoHook, 4>(lds, P, E, pg8::NoHook{});
    }
#endif
#if PROBE_PHASE == 64
    {
        pg8::DenseProb P; P.init(XN, WIN, T, IN_COLS, 1024, G, bx);
        pg8::EpiInProj E{UV, Qb, Kb, Vb, G8, CS, Q8, K8};
        pg8::gemm_core<false, pg8::DenseProb, pg8::EpiInProj, pg8::NoHook, 4>(lds, P, E, pg8::NoHook{});
    }
#endif
    for (int rep = 0; rep < REPS(1); ++rep) {
#ifdef STAG1
        phase_stagger(((bx >> 3) & 7) >> 1, STAG1);
#endif
        pg8::DenseProb P; P.init(XN, WIN, T, IN_COLS, 1024, G, bx);
        pg8::EpiInProj E{UV, Qb, Kb, Vb, G8, CS, Q8, K8};
        pg8::gemm_core<false>(lds, P, E, pg8::NoHook{});
    }
#if PROBE_PHASE == 11
    {
        pg8::DenseProb P; P.init(XN, WIN, T, IN_COLS, 1024, G, bx);
        pg8::gemm_core<false>(lds, P, pg8::EpiNull{}, pg8::NoHook{});
    }
#endif
#if PROBE_PHASE >= 61 && PROBE_PHASE <= 63
    {
        pg8::DenseProb P; P.init(XN, WIN, T, IN_COLS, 1024, G, bx);
        pg8::gemm_core<false, pg8::DenseProb, pg8::EpiNull, pg8::NoHook, PROBE_PHASE - 60>(lds, P, pg8::EpiNull{}, pg8::NoHook{});
    }
#endif
#if PROBE_PHASE == 31
    {
        pg8::DenseProb P; P.init(XN, WIN, T, IN_COLS, 1024, G, bx);
        pg8::gemm_core<false>(lds, P, pg8::EpiStoreOnly{(bf16_t*)(ws + WS_END)}, pg8::NoHook{});
    }
#endif
#if PROBE_PHASE == 12
    {
        pg8::DenseProbSame P; P.init(XN, WIN, T, IN_COLS, 1024, G, bx);
        pg8::gemm_core<false>(lds, P, pg8::EpiNull{}, pg8::NoHook{});
    }
#endif
#endif
    GRID_BAR();

#if LEVEL >= 1 && !defined(NO_P2A)
    for (int rep = 0; rep < REPS(2); ++rep) {
        PHASE_IDS();
        LAS bf16_t* VT = (LAS bf16_t*)lds;
        LAS float* SV = (LAS float*)(lds + 36864);
        const int r32 = lane & 31, hi = lane >> 5;
        for (int un = vcu; un < 2048; un += G) {
            const int ch = un >> 2, g = un & 3; const size_t row0 = (size_t)ch * 128;
            {
                const int s = tid >> 2, qd = tid & 3;
                const u32x4* vp = (const u32x4*)(UV + (row0 + s) * 1024 + 512 + g * 128 + qd * 32);
                float v[32]; float sm = 0.f;
#pragma unroll
                for (int j = 0; j < 4; ++j) { const u32x4 w = vp[j]; f32x4 x0, x1; pg8::unpack8(w, x0, x1);
#pragma unroll
                    for (int e = 0; e < 4; ++e) { v[8 * j + e] = x0[e]; v[8 * j + 4 + e] = x1[e]; sm += x0[e] + x1[e]; } }
                sm += __shfl_xor(sm, 1); sm += __shfl_xor(sm, 2);
                const float mu = sm * (1.0f / 128.0f); float sq = 0.f;
#pragma unroll
                for (int i = 0; i < 32; ++i) { v[i] -= mu; sq += v[i] * v[i]; }
                sq += __shfl_xor(sq, 1); sq += __shfl_xor(sq, 2);
                const float rstd = 1.0f / sqrtf(sq * (1.0f / 128.0f) + EPS);
                const float* lg = a.gm_ln_g + g * 128 + qd * 32; const float* lb = a.gm_ln_b + g * 128 + qd * 32;
#pragma unroll
                for (int i = 0; i < 32; ++i) { const float y = v[i] * rstd * lg[i] + lb[i]; VT[(qd * 32 + i) * 136 + s] = (bf16_t)(cvt_pk_bf16(y, 0.f) & 0xffffu); }
            }
            LDS_WAIT(); __syncthreads();
            {
                const int tb = wave >> 1, db0 = 2 * (wave & 1);
                f32x16 c0 = f32x16{}, c1 = f32x16{};
                const float* wrow = a.gm_w_s + ((size_t)g * 128 + tb * 32 + r32) * 128;
                const int trow = tb * 32 + r32;
                for (int ks = 0; ks <= 2 * tb + 1; ++ks) {
                    const int s0 = 16 * ks + 8 * hi;
                    const f32x4 wa = *(const f32x4*)(wrow + s0), wb = *(const f32x4*)(wrow + s0 + 4);
                    float w8[8] = {wa[0], wa[1], wa[2], wa[3], wb[0], wb[1], wb[2], wb[3]};
#pragma unroll
                    for (int j = 0; j < 8; ++j) if (s0 + j > trow) w8[j] = 0.f;
                    u32x4 aw; aw.x = cvt_pk_bf16(w8[0], w8[1]); aw.y = cvt_pk_bf16(w8[2], w8[3]); aw.z = cvt_pk_bf16(w8[4], w8[5]); aw.w = cvt_pk_bf16(w8[6], w8[7]);
                    const bf16x8 af = __builtin_bit_cast(bf16x8, aw);
                    const bf16x8 b0 = *(const LAS bf16x8*)(VT + ((db0 + 0) * 32 + r32) * 136 + s0);
                    const bf16x8 b1 = *(const LAS bf16x8*)(VT + ((db0 + 1) * 32 + r32) * 136 + s0);
                    c0 = __builtin_amdgcn_mfma_f32_32x32x16_bf16(af, b0, c0, 0, 0, 0);
                    c1 = __builtin_amdgcn_mfma_f32_32x32x16_bf16(af, b1, c1, 0, 0, 0);
                }
#pragma unroll
                for (int r = 0; r < 16; ++r) { const int t = tb * 32 + att::crow(r, hi); const float bs = a.gm_b_s[g * 128 + t];
                    SV[t * 132 + db0 * 32 + r32] = c0[r] + bs; SV[t * 132 + db0 * 32 + 32 + r32] = c1[r] + bs; }
            }
            LDS_WAIT(); __syncthreads();
            {
#pragma unroll
                for (int i = 0; i < 4; ++i) { const int t = i * 32 + (tid >> 4), dc = (tid & 15) * 8;
                    const size_t ro = (row0 + t) * 1024 + g * 128 + dc;
                    const u32x4 uw = *(const u32x4*)(UV + ro); f32x4 u0, u1; pg8::unpack8(uw, u0, u1);
                    const f32x4 s0 = *(const LAS f32x4*)(SV + t * 132 + dc), s1 = *(const LAS f32x4*)(SV + t * 132 + dc + 4);
                    *(u32x4*)(YAB + ro) = pg8::pack8(u0 * s0, u1 * s1); }
            }
            LDS_WAIT(); __syncthreads();
        }
    }
#endif
#if LEVEL >= 2
    {
        PHASE_IDS();
        LAS unsigned char* TB = (LAS unsigned char*)lds + wave * 8192;
        for (int tl = gw; tl < BATCH * 4 * (SEQ / 64); tl += NGW) {
            const int bh = tl >> 7, tt = tl & 127, b = bh >> 2, h = bh & 3;
            const bf16_t* vsrc = Vb + ((size_t)b * SEQ + tt * 64) * 512 + h * 128;
            u32x4 w[16];
#pragma unroll
            for (int i = 0; i < 16; ++i) w[i] = *(const u32x4*)(vsrc + (size_t)(i * 4 + (lane >> 4)) * 512 + (lane & 15) * 8);
#pragma unroll
            for (int i = 0; i < 16; ++i) { const int key = i * 4 + (lane >> 4), kk = key & 31, khi = (kk >> 2) & 1, j = (kk & 3) + 4 * (kk >> 3) + 16 * (key >> 5), cc = khi * 2 + (j >> 4);
                f32x4 x0, x1; pg8::unpack8(w[i], x0, x1); const unsigned q0_ = cvt_pk4_fp8(x0[0], x0[1], x0[2], x0[3]), q1_ = cvt_pk4_fp8(x1[0], x1[1], x1[2], x1[3]);
#pragma unroll
                for (int e = 0; e < 8; ++e) { const int d = (lane & 15) * 8 + e; const unsigned byte = ((e < 4 ? q0_ : q1_) >> (8 * (e & 3))) & 0xffu;
                    TB[d * 64 + ((cc ^ ((d >> 2) & 3)) * 16) + (j & 15)] = (unsigned char)byte; } }
            LDS_WAIT(); asm volatile("" ::: "memory");
            unsigned char* dst = V8T + (size_t)tl * 8192;
#pragma unroll
            for (int i = 0; i < 8; ++i) *(u32x4*)(dst + (i * 64 + lane) * 16) = *(const LAS u32x4*)(TB + (i * 64 + lane) * 16);
            LDS_WAIT(); asm volatile("" ::: "memory");
        }
    }
    GRID_BAR();
#endif
#if LEVEL >= 2 && !defined(NO_P2B)
    {
        PHASE_IDS();
        float lam;
        { const float p1 = wave_sum(a.lam_q1[lane] * a.lam_k1[lane]), p2 = wave_sum(a.lam_q2[lane] * a.lam_k2[lane]); lam = expf(p1) - expf(p2) + 0.2f; }
        const int bh = vcu >> 3, s = vcu & 7, b = bh >> 2, h = bh & 3;
        float* park = PARK + (size_t)bx * 32768;
        if (G == 256) {
            for (int ii = 0; ii < 4 * REPS(3); ++ii) { const int i = ii & 3; const int qb = (i == 0) ? s : (i == 1) ? 15 - s : (i == 2) ? 16 + s : 31 - s;
                att::attn_unit<0>(b, h, qb, Qb, Kb, Q8, K8, V8T, YAB, park, lam, a.subln_g, (LAS char*)lds);
#if LEVEL >= 3
                if (ii < 4) {
                    LAS float* scr = (LAS float*)(lds + wave * 16896);
                    for (int k = wave; k < 12; k += NWAVES) expert_item((bx * 4 + ii) * 12 + k, a.w_gate, a.w_up, a.w_down, a.norm_ffn_g, W13, W2, scr, lane);
                    LDS_WAIT(); __syncthreads();
                }
#endif
            }
#if PROBE_PHASE == 13 || PROBE_PHASE == 14 || PROBE_PHASE == 15 || PROBE_PHASE == 16
            for (int i = 0; i < 4; ++i) { const int qb = (i == 0) ? s : (i == 1) ? 15 - s : (i == 2) ? 16 + s : 31 - s;
                att::attn_unit<PROBE_PHASE - 13>(0, 0, qb, Qb, Kb, Q8, K8, V8T, (bf16_t*)(ws + WS_END), park, lam, a.subln_g, (LAS char*)lds); }
#endif
        }
    }
#elif LEVEL >= 1
    {
        PHASE_IDS();
        for (int i = bx * NTHREADS + tid; i < T * 64; i += G * NTHREADS) { const int row = i >> 6, c = i & 63; *(u32x4*)(YAB + (size_t)row * 1024 + 512 + c * 8) = (u32x4){0u, 0u, 0u, 0u}; }
    }
#endif
    GRID_BAR();

#if LEVEL >= 1 && !defined(NO_P3)
    for (int rep = 0; rep < REPS(4); ++rep) {
        pg8::PanelProb P; P.init(YAB, WBR, T, 1024, 1024, G, bx);
        pg8::EpiMerge E{G8, MG};
        pg8::gemm_core<false>(lds, P, E, pg8::HookMerge{G8});
    }
#endif
    asm volatile("s_waitcnt vmcnt(0)" ::: "memory"); __syncthreads();
#if LEVEL >= 1 && !defined(NO_P4)
    for (int rep = 0; rep < REPS(5); ++rep) {
        pg8::PanelProb P; P.init(MG, WO, T, 1024, 1024, G, bx);
        pg8::EpiX1 E{a.x, XB, XB8, SSQ};
        pg8::gemm_core<false>(lds, P, E, pg8::NoHook{});
    }
#endif
    asm volatile("s_waitcnt vmcnt(0)" ::: "memory"); __syncthreads();

#if LEVEL >= 3 && !defined(NO_P5)
    {
        PHASE_IDS();
        LAS float* LG = (LAS float*)lds;
        volatile LAS int* LCNT = (volatile LAS int*)(LCTL + 96); volatile LAS int* LBASE = (volatile LAS int*)(LCTL + 128);
        const int r32 = lane & 31, hi = lane >> 5;
        for (int tb = bx; tb < T / 256; tb += G) {
            const size_t tok0 = (size_t)tb * 256 + wave * 32;
            const bf16_t* xa = XB + (tok0 + r32) * 1024 + hi * 8;
            const bf16_t* wh0 = WRH + (size_t)r32 * 1024 + hi * 8; const bf16_t* wh1 = wh0 + 32 * 1024;
            const bf16_t* wl0 = WRL + (size_t)r32 * 1024 + hi * 8; const bf16_t* wl1 = wl0 + 32 * 1024;
            f32x16 c0 = f32x16{}, c1 = f32x16{};
#pragma unroll 4
            for (int ks = 0; ks < 64; ++ks) {
                const bf16x8 av = *(const bf16x8*)(xa + ks * 16);
                const bf16x8 h0 = *(const bf16x8*)(wh0 + ks * 16), h1 = *(const bf16x8*)(wh1 + ks * 16), l0 = *(const bf16x8*)(wl0 + ks * 16), l1 = *(const bf16x8*)(wl1 + ks * 16);
                c0 = __builtin_amdgcn_mfma_f32_32x32x16_bf16(av, h0, c0, 0, 0, 0); c1 = __builtin_amdgcn_mfma_f32_32x32x16_bf16(av, h1, c1, 0, 0, 0);
                c0 = __builtin_amdgcn_mfma_f32_32x32x16_bf16(av, l0, c0, 0, 0, 0); c1 = __builtin_amdgcn_mfma_f32_32x32x16_bf16(av, l1, c1, 0, 0, 0);
            }
#pragma unroll
            for (int r = 0; r < 16; ++r) { const int tl = wave * 32 + att::crow(r, hi); LG[tl * 37 + r32] = c0[r]; if (r32 < 4) LG[tl * 37 + 32 + r32] = c1[r]; }
            if (tid < 32) LCNT[tid] = 0;
            LDS_WAIT(); __syncthreads();
            int eid0 = 0, eid1 = 0, rk0 = 0, rk1 = 0; float w0 = 0.f, w1 = 0.f; const size_t tok = (size_t)tb * 256 + tid;
            if (tid < 256) {
                float ssq = 0.f;
#pragma unroll
                for (int j = 0; j < 16; ++j) ssq += SSQ[tok * 16 + j];
                const float rstd = 1.0f / sqrtf(ssq * (1.0f / 1024.0f) + EPS);
                RSTD[tok] = rstd;
                const LAS float* p0 = LG + tid * 37;
                float gl[4]; int grp = 0;
#pragma unroll
                for (int j = 0; j < 4; ++j) gl[j] = p0[j] * rstd + a.b_rg[j];
                float gmx = gl[0];
#pragma unroll
                for (int j = 1; j < 4; ++j) if (gl[j] > gmx) { gmx = gl[j]; grp = j; }
                float gs = 0.f;
#pragma unroll
                for (int j = 0; j < 4; ++j) gs += expf(gl[j] - gmx);
                const float gwt = 1.0f / gs;
                float el[8];
#pragma unroll
                for (int j = 0; j < 8; ++j) el[j] = p0[4 + grp * 8 + j] * rstd + a.b_re[grp * 8 + j];
                int i0 = 0; float v0 = el[0];
#pragma unroll
                for (int j = 1; j < 8; ++j) if (el[j] > v0) { v0 = el[j]; i0 = j; }
                int i1 = -1; float v1 = -INFINITY;
#pragma unroll
                for (int j = 0; j < 8; ++j) if (j != i0 && el[j] > v1) { v1 = el[j]; i1 = j; }
                const float e1 = expf(v1 - v0); w0 = gwt / (1.0f + e1); w1 = gwt * e1 / (1.0f + e1);
                eid0 = grp * 8 + i0; eid1 = grp * 8 + i1;
                rk0 = atomicAdd((int*)(LCNT + eid0), 1); rk1 = atomicAdd((int*)(LCNT + eid1), 1);
            }
            LDS_WAIT(); __syncthreads();
            if (tid < 32) LBASE[tid] = (int)__hip_atomic_fetch_add(ctl + CW_CNT + tid, (unsigned)LCNT[tid], RLX_AGENT);
            LDS_WAIT(); __syncthreads();
            if (tid < 256) {
                const int s0_ = eid0 * LISTCAP + LBASE[eid0] + rk0, s1_ = eid1 * LISTCAP + LBASE[eid1] + rk1;
                LIST[s0_] = (int)(((unsigned)(tok * 2) << 15) | (cvt_pk_bf16(w0, 0.f) & 0x7fffu)); LIST[s1_] = (int)(((unsigned)(tok * 2 + 1) << 15) | (cvt_pk_bf16(w1, 0.f) & 0x7fffu));
            }
            LDS_WAIT(); __syncthreads();
        }
    }
#endif
    GRID_BAR();
#if LEVEL >= 3
    {
        PHASE_IDS();
        volatile LAS int* BST = (volatile LAS int*)(LCTL + 16); volatile LAS int* CNT = (volatile LAS int*)(LCTL + 64);
        if (tid == 0) { int accb = 0; for (int e = 0; e < NEXP; ++e) { const int c = (int)__hip_atomic_load(ctl + CW_CNT + e, RLX_AGENT); CNT[e] = c; BST[e] = accb; accb += (c + 255) >> 8; } BST[NEXP] = accb; }
        LDS_WAIT(); __syncthreads();
    }
#if !defined(NO_P6)
    for (int rep = 0; rep < REPS(6); ++rep) {
        pg8::MoeUpProb P; P.init((const LAS int*)(LCTL + 16), (const LAS int*)(LCTL + 64), G, bx); P.A = (const char*)XB8; P.Bt = (const char*)W13; P.pitch = 1024; P.list = LIST;
        pg8::EpiMoeUp E{LIST, RSTD, H8, {}};
        pg8::gemm_core<true>(lds, P, E, pg8::NoHook{});
    }
#endif
#endif
    GRID_BAR();
#if LEVEL >= 3 && !defined(NO_P7)
    for (int rep = 0; rep < REPS(7); ++rep) {
        pg8::MoeDownProb P; P.init((const LAS int*)(LCTL + 16), (const LAS int*)(LCTL + 64), G, bx); P.A = (const char*)H8; P.Bt = (const char*)W2; P.pitch = 512;
        pg8::EpiMoeDown E{LIST, YB8, {}};
        pg8::gemm_core<true>(lds, P, E, pg8::NoHook{});
    }
#endif
    GRID_BAR();

    {
        PHASE_IDS();
        const bool tmo = (__hip_atomic_load(ctl + CW_BAR + XB_TMO, RLX_AGENT) != 0u);
        for (int m = gw; m < T; m += NGW) {
            const f32x4* gr = (const f32x4*)a.final_g + lane;
            f32x4 v[4]; float s = 0.f;
#pragma unroll
            for (int j = 0; j < 4; ++j) {
#if LEVEL >= 1
                { const u32x2 xw = *((const u32x2*)(XB + (size_t)m * D) + lane + 64 * j); v[j] = (f32x4){bf_lo(xw.x), bf_hi(xw.x), bf_lo(xw.y), bf_hi(xw.y)}; }
#else
                v[j] = ((const f32x4*)(a.x + (size_t)m * D) + lane)[64 * j];
#endif
#if LEVEL >= 3
                const unsigned y0 = *((const unsigned*)(YB8 + (size_t)(2 * m) * D) + lane + 64 * j), y1 = *((const unsigned*)(YB8 + (size_t)(2 * m + 1) * D) + lane + 64 * j);
                v[j] = v[j] + (fp8x4_to_f32(y0) + fp8x4_to_f32(y1)) * 0.0625f;
#endif
                s += (v[j].x * v[j].x + v[j].y * v[j].y) + (v[j].z * v[j].z + v[j].w * v[j].w); }
            float rstd = 1.f / sqrtf(wave_sum(s) * (1.f / D) + EPS);
            if (tmo) rstd = __builtin_nanf("");
            f32x4* o = (f32x4*)(a.out + (size_t)m * D) + lane;
#pragma unroll
            for (int j = 0; j < 4; ++j) { f32x4 ov = v[j] * rstd * gr[64 * j];
#if PROBE_PHASE == 50
#pragma unroll
                for (int e = 0; e < 4; ++e) if (!(__builtin_fabsf(ov[e]) < 1e30f)) ov[e] = 0.f;
#endif
                o[64 * j] = ov; }
        }
    }
}

extern "C" void kernel_launch(void* const* d_in, const int* in_sizes, int n_in, void* d_out, int out_size, void* d_ws, size_t ws_size, hipStream_t stream) {
    static int grid = 0;
    if (grid == 0) {
        if (n_in != 25 || in_sizes[0] != T * D || out_size != T * D || ws_size < WS_END + 64 * MiB) { fprintf(stderr, "kernel_launch: unexpected shapes (n_in %d, in0 %d, out %d, ws %zu); nothing launched\n", n_in, n_in > 0 ? in_sizes[0] : -1, out_size, ws_size); grid = -1; return; }
        int dev = 0, cus = 0, per_cu = 0;
        if (hipGetDevice(&dev) != hipSuccess || hipDeviceGetAttribute(&cus, hipDeviceAttributeMultiprocessorCount, dev) != hipSuccess) { grid = -1; return; }
        if (hipFuncSetAttribute((const void*)fwd_kernel, hipFuncAttributeMaxDynamicSharedMemorySize, LDS_BYTES) != hipSuccess) { fprintf(stderr, "kernel_launch: hipFuncSetAttribute failed\n"); grid = -1; return; }
        if (hipOccupancyMaxActiveBlocksPerMultiprocessor(&per_cu, (const void*)fwd_kernel, NTHREADS, LDS_BYTES) != hipSuccess || per_cu < 1) fprintf(stderr, "kernel_launch: occupancy query reports %d\n", per_cu);
        (void)hipGetLastError();
        grid = cus;
        if (grid != 256) fprintf(stderr, "kernel_launch: %d CUs (built for 256)\n", grid);
    }
    if (grid < 0) return;
    if (hipMemsetAsync((char*)d_ws + WS_CTL, 0, CTL_ZERO_BYTES, stream) != hipSuccess) return;
    Args a{};
    a.x = (const float*)d_in[0]; a.pos = (const int*)d_in[1]; a.norm_mix_g = (const float*)d_in[2]; a.w_in = (const float*)d_in[3]; a.gm_ln_g = (const float*)d_in[4]; a.gm_ln_b = (const float*)d_in[5];
    a.gm_w_s = (const float*)d_in[6]; a.gm_b_s = (const float*)d_in[7]; a.lam_q1 = (const float*)d_in[8]; a.lam_k1 = (const float*)d_in[9]; a.lam_q2 = (const float*)d_in[10]; a.lam_k2 = (const float*)d_in[11];
    a.subln_g = (const float*)d_in[12]; a.w_br_a = (const float*)d_in[13]; a.w_br_b = (const float*)d_in[14]; a.w_out = (const float*)d_in[15]; a.norm_ffn_g = (const float*)d_in[16];
    a.w_rg = (const float*)d_in[17]; a.b_rg = (const float*)d_in[18]; a.w_re = (const float*)d_in[19]; a.b_re = (const float*)d_in[20]; a.w_gate = (const float*)d_in[21]; a.w_up = (const float*)d_in[22];
    a.w_down = (const float*)d_in[23]; a.final_g = (const float*)d_in[24];
    a.out = (float*)d_out; a.ws = (unsigned char*)d_ws;
    hipLaunchKernelGGL(fwd_kernel, dim3(grid), dim3(NTHREADS), LDS_BYTES, stream, a);
    const hipError_t le = hipPeekAtLastError();
    if (le != hipSuccess) fprintf(stderr, "kernel_launch: launch failed: %s\n", hipGetErrorName(le));
}
```

```cpp
#include <hip/hip_runtime.h>
#include <cstdio>
#include <cstdint>

#ifndef LEVEL
#define LEVEL 3
#endif

#ifndef PROBE_PHASE
#define PROBE_PHASE -1
#endif
#define REPS(p) ((PROBE_PHASE == (p)) ? 2 : 1)
#define LAS __attribute__((address_space(3)))
#define GAS __attribute__((address_space(1)))
typedef unsigned short bf16_t;
typedef short bf16x8 __attribute__((ext_vector_type(8)));
typedef short s16x4 __attribute__((ext_vector_type(4)));
typedef float f32x2 __attribute__((ext_vector_type(2)));
typedef float f32x4 __attribute__((ext_vector_type(4)));
typedef float f32x16 __attribute__((ext_vector_type(16)));
typedef unsigned u32x2 __attribute__((ext_vector_type(2)));
typedef unsigned u32x4 __attribute__((ext_vector_type(4)));
typedef int i32x8 __attribute__((ext_vector_type(8)));
typedef short s16x16 __attribute__((ext_vector_type(16)));

constexpr int D = 1024, BATCH = 8, SEQ = 8192, T = BATCH * SEQ;
constexpr int IN_COLS = 4608;
constexpr int NEXP = 32, DEXP = 512;
constexpr int LISTCAP = T;
constexpr float EPS = 1e-6f;
constexpr float LOG2E = 1.4426950408889634f;
constexpr float C2 = 0.125f * LOG2E;
constexpr int NWAVES = 8, NTHREADS = 512;

constexpr size_t MiB = 1u << 20;
constexpr size_t WS_CTL = 0, CTL_ZERO_BYTES = 1 * MiB;
constexpr size_t WS_WIN = 2 * MiB;
constexpr size_t WS_WBR = 12 * MiB;
constexpr size_t WS_WO = 14 * MiB;
constexpr size_t WS_W13 = 16 * MiB;
constexpr size_t WS_W2 = 80 * MiB;
constexpr size_t WS_WRH = 112 * MiB;
constexpr size_t WS_WRL = 112 * MiB + 131072;
constexpr size_t WS_CS = 113 * MiB;
constexpr size_t WS_SSQ = 117 * MiB;
constexpr size_t WS_RSTD = 121 * MiB;
constexpr size_t WS_WTS = 122 * MiB;
constexpr size_t WS_LIST = 123 * MiB;
constexpr size_t WS_PARK = 131 * MiB;
constexpr size_t WS_RA = 164 * MiB;
constexpr size_t WS_RB = 292 * MiB;
constexpr size_t WS_RC = 420 * MiB;
constexpr size_t WS_RD = 548 * MiB;
constexpr size_t WS_RE = 612 * MiB;
constexpr size_t WS_END = 868 * MiB;
constexpr int CW_TMO = 0;
constexpr int CW_BAR = 4096;
constexpr int CW_CNT = 8192;

constexpr int RING_BYTES = 147456;
constexpr int LDSCTL_OFF = RING_BYTES;
constexpr int LDS_BYTES = RING_BYTES + 1024;

#define RLX_AGENT __ATOMIC_RELAXED, __HIP_MEMORY_SCOPE_AGENT
#define LDS_WAIT() asm volatile("s_waitcnt lgkmcnt(0)" ::: "memory")
#define VM_WAIT() asm volatile("s_waitcnt vmcnt(0)" ::: "memory")

__device__ __forceinline__ unsigned cvt_pk_bf16(float lo, float hi) { unsigned r; asm("v_cvt_pk_bf16_f32 %0, %1, %2" : "=v"(r) : "v"(lo), "v"(hi)); return r; }
__device__ __forceinline__ unsigned cvt_pk4_fp8(float a, float b, float c, float d) { int w; asm("v_cvt_pk_fp8_f32 %0, %1, %2" : "=v"(w) : "v"(a), "v"(b)); w = __builtin_amdgcn_cvt_pk_fp8_f32(c, d, w, true); return (unsigned)w; }
__device__ __forceinline__ unsigned cvt_pk4_u8(float a, float b, float c, float d) { unsigned w = 0; w = __builtin_amdgcn_cvt_pk_u8_f32(a, 0, w); w = __builtin_amdgcn_cvt_pk_u8_f32(b, 1, w); w = __builtin_amdgcn_cvt_pk_u8_f32(c, 2, w); w = __builtin_amdgcn_cvt_pk_u8_f32(d, 3, w); return w; }
__device__ __forceinline__ f32x4 u8x4_to_f32(unsigned w) { return (f32x4){(float)(w & 0xffu), (float)((w >> 8) & 0xffu), (float)((w >> 16) & 0xffu), (float)(w >> 24)}; }
__device__ __forceinline__ f32x4 fp8x4_to_f32(unsigned w) { const f32x2 lo = __builtin_amdgcn_cvt_pk_f32_fp8((int)w, false), hi = __builtin_amdgcn_cvt_pk_f32_fp8((int)w, true); return (f32x4){lo[0], lo[1], hi[0], hi[1]}; }
__device__ __forceinline__ float bf_lo(unsigned w) { return __uint_as_float(w << 16); }
__device__ __forceinline__ float bf_hi(unsigned w) { return __uint_as_float(w & 0xffff0000u); }
__device__ __forceinline__ float fast_exp2(float x) { return __builtin_amdgcn_exp2f(x); }
__device__ __forceinline__ float fast_rcp(float x) { return __builtin_amdgcn_rcpf(x); }
__device__ __forceinline__ float sigmoidf_(float x) { return fast_rcp(1.0f + fast_exp2(-LOG2E * x)); }
__device__ __forceinline__ float gelu_tanh(float x) {
    const float u = x * (0.7978845608028654f + 0.0356774081363001f * x * x);
    return x * fast_rcp(1.0f + fast_exp2(-2.0f * LOG2E * u));
}
__device__ __forceinline__ f32x2 pk_fma(f32x2 a, f32x2 b, f32x2 c) { return __builtin_elementwise_fma(a, b, c); }
__device__ __forceinline__ f32x2 gelu_tanh2(f32x2 x) {
    constexpr float K0 = -2.0f * LOG2E * 0.7978845608028654f, K1 = -2.0f * LOG2E * 0.0356774081363001f;
    const f32x2 z = x * pk_fma(x * x, (f32x2){K1, K1}, (f32x2){K0, K0});
    const f32x2 d = (f32x2){fast_exp2(z.x), fast_exp2(z.y)} + 1.0f;
    return x * (f32x2){fast_rcp(d.x), fast_rcp(d.y)};
}
__device__ __forceinline__ f32x2 sig255_2(f32x2 a) {
    constexpr float S = 1.0f / 255.0f;
    const f32x2 d = pk_fma((f32x2){fast_exp2(a.x), fast_exp2(a.y)}, (f32x2){S, S}, (f32x2){S, S});
    return (f32x2){fast_rcp(d.x), fast_rcp(d.y)};
}
__device__ __forceinline__ int opaque_tid() { int t = threadIdx.x; asm volatile("" : "+v"(t)); return t; }
__device__ __forceinline__ float wave_sum(float v) {
#pragma unroll
    for (int o = 1; o < 64; o <<= 1) v += __shfl_xor(v, o);
    return v;
}

namespace pg8 {
constexpr int BM = 256, BK = 64, HALF = 128, HTB = HALF * BK * 2, STAGE_BYTES = 8 * HTB, NXCD = 8, WGM = 8;
__host__ __device__ __forceinline__ int lds_byte(int r, int c) { const int st = (r >> 4) * 2 + (c >> 5), rr = r & 15, cc = c & 31, ob = rr * 64 + cc * 2; return st * 1024 + (ob ^ (((ob >> 9) & 1) << 5)); }
__host__ __device__ __forceinline__ void stage_rc(int b, int& R, int& C) { const int st = b / 1024, sb = b % 1024, swz = sb ^ (((sb >> 9) & 1) << 5); R = (st >> 1) * 16 + swz / 64; C = (st & 1) * 32 + (swz % 64) / 2; }
__host__ __device__ __forceinline__ int perm32(int rho) { const int n = rho >> 4, i = rho & 15; return 8 * (i >> 2) + 4 * n + (i & 3); }

struct Unit { int pm, pn, e, lbase, nv; };

struct DenseProb {
    static constexpr bool GATHER = false;
    const char* A; const char* Bt; int pitch  ; int nM, nN, nwg, G, c;
    __device__ __forceinline__ void init(const void* A_, const void* Bt_, int M, int N, int K_, int G_, int c_) { A = (const char*)A_; Bt = (const char*)Bt_; pitch = K_ * 2; nM = M / BM; nN = N / BM; nwg = nM * nN; G = G_; c = c_; }
    __device__ __forceinline__ bool next(int i, Unit& u) const {
        const long L = (long)i * G + c; if (L >= nwg) return false;
        int wgid = (int)L; { const int q = nwg / NXCD, r = nwg % NXCD, xcd = wgid % NXCD, off = wgid / NXCD; wgid = (xcd < r ? xcd * (q + 1) : r * (q + 1) + (xcd - r) * q) + off; }
        const int nig = WGM * nN, gid = wgid / nig, fm = gid * WGM, gsz = (nM - fm) < WGM ? (nM - fm) : WGM;
        u.pm = fm + ((wgid % nig) % gsz); u.pn = (wgid % nig) / gsz; u.e = 0; u.lbase = 0; u.nv = 256; return true;
    }
    __device__ __forceinline__ void a_offs(const Unit& u, const int (&R)[2], const int (&C)[2], unsigned (&o)[2][2]) const {
#pragma unroll
        for (int h = 0; h < 2; ++h)
#pragma unroll
            for (int i = 0; i < 2; ++i) o[h][i] = (unsigned)((u.pm * BM + h * HALF + R[i]) * pitch + C[i] * 2);
    }
    __device__ __forceinline__ const char* b_tile(const Unit& u) const { return Bt + (size_t)u.pn * BM * pitch; }
    __device__ __forceinline__ const char* a_tile(const Unit& u) const { return A + (size_t)u.pm * BM * pitch; }
};

struct PanelProb : DenseProb {
    __device__ __forceinline__ bool next(int i, Unit& u) const { if (i >= nN || c >= nM) return false; u.pm = c; u.pn = i; u.e = 0; u.lbase = 0; u.nv = 256; return true; }
};
struct MoeOrder {
    const LAS int* bstart; const LAS int* cnt; int nblk, nwg, G, c;
    __device__ __forceinline__ void init(const LAS int* bs, const LAS int* cn, int G_, int c_) { bstart = bs; cnt = cn; nblk = bs[NEXP]; nwg = nblk * 4; G = G_; c = c_; }
    __device__ __forceinline__ bool next(int i, Unit& u) const {
        const long L = (long)i * G + c; if (L >= nwg) return false;
        int wgid = (int)L; { const int q = nwg / NXCD, r = nwg % NXCD, xcd = wgid % NXCD, off = wgid / NXCD; wgid = (xcd < r ? xcd * (q + 1) : r * (q + 1) + (xcd - r) * q) + off; }
        const int gid = wgid / 32, fm = gid * 8, gsz = (nblk - fm) < 8 ? (nblk - fm) : 8, w = wgid - gid * 32;
        const int blk = fm + (w % gsz); u.pn = w / gsz; u.pm = blk;
        int e = 0;
        while (e < NEXP - 1 && blk >= bstart[e + 1]) ++e;
        const int rb = blk - bstart[e]; u.e = e; u.lbase = e * LISTCAP + rb * 256; const int rem = cnt[e] - rb * 256; u.nv = rem < 256 ? rem : 256; return true;
    }
};
struct MoeUpProb : MoeOrder {
    static constexpr bool GATHER = true;
    const char* A; const char* Bt; int pitch; const int* list;
    __device__ __forceinline__ const char* a_tile(const Unit&) const { return A; }
    __device__ __forceinline__ void a_offs(const Unit& u, const int (&R)[2], const int (&C)[2], unsigned (&o)[2][2]) const {
#pragma unroll
        for (int h = 0; h < 2; ++h)
#pragma unroll
            for (int i = 0; i < 2; ++i) { const int r = h * HALF + R[i]; const int tok = (r < u.nv) ? (int)((unsigned)list[u.lbase + r] >> 16) : 0; o[h][i] = (unsigned)(tok * pitch + C[i] * 2); }
    }
    __device__ __forceinline__ const char* b_tile(const Unit& u) const { return Bt + ((size_t)u.e * 1024 + (size_t)u.pn * BM) * pitch; }
};
struct MoeDownProb : MoeOrder {
    static constexpr bool GATHER = false;
    const char* A; const char* Bt; int pitch;
    __device__ __forceinline__ const char* a_tile(const Unit& u) const { return A + (size_t)u.pm * BM * pitch; }
    __device__ __forceinline__ void a_offs(const Unit& u, const int (&R)[2], const int (&C)[2], unsigned (&o)[2][2]) const {
#pragma unroll
        for (int h = 0; h < 2; ++h)
#pragma unroll
            for (int i = 0; i < 2; ++i) o[h][i] = (unsigned)((u.pm * BM + h * HALF + R[i]) * pitch + C[i] * 2);
    }
    __device__ __forceinline__ const char* b_tile(const Unit& u) const { return Bt + ((size_t)u.e * 1024 + (size_t)u.pn * BM) * pitch; }
};

struct EpiNull { __device__ __forceinline__ void prefetch(const Unit&, int, int, int, int) const {}
    __device__ __forceinline__ void operator()(f32x4 (&acc)[2][2][4][2], const Unit&, int, int, int, int) const {
#pragma unroll
    for (int a = 0; a < 2; ++a)
#pragma unroll
        for (int b = 0; b < 2; ++b)
#pragma unroll
            for (int m = 0; m < 4; ++m) asm volatile("" :: "v"(acc[a][b][m][0]), "v"(acc[a][b][m][1])); } };
struct DenseProbSame : DenseProb {
    __device__ __forceinline__ void a_offs(const Unit&, const int (&R)[2], const int (&C)[2], unsigned (&o)[2][2]) const { Unit z{0, 0, 0, 0, 256}; DenseProb::a_offs(z, R, C, o); }
    __device__ __forceinline__ const char* b_tile(const Unit&) const { return Bt; }
};
struct NoHook { static constexpr int AT = -1; __device__ __forceinline__ void operator()(f32x4 (&)[2][2][4][2], const Unit&, int, int, int, int) const {} };

template <bool FP8, class Prob, class Epi, class Hook, int PM = 0>
__device__ __forceinline__ void gemm_core(LAS unsigned char* lds, const Prob& P, const Epi& E, const Hook& HK) {
    const int tid = opaque_tid(), wid = __builtin_amdgcn_readfirstlane(tid >> 6), lane = tid & 63, wr = wid >> 2, wc = wid & 3, fr = lane & 15, fq = lane >> 4;
    const int pitch = P.pitch, nt = pitch / (BK * 2);
    int R[2], C[2]; unsigned voffB[2], voffA[2];
#pragma unroll
    for (int i = 0; i < 2; ++i) { stage_rc(tid * 16 + i * 8192, R[i], C[i]); const int Rb = (R[i] & ~31) + perm32(R[i] & 31); voffB[i] = (unsigned)(Rb * pitch + C[i] * 2); voffA[i] = (unsigned)(R[i] * pitch + C[i] * 2); }
    const size_t kstep = (size_t)(BK * 2);
    const size_t hstep = (size_t)HALF * pitch;
    const unsigned ldsw = (unsigned)wid * 1024u;
    const int aoff = lds_byte(wr * 64 + fr, fq * 8), boff = lds_byte(wc * 32 + fr, fq * 8);
#define PG8_SA(b, h) (((b) * 2 + (h)) * HTB)
#define PG8_SB(b, h) ((4 + (b) * 2 + (h)) * HTB)
#define PG8_STAGE_B(bufoff, gbase) do { if constexpr (PM != 1) _Pragma("unroll") for (int _i = 0; _i < 2; ++_i) \
        __builtin_amdgcn_global_load_lds((const unsigned*)((const char*)(gbase) + voffB[_i]), (LAS unsigned*)(lds + (bufoff) + ldsw + _i * 8192), 16, 0, 0); } while (0)
#define PG8_STAGE_AG(bufoff, kb, va) do { if constexpr (PM != 1) _Pragma("unroll") for (int _i = 0; _i < 2; ++_i) \
        __builtin_amdgcn_global_load_lds((const unsigned*)(P.A + (kb) + (va)[_i]), (LAS unsigned*)(lds + (bufoff) + ldsw + _i * 8192), 16, 0, 0); } while (0)
#define PG8_STAGE_AD(bufoff, ubase) do { if constexpr (PM != 1) _Pragma("unroll") for (int _i = 0; _i < 2; ++_i) \
        __builtin_amdgcn_global_load_lds((const unsigned*)((const char*)(ubase) + voffA[_i]), (LAS unsigned*)(lds + (bufoff) + ldsw + _i * 8192), 16, 0, 0); } while (0)
#define PG8_STAGE_AC(bufoff, kb, h) do { if constexpr (Prob::GATHER) { PG8_STAGE_AG(bufoff, kb, cvA[h]); } else { PG8_STAGE_AD(bufoff, cA + (h) * hstep + (kb)); } } while (0)
#define PG8_STAGE_AN(bufoff, kb, h) do { if constexpr (Prob::GATHER) { PG8_STAGE_AG(bufoff, kb, v2[h]); } else { PG8_STAGE_AD(bufoff, (last ? nA : cA) + (h) * hstep + (kb)); } } while (0)
#define PG8_LDA(dst, b, h) do { _Pragma("unroll") for (int m = 0; m < 4; ++m) _Pragma("unroll") for (int k = 0; k < 2; ++k) { if constexpr (PM == 3) asm volatile("" : "=v"(dst[m][k])); else dst[m][k] = *(const LAS bf16x8*)(lds + PG8_SA(b, h) + aoff + m * 2048 + k * 1024); } } while (0)
#define PG8_LDB(dst, b, h) do { _Pragma("unroll") for (int n = 0; n < 2; ++n) _Pragma("unroll") for (int k = 0; k < 2; ++k) { if constexpr (PM == 3) asm volatile("" : "=v"(dst[n][k])); else dst[n][k] = *(const LAS bf16x8*)(lds + PG8_SB(b, h) + boff + n * 2048 + k * 1024); } } while (0)
#define PG8_CAT(x) __builtin_bit_cast(i32x8, __builtin_shufflevector((x)[0], (x)[1], 0, 1, 2, 3, 4, 5, 6, 7, 8, 9, 10, 11, 12, 13, 14, 15))
#define PG8_MMA(ai, bj, At, Bt) do { __builtin_amdgcn_s_setprio(1); \
        if constexpr (PM == 2) { _Pragma("unroll") for (int m = 0; m < 4; ++m) asm volatile("" :: "v"(At[m][0]), "v"(At[m][1])); _Pragma("unroll") for (int n = 0; n < 2; ++n) asm volatile("" :: "v"(Bt[n][0]), "v"(Bt[n][1])); } \
        else if constexpr (FP8) { _Pragma("unroll") for (int m = 0; m < 4; ++m) _Pragma("unroll") for (int n = 0; n < 2; ++n) \
            { const i32x8 bq_ = PG8_CAT(Bt[n]), aq_ = PG8_CAT(At[m]); \
              asm volatile("v_mfma_scale_f32_16x16x128_f8f6f4 %0, %1, %2, %0, %3, %3 op_sel_hi:[0,0,0]" : "+v"(acc[ai][bj][m][n]) : "v"(bq_), "v"(aq_), "v"(sc8)); } } \
        else { _Pragma("unroll") for (int m = 0; m < 4; ++m) _Pragma("unroll") for (int n = 0; n < 2; ++n) _Pragma("unroll") for (int k = 0; k < 2; ++k) \
            acc[ai][bj][m][n] = __builtin_amdgcn_mfma_f32_16x16x32_bf16(Bt[n][k], At[m][k], acc[ai][bj][m][n], 0, 0, 0); } \
        __builtin_amdgcn_s_setprio(0); } while (0)
#define PG8_WAIT_V(n) asm volatile("s_waitcnt vmcnt(" #n ")" ::: "memory")
#define PG8_WAIT_L(n) asm volatile("s_waitcnt lgkmcnt(" #n ")" ::: "memory")
#define PG8_BAR __builtin_amdgcn_s_barrier()
#define PG8_SCHED __builtin_amdgcn_sched_barrier(0)
    Unit cur, nxt; int ui = 0;
    if (!P.next(0, cur)) return;
    int sc8 = 0x7f7f7f7f; asm volatile("" : "+v"(sc8));
    f32x4 acc[2][2][4][2];
#pragma unroll
    for (int a = 0; a < 2; ++a)
#pragma unroll
        for (int b = 0; b < 2; ++b)
#pragma unroll
            for (int m = 0; m < 4; ++m)
#pragma unroll
                for (int n = 0; n < 2; ++n) acc[a][b][m][n] = (f32x4){0.f, 0.f, 0.f, 0.f};
    bf16x8 At[4][2], B0[2][2], B1[2][2];
    unsigned cvA[2][2], nvA[2][2];
    if constexpr (Prob::GATHER) P.a_offs(cur, R, C, cvA);
    const char* cA = P.a_tile(cur);
    const char* cB = P.b_tile(cur);
    PG8_STAGE_B(PG8_SB(0, 0), cB); PG8_STAGE_B(PG8_SB(0, 1), cB + hstep); PG8_STAGE_AC(PG8_SA(0, 0), 0, 0); PG8_STAGE_AC(PG8_SA(0, 1), 0, 1);
    if (wr == 1) PG8_BAR;
    PG8_WAIT_V(2); PG8_BAR;
    PG8_STAGE_B(PG8_SB(1, 0), cB + kstep); PG8_STAGE_AC(PG8_SA(1, 0), kstep, 0); PG8_STAGE_B(PG8_SB(1, 1), cB + hstep + kstep);
    PG8_WAIT_V(6); PG8_BAR;
    for (;;) {
        E.prefetch(cur, wr, wc, fr, fq);
        const bool has_next = P.next(ui + 1, nxt);
        if constexpr (Prob::GATHER) {
            if (has_next) P.a_offs(nxt, R, C, nvA);
            else {
#pragma unroll
                for (int h = 0; h < 2; ++h)
#pragma unroll
                    for (int i = 0; i < 2; ++i) nvA[h][i] = cvA[h][i];
            }
        }
        const char* nA = has_next ? P.a_tile(nxt) : cA;
        const char* nB = has_next ? P.b_tile(nxt) : cB;
        for (int t = 0; t < (PM == 4 ? 0 : nt); t += 2) {
            if (Hook::AT >= 0 && t == Hook::AT) HK(acc, cur, wr, wc, fr, fq);
            const bool last = (t == nt - 2);
            const size_t k1 = (size_t)(t + 1) * kstep;
            const size_t k2 = last ? 0 : (size_t)(t + 2) * kstep, k3 = k2 + kstep;
            const char* b2 = last ? nB : cB + (size_t)(t + 2) * kstep; const char* b3 = b2 + kstep;
            unsigned v2[2][2];
            if constexpr (Prob::GATHER) {
#pragma unroll
                for (int h = 0; h < 2; ++h)
#pragma unroll
                    for (int i = 0; i < 2; ++i) v2[h][i] = last ? nvA[h][i] : cvA[h][i];
            }
            PG8_LDB(B0, 0, 0); PG8_LDB(B1, 0, 1); PG8_SCHED; PG8_LDA(At, 0, 0); PG8_STAGE_AC(PG8_SA(1, 1), k1, 1);
            PG8_WAIT_V(8); PG8_WAIT_L(0); PG8_BAR; PG8_MMA(0, 0, At, B0); PG8_MMA(0, 1, At, B1); PG8_BAR; PG8_SCHED;
            PG8_LDA(At, 0, 1); PG8_STAGE_B(PG8_SB(0, 0), b2); PG8_STAGE_B(PG8_SB(0, 1), b2 + hstep); PG8_STAGE_AN(PG8_SA(0, 0), k2, 0);
            PG8_WAIT_V(8); PG8_WAIT_L(0); PG8_BAR; PG8_MMA(1, 0, At, B0); PG8_MMA(1, 1, At, B1); PG8_BAR; PG8_SCHED;
            PG8_LDB(B0, 1, 0); PG8_LDB(B1, 1, 1); PG8_SCHED; PG8_LDA(At, 1, 0); PG8_STAGE_AN(PG8_SA(0, 1), k2, 1);
            PG8_WAIT_V(8); PG8_WAIT_L(0); PG8_BAR; PG8_MMA(0, 0, At, B0); PG8_MMA(0, 1, At, B1); PG8_BAR; PG8_SCHED;
            PG8_LDA(At, 1, 1); PG8_STAGE_B(PG8_SB(1, 0), b3); PG8_STAGE_B(PG8_SB(1, 1), b3 + hstep); PG8_STAGE_AN(PG8_SA(1, 0), k3, 0);
            PG8_WAIT_V(8); PG8_WAIT_L(0); PG8_BAR; PG8_MMA(1, 0, At, B0); PG8_MMA(1, 1, At, B1); PG8_BAR; PG8_SCHED;
        }
        if (wr == 0) PG8_BAR;
        if constexpr (FP8) {
            asm volatile("s_nop 15\n\ts_nop 7" ::: "memory");
#pragma unroll
            for (int a = 0; a < 2; ++a)
#pragma unroll
                for (int b = 0; b < 2; ++b)
#pragma unroll
                    for (int m = 0; m < 4; ++m) asm volatile("" : "+v"(acc[a][b][m][0]), "+v"(acc[a][b][m][1]));
        }
        E(acc, cur, wr, wc, fr, fq);
        if (!has_next) break;
#pragma unroll
        for (int a = 0; a < 2; ++a)
#pragma unroll
            for (int b = 0; b < 2; ++b)
#pragma unroll
                for (int m = 0; m < 4; ++m)
#pragma unroll
                    for (int n = 0; n < 2; ++n) acc[a][b][m][n] = (f32x4){0.f, 0.f, 0.f, 0.f};
        cur = nxt; cA = nA; cB = nB; ++ui;
        if constexpr (Prob::GATHER) {
#pragma unroll
            for (int h = 0; h < 2; ++h)
#pragma unroll
                for (int i = 0; i < 2; ++i) cvA[h][i] = nvA[h][i];
        }
        if (wr == 1) PG8_BAR;
    }
    PG8_WAIT_V(0);
    PG8_BAR;
#undef PG8_SA
#undef PG8_SB
#undef PG8_STAGE_AG
#undef PG8_STAGE_AD
#undef PG8_STAGE_AC
#undef PG8_STAGE_AN
#undef PG8_STAGE_B
#undef PG8_LDA
#undef PG8_LDB
#undef PG8_MMA
#undef PG8_CAT
#undef PG8_WAIT_V
#undef PG8_WAIT_L
#undef PG8_BAR
#undef PG8_SCHED
}

__device__ __forceinline__ void pair_store16(unsigned char* p, size_t r8, const u32x4& A, const u32x4& B) {
    u32x4 s1, s2;
    s1.x = __builtin_amdgcn_update_dpp(A.x, B.x, 0x128, 0xf, 0xc, false); s1.y = __builtin_amdgcn_update_dpp(A.y, B.y, 0x128, 0xf, 0xc, false);
    s1.z = __builtin_amdgcn_update_dpp(A.z, B.z, 0x128, 0xf, 0xc, false); s1.w = __builtin_amdgcn_update_dpp(A.w, B.w, 0x128, 0xf, 0xc, false);
    s2.x = __builtin_amdgcn_update_dpp(B.x, A.x, 0x128, 0xf, 0x3, false); s2.y = __builtin_amdgcn_update_dpp(B.y, A.y, 0x128, 0xf, 0x3, false);
    s2.z = __builtin_amdgcn_update_dpp(B.z, A.z, 0x128, 0xf, 0x3, false); s2.w = __builtin_amdgcn_update_dpp(B.w, A.w, 0x128, 0xf, 0x3, false);
    *(u32x4*)p = s1; *(u32x4*)(p + r8) = s2;
}
__device__ __forceinline__ u32x4 pack8(const f32x4& v0, const f32x4& v1) { u32x4 w; w.x = cvt_pk_bf16(v0[0], v0[1]); w.y = cvt_pk_bf16(v0[2], v0[3]); w.z = cvt_pk_bf16(v1[0], v1[1]); w.w = cvt_pk_bf16(v1[2], v1[3]); return w; }

struct EpiStoreOnly {
    bf16_t* O;
    __device__ __forceinline__ void prefetch(const Unit&, int, int, int, int) const {}
    __device__ __forceinline__ void operator()(f32x4 (&acc)[2][2][4][2], const Unit& u, int wr, int wc, int fr, int fq) const {
        const int cl0 = wc * 32 + 8 * fq; int row0 = u.pm * BM + wr * 64 + fr; asm volatile("" : "+v"(row0));
#pragma unroll
        for (int ai = 0; ai < 2; ++ai)
#pragma unroll
            for (int m = 0; m < 4; ++m) { bf16_t* rowp = O + (size_t)(row0 + ai * HALF + m * 16) * 256 + cl0;
#pragma unroll
                for (int bj = 0; bj < 2; ++bj) *(u32x4*)(rowp + bj * HALF) = pack8(acc[ai][bj][m][0], acc[ai][bj][m][1]); }
    }
};
#define EPI_ST(val, ptr) do { if constexpr (MODE == 1) { auto v_ = (val); asm volatile("" :: "v"(v_)); } else *(ptr) = (val); } while (0)
template <int MODE> struct EpiInProjT {
    bf16_t *UV, *Q, *Kb, *Vb; unsigned char* G8; const float* cs; unsigned char *Q8, *K8;
    __device__ __forceinline__ void prefetch(const Unit&, int, int, int, int) const {}
    template <class PT> __device__ __forceinline__ void st_pair(PT* p, int pitch, const u32x4& A, const u32x4& B) const {
        if constexpr (MODE == 1) { asm volatile("" :: "v"(A), "v"(B)); } else pair_store16((unsigned char*)p, (size_t)8 * pitch * sizeof(PT), A, B); }
    __device__ __forceinline__ void operator()(f32x4 (&acc)[2][2][4][2], const Unit& u, int wr, int wc, int fr, int fq) const {
        constexpr bool NOMATH = (MODE == 2);
        const int pn = u.pn; int row0 = u.pm * BM + wr * 64 + fr; asm volatile("" : "+v"(row0));
        int prow0 = row0 - (fr & 8), pcl = wc * 64 + 8 * fq + 4 * (fr & 8);
        asm volatile("" : "+v"(prow0), "+v"(pcl));
        if (pn < 4) {
#pragma unroll
            for (int ai = 0; ai < 2; ++ai)
#pragma unroll
                for (int m = 0; m < 4; ++m) { u32x4 w[2];
#pragma unroll
                    for (int bj = 0; bj < 2; ++bj) { f32x4 v0 = acc[ai][bj][m][0], v1 = acc[ai][bj][m][1];
                        if constexpr (!NOMATH) { const f32x2 a = gelu_tanh2(v0.xy), b = gelu_tanh2(v0.zw), c = gelu_tanh2(v1.xy), d = gelu_tanh2(v1.zw); v0 = (f32x4){a.x, a.y, b.x, b.y}; v1 = (f32x4){c.x, c.y, d.x, d.y}; }
                        w[bj] = pack8(v0, v1); }
                    st_pair(UV + (size_t)(prow0 + ai * HALF + m * 16) * 1024 + pn * 256 + pcl, 1024, w[0], w[1]); }
        } else if (pn < 8) {
            bf16_t* dst = (pn < 6) ? Q : Kb; const float sc = (pn < 6) ? C2 : 1.0f;
            const float sgn = (fq == 0) ? -1.0f : 1.0f; const bool rot_lane = fq < 2;
#pragma unroll
            for (int ai = 0; ai < 2; ++ai) {
                f32x4 cs4[4][4];
#pragma unroll
                for (int m = 0; m < 4; ++m) { const f32x4* cp = (const f32x4*)(cs + (size_t)(row0 + ai * HALF + m * 16) * 16);
#pragma unroll
                    for (int j = 0; j < 4; ++j) cs4[m][j] = cp[j]; }
#pragma unroll
                for (int m = 0; m < 4; ++m) { const int row = row0 + ai * HALF + m * 16; f32x4 v[2][2];
#pragma unroll
                    for (int bj = 0; bj < 2; ++bj) { v[bj][0] = acc[ai][bj][m][0]; v[bj][1] = acc[ai][bj][m][1]; }
                    if constexpr (!NOMATH) {
                        f32x4 p0, p1;
#pragma unroll
                        for (int e = 0; e < 4; ++e) { p0[e] = __shfl_xor(v[0][0][e], 16); p1[e] = __shfl_xor(v[0][1][e], 16); }
                        if (rot_lane) {
#pragma unroll
                            for (int e = 0; e < 4; ++e) { v[0][0][e] = v[0][0][e] * cs4[m][0][e] + sgn * p0[e] * cs4[m][2][e]; v[0][1][e] = v[0][1][e] * cs4[m][1][e] + sgn * p1[e] * cs4[m][3][e]; }
                        }
                    }
                    if ((wc & 1) == 0) {
                        st_pair(dst + (size_t)(prow0 + ai * HALF + m * 16) * 512 + (pn & 1) * 256 + pcl, 512, pack8(v[0][0] * sc, v[0][1] * sc), pack8(v[1][0] * sc, v[1][1] * sc));
                    } else {
                        const float s8 = (pn < 6) ? sc * 8.0f : 1.0f;
#pragma unroll
                        for (int bj = 0; bj < 2; ++bj) { const f32x4 v0 = v[bj][0] * s8, v1 = v[bj][1] * s8;
                            u32x2 q8; q8.x = cvt_pk4_fp8(v0[0], v0[1], v0[2], v0[3]); q8.y = cvt_pk4_fp8(v1[0], v1[1], v1[2], v1[3]);
                            EPI_ST(q8, (u32x2*)(((pn < 6) ? Q8 : K8) + (size_t)row * 256 + ((pn & 1) * 2 + (wc >> 1)) * 64 + bj * 32 + 8 * fq)); } } }
            }
        } else if (pn < 10) {
#pragma unroll
            for (int ai = 0; ai < 2; ++ai)
#pragma unroll
                for (int m = 0; m < 4; ++m)
                    st_pair(Vb + (size_t)(prow0 + ai * HALF + m * 16) * 512 + (pn - 8) * 256 + pcl, 512, pack8(acc[ai][0][m][0], acc[ai][0][m][1]), pack8(acc[ai][1][m][0], acc[ai][1][m][1]));
        } else {
            int gl = (fq * 16 + fr) * 16; asm volatile("" : "+v"(gl));
            unsigned char* gb = G8 + (size_t)((u.pm * 8 + (pn - 10)) * 8 + wr * 4 + wc) * 8192 + gl;
#pragma unroll
            for (int ai = 0; ai < 2; ++ai)
#pragma unroll
                for (int m = 0; m < 4; ++m) { u32x4 qq;
#pragma unroll
                    for (int bj = 0; bj < 2; ++bj) { f32x4 v0 = acc[ai][bj][m][0], v1 = acc[ai][bj][m][1];
                        if constexpr (!NOMATH) { const f32x2 a = sig255_2(v0.xy), b = sig255_2(v0.zw), c = sig255_2(v1.xy), d = sig255_2(v1.zw); v0 = (f32x4){a.x, a.y, b.x, b.y}; v1 = (f32x4){c.x, c.y, d.x, d.y}; }
                        const unsigned qa = cvt_pk4_u8(v0[0], v0[1], v0[2], v0[3]), qb = cvt_pk4_u8(v1[0], v1[1], v1[2], v1[3]);
                        if (bj == 0) { qq.x = qa; qq.y = qb; } else { qq.z = qa; qq.w = qb; } }
                    EPI_ST(qq, (u32x4*)(gb + (ai * 4 + m) * 1024)); }
        }
    }
};

#undef EPI_ST
using EpiInProj = EpiInProjT<0>;
__device__ __forceinline__ void unpack8(const u32x4& w, f32x4& a, f32x4& b) { a = (f32x4){bf_lo(w.x), bf_hi(w.x), bf_lo(w.y), bf_hi(w.y)}; b = (f32x4){bf_lo(w.z), bf_hi(w.z), bf_lo(w.w), bf_hi(w.w)}; }
struct HookMerge {
    static constexpr int AT = 8;
    const unsigned char* G8;
    __device__ __forceinline__ void operator()(f32x4 (&acc)[2][2][4][2], const Unit& u, int wr, int wc, int fr, int fq) const {
        const unsigned char* gp = G8 + (size_t)((u.pm * 8 + u.pn) * 8 + wr * 4 + wc) * 8192 + ((fq >> 1) * 16 + fr) * 16 + 8 * (fq & 1); asm volatile("" : "+v"(gp));
        u32x2 w0[2][4][2], w1[2][4][2];
#pragma unroll
        for (int ai = 0; ai < 2; ++ai)
#pragma unroll
            for (int m = 0; m < 4; ++m)
#pragma unroll
                for (int bj = 0; bj < 2; ++bj) { w0[ai][m][bj] = *(const u32x2*)(gp + (ai * 4 + m) * 1024 + bj * 512); w1[ai][m][bj] = *(const u32x2*)(gp + 4 * 65536 + (ai * 4 + m) * 1024 + bj * 512); }
#pragma unroll
        for (int ai = 0; ai < 2; ++ai)
#pragma unroll
            for (int m = 0; m < 4; ++m)
#pragma unroll
                for (int bj = 0; bj < 2; ++bj) { const f32x4 a0 = u8x4_to_f32(w0[ai][m][bj].x), a1 = u8x4_to_f32(w0[ai][m][bj].y), b0 = u8x4_to_f32(w1[ai][m][bj].x), b1 = u8x4_to_f32(w1[ai][m][bj].y);
#pragma unroll
                    for (int e = 0; e < 4; ++e) { acc[ai][bj][m][0][e] *= a0[e] * fast_rcp(fmaxf(b0[e], 0.5f)); acc[ai][bj][m][1][e] *= a1[e] * fast_rcp(fmaxf(b1[e], 0.5f)); } }
    }
};
struct EpiMerge {
    const unsigned char* G8; bf16_t* MG;
    __device__ __forceinline__ void prefetch(const Unit&, int, int, int, int) const {}
    __device__ __forceinline__ void operator()(f32x4 (&acc)[2][2][4][2], const Unit& u, int wr, int wc, int fr, int fq) const {
        const unsigned char* gp = G8 + (size_t)((u.pm * 8 + u.pn + 4) * 8 + wr * 4 + wc) * 8192 + ((fq >> 1) * 16 + fr) * 16 + 8 * (fq & 1); asm volatile("" : "+v"(gp));
        int prow0 = u.pm * BM + wr * 64 + (fr & 7), pcol = u.pn * BM + wc * 64 + 8 * fq + 4 * (fr & 8); asm volatile("" : "+v"(prow0), "+v"(pcol));
        u32x2 w1[2][4][2];
#pragma unroll
        for (int ai = 0; ai < 2; ++ai)
#pragma unroll
            for (int m = 0; m < 4; ++m)
#pragma unroll
                for (int bj = 0; bj < 2; ++bj) w1[ai][m][bj] = *(const u32x2*)(gp + (ai * 4 + m) * 1024 + bj * 512);
        const float s255 = 1.0f / 255.0f;
#pragma unroll
        for (int ai = 0; ai < 2; ++ai)
#pragma unroll
            for (int m = 0; m < 4; ++m) { u32x4 w[2];
#pragma unroll
                for (int bj = 0; bj < 2; ++bj) { f32x4 b0 = u8x4_to_f32(w1[ai][m][bj].x), b1 = u8x4_to_f32(w1[ai][m][bj].y);
#pragma unroll
                    for (int e = 0; e < 4; ++e) { b0[e] = fmaxf(b0[e], 0.5f) * s255; b1[e] = fmaxf(b1[e], 0.5f) * s255; }
                    w[bj] = pack8(acc[ai][bj][m][0] * b0, acc[ai][bj][m][1] * b1); }
                pair_store16((unsigned char*)(MG + (size_t)(prow0 + ai * HALF + m * 16) * 1024 + pcol), (size_t)8 * 1024 * 2, w[0], w[1]); }
    }
};

struct EpiX1 {
    const float* X; bf16_t* XB; unsigned char* XB8; float* ssq;
    __device__ __forceinline__ void prefetch(const Unit&, int, int, int, int) const {}
    __device__ __forceinline__ void operator()(f32x4 (&acc)[2][2][4][2], const Unit& u, int wr, int wc, int fr, int fq) const {
        const int col0 = u.pn * BM + wc * 64 + 8 * fq; int row0 = u.pm * BM + wr * 64 + fr; asm volatile("" : "+v"(row0));
#pragma unroll
        for (int ai = 0; ai < 2; ++ai) {
            f32x4 xv[4][2][2];
#pragma unroll
            for (int m = 0; m < 4; ++m) { const float* xp = X + (size_t)(row0 + ai * HALF + m * 16) * 1024 + col0;
#pragma unroll
                for (int bj = 0; bj < 2; ++bj) { xv[m][bj][0] = *(const f32x4*)(xp + bj * 32); xv[m][bj][1] = *(const f32x4*)(xp + bj * 32 + 4); } }
#pragma unroll
            for (int m = 0; m < 4; ++m) { const size_t row = (size_t)(row0 + ai * HALF + m * 16); u32x4 wb[2];
                float s = 0.f;
#pragma unroll
                for (int bj = 0; bj < 2; ++bj) { const f32x4 v0 = acc[ai][bj][m][0] + xv[m][bj][0], v1 = acc[ai][bj][m][1] + xv[m][bj][1];
                    wb[bj] = pack8(v0, v1);
                    { u32x2 q8; q8.x = cvt_pk4_fp8(v0[0], v0[1], v0[2], v0[3]); q8.y = cvt_pk4_fp8(v1[0], v1[1], v1[2], v1[3]); *(u32x2*)(XB8 + row * 1024 + col0 + bj * 32) = q8; }
                    s += (v0[0] * v0[0] + v0[1] * v0[1]) + (v0[2] * v0[2] + v0[3] * v0[3]) + (v1[0] * v1[0] + v1[1] * v1[1]) + (v1[2] * v1[2] + v1[3] * v1[3]); }
                pair_store16((unsigned char*)(XB + (row - (fr & 8)) * 1024 + col0 + 4 * (fr & 8)), (size_t)8 * 1024 * 2, wb[0], wb[1]);
                s += __shfl_xor(s, 16); s += __shfl_xor(s, 32);
                if (fq == 0) ssq[row * 16 + u.pn * 4 + wc] = s; }
        }
    }
};

struct EpiMoeUp {
    const int* list; const float* rstd; unsigned char* H8;
    mutable float rs[2][4];
    __device__ __forceinline__ void prefetch(const Unit& u, int wr, int wc, int fr, int fq) const {
        int r0 = wr * 64 + fr; asm volatile("" : "+v"(r0));
        int tok[2][4];
#pragma unroll
        for (int ai = 0; ai < 2; ++ai)
#pragma unroll
            for (int m = 0; m < 4; ++m) { const int r = r0 + ai * HALF + m * 16; tok[ai][m] = (r < u.nv) ? (int)((unsigned)list[u.lbase + r] >> 16) : 0; }
#pragma unroll
        for (int ai = 0; ai < 2; ++ai)
#pragma unroll
            for (int m = 0; m < 4; ++m) rs[ai][m] = rstd[tok[ai][m]] * 0.015625f;
    }
    __device__ __forceinline__ void operator()(f32x4 (&acc)[2][2][4][2], const Unit& u, int wr, int wc, int fr, int fq) const {
        const int col0 = u.pn * 128 + wc * 32 + 8 * fq; int r0 = wr * 64 + fr; asm volatile("" : "+v"(r0));
#pragma unroll
        for (int ai = 0; ai < 2; ++ai)
#pragma unroll
            for (int m = 0; m < 4; ++m) { const int r = r0 + ai * HALF + m * 16; const float rsv = rs[ai][m];
                f32x4 g0 = acc[ai][0][m][0] * rsv, g1 = acc[ai][0][m][1] * rsv, u0 = acc[ai][1][m][0] * rsv, u1 = acc[ai][1][m][1] * rsv;
#pragma unroll
                for (int e = 0; e < 4; ++e) { g0[e] = g0[e] * sigmoidf_(g0[e]) * (u0[e] * 8.f); g1[e] = g1[e] * sigmoidf_(g1[e]) * (u1[e] * 8.f); }
                u32x2 q8; q8.x = cvt_pk4_fp8(g0[0], g0[1], g0[2], g0[3]); q8.y = cvt_pk4_fp8(g1[0], g1[1], g1[2], g1[3]);
                *(u32x2*)(H8 + (size_t)(u.pm * BM + r) * 512 + col0) = q8; }
    }
};
struct EpiMoeDown {
    const int* list; unsigned char* YB8;
    mutable unsigned lw[2][4];
    __device__ __forceinline__ void prefetch(const Unit& u, int wr, int wc, int fr, int fq) const {
        int r0 = wr * 64 + fr; asm volatile("" : "+v"(r0));
#pragma unroll
        for (int ai = 0; ai < 2; ++ai)
#pragma unroll
            for (int m = 0; m < 4; ++m) { const int r = r0 + ai * HALF + m * 16; lw[ai][m] = (r < u.nv) ? (unsigned)list[u.lbase + r] : 0xffffffffu; }
    }
    __device__ __forceinline__ void operator()(f32x4 (&acc)[2][2][4][2], const Unit& u, int wr, int wc, int fr, int fq) const {
        const int col0 = u.pn * BM + wc * 64 + 16 * fq;
#pragma unroll
        for (int ai = 0; ai < 2; ++ai)
#pragma unroll
            for (int m = 0; m < 4; ++m) { const unsigned word = lw[ai][m];
                if (word != 0xffffffffu) { const float w = __uint_as_float((word & 0x7fffu) << 16) * 0.0625f;
                    unsigned char* op = YB8 + (size_t)(word >> 15) * 1024 + col0; u32x4 q;
                    { const f32x4 y0 = acc[ai][0][m][0] * w, y1 = acc[ai][0][m][1] * w; q.x = cvt_pk4_fp8(y0[0], y0[1], y0[2], y0[3]); q.y = cvt_pk4_fp8(y1[0], y1[1], y1[2], y1[3]); }
                    { const f32x4 y0 = acc[ai][1][m][0] * w, y1 = acc[ai][1][m][1] * w; q.z = cvt_pk4_fp8(y0[0], y0[1], y0[2], y0[3]); q.w = cvt_pk4_fp8(y1[0], y1[1], y1[2], y1[3]); }
                    *(u32x4*)op = q; } }
    }
};
}


namespace att {
constexpr int QB = 256, KVB = 64, QP = 512  ;
#if PROBE_PHASE == 52
#define ATT_REF_OFF 0.0f
#else
#define ATT_REF_OFF 0.0f
#endif
constexpr int KSLOT = 8192, VSLOT = 8192, NSLOT = 3;
constexpr int L_K = 0, L_V = NSLOT * KSLOT, L_WS = L_V + NSLOT * VSLOT, L_OST = L_WS + NWAVES * 256, L_END = L_OST + NWAVES * 8192;
static_assert(L_END <= RING_BYTES, "attention LDS");
#if PROBE_PHASE == 40
#define ATT_RESC_THR 0.f
#define ATT_RESC_MIN 0.001f
#define ATT_RESC_LO -2.f
#else
#define ATT_RESC_THR 512.f
#define ATT_RESC_MIN 64.f
#define ATT_RESC_LO 0.f
#endif
__device__ __forceinline__ int crow(int r, int hi) { return (r & 3) + 8 * (r >> 2) + 4 * hi; }
__device__ __forceinline__ void glds16(const void* gsrc, unsigned lds_dst) { unsigned keep;
    asm volatile("s_mov_b32 %0, m0\n\ts_mov_b32 m0, %2\n\ts_nop 0\n\tglobal_load_lds_dwordx4 %1, off\n\ts_mov_b32 m0, %0" : "=&s"(keep) : "v"(gsrc), "s"(lds_dst) : "memory"); }
#define ATT_WAIT_BAR(N) asm volatile("s_waitcnt vmcnt(" #N ") lgkmcnt(0)\n\ts_barrier" ::: "memory")
#define MX3(a, b, c) __builtin_fmaxf(__builtin_fmaxf((a), (b)), (c))
#define ATT_SBAR() __builtin_amdgcn_sched_barrier(0)
#define ATT_MFMA(a, b, c) __builtin_amdgcn_mfma_f32_32x32x16_bf16(a, b, c, 0, 0, 0)
__device__ __forceinline__ float rowmax(const f32x16& p0, const f32x16& p1) {
    float a = MX3(p0[0], p0[1], p1[0]), b = MX3(p0[2], p0[3], p1[1]); a = MX3(a, p1[2], p1[3]);
#pragma unroll
    for (int r = 4; r < 16; r += 4) { a = MX3(a, p0[r], p0[r + 1]); b = MX3(b, p0[r + 2], p0[r + 3]); a = MX3(a, p1[r], p1[r + 1]); b = MX3(b, p1[r + 2], p1[r + 3]); }
    const float m = __builtin_fmaxf(a, b); auto rr = __builtin_amdgcn_permlane32_swap(__float_as_uint(m), __float_as_uint(m), false, false);
    return __builtin_fmaxf(__uint_as_float(rr[0]), __uint_as_float(rr[1])); }
__device__ __forceinline__ void cmask(f32x16& p0, f32x16& p1, int jb, int qrel, int hi) {
    const int kb = 64 * jb + 4 * hi;
#pragma unroll
    for (int r = 0; r < 16; ++r) { const int kv = kb + (r & 3) + 8 * (r >> 2); if (kv > qrel) p0[r] = -INFINITY; if (kv + 32 > qrel) p1[r] = -INFINITY; } }
typedef int i32x4 __attribute__((ext_vector_type(4)));
__device__ __forceinline__ void kload2(bf16x8* kf, const LAS char* kp, int j) { kf[2 * j] = *(const LAS bf16x8*)(kp + j * 2048); kf[2 * j + 1] = *(const LAS bf16x8*)(kp + j * 2048 + 512); }
__device__ __forceinline__ i32x8 frag32(const LAS char* row, int c0) {
    const i32x4 lo = *(const LAS i32x4*)(row + c0 * 16), hi = *(const LAS i32x4*)(row + (c0 ^ 1) * 16);
    return __builtin_shufflevector(lo, hi, 0, 1, 2, 3, 4, 5, 6, 7); }
#define MFMA8_PV(O, A, B) asm volatile("v_mfma_scale_f32_32x32x64_f8f6f4 %0, %1, %2, %0, %3, %3 op_sel_hi:[0,0,0]" : "+v"(O) : "v"(A), "v"(B), "v"(sc_1))
template <int MODE> __device__ __forceinline__ void attn_pass(f32x16 (&o)[4], int b, int hm, int h, int qb, const bf16_t* Q, const bf16_t* __restrict__ K, const unsigned char* __restrict__ V8T, LAS char* shm) {
    const int tid = opaque_tid(), lane = tid & 63, r32 = lane & 31, hi = lane >> 5; const int wid = __builtin_amdgcn_readfirstlane(tid >> 6);
    const long rowbase = (long)b * SEQ; const int q0 = qb * QB, NT = (q0 + QB) / KVB;
    const bf16_t* Qw = Q + (rowbase + q0 + wid * 32) * QP + hm * 64;
    const bf16_t* Kh = K + rowbase * QP + hm * 64;
    const unsigned lds0 = (unsigned)(uintptr_t)shm;
    LAS float* wsf = (LAS float*)(shm + L_WS) + wid * 64;
    const bf16_t* ksrc = Kh + (long)lane * QP + wid * 8;
    const unsigned char* vsrc = V8T + ((size_t)(b * 4 + h) * (SEQ / KVB)) * VSLOT + wid * 1024 + lane * 16;
    const unsigned kdst = lds0 + L_K + wid * 1024, vdst = lds0 + L_V + wid * 1024;
#define DMA_K(t, s) glds16(ksrc + (long)(t) * KVB * QP, (unsigned)__builtin_amdgcn_readfirstlane(kdst + (unsigned)(s) * KSLOT))
#define DMA_V(t, s) glds16(vsrc + (long)(t) * VSLOT, (unsigned)__builtin_amdgcn_readfirstlane(vdst + (unsigned)(s) * VSLOT))
    const LAS char* kp0 = shm + L_K + hi * 1024 + r32 * 16;
    const LAS char* vp0 = shm + L_V + r32 * 64;  const int vc0 = (2 * hi) ^ ((r32 >> 2) & 3);
    DMA_K(0, 0); DMA_V(0, 0); DMA_K(1, 1);
    bf16x8 qr[4];
#pragma unroll
    for (int d0 = 0; d0 < 4; ++d0) qr[d0] = *(const bf16x8*)(Qw + (long)r32 * QP + d0 * 16 + hi * 8);
    float mhat = 0.f, l_reg = 0.f;
    float zf = 0.f; asm volatile("" : "+v"(zf));
    int sc_1 = 0x7f7f7f7f; asm volatile("" : "+v"(sc_1));
    f32x16 negm;
#pragma unroll
    for (int r = 0; r < 16; ++r) { negm[r] = zf;
#pragma unroll
        for (int d0 = 0; d0 < 4; ++d0) o[d0][r] = zf; }
    asm volatile("" : "+v"(negm));
    const int qrel = wid * 32 + r32;
    asm volatile("" : "+v"(qr[0]), "+v"(qr[1]), "+v"(qr[2]), "+v"(qr[3]));
    LAS bf16x8* qlds = (LAS bf16x8*)(shm + L_OST + wid * 8192) + lane;
#pragma unroll
    for (int d0 = 0; d0 < 4; ++d0) qlds[d0 * 64] = qr[d0];
    DMA_K(2, 2);
    ATT_WAIT_BAR(1);
    bool resc = false;
#define CMASK(P0, P1, t) do { const int jb_ = (t) - (NT - 4); if (jb_ >= 0) cmask(P0, P1, jb_, qrel, hi); } while (0)
#define RESC() do { if (resc) { asm volatile("s_waitcnt lgkmcnt(0)\n\ts_nop 15\n\ts_nop 15\n\ts_nop 7" ::: "memory"); \
        _Pragma("unroll") for (int r = 0; r < 16; ++r) { const float fr_ = wsf[crow(r, hi)]; _Pragma("unroll") for (int d_ = 0; d_ < 4; ++d_) asm volatile("v_mul_f32 %0, %0, %1" : "+v"(o[d_][r]) : "v"(fr_)); } } } while (0)
    f32x16 pA0, pA1, pB0, pB1;
    int sl_prev = 0, sl_cur = 0, sl_next = 1;
#define ROT() do { sl_prev = sl_cur; sl_cur = sl_next; sl_next = (sl_next == NSLOT - 1) ? 0 : sl_next + 1; } while (0)
    bf16x8 kf[8];
#pragma unroll
    for (int j = 0; j < 4; ++j) kload2(kf, kp0, j);
    pA0 = ATT_MFMA(kf[0], qr[0], negm); pA1 = ATT_MFMA(kf[1], qr[0], negm);
#pragma unroll
    for (int d0 = 1; d0 < 4; ++d0) { pA0 = ATT_MFMA(kf[2 * d0], qr[d0], pA0); pA1 = ATT_MFMA(kf[2 * d0 + 1], qr[d0], pA1); }
    CMASK(pA0, pA1, 0);
    { const float rm = rowmax(pA0, pA1) - ATT_REF_OFF; mhat = rm;
#pragma unroll
      for (int r = 0; r < 16; ++r) { pA0[r] -= rm; pA1[r] -= rm; negm[r] = -rm; }
      asm volatile("" : "+v"(negm));
#pragma unroll
      for (int r = 0; r < 16; ++r) { pA0[r] = fast_exp2(pA0[r]); pA1[r] = fast_exp2(pA1[r]); } }
    ATT_WAIT_BAR(0);
    DMA_K(3, 0); DMA_V(1, 1);
    ROT();
#pragma unroll
    for (int j = 0; j < 4; ++j) kload2(kf, kp0 + sl_cur * KSLOT, j);
    ATT_WAIT_BAR(2);
    i32x8 vf[4], pf;
#define PK4(P, B) cvt_pk4_fp8(P[B], P[(B) + 1], P[(B) + 2], P[(B) + 3])
#define PIN(x) asm volatile("" : "+v"(x))
#define GAPA(MF, P, B, W) do { MF; sacc += P[B]; sacc += P[(B) + 1]; sacc += P[(B) + 2]; sacc += P[(B) + 3]; PIN(sacc); pf[W] = PK4(P, B); PIN(pf); ATT_SBAR(); } while (0)
#define EXP8(X, B) do { X[B] = fast_exp2(X[B]); X[(B) + 1] = fast_exp2(X[(B) + 1]); X[(B) + 2] = fast_exp2(X[(B) + 2]); X[(B) + 3] = fast_exp2(X[(B) + 3]); \
        X[(B) + 4] = fast_exp2(X[(B) + 4]); X[(B) + 5] = fast_exp2(X[(B) + 5]); X[(B) + 6] = fast_exp2(X[(B) + 6]); X[(B) + 7] = fast_exp2(X[(B) + 7]); PIN(X); } while (0)
#define STEP(C0, C1, P0, P1, t, GK, GV, GL) do { ATT_SBAR(); \
    const LAS char* vp_ = vp0 + sl_prev * VSLOT; \
    float sacc = 0.f; \
    bf16x8 qa_ = qlds[0], qb_ = qlds[64]; ATT_SBAR(); \
    GAPA(C0 = ATT_MFMA(kf[0], qa_, negm), P0, 0, 0); \
    GAPA(C1 = ATT_MFMA(kf[1], qa_, negm), P0, 4, 1); \
    qa_ = qlds[128]; ATT_SBAR(); \
    GAPA(C0 = ATT_MFMA(kf[2], qb_, C0), P0, 8, 2); \
    GAPA(C1 = ATT_MFMA(kf[3], qb_, C1), P0, 12, 3); \
    qb_ = qlds[192]; ATT_SBAR(); \
    vf[0] = frag32(vp_, vc0); ATT_SBAR(); GAPA(C0 = ATT_MFMA(kf[4], qa_, C0), P1, 0, 4); \
    vf[1] = frag32(vp_ + 32 * 64, vc0); ATT_SBAR(); GAPA(C1 = ATT_MFMA(kf[5], qa_, C1), P1, 4, 5); \
    vf[2] = frag32(vp_ + 64 * 64, vc0); ATT_SBAR(); GAPA(C0 = ATT_MFMA(kf[6], qb_, C0), P1, 8, 6); \
    vf[3] = frag32(vp_ + 96 * 64, vc0); ATT_SBAR(); GAPA(C1 = ATT_MFMA(kf[7], qb_, C1), P1, 12, 7); \
    l_reg += sacc; \
    if (GK) { DMA_K((t) + 3, sl_cur); } if (GV) { DMA_V((t) + 1, sl_next); } \
    CMASK(C0, C1, t); \
    {   \
      float st_; { auto rr = __builtin_amdgcn_permlane32_swap(__float_as_uint(sacc), __float_as_uint(sacc), false, false); st_ = __uint_as_float(rr[0]) + __uint_as_float(rr[1]); } \
      resc = false; \
      if (__builtin_expect(__any(st_ > ATT_RESC_THR), 0)) { const float dl = (st_ > ATT_RESC_MIN) ? __builtin_fmaxf(__builtin_floorf(__builtin_amdgcn_logf(st_)) - 6.f, ATT_RESC_LO) : 0.f; mhat += dl; \
        _Pragma("unroll") for (int r = 0; r < 16; ++r) { asm volatile("v_sub_f32 %0, %0, %1" : "+v"(C0[r]) : "v"(dl)); asm volatile("v_sub_f32 %0, %0, %1" : "+v"(C1[r]) : "v"(dl)); } \
        _Pragma("unroll") for (int r = 0; r < 16; ++r) negm[r] = -mhat; asm volatile("" : "+v"(negm)); \
        const float f = fast_exp2(-dl); l_reg *= f; if (hi == 0) wsf[r32] = f; resc = true; } } \
    ATT_SBAR(); \
    MFMA8_PV(o[0], pf, vf[0]); EXP8(C0, 0); if (GL) { kload2(kf, kp0 + sl_next * KSLOT, 0); } ATT_SBAR(); \
    MFMA8_PV(o[1], pf, vf[1]); EXP8(C0, 8); if (GL) { kload2(kf, kp0 + sl_next * KSLOT, 1); } ATT_SBAR(); \
    MFMA8_PV(o[2], pf, vf[2]); EXP8(C1, 0); if (GL) { kload2(kf, kp0 + sl_next * KSLOT, 2); } ATT_SBAR(); \
    MFMA8_PV(o[3], pf, vf[3]); EXP8(C1, 8); if (GL) { kload2(kf, kp0 + sl_next * KSLOT, 3); } ATT_SBAR(); \
    } while (0)
    int t = 1;
#undef CMASK
#define CMASK(P0, P1, t) do {} while (0)
    for (; t + 5 < NT; t += 2) {
        STEP(pB0, pB1, pA0, pA1, t, true, true, true);       if (MODE == 3) { asm volatile("s_waitcnt lgkmcnt(0)" ::: "memory"); } else { ATT_WAIT_BAR(2); } RESC(); ROT();
        STEP(pA0, pA1, pB0, pB1, t + 1, true, true, true);   if (MODE == 3) { asm volatile("s_waitcnt lgkmcnt(0)" ::: "memory"); } else { ATT_WAIT_BAR(2); } RESC(); ROT();
    }
#undef CMASK
#define CMASK(P0, P1, t) do { const int jb_ = (t) - (NT - 4); if (jb_ >= 0) cmask(P0, P1, jb_, qrel, hi); } while (0)
#define ENDW(tt) do { if ((tt) + 3 < NT) { ATT_WAIT_BAR(2); } else if ((tt) + 2 < NT) { ATT_WAIT_BAR(1); } else { ATT_WAIT_BAR(0); } } while (0)
    for (; t + 1 < NT; t += 2) {
        STEP(pB0, pB1, pA0, pA1, t, (t + 3 < NT), (t + 1 < NT), (t + 1 < NT));       ENDW(t);     RESC(); ROT();
        STEP(pA0, pA1, pB0, pB1, t + 1, (t + 4 < NT), (t + 2 < NT), (t + 2 < NT));   ENDW(t + 1); RESC(); ROT();
    }
    STEP(pB0, pB1, pA0, pA1, NT - 1, false, false, false); RESC();
    { float sacc = 0.f;
#pragma unroll
      for (int r = 0; r < 16; ++r) sacc += pB0[r] + pB1[r];
      l_reg += sacc;
      pf[0] = PK4(pB0, 0); pf[1] = PK4(pB0, 4); pf[2] = PK4(pB0, 8); pf[3] = PK4(pB0, 12); pf[4] = PK4(pB1, 0); pf[5] = PK4(pB1, 4); pf[6] = PK4(pB1, 8); pf[7] = PK4(pB1, 12);
      const LAS char* vp_ = vp0 + sl_cur * VSLOT;
      vf[0] = frag32(vp_, vc0); vf[1] = frag32(vp_ + 32 * 64, vc0); vf[2] = frag32(vp_ + 64 * 64, vc0); vf[3] = frag32(vp_ + 96 * 64, vc0);
      asm volatile("s_nop 3" : "+v"(pf));
      MFMA8_PV(o[0], pf, vf[0]); MFMA8_PV(o[1], pf, vf[1]); MFMA8_PV(o[2], pf, vf[2]); MFMA8_PV(o[3], pf, vf[3]);
      asm volatile("s_nop 15\n\ts_nop 15\n\ts_nop 7" : "+v"(o[0]), "+v"(o[1]), "+v"(o[2]), "+v"(o[3])); }
#undef PK4
#undef PIN
#undef GAPA
#undef EXP8
#undef STEP
#undef ENDW
#undef CMASK
#undef RESC
#undef ROT
    { auto rr = __builtin_amdgcn_permlane32_swap(__float_as_uint(l_reg), __float_as_uint(l_reg), false, false); l_reg = __uint_as_float(rr[0]) + __uint_as_float(rr[1]); }
    if (hi == 0) wsf[32 + r32] = l_reg;
    asm volatile("s_waitcnt lgkmcnt(0)" ::: "memory");
#pragma unroll
    for (int r = 0; r < 16; ++r) { const float rl = fast_rcp(wsf[32 + crow(r, hi)]);
#pragma unroll
        for (int d0 = 0; d0 < 4; ++d0) o[d0][r] *= rl; }
    asm volatile("s_waitcnt lgkmcnt(0)" ::: "memory");
#undef DMA_K
#undef DMA_V
}

constexpr int KSLOT8 = 4096, QP8 = 256  ;
constexpr int L_V8 = NSLOT * KSLOT8, L_WS8 = L_V8 + NSLOT * VSLOT;
static_assert(L_WS8 + NWAVES * 256 <= L_OST, "fp8 pass LDS");
#define MFMA8_QK(C, A, B) asm volatile("v_mfma_scale_f32_32x32x64_f8f6f4 %0, %1, %2, %3, %4, %5 op_sel_hi:[0,0,0]" : "=&v"(C) : "v"(A), "v"(B), "v"(negm), "v"(sc_k), "v"(sc_q))
#define MFMA8_PV8(O, A, B) asm volatile("v_mfma_scale_f32_32x32x64_f8f6f4 %0, %1, %2, %0, %3, %3 op_sel_hi:[0,0,0]" : "+v"(O) : "v"(A), "v"(B), "v"(sc_k))
template <int MODE> __device__ __forceinline__ void attn_pass8(f32x16 (&o)[4], int b, int hm, int h, int qb, const unsigned char* Q8, const unsigned char* __restrict__ K8, const unsigned char* __restrict__ V8T, LAS char* shm) {
    const int tid = opaque_tid(), lane = tid & 63, r32 = lane & 31, hi = lane >> 5; const int wid = __builtin_amdgcn_readfirstlane(tid >> 6);
    const long rowbase = (long)b * SEQ; const int q0 = qb * QB, NT = (q0 + QB) / KVB;
    const unsigned lds0 = (unsigned)(uintptr_t)shm;
    LAS float* wsf = (LAS float*)(shm + L_WS8) + wid * 64;
    const int kkey = (wid & 3) * 16 + (lane >> 2);
    const unsigned char* ksrc = K8 + (rowbase + kkey) * QP8 + h * 64 + (((lane & 3) ^ ((kkey >> 2) & 3)) * 16);
    const unsigned char* vsrc = V8T + ((size_t)(b * 4 + h) * (SEQ / KVB)) * VSLOT + wid * 1024 + lane * 16;
    const unsigned kdst = lds0 + L_K + (wid & 3) * 1024, vdst = lds0 + L_V8 + wid * 1024;
#define DMA_K(t, s) glds16(ksrc + (long)(t) * KVB * QP8, (unsigned)__builtin_amdgcn_readfirstlane(kdst + (unsigned)(s) * KSLOT8))
#define DMA_V(t, s) glds16(vsrc + (long)(t) * VSLOT, (unsigned)__builtin_amdgcn_readfirstlane(vdst + (unsigned)(s) * VSLOT))
    const int sw = (r32 >> 2) & 3;
    const LAS char* kp0 = shm + L_K + r32 * 64;  const int kc0 = (2 * hi) ^ sw;
    const LAS char* vp0 = shm + L_V8 + r32 * 64;  const int vc0 = (2 * hi) ^ sw;
    DMA_K(0, 0); DMA_V(0, 0); DMA_K(1, 1);
    i32x8 qf;
    { const unsigned char* qp = Q8 + (rowbase + q0 + wid * 32 + r32) * QP8 + h * 64 + hi * 32; const i32x4 lo = *(const i32x4*)qp, hi4 = *(const i32x4*)(qp + 16); qf = __builtin_shufflevector(lo, hi4, 0, 1, 2, 3, 4, 5, 6, 7); }
    float mhat = 0.f;
    f32x16 ol;
    float zf = 0.f; asm volatile("" : "+v"(zf));
    int sc_k = 0x7f7f7f7f, sc_q = 0x7c7c7c7c; asm volatile("" : "+v"(sc_k), "+v"(sc_q));
    f32x16 negm;
#pragma unroll
    for (int r = 0; r < 16; ++r) { negm[r] = zf;
#pragma unroll
        for (int d0 = 0; d0 < 4; ++d0) o[d0][r] = zf;
        ol[r] = zf; }
    i32x8 ones8; { int o1 = 0x38383838; asm volatile("" : "+v"(o1)); ones8 = (i32x8){o1, o1, o1, o1, o1, o1, o1, o1}; }
    asm volatile("" : "+v"(negm));
    const int qrel = wid * 32 + r32;
    asm volatile("" : "+v"(qf));
    DMA_K(2, 2);
    ATT_WAIT_BAR(1);
    bool resc = false;
#define CMASK(P0, P1, t) do { const int jb_ = (t) - (NT - 4); if (jb_ >= 0) cmask(P0, P1, jb_, qrel, hi); } while (0)
#define RESC() do { if (resc) { asm volatile("s_waitcnt lgkmcnt(0)\n\ts_nop 15\n\ts_nop 7" ::: "memory"); \
        _Pragma("unroll") for (int r = 0; r < 16; ++r) { const float fr_ = wsf[crow(r, hi)]; _Pragma("unroll") for (int d_ = 0; d_ < 4; ++d_) asm volatile("v_mul_f32 %0, %0, %1" : "+v"(o[d_][r]) : "v"(fr_)); asm volatile("v_mul_f32 %0, %0, %1" : "+v"(ol[r]) : "v"(fr_)); } } } while (0)
    f32x16 pA0, pA1, pB0, pB1;
    int sl_prev = 0, sl_cur = 0, sl_next = 1;
#define ROT() do { sl_prev = sl_cur; sl_cur = sl_next; sl_next = (sl_next == NSLOT - 1) ? 0 : sl_next + 1; } while (0)
    i32x8 kf0, kf1;
    kf0 = frag32(kp0, kc0); kf1 = frag32(kp0 + 32 * 64, kc0);
    MFMA8_QK(pA0, kf0, qf); MFMA8_QK(pA1, kf1, qf);
    asm volatile("s_nop 15\n\ts_nop 15\n\ts_nop 7" : "+v"(pA0), "+v"(pA1));
    CMASK(pA0, pA1, 0);
    { const float rm = rowmax(pA0, pA1) - ATT_REF_OFF; mhat = rm;
#pragma unroll
      for (int r = 0; r < 16; ++r) { pA0[r] -= rm; pA1[r] -= rm; negm[r] = -rm; }
      asm volatile("" : "+v"(negm));
#pragma unroll
      for (int r = 0; r < 16; ++r) { pA0[r] = fast_exp2(pA0[r]); pA1[r] = fast_exp2(pA1[r]); } }
    ATT_WAIT_BAR(0);
    DMA_K(3, 0); DMA_V(1, 1);
    ROT();
    kf0 = frag32(kp0 + sl_cur * KSLOT8, kc0); kf1 = frag32(kp0 + sl_cur * KSLOT8 + 32 * 64, kc0);
    ATT_WAIT_BAR(2);
    i32x8 vf[4], pf;
#define PK4(P, B) cvt_pk4_fp8(P[B], P[(B) + 1], P[(B) + 2], P[(B) + 3])
#define PIN(x) asm volatile("" : "+v"(x))
#define SUM8(P, B) do { sacc += P[B]; sacc += P[(B) + 1]; sacc += P[(B) + 2]; sacc += P[(B) + 3]; sacc += P[(B) + 4]; sacc += P[(B) + 5]; sacc += P[(B) + 6]; sacc += P[(B) + 7]; PIN(sacc); } while (0)
#define EXP8(X, B) do { X[B] = fast_exp2(X[B]); X[(B) + 1] = fast_exp2(X[(B) + 1]); X[(B) + 2] = fast_exp2(X[(B) + 2]); X[(B) + 3] = fast_exp2(X[(B) + 3]); \
        X[(B) + 4] = fast_exp2(X[(B) + 4]); X[(B) + 5] = fast_exp2(X[(B) + 5]); X[(B) + 6] = fast_exp2(X[(B) + 6]); X[(B) + 7] = fast_exp2(X[(B) + 7]); PIN(X); } while (0)
#define STEP(C0, C1, P0, P1, t, GK, GV, GL) do { ATT_SBAR(); \
    const LAS char* vp_ = vp0 + sl_prev * VSLOT; \
    const bool det_ = (((t) & 3) == 1);            \
    float sacc = 0.f; \
    MFMA8_QK(C0, kf0, qf); \
    if (det_) { SUM8(P0, 0); SUM8(P0, 8); } \
    pf[0] = PK4(P0, 0); pf[1] = PK4(P0, 4); pf[2] = PK4(P0, 8); pf[3] = PK4(P0, 12); PIN(pf); \
    vf[0] = frag32(vp_, vc0); vf[1] = frag32(vp_ + 32 * 64, vc0); ATT_SBAR(); \
    MFMA8_QK(C1, kf1, qf); \
    if (det_) { SUM8(P1, 0); SUM8(P1, 8); } \
    pf[4] = PK4(P1, 0); pf[5] = PK4(P1, 4); pf[6] = PK4(P1, 8); pf[7] = PK4(P1, 12); PIN(pf); \
    vf[2] = frag32(vp_ + 64 * 64, vc0); vf[3] = frag32(vp_ + 96 * 64, vc0); ATT_SBAR(); \
    if (GK) { DMA_K((t) + 3, sl_cur); } if (GV) { DMA_V((t) + 1, sl_next); } \
    {   \
      float st_; { auto rr = __builtin_amdgcn_permlane32_swap(__float_as_uint(sacc), __float_as_uint(sacc), false, false); st_ = __uint_as_float(rr[0]) + __uint_as_float(rr[1]); } \
      resc = false; \
      if (__builtin_expect(det_ && __any(st_ > ATT_RESC_THR), 0)) { const float dl = (st_ > ATT_RESC_MIN) ? __builtin_fmaxf(__builtin_floorf(__builtin_amdgcn_logf(st_)) - 6.f, ATT_RESC_LO) : 0.f; mhat += dl; \
        asm volatile("s_nop 15\n\ts_nop 15" ::: "memory"); \
        _Pragma("unroll") for (int r = 0; r < 16; ++r) { asm volatile("v_sub_f32 %0, %0, %1" : "+v"(C0[r]) : "v"(dl)); asm volatile("v_sub_f32 %0, %0, %1" : "+v"(C1[r]) : "v"(dl)); } \
        _Pragma("unroll") for (int r = 0; r < 16; ++r) negm[r] = -mhat; asm volatile("" : "+v"(negm)); \
        const float f = fast_exp2(-dl); if (hi == 0) wsf[r32] = f; resc = true; } } \
    asm volatile("s_nop 7" : "+v"(C0), "+v"(C1)); CMASK(C0, C1, t); \
    ATT_SBAR(); \
    MFMA8_PV8(o[0], pf, vf[0]); EXP8(C0, 0); if (GL) kf0 = frag32(kp0 + sl_next * KSLOT8, kc0); ATT_SBAR(); \
    MFMA8_PV8(o[1], pf, vf[1]); EXP8(C0, 8); ATT_SBAR(); \
    MFMA8_PV8(o[2], pf, vf[2]); EXP8(C1, 0); if (GL) kf1 = frag32(kp0 + sl_next * KSLOT8 + 32 * 64, kc0); ATT_SBAR(); \
    MFMA8_PV8(o[3], pf, vf[3]); EXP8(C1, 8); ATT_SBAR(); \
    MFMA8_PV8(ol, pf, ones8); ATT_SBAR(); \
    } while (0)
    int t = 1;
#undef CMASK
#define CMASK(P0, P1, t) do {} while (0)
    for (; t + 5 < NT; t += 2) {
        STEP(pB0, pB1, pA0, pA1, t, true, true, true);       ATT_WAIT_BAR(2); RESC(); ROT();
        STEP(pA0, pA1, pB0, pB1, t + 1, true, true, true);   ATT_WAIT_BAR(2); RESC(); ROT();
    }
#undef CMASK
#define CMASK(P0, P1, t) do { const int jb_ = (t) - (NT - 4); if (jb_ >= 0) cmask(P0, P1, jb_, qrel, hi); } while (0)
#define ENDW(tt) do { if ((tt) + 3 < NT) { ATT_WAIT_BAR(2); } else if ((tt) + 2 < NT) { ATT_WAIT_BAR(1); } else { ATT_WAIT_BAR(0); } } while (0)
    for (; t + 1 < NT; t += 2) {
        STEP(pB0, pB1, pA0, pA1, t, (t + 3 < NT), (t + 1 < NT), (t + 1 < NT));       ENDW(t);     RESC(); ROT();
        STEP(pA0, pA1, pB0, pB1, t + 1, (t + 4 < NT), (t + 2 < NT), (t + 2 < NT));   ENDW(t + 1); RESC(); ROT();
    }
    STEP(pB0, pB1, pA0, pA1, NT - 1, false, false, false); RESC();
    {
      pf[0] = PK4(pB0, 0); pf[1] = PK4(pB0, 4); pf[2] = PK4(pB0, 8); pf[3] = PK4(pB0, 12); pf[4] = PK4(pB1, 0); pf[5] = PK4(pB1, 4); pf[6] = PK4(pB1, 8); pf[7] = PK4(pB1, 12);
      const LAS char* vp_ = vp0 + sl_cur * VSLOT;
      vf[0] = frag32(vp_, vc0); vf[1] = frag32(vp_ + 32 * 64, vc0); vf[2] = frag32(vp_ + 64 * 64, vc0); vf[3] = frag32(vp_ + 96 * 64, vc0);
      asm volatile("s_nop 3" : "+v"(pf));
      MFMA8_PV8(o[0], pf, vf[0]); MFMA8_PV8(o[1], pf, vf[1]); MFMA8_PV8(o[2], pf, vf[2]); MFMA8_PV8(o[3], pf, vf[3]); MFMA8_PV8(ol, pf, ones8);
      asm volatile("s_nop 15\n\ts_nop 15\n\ts_nop 7" : "+v"(o[0]), "+v"(o[1]), "+v"(o[2]), "+v"(o[3]), "+v"(ol)); }
#undef PK4
#undef PIN
#undef SUM8
#undef EXP8
#undef STEP
#undef ENDW
#undef CMASK
#undef RESC
#undef ROT
#pragma unroll
    for (int r = 0; r < 16; ++r) { const float rl = fast_rcp(ol[r]);
#pragma unroll
        for (int d0 = 0; d0 < 4; ++d0) o[d0][r] *= rl; }
#undef DMA_K
#undef DMA_V
}

template <int MODE> __device__ __forceinline__ void attn_unit(int b, int h, int qb, const bf16_t* Q, const bf16_t* K, const unsigned char* Q8, const unsigned char* K8, const unsigned char* V, bf16_t* YAB, float* park, float lam, const float* subg, LAS char* shm) {
    const int tid = opaque_tid(), lane = tid & 63, r32 = lane & 31, hi = lane >> 5; const int wid = __builtin_amdgcn_readfirstlane(tid >> 6);
    for (int m = 0; m < 2; ++m) {
        f32x16 o[4];
        if (m == 0) attn_pass<MODE>(o, b, 2 * h, h, qb, Q, K, V, shm);
        else attn_pass8<MODE>(o, b, 2 * h + 1, h, qb, Q8, K8, V, shm);
        int lo_ = lane; asm volatile("" : "+v"(lo_));
        f32x4* pk = (f32x4*)park + (size_t)wid * 1024 + lo_;
        if (m == 0) {
#pragma unroll
            for (int d0 = 0; d0 < 4; ++d0)
#pragma unroll
                for (int j = 0; j < 4; ++j) pk[(d0 * 4 + j) * 64] = (f32x4){o[d0][4 * j], o[d0][4 * j + 1], o[d0][4 * j + 2], o[d0][4 * j + 3]};
        } else {
            float ss[16];
#pragma unroll
            for (int r = 0; r < 16; ++r) ss[r] = 0.f;
#pragma unroll
            for (int d0 = 0; d0 < 4; ++d0)
#pragma unroll
                for (int j = 0; j < 4; ++j) { const f32x4 a = pk[(d0 * 4 + j) * 64];
#pragma unroll
                    for (int e = 0; e < 4; ++e) { const float v = a[e] - lam * o[d0][4 * j + e]; o[d0][4 * j + e] = v; ss[4 * j + e] += v * v; } }
#pragma unroll
            for (int r = 0; r < 16; ++r) { float s = ss[r]; s += __shfl_xor(s, 1); s += __shfl_xor(s, 2); s += __shfl_xor(s, 4); s += __shfl_xor(s, 8); s += __shfl_xor(s, 16); ss[r] = 0.8f / sqrtf(s * (1.0f / 128.0f) + EPS); }
            float gd[4];
#pragma unroll
            for (int d0 = 0; d0 < 4; ++d0) gd[d0] = subg[d0 * 32 + r32];
            LAS bf16_t* stg = (LAS bf16_t*)(shm + L_OST) + wid * 4096;
#pragma unroll
            for (int r = 0; r < 16; ++r) { const int orow = crow(r, hi);
#pragma unroll
                for (int d0 = 0; d0 < 4; ++d0) { float y = o[d0][r] * ss[r] * gd[d0];
#if PROBE_PHASE == 51
                    if (!(__builtin_fabsf(y) < 1e30f)) y = 0.f;
#endif
                    stg[orow * 128 + d0 * 32 + r32] = (bf16_t)(cvt_pk_bf16(y, 0.f) & 0xffffu); } }
            asm volatile("s_waitcnt lgkmcnt(0)" ::: "memory");
            bf16_t* Ow = YAB + ((long)b * SEQ + qb * QB + wid * 32) * 1024 + 512 + h * 128;
#pragma unroll
            for (int i = 0; i < 8; ++i) { const int row = i * 4 + (lo_ >> 4), ch = lo_ & 15; const u32x4 v = *(const LAS u32x4*)(stg + row * 128 + ch * 8); *(u32x4*)(Ow + (long)row * 1024 + ch * 8) = v; }
        }
        asm volatile("s_waitcnt lgkmcnt(0)\n\ts_barrier" ::: "memory");
    }
}
#undef ATT_WAIT_BAR
#undef MX3
#undef ATT_SBAR
#undef ATT_MFMA
#undef MFMA8_PV
#undef MFMA8_QK
#undef MFMA8_PV8
}

#define XB_TMO      128
#define XB_XCNT(j)  (256  + 64 * (j))
#define XB_XSUB(j)  (1280 + 64 * (j))
#define XB_XGEN(j)  (2304 + 64 * (j))
#define XB_TOP      3328
#define XB_TOPGEN   3392
#define XCD_BAR_WORDS 3456
#define XB_SPIN_CAP (1u << 18)
__device__ __forceinline__ unsigned xb_ld(unsigned* p)              { return __hip_atomic_load(p, __ATOMIC_RELAXED, __HIP_MEMORY_SCOPE_AGENT); }
__device__ __forceinline__ unsigned xb_add(unsigned* p, unsigned v) { return __hip_atomic_fetch_add(p, v, __ATOMIC_RELAXED, __HIP_MEMORY_SCOPE_AGENT); }
__device__ __forceinline__ unsigned xb_xcc_id() { return (unsigned)__builtin_amdgcn_s_getreg((3 << 11) | 20) & 0xFu; }
#define XB_SPIN(cond, bar) do { unsigned _sp = 0; while (cond) { __builtin_amdgcn_s_sleep(1); \
    if ((++_sp & 255u) == 0u) { if (xb_ld(&(bar)[XB_TMO])) break; if (_sp > XB_SPIN_CAP) { atomicAdd(&(bar)[XB_TMO], 1u); break; } } } } while (0)
struct XcdBarrier { unsigned* bar; unsigned x; volatile LAS unsigned* st; };
__device__ __forceinline__ XcdBarrier xcd_barrier_post(unsigned* bar, volatile LAS unsigned* st) {
    XcdBarrier b; b.bar = bar; b.x = xb_xcc_id(); b.st = st;
    if (threadIdx.x == 0) (void)xb_add(&bar[XB_XCNT(b.x)], 1u);
    return b;
}
__device__ __forceinline__ void xcd_barrier_complete(unsigned* bar, unsigned x, unsigned& nloc, unsigned& nx) {
    const unsigned G = gridDim.x * gridDim.y * gridDim.z;
    unsigned sum, cnt, mine, sp = 0u;
    for (;;) {
        sum = 0u; cnt = 0u; mine = 0u;
#pragma unroll
        for (unsigned j = 0; j < 16; ++j) { const unsigned c = xb_ld(&bar[XB_XCNT(j)]); sum += c; cnt += (c > 0u) ? 1u : 0u; mine = (j == x) ? c : mine; }
        if (sum == G) break;
        __builtin_amdgcn_s_sleep(1);
        if ((++sp & 255u) == 0u) { if (xb_ld(&bar[XB_TMO])) break; if (sp > XB_SPIN_CAP) { atomicAdd(&bar[XB_TMO], 1u); break; } }
    }
    nloc = mine > 0u ? mine : 1u; nx = cnt > 0u ? cnt : 1u;
}
__device__ __forceinline__ void xcd_barrier(const XcdBarrier& b) {
    asm volatile("s_waitcnt vmcnt(0)" ::: "memory");
    __syncthreads();
    if (threadIdx.x == 0) {
        unsigned* bar = b.bar;
        __builtin_amdgcn_s_waitcnt(0);
        unsigned nloc = b.st[0], nx = b.st[1];
        if (nloc == 0u) { xcd_barrier_complete(bar, b.x, nloc, nx); b.st[0] = nloc; b.st[1] = nx; }
        const unsigned old = xb_add(&bar[XB_XSUB(b.x)], 1u);
        const unsigned gen = old / nloc;
        if (old + 1u == (gen + 1u) * nloc) {
            __builtin_amdgcn_fence(__ATOMIC_RELEASE, "agent");
            asm volatile("s_waitcnt vmcnt(0)" ::: "memory");
            const unsigned og = xb_add(&bar[XB_TOP], 1u);
            const unsigned tg = og / nx;
            if (og + 1u == (tg + 1u) * nx) xb_add(&bar[XB_TOPGEN], 1u);
            else XB_SPIN(xb_ld(&bar[XB_TOPGEN]) == tg, bar);
            __builtin_amdgcn_fence(__ATOMIC_ACQUIRE, "agent");
            xb_add(&bar[XB_XGEN(b.x)], 1u);
            asm volatile("s_waitcnt vmcnt(0)" ::: "memory");
        } else {
            XB_SPIN(xb_ld(&bar[XB_XGEN(b.x)]) == gen, bar);
            __builtin_amdgcn_fence(__ATOMIC_ACQUIRE, "agent");
            asm volatile("s_waitcnt vmcnt(0)" ::: "memory");
        }
    }
    __syncthreads();
}

#define GRID_BAR() xcd_barrier(bar)

__device__ __forceinline__ void phase_stagger(int cls, unsigned ticks) {
    const unsigned long long t0 = __builtin_amdgcn_s_memrealtime(); const unsigned long long want = (unsigned long long)cls * ticks;
    while (__builtin_amdgcn_s_memrealtime() - t0 < want) __builtin_amdgcn_s_sleep(8);
}

struct Args {
    const float* x; const int* pos; const float* norm_mix_g; const float* w_in; const float* gm_ln_g; const float* gm_ln_b; const float* gm_w_s; const float* gm_b_s;
    const float* lam_q1; const float* lam_k1; const float* lam_q2; const float* lam_k2; const float* subln_g; const float* w_br_a; const float* w_br_b; const float* w_out;
    const float* norm_ffn_g; const float* w_rg; const float* b_rg; const float* w_re; const float* b_re; const float* w_gate; const float* w_up; const float* w_down; const float* final_g;
    float* out; unsigned char* ws;
};

__device__ __forceinline__ int wrow_map(int rmode, int n) { return rmode == 0 ? n : rmode == 1 ? ((n >> 5) * 128 + (n & 31)) : (((n >> 3) & 1) * 128 + (n >> 4) * 8 + (n & 7)); }
__device__ __forceinline__ void transpose_item(const float* W, int ldw, int k0, int n0, bf16_t* WT, int ldt, int drow0, int dk0, const float* gk, LAS float* scr, int lane, float sc = 1.0f, int rmode = 0) {
    f32x4 v[16];
    const int kr = lane >> 4, nc = (lane & 15) * 4;
#pragma unroll
    for (int i = 0; i < 16; ++i) v[i] = *(const f32x4*)(W + (size_t)(k0 + 4 * i + kr) * ldw + n0 + nc);
    if (gk) {
#pragma unroll
        for (int i = 0; i < 16; ++i) v[i] = v[i] * gk[k0 + 4 * i + kr];
    }
    if (sc != 1.0f) {
#pragma unroll
        for (int i = 0; i < 16; ++i) v[i] = v[i] * sc;
    }
#pragma unroll
    for (int i = 0; i < 16; ++i) { LAS float* d = scr + (4 * i + kr) * 65 + nc; d[0] = v[i][0]; d[1] = v[i][1]; d[2] = v[i][2]; d[3] = v[i][3]; }
    LDS_WAIT(); asm volatile("" ::: "memory");
    const int c = lane & 7;
#pragma unroll
    for (int j = 0; j < 8; ++j) { const int n = (lane >> 3) + 8 * j; const LAS float* s = scr + (8 * c) * 65 + n;
        u32x4 o; o.x = cvt_pk_bf16(s[0 * 65], s[1 * 65]); o.y = cvt_pk_bf16(s[2 * 65], s[3 * 65]); o.z = cvt_pk_bf16(s[4 * 65], s[5 * 65]); o.w = cvt_pk_bf16(s[6 * 65], s[7 * 65]);
        *(u32x4*)(WT + (size_t)(drow0 + wrow_map(rmode, n)) * ldt + dk0 + k0 + 8 * c) = o; }
    LDS_WAIT(); asm volatile("" ::: "memory");
}
__device__ __forceinline__ void transpose_item8(const float* W, int ldw, int k0, int n0, unsigned char* WT, int ldt, int drow0, const float* gk, float sc, LAS float* scr, int lane, int rmode = 0) {
    f32x4 v[16];
    const int kr = lane >> 4, nc = (lane & 15) * 4;
#pragma unroll
    for (int i = 0; i < 16; ++i) v[i] = *(const f32x4*)(W + (size_t)(k0 + 4 * i + kr) * ldw + n0 + nc);
#pragma unroll
    for (int i = 0; i < 16; ++i) v[i] = v[i] * (gk ? gk[k0 + 4 * i + kr] * sc : sc);
#pragma unroll
    for (int i = 0; i < 16; ++i) { LAS float* d = scr + (4 * i + kr) * 65 + nc; d[0] = v[i][0]; d[1] = v[i][1]; d[2] = v[i][2]; d[3] = v[i][3]; }
    LDS_WAIT(); asm volatile("" ::: "memory");
    const int c = lane & 7;
#pragma unroll
    for (int j = 0; j < 8; ++j) { const int n = (lane >> 3) + 8 * j; const LAS float* s = scr + (8 * c) * 65 + n;
        u32x2 o; o.x = cvt_pk4_fp8(s[0 * 65], s[1 * 65], s[2 * 65], s[3 * 65]); o.y = cvt_pk4_fp8(s[4 * 65], s[5 * 65], s[6 * 65], s[7 * 65]);
        *(u32x2*)(WT + (size_t)(drow0 + wrow_map(rmode, n)) * ldt + k0 + 8 * c) = o; }
    LDS_WAIT(); asm volatile("" ::: "memory");
}
__device__ __forceinline__ void expert_item(int r, const float* w_gate, const float* w_up, const float* w_down, const float* gffn, unsigned char* W13, unsigned char* W2, LAS float* scr, int lane) {
    constexpr int I_G = 32 * 128;
    if (r < 2 * I_G) { const int up = r >= I_G; if (up) r -= I_G; const int e = r / 128, q = r % 128, kb = q / 8, nb = q % 8;
        const int n0 = 64 * nb, drow = e * 1024 + (n0 >> 7) * 256 + up * 128 + (n0 & 127);
        transpose_item8((up ? w_up : w_gate) + (size_t)e * 1024 * 512, 512, 64 * kb, n0, W13, 1024, drow, gffn, 64.f, scr, lane); return; }
    r -= 2 * I_G;
    { const int e = r / 128, q = r % 128, kb = q / 16, nb = q % 16;
        transpose_item8(w_down + (size_t)e * 512 * 1024, 1024, 64 * kb, 64 * nb, W2, 512, e * 1024 + (nb >> 2) * 256 + (nb & 3) * 32, nullptr, 32.f, scr, lane, 2); }
}
__device__ __forceinline__ void rms_row_to_bf16(const float* xrow, const float* g, bf16_t* orow, int lane) {
    const f32x4* xr = (const f32x4*)xrow + lane; const f32x4* gr = (const f32x4*)g + lane;
    f32x4 v[4]; float s = 0.f;
#pragma unroll
    for (int j = 0; j < 4; ++j) { v[j] = xr[64 * j]; s += (v[j].x * v[j].x + v[j].y * v[j].y) + (v[j].z * v[j].z + v[j].w * v[j].w); }
    const float rstd = 1.f / sqrtf(wave_sum(s) * (1.f / D) + EPS);
    u32x2* o8 = (u32x2*)orow + lane;
#pragma unroll
    for (int j = 0; j < 4; ++j) { const f32x4 gg = gr[64 * j]; u32x2 w; w.x = cvt_pk_bf16(v[j].x * rstd * gg.x, v[j].y * rstd * gg.y); w.y = cvt_pk_bf16(v[j].z * rstd * gg.z, v[j].w * rstd * gg.w); o8[64 * j] = w; }
}

__global__ void __launch_bounds__(NTHREADS, 2) fwd_kernel(Args a) {
    extern __shared__ __attribute__((aligned(16))) unsigned char lds_raw[];
    LAS unsigned char* lds = (LAS unsigned char*)lds_raw;
    volatile LAS unsigned* LCTL = (volatile LAS unsigned*)(lds + LDSCTL_OFF);
    const int tid0 = threadIdx.x;
    const int G = gridDim.x, bx = blockIdx.x;
    const int vcu = (G % 8 == 0) ? (bx % 8) * (G / 8) + bx / 8 : bx;
    unsigned char* ws = a.ws;
    unsigned* ctl = (unsigned*)(ws + WS_CTL);
    __builtin_amdgcn_s_setreg((23 << 6) | 1, 1);
    for (int u = tid0; u < (LDS_BYTES - LDSCTL_OFF) / 4; u += NTHREADS) LCTL[u] = 0u;
    __syncthreads();
    XcdBarrier bar = xcd_barrier_post(ctl + CW_BAR, LCTL);
    const int NGW = G * NWAVES;
#define PHASE_IDS() const int tid = opaque_tid(), lane = tid & 63, wave = __builtin_amdgcn_readfirstlane(tid >> 6), gw = vcu * NWAVES + wave; (void)lane; (void)gw

    bf16_t* WIN = (bf16_t*)(ws + WS_WIN); bf16_t* WBR = (bf16_t*)(ws + WS_WBR); bf16_t* WO = (bf16_t*)(ws + WS_WO); unsigned char* W13 = ws + WS_W13; unsigned char* W2 = ws + WS_W2;
    bf16_t* WRH = (bf16_t*)(ws + WS_WRH); bf16_t* WRL = (bf16_t*)(ws + WS_WRL); float* CS = (float*)(ws + WS_CS); float* SSQ = (float*)(ws + WS_SSQ); float* RSTD = (float*)(ws + WS_RSTD); float* WTS = (float*)(ws + WS_WTS);
    int* LIST = (int*)(ws + WS_LIST);
    float* PARK = (float*)(ws + WS_PARK);
    bf16_t* XN = (bf16_t*)(ws + WS_RA); bf16_t* YAB = (bf16_t*)(ws + WS_RA); unsigned char* YB8 = ws + WS_RA;
    bf16_t* UV = (bf16_t*)(ws + WS_RB); bf16_t* MG = (bf16_t*)(ws + WS_RB);
    bf16_t* Qb = (bf16_t*)(ws + WS_RC); bf16_t* Kb = Qb + (size_t)T * 512; bf16_t* XB = (bf16_t*)(ws + WS_RC); unsigned char* V8T = ws + WS_RE + 128 * MiB; unsigned char* Q8 = V8T + 32 * MiB; unsigned char* K8 = Q8 + 16 * MiB;
    bf16_t* Vb = (bf16_t*)(ws + WS_RD);
    unsigned char* G8 = ws + WS_RE; unsigned char* H8 = ws + WS_RE; unsigned char* XB8 = ws + WS_RD;

    for (int rep = 0; rep < REPS(0); ++rep) {
        PHASE_IDS();
        LAS float* scr = (LAS float*)(lds + wave * 16896);
#if LEVEL >= 1
        constexpr int I_IN = 16 * 72, I_BA = 8 * 16, I_BB = 8 * 16, I_O = 16 * 16;
        constexpr int NITEMS = I_IN + I_BA + I_BB + I_O;
        for (int it = gw; it < NITEMS; it += NGW) {
            int r = it;
            if (r < I_IN) { const int kb = r / 72, nb = r % 72; transpose_item(a.w_in, IN_COLS, 64 * kb, 64 * nb, WIN, 1024, (nb >> 2) * 256 + (nb & 3) * 32, 0, nullptr, scr, lane, (64 * nb >= 2560) ? -LOG2E : 1.0f, (64 * nb >= 2560) ? 2 : 1); continue; } r -= I_IN;
            if (r < I_BA) { const int kb = r / 16, nb = r % 16; transpose_item(a.w_br_a, 1024, 64 * kb, 64 * nb, WBR, 1024, (nb >> 2) * 256 + (nb & 3) * 32, 0, nullptr, scr, lane, 1.0f, 1); continue; } r -= I_BA;
            if (r < I_BB) { const int kb = r / 16, nb = r % 16; transpose_item(a.w_br_b, 1024, 64 * kb, 64 * nb, WBR, 1024, (nb >> 2) * 256 + (nb & 3) * 32, 512, nullptr, scr, lane, 1.0f, 1); continue; } r -= I_BB;
            { const int kb = r / 16, nb = r % 16; transpose_item(a.w_out, 1024, 64 * kb, 64 * nb, WO, 1024, (nb >> 2) * 256 + (nb & 3) * 32, 0, nullptr, scr, lane, 1.0f, 1); }
        }
#if LEVEL >= 3
        for (int i = bx * NTHREADS + tid; i < 64 * 1024; i += G * NTHREADS) { const int n = i >> 10, k = i & 1023; float v = 0.f; if (n < 4) v = a.w_rg[k * 4 + n]; else if (n < 36) v = a.w_re[k * 32 + (n - 4)];
            v *= a.norm_ffn_g[k]; const unsigned h = cvt_pk_bf16(v, 0.f) & 0xffffu; const float r = v - __uint_as_float(h << 16); WRH[i] = (bf16_t)h; WRL[i] = (bf16_t)(cvt_pk_bf16(r, 0.f) & 0xffffu); }
#endif
        for (int i = bx * NTHREADS + tid; i < T * 8; i += G * NTHREADS) { const int t = i >> 3, j = i & 7;
            const double invf = exp2(-(double)j * (18.931568569324174 / 8.0));
            const double ang = (double)a.pos[t] * invf; const double kk = rint(ang * 0.15915494309189535); const float rr = (float)(ang - kk * 6.283185307179586);
            CS[t * 16 + j] = cosf(rr); CS[t * 16 + 8 + j] = sinf(rr); }
        for (int m = gw; m < T; m += NGW) rms_row_to_bf16(a.x + (size_t)m * D, a.norm_mix_g, XN + (size_t)m * D, lane);
#endif
    }
    GRID_BAR();

#if LEVEL >= 1 && !defined(NO_P1)
#if PROBE_PHASE >= 71 && PROBE_PHASE <= 73
    {
        pg8::DenseProb P; P.init(XN, WIN, T, IN_COLS, 1024, G, bx);
        pg8::EpiInProjT<(PROBE_PHASE == 73 ? 4 : PROBE_PHASE - 70)> E{UV, Qb, Kb, Vb, G8, CS, Q8, K8};
        pg8::gemm_core<false>(lds, P, E, pg8::NoHook{});
    }
#endif
#if PROBE_PHASE == 66 || PROBE_PHASE == 67
    {
        pg8::DenseProb P; P.init(XN, WIN, T, IN_COLS, 1024, G, bx);
        pg8::EpiInProjT<PROBE_PHASE - 65> E{UV, Qb, Kb, Vb, G8, CS, Q8, K8};
        pg8::gemm_core<false, pg8::DenseProb, pg8::EpiInProjT<PROBE_PHASE - 65>, pg8::NoHook, 4>(lds, P, E, pg8::NoHook{});
    }
#endif
#if PROBE_PHASE == 64
    {
        pg8::DenseProb P; P.init(XN, WIN, T, IN_COLS, 1024, G, bx);
        pg8::EpiInProj E{UV, Qb, Kb, Vb, G8, CS, Q8, K8};
        pg8::gemm_core<false, pg8::DenseProb, pg8::EpiInProj, pg8::NoHook, 4>(lds, P, E, pg8::NoHook{});
    }
#endif
    for (int rep = 0; rep < REPS(1); ++rep) {
#ifdef STAG1
        phase_stagger(((bx >> 3) & 7) >> 1, STAG1);
#endif
        pg8::DenseProb P; P.init(XN, WIN, T, IN_COLS, 1024, G, bx);
        pg8::EpiInProj E{UV, Qb, Kb, Vb, G8, CS, Q8, K8};
        pg8::gemm_core<false>(lds, P, E, pg8::NoHook{});
    }
#if PROBE_PHASE == 11
    {
        pg8::DenseProb P; P.init(XN, WIN, T, IN_COLS, 1024, G, bx);
        pg8::gemm_core<false>(lds, P, pg8::EpiNull{}, pg8::NoHook{});
    }
#endif
#if PROBE_PHASE >= 61 && PROBE_PHASE <= 63
    {
        pg8::DenseProb P; P.init(XN, WIN, T, IN_COLS, 1024, G, bx);
        pg8::gemm_core<false, pg8::DenseProb, pg8::EpiNull, pg8::NoHook, PROBE_PHASE - 60>(lds, P, pg8::EpiNull{}, pg8::NoHook{});
    }
#endif
#if PROBE_PHASE == 31
    {
        pg8::DenseProb P; P.init(XN, WIN, T, IN_COLS, 1024, G, bx);
        pg8::gemm_core<false>(lds, P, pg8::EpiStoreOnly{(bf16_t*)(ws + WS_END)}, pg8::NoHook{});
    }
#endif
#if PROBE_PHASE == 12
    {
        pg8::DenseProbSame P; P.init(XN, WIN, T, IN_COLS, 1024, G, bx);
        pg8::gemm_core<false>(lds, P, pg8::EpiNull{}, pg8::NoHook{});
    }
#endif
#endif
    GRID_BAR();

#if LEVEL >= 1 && !defined(NO_P2A)
    for (int rep = 0; rep < REPS(2); ++rep) {
        PHASE_IDS();
        LAS bf16_t* VT = (LAS bf16_t*)lds;
        LAS float* SV = (LAS float*)(lds + 36864);
        const int r32 = lane & 31, hi = lane >> 5;
        for (int un = vcu; un < 2048; un += G) {
            const int ch = un >> 2, g = un & 3; const size_t row0 = (size_t)ch * 128;
            {
                const int s = tid >> 2, qd = tid & 3;
                const u32x4* vp = (const u32x4*)(UV + (row0 + s) * 1024 + 512 + g * 128 + qd * 32);
                float v[32]; float sm = 0.f;
#pragma unroll
                for (int j = 0; j < 4; ++j) { const u32x4 w = vp[j]; f32x4 x0, x1; pg8::unpack8(w, x0, x1);
#pragma unroll
                    for (int e = 0; e < 4; ++e) { v[8 * j + e] = x0[e]; v[8 * j + 4 + e] = x1[e]; sm += x0[e] + x1[e]; } }
                sm += __shfl_xor(sm, 1); sm += __shfl_xor(sm, 2);
                const float mu = sm * (1.0f / 128.0f); float sq = 0.f;
#pragma unroll
                for (int i = 0; i < 32; ++i) { v[i] -= mu; sq += v[i] * v[i]; }
                sq += __shfl_xor(sq, 1); sq += __shfl_xor(sq, 2);
                const float rstd = 1.0f / sqrtf(sq * (1.0f / 128.0f) + EPS);
                const float* lg = a.gm_ln_g + g * 128 + qd * 32; const float* lb = a.gm_ln_b + g * 128 + qd * 32;
#pragma unroll
                for (int i = 0; i < 32; ++i) { const float y = v[i] * rstd * lg[i] + lb[i]; VT[(qd * 32 + i) * 136 + s] = (bf16_t)(cvt_pk_bf16(y, 0.f) & 0xffffu); }
            }
            LDS_WAIT(); __syncthreads();
            {
                const int tb = wave >> 1, db0 = 2 * (wave & 1);
                f32x16 c0 = f32x16{}, c1 = f32x16{};
                const float* wrow = a.gm_w_s + ((size_t)g * 128 + tb * 32 + r32) * 128;
                const int trow = tb * 32 + r32;
                for (int ks = 0; ks <= 2 * tb + 1; ++ks) {
                    const int s0 = 16 * ks + 8 * hi;
                    const f32x4 wa = *(const f32x4*)(wrow + s0), wb = *(const f32x4*)(wrow + s0 + 4);
                    float w8[8] = {wa[0], wa[1], wa[2], wa[3], wb[0], wb[1], wb[2], wb[3]};
#pragma unroll
                    for (int j = 0; j < 8; ++j) if (s0 + j > trow) w8[j] = 0.f;
                    u32x4 aw; aw.x = cvt_pk_bf16(w8[0], w8[1]); aw.y = cvt_pk_bf16(w8[2], w8[3]); aw.z = cvt_pk_bf16(w8[4], w8[5]); aw.w = cvt_pk_bf16(w8[6], w8[7]);
                    const bf16x8 af = __builtin_bit_cast(bf16x8, aw);
                    const bf16x8 b0 = *(const LAS bf16x8*)(VT + ((db0 + 0) * 32 + r32) * 136 + s0);
                    const bf16x8 b1 = *(const LAS bf16x8*)(VT + ((db0 + 1) * 32 + r32) * 136 + s0);
                    c0 = __builtin_amdgcn_mfma_f32_32x32x16_bf16(af, b0, c0, 0, 0, 0);
                    c1 = __builtin_amdgcn_mfma_f32_32x32x16_bf16(af, b1, c1, 0, 0, 0);
                }
#pragma unroll
                for (int r = 0; r < 16; ++r) { const int t = tb * 32 + att::crow(r, hi); const float bs = a.gm_b_s[g * 128 + t];
                    SV[t * 132 + db0 * 32 + r32] = c0[r] + bs; SV[t * 132 + db0 * 32 + 32 + r32] = c1[r] + bs; }
            }
            LDS_WAIT(); __syncthreads();
            {
#pragma unroll
                for (int i = 0; i < 4; ++i) { const int t = i * 32 + (tid >> 4), dc = (tid & 15) * 8;
                    const size_t ro = (row0 + t) * 1024 + g * 128 + dc;
                    const u32x4 uw = *(const u32x4*)(UV + ro); f32x4 u0, u1; pg8::unpack8(uw, u0, u1);
                    const f32x4 s0 = *(const LAS f32x4*)(SV + t * 132 + dc), s1 = *(const LAS f32x4*)(SV + t * 132 + dc + 4);
                    *(u32x4*)(YAB + ro) = pg8::pack8(u0 * s0, u1 * s1); }
            }
            LDS_WAIT(); __syncthreads();
        }
    }
#endif
#if LEVEL >= 2
    {
        PHASE_IDS();
        LAS unsigned char* TB = (LAS unsigned char*)lds + wave * 8192;
        for (int tl = gw; tl < BATCH * 4 * (SEQ / 64); tl += NGW) {
            const int bh = tl >> 7, tt = tl & 127, b = bh >> 2, h = bh & 3;
            const bf16_t* vsrc = Vb + ((size_t)b * SEQ + tt * 64) * 512 + h * 128;
            u32x4 w[16];
#pragma unroll
            for (int i = 0; i < 16; ++i) w[i] = *(const u32x4*)(vsrc + (size_t)(i * 4 + (lane >> 4)) * 512 + (lane & 15) * 8);
#pragma unroll
            for (int i = 0; i < 16; ++i) { const int key = i * 4 + (lane >> 4), kk = key & 31, khi = (kk >> 2) & 1, j = (kk & 3) + 4 * (kk >> 3) + 16 * (key >> 5), cc = khi * 2 + (j >> 4);
                f32x4 x0, x1; pg8::unpack8(w[i], x0, x1); const unsigned q0_ = cvt_pk4_fp8(x0[0], x0[1], x0[2], x0[3]), q1_ = cvt_pk4_fp8(x1[0], x1[1], x1[2], x1[3]);
#pragma unroll
                for (int e = 0; e < 8; ++e) { const int d = (lane & 15) * 8 + e; const unsigned byte = ((e < 4 ? q0_ : q1_) >> (8 * (e & 3))) & 0xffu;
                    TB[d * 64 + ((cc ^ ((d >> 2) & 3)) * 16) + (j & 15)] = (unsigned char)byte; } }
            LDS_WAIT(); asm volatile("" ::: "memory");
            unsigned char* dst = V8T + (size_t)tl * 8192;
#pragma unroll
            for (int i = 0; i < 8; ++i) *(u32x4*)(dst + (i * 64 + lane) * 16) = *(const LAS u32x4*)(TB + (i * 64 + lane) * 16);
            LDS_WAIT(); asm volatile("" ::: "memory");
        }
    }
    GRID_BAR();
#endif
#if LEVEL >= 2 && !defined(NO_P2B)
    {
        PHASE_IDS();
        float lam;
        { const float p1 = wave_sum(a.lam_q1[lane] * a.lam_k1[lane]), p2 = wave_sum(a.lam_q2[lane] * a.lam_k2[lane]); lam = expf(p1) - expf(p2) + 0.2f; }
        const int bh = vcu >> 3, s = vcu & 7, b = bh >> 2, h = bh & 3;
        float* park = PARK + (size_t)bx * 32768;
        if (G == 256) {
            for (int ii = 0; ii < 4 * REPS(3); ++ii) { const int i = ii & 3; const int qb = (i == 0) ? s : (i == 1) ? 15 - s : (i == 2) ? 16 + s : 31 - s;
                att::attn_unit<0>(b, h, qb, Qb, Kb, Q8, K8, V8T, YAB, park, lam, a.subln_g, (LAS char*)lds);
#if LEVEL >= 3
                if (ii < 4) {
                    LAS float* scr = (LAS float*)(lds + wave * 16896);
                    for (int k = wave; k < 12; k += NWAVES) expert_item((bx * 4 + ii) * 12 + k, a.w_gate, a.w_up, a.w_down, a.norm_ffn_g, W13, W2, scr, lane);
                    LDS_WAIT(); __syncthreads();
                }
#endif
            }
#if PROBE_PHASE == 13 || PROBE_PHASE == 14 || PROBE_PHASE == 15 || PROBE_PHASE == 16
            for (int i = 0; i < 4; ++i) { const int qb = (i == 0) ? s : (i == 1) ? 15 - s : (i == 2) ? 16 + s : 31 - s;
                att::attn_unit<PROBE_PHASE - 13>(0, 0, qb, Qb, Kb, Q8, K8, V8T, (bf16_t*)(ws + WS_END), park, lam, a.subln_g, (LAS char*)lds); }
#endif
        }
    }
#elif LEVEL >= 1
    {
        PHASE_IDS();
        for (int i = bx * NTHREADS + tid; i < T * 64; i += G * NTHREADS) { const int row = i >> 6, c = i & 63; *(u32x4*)(YAB + (size_t)row * 1024 + 512 + c * 8) = (u32x4){0u, 0u, 0u, 0u}; }
    }
#endif
    GRID_BAR();

#if LEVEL >= 1 && !defined(NO_P3)
    for (int rep = 0; rep < REPS(4); ++rep) {
        pg8::PanelProb P; P.init(YAB, WBR, T, 1024, 1024, G, bx);
        pg8::EpiMerge E{G8, MG};
        pg8::gemm_core<false>(lds, P, E, pg8::HookMerge{G8});
    }
#endif
    asm volatile("s_waitcnt vmcnt(0)" ::: "memory"); __syncthreads();
#if LEVEL >= 1 && !defined(NO_P4)
    for (int rep = 0; rep < REPS(5); ++rep) {
        pg8::PanelProb P; P.init(MG, WO, T, 1024, 1024, G, bx);
        pg8::EpiX1 E{a.x, XB, XB8, SSQ};
        pg8::gemm_core<false>(lds, P, E, pg8::NoHook{});
    }
#endif
    asm volatile("s_waitcnt vmcnt(0)" ::: "memory"); __syncthreads();

#if LEVEL >= 3 && !defined(NO_P5)
    {
        PHASE_IDS();
        LAS float* LG = (LAS float*)lds;
        volatile LAS int* LCNT = (volatile LAS int*)(LCTL + 96); volatile LAS int* LBASE = (volatile LAS int*)(LCTL + 128);
        const int r32 = lane & 31, hi = lane >> 5;
        for (int tb = bx; tb < T / 256; tb += G) {
            const size_t tok0 = (size_t)tb * 256 + wave * 32;
            const bf16_t* xa = XB + (tok0 + r32) * 1024 + hi * 8;
            const bf16_t* wh0 = WRH + (size_t)r32 * 1024 + hi * 8; const bf16_t* wh1 = wh0 + 32 * 1024;
            const bf16_t* wl0 = WRL + (size_t)r32 * 1024 + hi * 8; const bf16_t* wl1 = wl0 + 32 * 1024;
            f32x16 c0 = f32x16{}, c1 = f32x16{};
#pragma unroll 4
            for (int ks = 0; ks < 64; ++ks) {
                const bf16x8 av = *(const bf16x8*)(xa + ks * 16);
                const bf16x8 h0 = *(const bf16x8*)(wh0 + ks * 16), h1 = *(const bf16x8*)(wh1 + ks * 16), l0 = *(const bf16x8*)(wl0 + ks * 16), l1 = *(const bf16x8*)(wl1 + ks * 16);
                c0 = __builtin_amdgcn_mfma_f32_32x32x16_bf16(av, h0, c0, 0, 0, 0); c1 = __builtin_amdgcn_mfma_f32_32x32x16_bf16(av, h1, c1, 0, 0, 0);
                c0 = __builtin_amdgcn_mfma_f32_32x32x16_bf16(av, l0, c0, 0, 0, 0); c1 = __builtin_amdgcn_mfma_f32_32x32x16_bf16(av, l1, c1, 0, 0, 0);
            }
#pragma unroll
            for (int r = 0; r < 16; ++r) { const int tl = wave * 32 + att::crow(r, hi); LG[tl * 37 + r32] = c0[r]; if (r32 < 4) LG[tl * 37 + 32 + r32] = c1[r]; }
            if (tid < 32) LCNT[tid] = 0;
            LDS_WAIT(); __syncthreads();
            int eid0 = 0, eid1 = 0, rk0 = 0, rk1 = 0; float w0 = 0.f, w1 = 0.f; const size_t tok = (size_t)tb * 256 + tid;
            if (tid < 256) {
                float ssq = 0.f;
#pragma unroll
                for (int j = 0; j < 16; ++j) ssq += SSQ[tok * 16 + j];
                const float rstd = 1.0f / sqrtf(ssq * (1.0f / 1024.0f) + EPS);
                RSTD[tok] = rstd;
                const LAS float* p0 = LG + tid * 37;
                float gl[4]; int grp = 0;
#pragma unroll
                for (int j = 0; j < 4; ++j) gl[j] = p0[j] * rstd + a.b_rg[j];
                float gmx = gl[0];
#pragma unroll
                for (int j = 1; j < 4; ++j) if (gl[j] > gmx) { gmx = gl[j]; grp = j; }
                float gs = 0.f;
#pragma unroll
                for (int j = 0; j < 4; ++j) gs += expf(gl[j] - gmx);
                const float gwt = 1.0f / gs;
                float el[8];
#pragma unroll
                for (int j = 0; j < 8; ++j) el[j] = p0[4 + grp * 8 + j] * rstd + a.b_re[grp * 8 + j];
                int i0 = 0; float v0 = el[0];
#pragma unroll
                for (int j = 1; j < 8; ++j) if (el[j] > v0) { v0 = el[j]; i0 = j; }
                int i1 = -1; float v1 = -INFINITY;
#pragma unroll
                for (int j = 0; j < 8; ++j) if (j != i0 && el[j] > v1) { v1 = el[j]; i1 = j; }
                const float e1 = expf(v1 - v0); w0 = gwt / (1.0f + e1); w1 = gwt * e1 / (1.0f + e1);
                eid0 = grp * 8 + i0; eid1 = grp * 8 + i1;
                rk0 = atomicAdd((int*)(LCNT + eid0), 1); rk1 = atomicAdd((int*)(LCNT + eid1), 1);
            }
            LDS_WAIT(); __syncthreads();
            if (tid < 32) LBASE[tid] = (int)__hip_atomic_fetch_add(ctl + CW_CNT + tid, (unsigned)LCNT[tid], RLX_AGENT);
            LDS_WAIT(); __syncthreads();
            if (tid < 256) {
                const int s0_ = eid0 * LISTCAP + LBASE[eid0] + rk0, s1_ = eid1 * LISTCAP + LBASE[eid1] + rk1;
                LIST[s0_] = (int)(((unsigned)(tok * 2) << 15) | (cvt_pk_bf16(w0, 0.f) & 0x7fffu)); LIST[s1_] = (int)(((unsigned)(tok * 2 + 1) << 15) | (cvt_pk_bf16(w1, 0.f) & 0x7fffu));
            }
            LDS_WAIT(); __syncthreads();
        }
    }
#endif
    GRID_BAR();
#if LEVEL >= 3
    {
        PHASE_IDS();
        volatile LAS int* BST = (volatile LAS int*)(LCTL + 16); volatile LAS int* CNT = (volatile LAS int*)(LCTL + 64);
        if (tid == 0) { int accb = 0; for (int e = 0; e < NEXP; ++e) { const int c = (int)__hip_atomic_load(ctl + CW_CNT + e, RLX_AGENT); CNT[e] = c; BST[e] = accb; accb += (c + 255) >> 8; } BST[NEXP] = accb; }
        LDS_WAIT(); __syncthreads();
    }
#if !defined(NO_P6)
    for (int rep = 0; rep < REPS(6); ++rep) {
        pg8::MoeUpProb P; P.init((const LAS int*)(LCTL + 16), (const LAS int*)(LCTL + 64), G, bx); P.A = (const char*)XB8; P.Bt = (const char*)W13; P.pitch = 1024; P.list = LIST;
        pg8::EpiMoeUp E{LIST, RSTD, H8, {}};
        pg8::gemm_core<true>(lds, P, E, pg8::NoHook{});
    }
#endif
#endif
    GRID_BAR();
#if LEVEL >= 3 && !defined(NO_P7)
    for (int rep = 0; rep < REPS(7); ++rep) {
        pg8::MoeDownProb P; P.init((const LAS int*)(LCTL + 16), (const LAS int*)(LCTL + 64), G, bx); P.A = (const char*)H8; P.Bt = (const char*)W2; P.pitch = 512;
        pg8::EpiMoeDown E{LIST, YB8, {}};
        pg8::gemm_core<true>(lds, P, E, pg8::NoHook{});
    }
#endif
    GRID_BAR();

    {
        PHASE_IDS();
        const bool tmo = (__hip_atomic_load(ctl + CW_BAR + XB_TMO, RLX_AGENT) != 0u);
        for (int m = gw; m < T; m += NGW) {
            const f32x4* gr = (const f32x4*)a.final_g + lane;
            f32x4 v[4]; float s = 0.f;
#pragma unroll
            for (int j = 0; j < 4; ++j) {
#if LEVEL >= 1
                { const u32x2 xw = *((const u32x2*)(XB + (size_t)m * D) + lane + 64 * j); v[j] = (f32x4){bf_lo(xw.x), bf_hi(xw.x), bf_lo(xw.y), bf_hi(xw.y)}; }
#else
                v[j] = ((const f32x4*)(a.x + (size_t)m * D) + lane)[64 * j];
#endif
#if LEVEL >= 3
                const unsigned y0 = *((const unsigned*)(YB8 + (size_t)(2 * m) * D) + lane + 64 * j), y1 = *((const unsigned*)(YB8 + (size_t)(2 * m + 1) * D) + lane + 64 * j);
                v[j] = v[j] + (fp8x4_to_f32(y0) + fp8x4_to_f32(y1)) * 0.0625f;
#endif
                s += (v[j].x * v[j].x + v[j].y * v[j].y) + (v[j].z * v[j].z + v[j].w * v[j].w); }
            float rstd = 1.f / sqrtf(wave_sum(s) * (1.f / D) + EPS);
            if (tmo) rstd = __builtin_nanf("");
            f32x4* o = (f32x4*)(a.out + (size_t)m * D) + lane;
#pragma unroll
            for (int j = 0; j < 4; ++j) { f32x4 ov = v[j] * rstd * gr[64 * j];
#if PROBE_PHASE == 50
#pragma unroll
                for (int e = 0; e < 4; ++e) if (!(__builtin_fabsf(ov[e]) < 1e30f)) ov[e] = 0.f;
#endif
                o[64 * j] = ov; }
        }
    }
}

extern "C" void kernel_launch(void* const* d_in, const int* in_sizes, int n_in, void* d_out, int out_size, void* d_ws, size_t ws_size, hipStream_t stream) {
    static int grid = 0;
    if (grid == 0) {
        if (n_in != 25 || in_sizes[0] != T * D || out_size != T * D || ws_size < WS_END + 64 * MiB) { fprintf(stderr, "kernel_launch: unexpected shapes (n_in %d, in0 %d, out %d, ws %zu); nothing launched\n", n_in, n_in > 0 ? in_sizes[0] : -1, out_size, ws_size); grid = -1; return; }
        int dev = 0, cus = 0, per_cu = 0;
        if (hipGetDevice(&dev) != hipSuccess || hipDeviceGetAttribute(&cus, hipDeviceAttributeMultiprocessorCount, dev) != hipSuccess) { grid = -1; return; }
        if (hipFuncSetAttribute((const void*)fwd_kernel, hipFuncAttributeMaxDynamicSharedMemorySize, LDS_BYTES) != hipSuccess) { fprintf(stderr, "kernel_launch: hipFuncSetAttribute failed\n"); grid = -1; return; }
        if (hipOccupancyMaxActiveBlocksPerMultiprocessor(&per_cu, (const void*)fwd_kernel, NTHREADS, LDS_BYTES) != hipSuccess || per_cu < 1) fprintf(stderr, "kernel_launch: occupancy query reports %d\n", per_cu);
        (void)hipGetLastError();
        grid = cus;
        if (grid != 256) fprintf(stderr, "kernel_launch: %d CUs (built for 256)\n", grid);
    }
    if (grid < 0) return;
    if (hipMemsetAsync((char*)d_ws + WS_CTL, 0, CTL_ZERO_BYTES, stream) != hipSuccess) return;
    Args a{};
    a.x = (const float*)d_in[0]; a.pos = (const int*)d_in[1]; a.norm_mix_g = (const float*)d_in[2]; a.w_in = (const float*)d_in[3]; a.gm_ln_g = (const float*)d_in[4]; a.gm_ln_b = (const float*)d_in[5];
    a.gm_w_s = (const float*)d_in[6]; a.gm_b_s = (const float*)d_in[7]; a.lam_q1 = (const float*)d_in[8]; a.lam_k1 = (const float*)d_in[9]; a.lam_q2 = (const float*)d_in[10]; a.lam_k2 = (const float*)d_in[11];
    a.subln_g = (const float*)d_in[12]; a.w_br_a = (const float*)d_in[13]; a.w_br_b = (const float*)d_in[14]; a.w_out = (const float*)d_in[15]; a.norm_ffn_g = (const float*)d_in[16];
    a.w_rg = (const float*)d_in[17]; a.b_rg = (const float*)d_in[18]; a.w_re = (const float*)d_in[19]; a.b_re = (const float*)d_in[20]; a.w_gate = (const float*)d_in[21]; a.w_up = (const float*)d_in[22];
    a.w_down = (const float*)d_in[23]; a.final_g = (const float*)d_in[24];
    a.out = (float*)d_out; a.ws = (unsigned char*)d_ws;
    hipLaunchKernelGGL(fwd_kernel, dim3(grid), dim3(NTHREADS), LDS_BYTES, stream, a);
    const hipError_t le = hipPeekAtLastError();
    if (le != hipSuccess) fprintf(stderr, "kernel_launch: launch failed: %s\n", hipGetErrorName(le));
}
```

```cpp
#include <hip/hip_runtime.h>
#include <cstdio>
#include <cstdint>

#ifndef LEVEL
#define LEVEL 3
#endif

#ifndef PROBE_PHASE
#define PROBE_PHASE -1
#endif
#define REPS(p) ((PROBE_PHASE == (p)) ? 2 : 1)
#define LAS __attribute__((address_space(3)))
#define GAS __attribute__((address_space(1)))
typedef unsigned short bf16_t;
typedef short bf16x8 __attribute__((ext_vector_type(8)));
typedef short s16x4 __attribute__((ext_vector_type(4)));
typedef float f32x2 __attribute__((ext_vector_type(2)));
typedef float f32x4 __attribute__((ext_vector_type(4)));
typedef float f32x16 __attribute__((ext_vector_type(16)));
typedef unsigned u32x2 __attribute__((ext_vector_type(2)));
typedef unsigned u32x4 __attribute__((ext_vector_type(4)));
typedef int i32x8 __attribute__((ext_vector_type(8)));
typedef short s16x16 __attribute__((ext_vector_type(16)));

constexpr int D = 1024, BATCH = 8, SEQ = 8192, T = BATCH * SEQ;
constexpr int IN_COLS = 4608;
constexpr int NEXP = 32, DEXP = 512;
constexpr int LISTCAP = T;
constexpr float EPS = 1e-6f;
constexpr float LOG2E = 1.4426950408889634f;
constexpr float C2 = 0.125f * LOG2E;
constexpr int NWAVES = 8, NTHREADS = 512;

constexpr size_t MiB = 1u << 20;
constexpr size_t WS_CTL = 0, CTL_ZERO_BYTES = 1 * MiB;
constexpr size_t WS_WIN = 2 * MiB;
constexpr size_t WS_WBR = 12 * MiB;
constexpr size_t WS_WO = 14 * MiB;
constexpr size_t WS_W13 = 16 * MiB;
constexpr size_t WS_W2 = 80 * MiB;
constexpr size_t WS_WRH = 112 * MiB;
constexpr size_t WS_WRL = 112 * MiB + 131072;
constexpr size_t WS_CS = 113 * MiB;
constexpr size_t WS_SSQ = 117 * MiB;
constexpr size_t WS_RSTD = 121 * MiB;
constexpr size_t WS_WTS = 122 * MiB;
constexpr size_t WS_LIST = 123 * MiB;
constexpr size_t WS_PARK = 131 * MiB;
constexpr size_t WS_RA = 164 * MiB;
constexpr size_t WS_RB = 292 * MiB;
constexpr size_t WS_RC = 420 * MiB;
constexpr size_t WS_RD = 548 * MiB;
constexpr size_t WS_RE = 612 * MiB;
constexpr size_t WS_END = 868 * MiB;
constexpr int CW_TMO = 0;
constexpr int CW_BAR = 4096;
constexpr int CW_CNT = 8192;

constexpr int RING_BYTES = 147456;
constexpr int LDSCTL_OFF = RING_BYTES;
constexpr int LDS_BYTES = RING_BYTES + 1024;

#define RLX_AGENT __ATOMIC_RELAXED, __HIP_MEMORY_SCOPE_AGENT
#define LDS_WAIT() asm volatile("s_waitcnt lgkmcnt(0)" ::: "memory")
#define VM_WAIT() asm volatile("s_waitcnt vmcnt(0)" ::: "memory")

__device__ __forceinline__ unsigned cvt_pk_bf16(float lo, float hi) { unsigned r; asm("v_cvt_pk_bf16_f32 %0, %1, %2" : "=v"(r) : "v"(lo), "v"(hi)); return r; }
__device__ __forceinline__ unsigned cvt_pk4_fp8(float a, float b, float c, float d) { int w; asm("v_cvt_pk_fp8_f32 %0, %1, %2" : "=v"(w) : "v"(a), "v"(b)); w = __builtin_amdgcn_cvt_pk_fp8_f32(c, d, w, true); return (unsigned)w; }
__device__ __forceinline__ unsigned cvt_pk4_u8(float a, float b, float c, float d) { unsigned w = 0; w = __builtin_amdgcn_cvt_pk_u8_f32(a, 0, w); w = __builtin_amdgcn_cvt_pk_u8_f32(b, 1, w); w = __builtin_amdgcn_cvt_pk_u8_f32(c, 2, w); w = __builtin_amdgcn_cvt_pk_u8_f32(d, 3, w); return w; }
__device__ __forceinline__ f32x4 u8x4_to_f32(unsigned w) { return (f32x4){(float)(w & 0xffu), (float)((w >> 8) & 0xffu), (float)((w >> 16) & 0xffu), (float)(w >> 24)}; }
__device__ __forceinline__ f32x4 fp8x4_to_f32(unsigned w) { const f32x2 lo = __builtin_amdgcn_cvt_pk_f32_fp8((int)w, false), hi = __builtin_amdgcn_cvt_pk_f32_fp8((int)w, true); return (f32x4){lo[0], lo[1], hi[0], hi[1]}; }
__device__ __forceinline__ float bf_lo(unsigned w) { return __uint_as_float(w << 16); }
__device__ __forceinline__ float bf_hi(unsigned w) { return __uint_as_float(w & 0xffff0000u); }
__device__ __forceinline__ float fast_exp2(float x) { return __builtin_amdgcn_exp2f(x); }
__device__ __forceinline__ float fast_rcp(float x) { return __builtin_amdgcn_rcpf(x); }
__device__ __forceinline__ float sigmoidf_(float x) { return fast_rcp(1.0f + fast_exp2(-LOG2E * x)); }
__device__ __forceinline__ float gelu_tanh(float x) {
    const float u = x * (0.7978845608028654f + 0.0356774081363001f * x * x);
    return x * fast_rcp(1.0f + fast_exp2(-2.0f * LOG2E * u));
}
__device__ __forceinline__ f32x2 pk_fma(f32x2 a, f32x2 b, f32x2 c) { return __builtin_elementwise_fma(a, b, c); }
__device__ __forceinline__ f32x2 gelu_tanh2(f32x2 x) {
    constexpr float K0 = -2.0f * LOG2E * 0.7978845608028654f, K1 = -2.0f * LOG2E * 0.0356774081363001f;
    const f32x2 z = x * pk_fma(x * x, (f32x2){K1, K1}, (f32x2){K0, K0});
    const f32x2 d = (f32x2){fast_exp2(z.x), fast_exp2(z.y)} + 1.0f;
    return x * (f32x2){fast_rcp(d.x), fast_rcp(d.y)};
}
__device__ __forceinline__ f32x2 sig255_2(f32x2 a) {
    constexpr float S = 1.0f / 255.0f;
    const f32x2 d = pk_fma((f32x2){fast_exp2(a.x), fast_exp2(a.y)}, (f32x2){S, S}, (f32x2){S, S});
    return (f32x2){fast_rcp(d.x), fast_rcp(d.y)};
}
__device__ __forceinline__ int opaque_tid() { int t = threadIdx.x; asm volatile("" : "+v"(t)); return t; }
__device__ __forceinline__ float wave_sum(float v) {
#pragma unroll
    for (int o = 1; o < 64; o <<= 1) v += __shfl_xor(v, o);
    return v;
}

namespace pg8 {
constexpr int BM = 256, BK = 64, HALF = 128, HTB = HALF * BK * 2, STAGE_BYTES = 8 * HTB, NXCD = 8, WGM = 8;
__host__ __device__ __forceinline__ int lds_byte(int r, int c) { const int st = (r >> 4) * 2 + (c >> 5), rr = r & 15, cc = c & 31, ob = rr * 64 + cc * 2; return st * 1024 + (ob ^ (((ob >> 9) & 1) << 5)); }
__host__ __device__ __forceinline__ void stage_rc(int b, int& R, int& C) { const int st = b / 1024, sb = b % 1024, swz = sb ^ (((sb >> 9) & 1) << 5); R = (st >> 1) * 16 + swz / 64; C = (st & 1) * 32 + (swz % 64) / 2; }
__host__ __device__ __forceinline__ int perm32(int rho) { const int n = rho >> 4, i = rho & 15; return 8 * (i >> 2) + 4 * n + (i & 3); }

struct Unit { int pm, pn, e, lbase, nv; };

struct DenseProb {
    static constexpr bool GATHER = false;
    const char* A; const char* Bt; int pitch  ; int nM, nN, nwg, G, c;
    __device__ __forceinline__ void init(const void* A_, const void* Bt_, int M, int N, int K_, int G_, int c_) { A = (const char*)A_; Bt = (const char*)Bt_; pitch = K_ * 2; nM = M / BM; nN = N / BM; nwg = nM * nN; G = G_; c = c_; }
    __device__ __forceinline__ bool next(int i, Unit& u) const {
        const long L = (long)i * G + c; if (L >= nwg) return false;
        int wgid = (int)L; { const int q = nwg / NXCD, r = nwg % NXCD, xcd = wgid % NXCD, off = wgid / NXCD; wgid = (xcd < r ? xcd * (q + 1) : r * (q + 1) + (xcd - r) * q) + off; }
        const int nig = WGM * nN, gid = wgid / nig, fm = gid * WGM, gsz = (nM - fm) < WGM ? (nM - fm) : WGM;
        u.pm = fm + ((wgid % nig) % gsz); u.pn = (wgid % nig) / gsz; u.e = 0; u.lbase = 0; u.nv = 256; return true;
    }
    __device__ __forceinline__ void a_offs(const Unit& u, const int (&R)[2], const int (&C)[2], unsigned (&o)[2][2]) const {
#pragma unroll
        for (int h = 0; h < 2; ++h)
#pragma unroll
            for (int i = 0; i < 2; ++i) o[h][i] = (unsigned)((u.pm * BM + h * HALF + R[i]) * pitch + C[i] * 2);
    }
    __device__ __forceinline__ const char* b_tile(const Unit& u) const { return Bt + (size_t)u.pn * BM * pitch; }
    __device__ __forceinline__ const char* a_tile(const Unit& u) const { return A + (size_t)u.pm * BM * pitch; }
};

struct PanelProb : DenseProb {
    __device__ __forceinline__ bool next(int i, Unit& u) const { if (i >= nN || c >= nM) return false; u.pm = c; u.pn = i; u.e = 0; u.lbase = 0; u.nv = 256; return true; }
};
struct MoeOrder {
    const LAS int* bstart; const LAS int* cnt; int nblk, nwg, G, c;
    __device__ __forceinline__ void init(const LAS int* bs, const LAS int* cn, int G_, int c_) { bstart = bs; cnt = cn; nblk = bs[NEXP]; nwg = nblk * 4; G = G_; c = c_; }
    __device__ __forceinline__ bool next(int i, Unit& u) const {
        const long L = (long)i * G + c; if (L >= nwg) return false;
        int wgid = (int)L; { const int q = nwg / NXCD, r = nwg % NXCD, xcd = wgid % NXCD, off = wgid / NXCD; wgid = (xcd < r ? xcd * (q + 1) : r * (q + 1) + (xcd - r) * q) + off; }
        const int gid = wgid / 32, fm = gid * 8, gsz = (nblk - fm) < 8 ? (nblk - fm) : 8, w = wgid - gid * 32;
        const int blk = fm + (w % gsz); u.pn = w / gsz; u.pm = blk;
        int e = 0;
        while (e < NEXP - 1 && blk >= bstart[e + 1]) ++e;
        const int rb = blk - bstart[e]; u.e = e; u.lbase = e * LISTCAP + rb * 256; const int rem = cnt[e] - rb * 256; u.nv = rem < 256 ? rem : 256; return true;
    }
};
struct MoeUpProb : MoeOrder {
    static constexpr bool GATHER = true;
    const char* A; const char* Bt; int pitch; const int* list;
    __device__ __forceinline__ const char* a_tile(const Unit&) const { return A; }
    __device__ __forceinline__ void a_offs(const Unit& u, const int (&R)[2], const int (&C)[2], unsigned (&o)[2][2]) const {
        unsigned w[2][2];
#pragma unroll
        for (int h = 0; h < 2; ++h)
#pragma unroll
            for (int i = 0; i < 2; ++i) { const int r = h * HALF + R[i]; w[h][i] = (unsigned)list[u.lbase + ((r < u.nv) ? r : 0)]; }
        asm volatile("" : "+v"(w[0][0]), "+v"(w[0][1]), "+v"(w[1][0]), "+v"(w[1][1]));
#pragma unroll
        for (int h = 0; h < 2; ++h)
#pragma unroll
            for (int i = 0; i < 2; ++i) { const int r = h * HALF + R[i]; const int tok = (r < u.nv) ? (int)(w[h][i] >> 16) : 0; o[h][i] = (unsigned)(tok * pitch + C[i] * 2); }
    }
    __device__ __forceinline__ const char* b_tile(const Unit& u) const { return Bt + ((size_t)u.e * 1024 + (size_t)u.pn * BM) * pitch; }
};
struct MoeDownProb : MoeOrder {
    static constexpr bool GATHER = false;
    const char* A; const char* Bt; int pitch;
    __device__ __forceinline__ const char* a_tile(const Unit& u) const { return A + (size_t)u.pm * BM * pitch; }
    __device__ __forceinline__ void a_offs(const Unit& u, const int (&R)[2], const int (&C)[2], unsigned (&o)[2][2]) const {
#pragma unroll
        for (int h = 0; h < 2; ++h)
#pragma unroll
            for (int i = 0; i < 2; ++i) o[h][i] = (unsigned)((u.pm * BM + h * HALF + R[i]) * pitch + C[i] * 2);
    }
    __device__ __forceinline__ const char* b_tile(const Unit& u) const { return Bt + ((size_t)u.e * 1024 + (size_t)u.pn * BM) * pitch; }
};

struct EpiNull { __device__ __forceinline__ void prefetch(const Unit&, int, int, int, int) const {}
    __device__ __forceinline__ void operator()(f32x4 (&acc)[2][2][4][2], const Unit&, int, int, int, int) const {
#pragma unroll
    for (int a = 0; a < 2; ++a)
#pragma unroll
        for (int b = 0; b < 2; ++b)
#pragma unroll
            for (int m = 0; m < 4; ++m) asm volatile("" :: "v"(acc[a][b][m][0]), "v"(acc[a][b][m][1])); } };
struct DenseProbSame : DenseProb {
    __device__ __forceinline__ void a_offs(const Unit&, const int (&R)[2], const int (&C)[2], unsigned (&o)[2][2]) const { Unit z{0, 0, 0, 0, 256}; DenseProb::a_offs(z, R, C, o); }
    __device__ __forceinline__ const char* b_tile(const Unit&) const { return Bt; }
};
struct NoHook { static constexpr int AT = -1; __device__ __forceinline__ void operator()(f32x4 (&)[2][2][4][2], const Unit&, int, int, int, int) const {} };

template <bool FP8, class Prob, class Epi, class Hook, int PM = 0>
__device__ __forceinline__ void gemm_core(LAS unsigned char* lds, const Prob& P, const Epi& E, const Hook& HK) {
    const int tid = opaque_tid(), wid = __builtin_amdgcn_readfirstlane(tid >> 6), lane = tid & 63, wr = wid >> 2, wc = wid & 3, fr = lane & 15, fq = lane >> 4;
    const int pitch = P.pitch, nt = pitch / (BK * 2);
    int R[2], C[2]; unsigned voffB[2], voffA[2];
#pragma unroll
    for (int i = 0; i < 2; ++i) { stage_rc(tid * 16 + i * 8192, R[i], C[i]); const int Rb = (R[i] & ~31) + perm32(R[i] & 31); voffB[i] = (unsigned)(Rb * pitch + C[i] * 2); voffA[i] = (unsigned)(R[i] * pitch + C[i] * 2); }
    const size_t kstep = (size_t)(BK * 2);
    const size_t hstep = (size_t)HALF * pitch;
    const unsigned ldsw = (unsigned)wid * 1024u;
    const int aoff = lds_byte(wr * 64 + fr, fq * 8), boff = lds_byte(wc * 32 + fr, fq * 8);
#define PG8_SA(b, h) (((b) * 2 + (h)) * HTB)
#define PG8_SB(b, h) ((4 + (b) * 2 + (h)) * HTB)
#define PG8_STAGE_B(bufoff, gbase) do { if constexpr (PM != 1) _Pragma("unroll") for (int _i = 0; _i < 2; ++_i) \
        __builtin_amdgcn_global_load_lds((const unsigned*)((const char*)(gbase) + voffB[_i]), (LAS unsigned*)(lds + (bufoff) + ldsw + _i * 8192), 16, 0, 0); } while (0)
#define PG8_STAGE_AG(bufoff, kb, va) do { if constexpr (PM != 1) _Pragma("unroll") for (int _i = 0; _i < 2; ++_i) \
        __builtin_amdgcn_global_load_lds((const unsigned*)(P.A + (kb) + (va)[_i]), (LAS unsigned*)(lds + (bufoff) + ldsw + _i * 8192), 16, 0, 0); } while (0)
#define PG8_STAGE_AD(bufoff, ubase) do { if constexpr (PM != 1) _Pragma("unroll") for (int _i = 0; _i < 2; ++_i) \
        __builtin_amdgcn_global_load_lds((const unsigned*)((const char*)(ubase) + voffA[_i]), (LAS unsigned*)(lds + (bufoff) + ldsw + _i * 8192), 16, 0, 0); } while (0)
#define PG8_STAGE_AC(bufoff, kb, h) do { if constexpr (Prob::GATHER) { PG8_STAGE_AG(bufoff, kb, cvA[h]); } else { PG8_STAGE_AD(bufoff, cA + (h) * hstep + (kb)); } } while (0)
#define PG8_STAGE_AN(bufoff, kb, h) do { if constexpr (Prob::GATHER) { PG8_STAGE_AG(bufoff, kb, v2[h]); } else { PG8_STAGE_AD(bufoff, (last ? nA : cA) + (h) * hstep + (kb)); } } while (0)
#define PG8_LDA(dst, b, h) do { _Pragma("unroll") for (int m = 0; m < 4; ++m) _Pragma("unroll") for (int k = 0; k < 2; ++k) { if constexpr (PM == 3) asm volatile("" : "=v"(dst[m][k])); else dst[m][k] = *(const LAS bf16x8*)(lds + PG8_SA(b, h) + aoff + m * 2048 + k * 1024); } } while (0)
#define PG8_LDB(dst, b, h) do { _Pragma("unroll") for (int n = 0; n < 2; ++n) _Pragma("unroll") for (int k = 0; k < 2; ++k) { if constexpr (PM == 3) asm volatile("" : "=v"(dst[n][k])); else dst[n][k] = *(const LAS bf16x8*)(lds + PG8_SB(b, h) + boff + n * 2048 + k * 1024); } } while (0)
#define PG8_CAT(x) __builtin_bit_cast(i32x8, __builtin_shufflevector((x)[0], (x)[1], 0, 1, 2, 3, 4, 5, 6, 7, 8, 9, 10, 11, 12, 13, 14, 15))
#define PG8_MMA(ai, bj, At, Bt) do { __builtin_amdgcn_s_setprio(1); \
        if constexpr (PM == 2) { _Pragma("unroll") for (int m = 0; m < 4; ++m) asm volatile("" :: "v"(At[m][0]), "v"(At[m][1])); _Pragma("unroll") for (int n = 0; n < 2; ++n) asm volatile("" :: "v"(Bt[n][0]), "v"(Bt[n][1])); } \
        else if constexpr (FP8) { _Pragma("unroll") for (int m = 0; m < 4; ++m) _Pragma("unroll") for (int n = 0; n < 2; ++n) \
            { const i32x8 bq_ = PG8_CAT(Bt[n]), aq_ = PG8_CAT(At[m]); \
              asm volatile("v_mfma_scale_f32_16x16x128_f8f6f4 %0, %1, %2, %0, %3, %3 op_sel_hi:[0,0,0]" : "+v"(acc[ai][bj][m][n]) : "v"(bq_), "v"(aq_), "v"(sc8)); } } \
        else { _Pragma("unroll") for (int m = 0; m < 4; ++m) _Pragma("unroll") for (int n = 0; n < 2; ++n) _Pragma("unroll") for (int k = 0; k < 2; ++k) \
            acc[ai][bj][m][n] = __builtin_amdgcn_mfma_f32_16x16x32_bf16(Bt[n][k], At[m][k], acc[ai][bj][m][n], 0, 0, 0); } \
        __builtin_amdgcn_s_setprio(0); } while (0)
#define PG8_WAIT_V(n) asm volatile("s_waitcnt vmcnt(" #n ")" ::: "memory")
#define PG8_WAIT_L(n) asm volatile("s_waitcnt lgkmcnt(" #n ")" ::: "memory")
#define PG8_BAR __builtin_amdgcn_s_barrier()
#define PG8_SCHED __builtin_amdgcn_sched_barrier(0)
    Unit cur, nxt; int ui = 0;
    if (!P.next(0, cur)) return;
    int sc8 = 0x7f7f7f7f; asm volatile("" : "+v"(sc8));
    f32x4 acc[2][2][4][2];
#pragma unroll
    for (int a = 0; a < 2; ++a)
#pragma unroll
        for (int b = 0; b < 2; ++b)
#pragma unroll
            for (int m = 0; m < 4; ++m)
#pragma unroll
                for (int n = 0; n < 2; ++n) acc[a][b][m][n] = (f32x4){0.f, 0.f, 0.f, 0.f};
    bf16x8 At[4][2], B0[2][2], B1[2][2];
    unsigned cvA[2][2], nvA[2][2];
    if constexpr (Prob::GATHER) P.a_offs(cur, R, C, cvA);
    const char* cA = P.a_tile(cur);
    const char* cB = P.b_tile(cur);
    PG8_STAGE_B(PG8_SB(0, 0), cB); PG8_STAGE_B(PG8_SB(0, 1), cB + hstep); PG8_STAGE_AC(PG8_SA(0, 0), 0, 0); PG8_STAGE_AC(PG8_SA(0, 1), 0, 1);
    if (wr == 1) PG8_BAR;
    PG8_WAIT_V(2); PG8_BAR;
    PG8_STAGE_B(PG8_SB(1, 0), cB + kstep); PG8_STAGE_AC(PG8_SA(1, 0), kstep, 0); PG8_STAGE_B(PG8_SB(1, 1), cB + hstep + kstep);
    PG8_WAIT_V(6); PG8_BAR;
    E.prefetch(cur, wr, wc, fr, fq);
    for (;;) {
        const bool has_next = P.next(ui + 1, nxt);
        if constexpr (Prob::GATHER) {
            if (has_next) P.a_offs(nxt, R, C, nvA);
            else {
#pragma unroll
                for (int h = 0; h < 2; ++h)
#pragma unroll
                    for (int i = 0; i < 2; ++i) nvA[h][i] = cvA[h][i];
            }
        }
        const char* nA = has_next ? P.a_tile(nxt) : cA;
        const char* nB = has_next ? P.b_tile(nxt) : cB;
        for (int t = 0; t < (PM == 4 ? 0 : nt); t += 2) {
            if (Hook::AT >= 0 && t == Hook::AT) HK(acc, cur, wr, wc, fr, fq);
            const bool last = (t == nt - 2);
            const size_t k1 = (size_t)(t + 1) * kstep;
            const size_t k2 = last ? 0 : (size_t)(t + 2) * kstep, k3 = k2 + kstep;
            const char* b2 = last ? nB : cB + (size_t)(t + 2) * kstep; const char* b3 = b2 + kstep;
            unsigned v2[2][2];
            if constexpr (Prob::GATHER) {
#pragma unroll
                for (int h = 0; h < 2; ++h)
#pragma unroll
                    for (int i = 0; i < 2; ++i) v2[h][i] = last ? nvA[h][i] : cvA[h][i];
            }
            PG8_LDB(B0, 0, 0); PG8_LDB(B1, 0, 1); PG8_SCHED; PG8_LDA(At, 0, 0); PG8_STAGE_AC(PG8_SA(1, 1), k1, 1);
            PG8_WAIT_V(8); PG8_WAIT_L(0); PG8_BAR; PG8_MMA(0, 0, At, B0); PG8_MMA(0, 1, At, B1); PG8_BAR; PG8_SCHED;
            PG8_LDA(At, 0, 1); PG8_STAGE_B(PG8_SB(0, 0), b2); PG8_STAGE_B(PG8_SB(0, 1), b2 + hstep); PG8_STAGE_AN(PG8_SA(0, 0), k2, 0);
            PG8_WAIT_V(8); PG8_WAIT_L(0); PG8_BAR; PG8_MMA(1, 0, At, B0); PG8_MMA(1, 1, At, B1); PG8_BAR; PG8_SCHED;
            PG8_LDB(B0, 1, 0); PG8_LDB(B1, 1, 1); PG8_SCHED; PG8_LDA(At, 1, 0); PG8_STAGE_AN(PG8_SA(0, 1), k2, 1);
            PG8_WAIT_V(8); PG8_WAIT_L(0); PG8_BAR; PG8_MMA(0, 0, At, B0); PG8_MMA(0, 1, At, B1); PG8_BAR; PG8_SCHED;
            PG8_LDA(At, 1, 1); PG8_STAGE_B(PG8_SB(1, 0), b3); PG8_STAGE_B(PG8_SB(1, 1), b3 + hstep); PG8_STAGE_AN(PG8_SA(1, 0), k3, 0);
            PG8_WAIT_V(8); PG8_WAIT_L(0); PG8_BAR; PG8_MMA(1, 0, At, B0); PG8_MMA(1, 1, At, B1); PG8_BAR; PG8_SCHED;
        }
        if (wr == 0) PG8_BAR;
        if constexpr (FP8) {
            asm volatile("s_nop 15\n\ts_nop 7" ::: "memory");
#pragma unroll
            for (int a = 0; a < 2; ++a)
#pragma unroll
                for (int b = 0; b < 2; ++b)
#pragma unroll
                    for (int m = 0; m < 4; ++m) asm volatile("" : "+v"(acc[a][b][m][0]), "+v"(acc[a][b][m][1]));
        }
        E(acc, cur, wr, wc, fr, fq);
        if (!has_next) break;
        E.prefetch(nxt, wr, wc, fr, fq);
#pragma unroll
        for (int a = 0; a < 2; ++a)
#pragma unroll
            for (int b = 0; b < 2; ++b)
#pragma unroll
                for (int m = 0; m < 4; ++m)
#pragma unroll
                    for (int n = 0; n < 2; ++n) acc[a][b][m][n] = (f32x4){0.f, 0.f, 0.f, 0.f};
        cur = nxt; cA = nA; cB = nB; ++ui;
        if constexpr (Prob::GATHER) {
#pragma unroll
            for (int h = 0; h < 2; ++h)
#pragma unroll
                for (int i = 0; i < 2; ++i) cvA[h][i] = nvA[h][i];
        }
        if (wr == 1) PG8_BAR;
    }
    PG8_WAIT_V(0);
    PG8_BAR;
#undef PG8_SA
#undef PG8_SB
#undef PG8_STAGE_AG
#undef PG8_STAGE_AD
#undef PG8_STAGE_AC
#undef PG8_STAGE_AN
#undef PG8_STAGE_B
#undef PG8_LDA
#undef PG8_LDB
#undef PG8_MMA
#undef PG8_CAT
#undef PG8_WAIT_V
#undef PG8_WAIT_L
#undef PG8_BAR
#undef PG8_SCHED
}

__device__ __forceinline__ void pair_store16(unsigned char* p, size_t r8, const u32x4& A, const u32x4& B) {
    u32x4 s1, s2;
    s1.x = __builtin_amdgcn_update_dpp(A.x, B.x, 0x128, 0xf, 0xc, false); s1.y = __builtin_amdgcn_update_dpp(A.y, B.y, 0x128, 0xf, 0xc, false);
    s1.z = __builtin_amdgcn_update_dpp(A.z, B.z, 0x128, 0xf, 0xc, false); s1.w = __builtin_amdgcn_update_dpp(A.w, B.w, 0x128, 0xf, 0xc, false);
    s2.x = __builtin_amdgcn_update_dpp(B.x, A.x, 0x128, 0xf, 0x3, false); s2.y = __builtin_amdgcn_update_dpp(B.y, A.y, 0x128, 0xf, 0x3, false);
    s2.z = __builtin_amdgcn_update_dpp(B.z, A.z, 0x128, 0xf, 0x3, false); s2.w = __builtin_amdgcn_update_dpp(B.w, A.w, 0x128, 0xf, 0x3, false);
    *(u32x4*)p = s1; *(u32x4*)(p + r8) = s2;
}
__device__ __forceinline__ u32x4 pack8(const f32x4& v0, const f32x4& v1) { u32x4 w; w.x = cvt_pk_bf16(v0[0], v0[1]); w.y = cvt_pk_bf16(v0[2], v0[3]); w.z = cvt_pk_bf16(v1[0], v1[1]); w.w = cvt_pk_bf16(v1[2], v1[3]); return w; }

struct EpiStoreOnly {
    bf16_t* O;
    __device__ __forceinline__ void prefetch(const Unit&, int, int, int, int) const {}
    __device__ __forceinline__ void operator()(f32x4 (&acc)[2][2][4][2], const Unit& u, int wr, int wc, int fr, int fq) const {
        const int cl0 = wc * 32 + 8 * fq; int row0 = u.pm * BM + wr * 64 + fr; asm volatile("" : "+v"(row0));
#pragma unroll
        for (int ai = 0; ai < 2; ++ai)
#pragma unroll
            for (int m = 0; m < 4; ++m) { bf16_t* rowp = O + (size_t)(row0 + ai * HALF + m * 16) * 256 + cl0;
#pragma unroll
                for (int bj = 0; bj < 2; ++bj) *(u32x4*)(rowp + bj * HALF) = pack8(acc[ai][bj][m][0], acc[ai][bj][m][1]); }
    }
};
#define EPI_ST(val, ptr) do { if constexpr (MODE == 1) { auto v_ = (val); asm volatile("" :: "v"(v_)); } else *(ptr) = (val); } while (0)
template <int MODE> struct EpiInProjT {
    bf16_t *UV, *Q, *Kb, *Vb; unsigned char* G8; const float* cs; unsigned char *Q8, *K8;
    __device__ __forceinline__ void prefetch(const Unit&, int, int, int, int) const {}
    template <class PT> __device__ __forceinline__ void st_pair(PT* p, int pitch, const u32x4& A, const u32x4& B) const {
        if constexpr (MODE == 1) { asm volatile("" :: "v"(A), "v"(B)); } else pair_store16((unsigned char*)p, (size_t)8 * pitch * sizeof(PT), A, B); }
    __device__ __forceinline__ void operator()(f32x4 (&acc)[2][2][4][2], const Unit& u, int wr, int wc, int fr, int fq) const {
        constexpr bool NOMATH = (MODE == 2);
        const int pn = u.pn; int row0 = u.pm * BM + wr * 64 + fr; asm volatile("" : "+v"(row0));
        int prow0 = row0 - (fr & 8), pcl = wc * 64 + 8 * fq + 4 * (fr & 8);
        asm volatile("" : "+v"(prow0), "+v"(pcl));
        if (pn < 4) {
#pragma unroll
            for (int ai = 0; ai < 2; ++ai)
#pragma unroll
                for (int m = 0; m < 4; ++m) { u32x4 w[2];
#pragma unroll
                    for (int bj = 0; bj < 2; ++bj) { f32x4 v0 = acc[ai][bj][m][0], v1 = acc[ai][bj][m][1];
                        if constexpr (!NOMATH) { const f32x2 a = gelu_tanh2(v0.xy), b = gelu_tanh2(v0.zw), c = gelu_tanh2(v1.xy), d = gelu_tanh2(v1.zw); v0 = (f32x4){a.x, a.y, b.x, b.y}; v1 = (f32x4){c.x, c.y, d.x, d.y}; }
                        w[bj] = pack8(v0, v1); }
                    st_pair(UV + (size_t)(prow0 + ai * HALF + m * 16) * 1024 + pn * 256 + pcl, 1024, w[0], w[1]); }
        } else if (pn < 8) {
            bf16_t* dst = (pn < 6) ? Q : Kb; const float sc = (pn < 6) ? C2 : 1.0f;
            const float sgn = (fq == 0) ? -1.0f : 1.0f; const bool rot_lane = fq < 2;
#pragma unroll
            for (int ai = 0; ai < 2; ++ai) {
                f32x4 cs4[4][4];
#pragma unroll
                for (int m = 0; m < 4; ++m) { const f32x4* cp = (const f32x4*)(cs + (size_t)(row0 + ai * HALF + m * 16) * 16);
#pragma unroll
                    for (int j = 0; j < 4; ++j) cs4[m][j] = cp[j]; }
#pragma unroll
                for (int m = 0; m < 4; ++m) { const int row = row0 + ai * HALF + m * 16; f32x4 v[2][2];
#pragma unroll
                    for (int bj = 0; bj < 2; ++bj) { v[bj][0] = acc[ai][bj][m][0]; v[bj][1] = acc[ai][bj][m][1]; }
                    if constexpr (!NOMATH) {
                        f32x4 p0, p1;
#pragma unroll
                        for (int e = 0; e < 4; ++e) { p0[e] = __shfl_xor(v[0][0][e], 16); p1[e] = __shfl_xor(v[0][1][e], 16); }
                        if (rot_lane) {
#pragma unroll
                            for (int e = 0; e < 4; ++e) { v[0][0][e] = v[0][0][e] * cs4[m][0][e] + sgn * p0[e] * cs4[m][2][e]; v[0][1][e] = v[0][1][e] * cs4[m][1][e] + sgn * p1[e] * cs4[m][3][e]; }
                        }
                    }
                    if ((wc & 1) == 0) {
                        st_pair(dst + (size_t)(prow0 + ai * HALF + m * 16) * 512 + (pn & 1) * 256 + pcl, 512, pack8(v[0][0] * sc, v[0][1] * sc), pack8(v[1][0] * sc, v[1][1] * sc));
                    } else {
                        const float s8 = (pn < 6) ? sc * 8.0f : 1.0f;
#pragma unroll
                        for (int bj = 0; bj < 2; ++bj) { const f32x4 v0 = v[bj][0] * s8, v1 = v[bj][1] * s8;
                            u32x2 q8; q8.x = cvt_pk4_fp8(v0[0], v0[1], v0[2], v0[3]); q8.y = cvt_pk4_fp8(v1[0], v1[1], v1[2], v1[3]);
                            EPI_ST(q8, (u32x2*)(((pn < 6) ? Q8 : K8) + (size_t)row * 256 + ((pn & 1) * 2 + (wc >> 1)) * 64 + bj * 32 + 8 * fq)); } } }
            }
        } else if (pn < 10) {
#pragma unroll
            for (int ai = 0; ai < 2; ++ai)
#pragma unroll
                for (int m = 0; m < 4; ++m)
                    st_pair(Vb + (size_t)(prow0 + ai * HALF + m * 16) * 512 + (pn - 8) * 256 + pcl, 512, pack8(acc[ai][0][m][0], acc[ai][0][m][1]), pack8(acc[ai][1][m][0], acc[ai][1][m][1]));
        } else {
            int gl = (fq * 16 + fr) * 16; asm volatile("" : "+v"(gl));
            unsigned char* gb = G8 + (size_t)((u.pm * 8 + (pn - 10)) * 8 + wr * 4 + wc) * 8192 + gl;
#pragma unroll
            for (int ai = 0; ai < 2; ++ai)
#pragma unroll
                for (int m = 0; m < 4; ++m) { u32x4 qq;
#pragma unroll
                    for (int bj = 0; bj < 2; ++bj) { f32x4 v0 = acc[ai][bj][m][0], v1 = acc[ai][bj][m][1];
                        if constexpr (!NOMATH) { const f32x2 a = sig255_2(v0.xy), b = sig255_2(v0.zw), c = sig255_2(v1.xy), d = sig255_2(v1.zw); v0 = (f32x4){a.x, a.y, b.x, b.y}; v1 = (f32x4){c.x, c.y, d.x, d.y}; }
                        const unsigned qa = cvt_pk4_u8(v0[0], v0[1], v0[2], v0[3]), qb = cvt_pk4_u8(v1[0], v1[1], v1[2], v1[3]);
                        if (bj == 0) { qq.x = qa; qq.y = qb; } else { qq.z = qa; qq.w = qb; } }
                    EPI_ST(qq, (u32x4*)(gb + (ai * 4 + m) * 1024)); }
        }
    }
};

#undef EPI_ST
using EpiInProj = EpiInProjT<0>;
__device__ __forceinline__ void unpack8(const u32x4& w, f32x4& a, f32x4& b) { a = (f32x4){bf_lo(w.x), bf_hi(w.x), bf_lo(w.y), bf_hi(w.y)}; b = (f32x4){bf_lo(w.z), bf_hi(w.z), bf_lo(w.w), bf_hi(w.w)}; }
struct HookMerge {
    static constexpr int AT = 8;
    const unsigned char* G8;
    __device__ __forceinline__ void operator()(f32x4 (&acc)[2][2][4][2], const Unit& u, int wr, int wc, int fr, int fq) const {
        const unsigned char* gp = G8 + (size_t)((u.pm * 8 + u.pn) * 8 + wr * 4 + wc) * 8192 + ((fq >> 1) * 16 + fr) * 16 + 8 * (fq & 1); asm volatile("" : "+v"(gp));
        u32x2 w0[2][4][2], w1[2][4][2];
#pragma unroll
        for (int ai = 0; ai < 2; ++ai)
#pragma unroll
            for (int m = 0; m < 4; ++m)
#pragma unroll
                for (int bj = 0; bj < 2; ++bj) { w0[ai][m][bj] = *(const u32x2*)(gp + (ai * 4 + m) * 1024 + bj * 512); w1[ai][m][bj] = *(const u32x2*)(gp + 4 * 65536 + (ai * 4 + m) * 1024 + bj * 512); }
#pragma unroll
        for (int ai = 0; ai < 2; ++ai)
#pragma unroll
            for (int m = 0; m < 4; ++m)
#pragma unroll
                for (int bj = 0; bj < 2; ++bj) { const f32x4 a0 = u8x4_to_f32(w0[ai][m][bj].x), a1 = u8x4_to_f32(w0[ai][m][bj].y), b0 = u8x4_to_f32(w1[ai][m][bj].x), b1 = u8x4_to_f32(w1[ai][m][bj].y);
#pragma unroll
                    for (int e = 0; e < 4; ++e) { acc[ai][bj][m][0][e] *= a0[e] * fast_rcp(fmaxf(b0[e], 0.5f)); acc[ai][bj][m][1][e] *= a1[e] * fast_rcp(fmaxf(b1[e], 0.5f)); } }
    }
};
struct EpiMerge {
    const unsigned char* G8; bf16_t* MG;
    __device__ __forceinline__ void prefetch(const Unit&, int, int, int, int) const {}
    __device__ __forceinline__ void operator()(f32x4 (&acc)[2][2][4][2], const Unit& u, int wr, int wc, int fr, int fq) const {
        const unsigned char* gp = G8 + (size_t)((u.pm * 8 + u.pn + 4) * 8 + wr * 4 + wc) * 8192 + ((fq >> 1) * 16 + fr) * 16 + 8 * (fq & 1); asm volatile("" : "+v"(gp));
        int prow0 = u.pm * BM + wr * 64 + (fr & 7), pcol = u.pn * BM + wc * 64 + 8 * fq + 4 * (fr & 8); asm volatile("" : "+v"(prow0), "+v"(pcol));
        u32x2 w1[2][4][2];
#pragma unroll
        for (int ai = 0; ai < 2; ++ai)
#pragma unroll
            for (int m = 0; m < 4; ++m)
#pragma unroll
                for (int bj = 0; bj < 2; ++bj) w1[ai][m][bj] = *(const u32x2*)(gp + (ai * 4 + m) * 1024 + bj * 512);
        const float s255 = 1.0f / 255.0f;
#pragma unroll
        for (int ai = 0; ai < 2; ++ai)
#pragma unroll
            for (int m = 0; m < 4; ++m) { u32x4 w[2];
#pragma unroll
                for (int bj = 0; bj < 2; ++bj) { f32x4 b0 = u8x4_to_f32(w1[ai][m][bj].x), b1 = u8x4_to_f32(w1[ai][m][bj].y);
#pragma unroll
                    for (int e = 0; e < 4; ++e) { b0[e] = fmaxf(b0[e], 0.5f) * s255; b1[e] = fmaxf(b1[e], 0.5f) * s255; }
                    w[bj] = pack8(acc[ai][bj][m][0] * b0, acc[ai][bj][m][1] * b1); }
                pair_store16((unsigned char*)(MG + (size_t)(prow0 + ai * HALF + m * 16) * 1024 + pcol), (size_t)8 * 1024 * 2, w[0], w[1]); }
    }
};

struct EpiX1 {
    const float* X; bf16_t* XB; unsigned char* XB8; float* ssq;
    __device__ __forceinline__ void prefetch(const Unit&, int, int, int, int) const {}
    __device__ __forceinline__ void operator()(f32x4 (&acc)[2][2][4][2], const Unit& u, int wr, int wc, int fr, int fq) const {
        const int col0 = u.pn * BM + wc * 64 + 8 * fq; int row0 = u.pm * BM + wr * 64 + fr; asm volatile("" : "+v"(row0));
#pragma unroll
        for (int ai = 0; ai < 2; ++ai) {
            f32x4 xv[4][2][2];
#pragma unroll
            for (int m = 0; m < 4; ++m) { const float* xp = X + (size_t)(row0 + ai * HALF + m * 16) * 1024 + col0;
#pragma unroll
                for (int bj = 0; bj < 2; ++bj) { xv[m][bj][0] = *(const f32x4*)(xp + bj * 32); xv[m][bj][1] = *(const f32x4*)(xp + bj * 32 + 4); } }
#pragma unroll
            for (int m = 0; m < 4; ++m) { const size_t row = (size_t)(row0 + ai * HALF + m * 16); u32x4 wb[2];
                float s = 0.f;
#pragma unroll
                for (int bj = 0; bj < 2; ++bj) { const f32x4 v0 = acc[ai][bj][m][0] + xv[m][bj][0], v1 = acc[ai][bj][m][1] + xv[m][bj][1];
                    wb[bj] = pack8(v0, v1);
                    { u32x2 q8; q8.x = cvt_pk4_fp8(v0[0], v0[1], v0[2], v0[3]); q8.y = cvt_pk4_fp8(v1[0], v1[1], v1[2], v1[3]); *(u32x2*)(XB8 + row * 1024 + col0 + bj * 32) = q8; }
                    s += (v0[0] * v0[0] + v0[1] * v0[1]) + (v0[2] * v0[2] + v0[3] * v0[3]) + (v1[0] * v1[0] + v1[1] * v1[1]) + (v1[2] * v1[2] + v1[3] * v1[3]); }
                pair_store16((unsigned char*)(XB + (row - (fr & 8)) * 1024 + col0 + 4 * (fr & 8)), (size_t)8 * 1024 * 2, wb[0], wb[1]);
                s += __shfl_xor(s, 16); s += __shfl_xor(s, 32);
                if (fq == 0) ssq[row * 16 + u.pn * 4 + wc] = s; }
        }
    }
};

struct EpiMoeUp {
    const int* list; const float* rstd; unsigned char* H8;
    mutable float rs[2][4];
    __device__ __forceinline__ void prefetch(const Unit& u, int wr, int wc, int fr, int fq) const {
        int r0 = wr * 64 + fr; asm volatile("" : "+v"(r0));
        int tok[2][4]; unsigned w[2][4];
#pragma unroll
        for (int ai = 0; ai < 2; ++ai)
#pragma unroll
            for (int m = 0; m < 4; ++m) { const int r = r0 + ai * HALF + m * 16; w[ai][m] = (unsigned)list[u.lbase + ((r < u.nv) ? r : 0)]; }
#pragma unroll
        for (int ai = 0; ai < 2; ++ai) asm volatile("" : "+v"(w[ai][0]), "+v"(w[ai][1]), "+v"(w[ai][2]), "+v"(w[ai][3]));
#pragma unroll
        for (int ai = 0; ai < 2; ++ai)
#pragma unroll
            for (int m = 0; m < 4; ++m) { const int r = r0 + ai * HALF + m * 16; tok[ai][m] = (r < u.nv) ? (int)(w[ai][m] >> 16) : 0; }
#pragma unroll
        for (int ai = 0; ai < 2; ++ai)
#pragma unroll
            for (int m = 0; m < 4; ++m) rs[ai][m] = rstd[tok[ai][m]];
    }
    __device__ __forceinline__ void pin() const {
#pragma unroll
        for (int ai = 0; ai < 2; ++ai) asm volatile("" : "+v"(rs[ai][0]), "+v"(rs[ai][1]), "+v"(rs[ai][2]), "+v"(rs[ai][3])); }
    __device__ __forceinline__ void operator()(f32x4 (&acc)[2][2][4][2], const Unit& u, int wr, int wc, int fr, int fq) const {
        const int col0 = u.pn * 128 + wc * 32 + 8 * fq; int r0 = wr * 64 + fr; asm volatile("" : "+v"(r0));
#pragma unroll
        for (int ai = 0; ai < 2; ++ai)
#pragma unroll
            for (int m = 0; m < 4; ++m) { const int r = r0 + ai * HALF + m * 16; const float rsv = rs[ai][m] * 0.015625f;
                f32x4 g0 = acc[ai][0][m][0] * rsv, g1 = acc[ai][0][m][1] * rsv, u0 = acc[ai][1][m][0] * rsv, u1 = acc[ai][1][m][1] * rsv;
#pragma unroll
                for (int e = 0; e < 4; ++e) { g0[e] = g0[e] * sigmoidf_(g0[e]) * (u0[e] * 8.f); g1[e] = g1[e] * sigmoidf_(g1[e]) * (u1[e] * 8.f); }
                u32x2 q8; q8.x = cvt_pk4_fp8(g0[0], g0[1], g0[2], g0[3]); q8.y = cvt_pk4_fp8(g1[0], g1[1], g1[2], g1[3]);
                *(u32x2*)(H8 + (size_t)(u.pm * BM + r) * 512 + col0) = q8; }
    }
};
struct EpiMoeDown {
    const int* list; unsigned char* YB8;
    mutable unsigned lw[2][4];
    __device__ __forceinline__ void prefetch(const Unit& u, int wr, int wc, int fr, int fq) const {
        int r0 = wr * 64 + fr; asm volatile("" : "+v"(r0));
#pragma unroll
        for (int ai = 0; ai < 2; ++ai)
#pragma unroll
            for (int m = 0; m < 4; ++m) { const int r = r0 + ai * HALF + m * 16; lw[ai][m] = (unsigned)list[u.lbase + ((r < u.nv) ? r : 0)]; }
    }
    __device__ __forceinline__ void pin() const {
#pragma unroll
        for (int ai = 0; ai < 2; ++ai) asm volatile("" : "+v"(lw[ai][0]), "+v"(lw[ai][1]), "+v"(lw[ai][2]), "+v"(lw[ai][3])); }
    __device__ __forceinline__ void operator()(f32x4 (&acc)[2][2][4][2], const Unit& u, int wr, int wc, int fr, int fq) const {
        int r0 = wr * 64 + fr; asm volatile("" : "+v"(r0));
        const int col0 = u.pn * BM + wc * 64 + 16 * fq;
#pragma unroll
        for (int ai = 0; ai < 2; ++ai)
#pragma unroll
            for (int m = 0; m < 4; ++m) { const unsigned word = lw[ai][m];
                if (r0 + ai * HALF + m * 16 < u.nv) { const float w = __uint_as_float((word & 0x7fffu) << 16) * 0.0625f;
                    unsigned char* op = YB8 + (size_t)(word >> 15) * 1024 + col0; u32x4 q;
                    { const f32x4 y0 = acc[ai][0][m][0] * w, y1 = acc[ai][0][m][1] * w; q.x = cvt_pk4_fp8(y0[0], y0[1], y0[2], y0[3]); q.y = cvt_pk4_fp8(y1[0], y1[1], y1[2], y1[3]); }
                    { const f32x4 y0 = acc[ai][1][m][0] * w, y1 = acc[ai][1][m][1] * w; q.z = cvt_pk4_fp8(y0[0], y0[1], y0[2], y0[3]); q.w = cvt_pk4_fp8(y1[0], y1[1], y1[2], y1[3]); }
                    *(u32x4*)op = q; } }
    }
};
template <class Epi> struct HookPin { static constexpr int AT = 2; const Epi* E;
    __device__ __forceinline__ void operator()(f32x4 (&)[2][2][4][2], const Unit&, int, int, int, int) const { E->pin(); } };
}


namespace att {
constexpr int QB = 256, KVB = 64, QP = 512  ;
#if PROBE_PHASE == 52
#define ATT_REF_OFF 0.0f
#else
#define ATT_REF_OFF 0.0f
#endif
constexpr int KSLOT = 8192, VSLOT = 8192, NSLOT = 3;
constexpr int L_K = 0, L_V = NSLOT * KSLOT, L_WS = L_V + NSLOT * VSLOT, L_OST = L_WS + NWAVES * 256, L_END = L_OST + NWAVES * 8192;
static_assert(L_END <= RING_BYTES, "attention LDS");
#if PROBE_PHASE == 40
#define ATT_RESC_THR 0.f
#define ATT_RESC_MIN 0.001f
#define ATT_RESC_LO -2.f
#else
#define ATT_RESC_THR 512.f
#define ATT_RESC_MIN 64.f
#define ATT_RESC_LO 0.f
#endif
__device__ __forceinline__ int crow(int r, int hi) { return (r & 3) + 8 * (r >> 2) + 4 * hi; }
__device__ __forceinline__ void glds16(const void* gsrc, unsigned lds_dst) { unsigned keep;
    asm volatile("s_mov_b32 %0, m0\n\ts_mov_b32 m0, %2\n\ts_nop 0\n\tglobal_load_lds_dwordx4 %1, off\n\ts_mov_b32 m0, %0" : "=&s"(keep) : "v"(gsrc), "s"(lds_dst) : "memory"); }
#define ATT_WAIT_BAR(N) asm volatile("s_waitcnt vmcnt(" #N ") lgkmcnt(0)\n\ts_barrier" ::: "memory")
#define MX3(a, b, c) __builtin_fmaxf(__builtin_fmaxf((a), (b)), (c))
#define ATT_SBAR() __builtin_amdgcn_sched_barrier(0)
#define ATT_MFMA(a, b, c) __builtin_amdgcn_mfma_f32_32x32x16_bf16(a, b, c, 0, 0, 0)
__device__ __forceinline__ float rowmax(const f32x16& p0, const f32x16& p1) {
    float a = MX3(p0[0], p0[1], p1[0]), b = MX3(p0[2], p0[3], p1[1]); a = MX3(a, p1[2], p1[3]);
#pragma unroll
    for (int r = 4; r < 16; r += 4) { a = MX3(a, p0[r], p0[r + 1]); b = MX3(b, p0[r + 2], p0[r + 3]); a = MX3(a, p1[r], p1[r + 1]); b = MX3(b, p1[r + 2], p1[r + 3]); }
    const float m = __builtin_fmaxf(a, b); auto rr = __builtin_amdgcn_permlane32_swap(__float_as_uint(m), __float_as_uint(m), false, false);
    return __builtin_fmaxf(__uint_as_float(rr[0]), __uint_as_float(rr[1])); }
__device__ __forceinline__ void cmask(f32x16& p0, f32x16& p1, int jb, int qrel, int hi) {
    const int kb = 64 * jb + 4 * hi;
#pragma unroll
    for (int r = 0; r < 16; ++r) { const int kv = kb + (r & 3) + 8 * (r >> 2); if (kv > qrel) p0[r] = -INFINITY; if (kv + 32 > qrel) p1[r] = -INFINITY; } }
typedef int i32x4 __attribute__((ext_vector_type(4)));
__device__ __forceinline__ void kload2(bf16x8* kf, const LAS char* kp, int j) { kf[2 * j] = *(const LAS bf16x8*)(kp + j * 2048); kf[2 * j + 1] = *(const LAS bf16x8*)(kp + j * 2048 + 512); }
__device__ __forceinline__ i32x8 frag32(const LAS char* row, int c0) {
    const i32x4 lo = *(const LAS i32x4*)(row + c0 * 16), hi = *(const LAS i32x4*)(row + (c0 ^ 1) * 16);
    return __builtin_shufflevector(lo, hi, 0, 1, 2, 3, 4, 5, 6, 7); }
#define MFMA8_PV(O, A, B) asm volatile("v_mfma_scale_f32_32x32x64_f8f6f4 %0, %1, %2, %0, %3, %3 op_sel_hi:[0,0,0]" : "+v"(O) : "v"(A), "v"(B), "v"(sc_1))
template <int MODE> __device__ __forceinline__ void attn_pass(f32x16 (&o)[4], int b, int hm, int h, int qb, const bf16_t* Q, const bf16_t* __restrict__ K, const unsigned char* __restrict__ V8T, LAS char* shm) {
    const int tid = opaque_tid(), lane = tid & 63, r32 = lane & 31, hi = lane >> 5; const int wid = __builtin_amdgcn_readfirstlane(tid >> 6);
    const long rowbase = (long)b * SEQ; const int q0 = qb * QB, NT = (q0 + QB) / KVB;
    const bf16_t* Qw = Q + (rowbase + q0 + wid * 32) * QP + hm * 64;
    const bf16_t* Kh = K + rowbase * QP + hm * 64;
    const unsigned lds0 = (unsigned)(uintptr_t)shm;
    LAS float* wsf = (LAS float*)(shm + L_WS) + wid * 64;
    const bf16_t* ksrc = Kh + (long)lane * QP + wid * 8;
    const unsigned char* vsrc = V8T + ((size_t)(b * 4 + h) * (SEQ / KVB)) * VSLOT + wid * 1024 + lane * 16;
    const unsigned kdst = lds0 + L_K + wid * 1024, vdst = lds0 + L_V + wid * 1024;
#define DMA_K(t, s) glds16(ksrc + (long)(t) * KVB * QP, (unsigned)__builtin_amdgcn_readfirstlane(kdst + (unsigned)(s) * KSLOT))
#define DMA_V(t, s) glds16(vsrc + (long)(t) * VSLOT, (unsigned)__builtin_amdgcn_readfirstlane(vdst + (unsigned)(s) * VSLOT))
    const LAS char* kp0 = shm + L_K + hi * 1024 + r32 * 16;
    const LAS char* vp0 = shm + L_V + r32 * 64;  const int vc0 = (2 * hi) ^ ((r32 >> 2) & 3);
    DMA_K(0, 0); DMA_V(0, 0); DMA_K(1, 1);
    bf16x8 qr[4];
#pragma unroll
    for (int d0 = 0; d0 < 4; ++d0) qr[d0] = *(const bf16x8*)(Qw + (long)r32 * QP + d0 * 16 + hi * 8);
    float mhat = 0.f, l_reg = 0.f;
    float zf = 0.f; asm volatile("" : "+v"(zf));
    int sc_1 = 0x7f7f7f7f; asm volatile("" : "+v"(sc_1));
    f32x16 negm;
#pragma unroll
    for (int r = 0; r < 16; ++r) { negm[r] = zf;
#pragma unroll
        for (int d0 = 0; d0 < 4; ++d0) o[d0][r] = zf; }
    asm volatile("" : "+v"(negm));
    const int qrel = wid * 32 + r32;
    asm volatile("" : "+v"(qr[0]), "+v"(qr[1]), "+v"(qr[2]), "+v"(qr[3]));
    LAS bf16x8* qlds = (LAS bf16x8*)(shm + L_OST + wid * 8192) + lane;
#pragma unroll
    for (int d0 = 0; d0 < 4; ++d0) qlds[d0 * 64] = qr[d0];
    DMA_K(2, 2);
    ATT_WAIT_BAR(1);
    bool resc = false;
#define CMASK(P0, P1, t) do { const int jb_ = (t) - (NT - 4); if (jb_ >= 0) cmask(P0, P1, jb_, qrel, hi); } while (0)
#define RESC() do { if (resc) { asm volatile("s_waitcnt lgkmcnt(0)\n\ts_nop 15\n\ts_nop 15\n\ts_nop 7" ::: "memory"); \
        _Pragma("unroll") for (int r = 0; r < 16; ++r) { const float fr_ = wsf[crow(r, hi)]; _Pragma("unroll") for (int d_ = 0; d_ < 4; ++d_) asm volatile("v_mul_f32 %0, %0, %1" : "+v"(o[d_][r]) : "v"(fr_)); } } } while (0)
    f32x16 pA0, pA1, pB0, pB1;
    int sl_prev = 0, sl_cur = 0, sl_next = 1;
#define ROT() do { sl_prev = sl_cur; sl_cur = sl_next; sl_next = (sl_next == NSLOT - 1) ? 0 : sl_next + 1; } while (0)
    bf16x8 kf[8];
#pragma unroll
    for (int j = 0; j < 4; ++j) kload2(kf, kp0, j);
    pA0 = ATT_MFMA(kf[0], qr[0], negm); pA1 = ATT_MFMA(kf[1], qr[0], negm);
#pragma unroll
    for (int d0 = 1; d0 < 4; ++d0) { pA0 = ATT_MFMA(kf[2 * d0], qr[d0], pA0); pA1 = ATT_MFMA(kf[2 * d0 + 1], qr[d0], pA1); }
    CMASK(pA0, pA1, 0);
    { const float rm = rowmax(pA0, pA1) - ATT_REF_OFF; mhat = rm;
#pragma unroll
      for (int r = 0; r < 16; ++r) { pA0[r] -= rm; pA1[r] -= rm; negm[r] = -rm; }
      asm volatile("" : "+v"(negm));
#pragma unroll
      for (int r = 0; r < 16; ++r) { pA0[r] = fast_exp2(pA0[r]); pA1[r] = fast_exp2(pA1[r]); } }
    ATT_WAIT_BAR(0);
    DMA_K(3, 0); DMA_V(1, 1);
    ROT();
#pragma unroll
    for (int j = 0; j < 4; ++j) kload2(kf, kp0 + sl_cur * KSLOT, j);
    ATT_WAIT_BAR(2);
    i32x8 vf[4], pf;
#define PK4(P, B) cvt_pk4_fp8(P[B], P[(B) + 1], P[(B) + 2], P[(B) + 3])
#define PIN(x) asm volatile("" : "+v"(x))
#define GAPA(MF, P, B, W) do { MF; sacc += P[B]; sacc += P[(B) + 1]; sacc += P[(B) + 2]; sacc += P[(B) + 3]; PIN(sacc); pf[W] = PK4(P, B); PIN(pf); ATT_SBAR(); } while (0)
#define EXP8(X, B) do { X[B] = fast_exp2(X[B]); X[(B) + 1] = fast_exp2(X[(B) + 1]); X[(B) + 2] = fast_exp2(X[(B) + 2]); X[(B) + 3] = fast_exp2(X[(B) + 3]); \
        X[(B) + 4] = fast_exp2(X[(B) + 4]); X[(B) + 5] = fast_exp2(X[(B) + 5]); X[(B) + 6] = fast_exp2(X[(B) + 6]); X[(B) + 7] = fast_exp2(X[(B) + 7]); PIN(X); } while (0)
#define STEP(C0, C1, P0, P1, t, GK, GV, GL) do { ATT_SBAR(); \
    const LAS char* vp_ = vp0 + sl_prev * VSLOT; \
    float sacc = 0.f; \
    bf16x8 qa_ = qlds[0], qb_ = qlds[64]; ATT_SBAR(); \
    GAPA(C0 = ATT_MFMA(kf[0], qa_, negm), P0, 0, 0); \
    GAPA(C1 = ATT_MFMA(kf[1], qa_, negm), P0, 4, 1); \
    qa_ = qlds[128]; ATT_SBAR(); \
    GAPA(C0 = ATT_MFMA(kf[2], qb_, C0), P0, 8, 2); \
    GAPA(C1 = ATT_MFMA(kf[3], qb_, C1), P0, 12, 3); \
    qb_ = qlds[192]; ATT_SBAR(); \
    vf[0] = frag32(vp_, vc0); ATT_SBAR(); GAPA(C0 = ATT_MFMA(kf[4], qa_, C0), P1, 0, 4); \
    vf[1] = frag32(vp_ + 32 * 64, vc0); ATT_SBAR(); GAPA(C1 = ATT_MFMA(kf[5], qa_, C1), P1, 4, 5); \
    vf[2] = frag32(vp_ + 64 * 64, vc0); ATT_SBAR(); GAPA(C0 = ATT_MFMA(kf[6], qb_, C0), P1, 8, 6); \
    vf[3] = frag32(vp_ + 96 * 64, vc0); ATT_SBAR(); GAPA(C1 = ATT_MFMA(kf[7], qb_, C1), P1, 12, 7); \
    l_reg += sacc; \
    if (GK) { DMA_K((t) + 3, sl_cur); } if (GV) { DMA_V((t) + 1, sl_next); } \
    CMASK(C0, C1, t); \
    {   \
      float st_; { auto rr = __builtin_amdgcn_permlane32_swap(__float_as_uint(sacc), __float_as_uint(sacc), false, false); st_ = __uint_as_float(rr[0]) + __uint_as_float(rr[1]); } \
      resc = false; \
      if (__builtin_expect(__any(st_ > ATT_RESC_THR), 0)) { const float dl = (st_ > ATT_RESC_MIN) ? __builtin_fmaxf(__builtin_floorf(__builtin_amdgcn_logf(st_)) - 6.f, ATT_RESC_LO) : 0.f; mhat += dl; \
        _Pragma("unroll") for (int r = 0; r < 16; ++r) { asm volatile("v_sub_f32 %0, %0, %1" : "+v"(C0[r]) : "v"(dl)); asm volatile("v_sub_f32 %0, %0, %1" : "+v"(C1[r]) : "v"(dl)); } \
        _Pragma("unroll") for (int r = 0; r < 16; ++r) negm[r] = -mhat; asm volatile("" : "+v"(negm)); \
        const float f = fast_exp2(-dl); l_reg *= f; if (hi == 0) wsf[r32] = f; resc = true; } } \
    ATT_SBAR(); \
    MFMA8_PV(o[0], pf, vf[0]); EXP8(C0, 0); if (GL) { kload2(kf, kp0 + sl_next * KSLOT, 0); } ATT_SBAR(); \
    MFMA8_PV(o[1], pf, vf[1]); EXP8(C0, 8); if (GL) { kload2(kf, kp0 + sl_next * KSLOT, 1); } ATT_SBAR(); \
    MFMA8_PV(o[2], pf, vf[2]); EXP8(C1, 0); if (GL) { kload2(kf, kp0 + sl_next * KSLOT, 2); } ATT_SBAR(); \
    MFMA8_PV(o[3], pf, vf[3]); EXP8(C1, 8); if (GL) { kload2(kf, kp0 + sl_next * KSLOT, 3); } ATT_SBAR(); \
    } while (0)
    int t = 1;
#undef CMASK
#define CMASK(P0, P1, t) do {} while (0)
    for (; t + 5 < NT; t += 2) {
        STEP(pB0, pB1, pA0, pA1, t, true, true, true);       if (MODE == 3) { asm volatile("s_waitcnt lgkmcnt(0)" ::: "memory"); } else { ATT_WAIT_BAR(2); } RESC(); ROT();
        STEP(pA0, pA1, pB0, pB1, t + 1, true, true, true);   if (MODE == 3) { asm volatile("s_waitcnt lgkmcnt(0)" ::: "memory"); } else { ATT_WAIT_BAR(2); } RESC(); ROT();
    }
#undef CMASK
#define CMASK(P0, P1, t) do { const int jb_ = (t) - (NT - 4); if (jb_ >= 0) cmask(P0, P1, jb_, qrel, hi); } while (0)
#define ENDW(tt) do { if ((tt) + 3 < NT) { ATT_WAIT_BAR(2); } else if ((tt) + 2 < NT) { ATT_WAIT_BAR(1); } else { ATT_WAIT_BAR(0); } } while (0)
    for (; t + 1 < NT; t += 2) {
        STEP(pB0, pB1, pA0, pA1, t, (t + 3 < NT), (t + 1 < NT), (t + 1 < NT));       ENDW(t);     RESC(); ROT();
        STEP(pA0, pA1, pB0, pB1, t + 1, (t + 4 < NT), (t + 2 < NT), (t + 2 < NT));   ENDW(t + 1); RESC(); ROT();
    }
    STEP(pB0, pB1, pA0, pA1, NT - 1, false, false, false); RESC();
    { float sacc = 0.f;
#pragma unroll
      for (int r = 0; r < 16; ++r) sacc += pB0[r] + pB1[r];
      l_reg += sacc;
      pf[0] = PK4(pB0, 0); pf[1] = PK4(pB0, 4); pf[2] = PK4(pB0, 8); pf[3] = PK4(pB0, 12); pf[4] = PK4(pB1, 0); pf[5] = PK4(pB1, 4); pf[6] = PK4(pB1, 8); pf[7] = PK4(pB1, 12);
      const LAS char* vp_ = vp0 + sl_cur * VSLOT;
      vf[0] = frag32(vp_, vc0); vf[1] = frag32(vp_ + 32 * 64, vc0); vf[2] = frag32(vp_ + 64 * 64, vc0); vf[3] = frag32(vp_ + 96 * 64, vc0);
      asm volatile("s_nop 3" : "+v"(pf));
      MFMA8_PV(o[0], pf, vf[0]); MFMA8_PV(o[1], pf, vf[1]); MFMA8_PV(o[2], pf, vf[2]); MFMA8_PV(o[3], pf, vf[3]);
      asm volatile("s_nop 15\n\ts_nop 15\n\ts_nop 7" : "+v"(o[0]), "+v"(o[1]), "+v"(o[2]), "+v"(o[3])); }
#undef PK4
#undef PIN
#undef GAPA
#undef EXP8
#undef STEP
#undef ENDW
#undef CMASK
#undef RESC
#undef ROT
    { auto rr = __builtin_amdgcn_permlane32_swap(__float_as_uint(l_reg), __float_as_uint(l_reg), false, false); l_reg = __uint_as_float(rr[0]) + __uint_as_float(rr[1]); }
    if (hi == 0) wsf[32 + r32] = l_reg;
    asm volatile("s_waitcnt lgkmcnt(0)" ::: "memory");
#pragma unroll
    for (int r = 0; r < 16; ++r) { const float rl = fast_rcp(wsf[32 + crow(r, hi)]);
#pragma unroll
        for (int d0 = 0; d0 < 4; ++d0) o[d0][r] *= rl; }
    asm volatile("s_waitcnt lgkmcnt(0)" ::: "memory");
#undef DMA_K
#undef DMA_V
}

constexpr int KSLOT8 = 4096, QP8 = 256  ;
constexpr int L_V8 = NSLOT * KSLOT8, L_WS8 = L_V8 + NSLOT * VSLOT;
static_assert(L_WS8 + NWAVES * 256 <= L_OST, "fp8 pass LDS");
#define MFMA8_QK(C, A, B) asm volatile("v_mfma_scale_f32_32x32x64_f8f6f4 %0, %1, %2, %3, %4, %5 op_sel_hi:[0,0,0]" : "=&v"(C) : "v"(A), "v"(B), "v"(negm), "v"(sc_k), "v"(sc_q))
#define MFMA8_PV8(O, A, B) asm volatile("v_mfma_scale_f32_32x32x64_f8f6f4 %0, %1, %2, %0, %3, %3 op_sel_hi:[0,0,0]" : "+v"(O) : "v"(A), "v"(B), "v"(sc_k))
template <int MODE> __device__ __forceinline__ void attn_pass8(f32x16 (&o)[4], int b, int hm, int h, int qb, const unsigned char* Q8, const unsigned char* __restrict__ K8, const unsigned char* __restrict__ V8T, LAS char* shm) {
    const int tid = opaque_tid(), lane = tid & 63, r32 = lane & 31, hi = lane >> 5; const int wid = __builtin_amdgcn_readfirstlane(tid >> 6);
    const long rowbase = (long)b * SEQ; const int q0 = qb * QB, NT = (q0 + QB) / KVB;
    const unsigned lds0 = (unsigned)(uintptr_t)shm;
    LAS float* wsf = (LAS float*)(shm + L_WS8) + wid * 64;
    const int kkey = (wid & 3) * 16 + (lane >> 2);
    const unsigned char* ksrc = K8 + (rowbase + kkey) * QP8 + h * 64 + (((lane & 3) ^ ((kkey >> 2) & 3)) * 16);
    const unsigned char* vsrc = V8T + ((size_t)(b * 4 + h) * (SEQ / KVB)) * VSLOT + wid * 1024 + lane * 16;
    const unsigned kdst = lds0 + L_K + (wid & 3) * 1024, vdst = lds0 + L_V8 + wid * 1024;
#define DMA_K(t, s) glds16(ksrc + (long)(t) * KVB * QP8, (unsigned)__builtin_amdgcn_readfirstlane(kdst + (unsigned)(s) * KSLOT8))
#define DMA_V(t, s) glds16(vsrc + (long)(t) * VSLOT, (unsigned)__builtin_amdgcn_readfirstlane(vdst + (unsigned)(s) * VSLOT))
    const int sw = (r32 >> 2) & 3;
    const LAS char* kp0 = shm + L_K + r32 * 64;  const int kc0 = (2 * hi) ^ sw;
    const LAS char* vp0 = shm + L_V8 + r32 * 64;  const int vc0 = (2 * hi) ^ sw;
    DMA_K(0, 0); DMA_V(0, 0); DMA_K(1, 1);
    i32x8 qf;
    { const unsigned char* qp = Q8 + (rowbase + q0 + wid * 32 + r32) * QP8 + h * 64 + hi * 32; const i32x4 lo = *(const i32x4*)qp, hi4 = *(const i32x4*)(qp + 16); qf = __builtin_shufflevector(lo, hi4, 0, 1, 2, 3, 4, 5, 6, 7); }
    float mhat = 0.f;
    f32x16 ol;
    float zf = 0.f; asm volatile("" : "+v"(zf));
    int sc_k = 0x7f7f7f7f, sc_q = 0x7c7c7c7c; asm volatile("" : "+v"(sc_k), "+v"(sc_q));
    f32x16 negm;
#pragma unroll
    for (int r = 0; r < 16; ++r) { negm[r] = zf;
#pragma unroll
        for (int d0 = 0; d0 < 4; ++d0) o[d0][r] = zf;
        ol[r] = zf; }
    i32x8 ones8; { int o1 = 0x38383838; asm volatile("" : "+v"(o1)); ones8 = (i32x8){o1, o1, o1, o1, o1, o1, o1, o1}; }
    asm volatile("" : "+v"(negm));
    const int qrel = wid * 32 + r32;
    asm volatile("" : "+v"(qf));
    DMA_K(2, 2);
    ATT_WAIT_BAR(1);
    bool resc = false;
#define CMASK(P0, P1, t) do { const int jb_ = (t) - (NT - 4); if (jb_ >= 0) cmask(P0, P1, jb_, qrel, hi); } while (0)
#define RESC() do { if (resc) { asm volatile("s_waitcnt lgkmcnt(0)\n\ts_nop 15\n\ts_nop 7" ::: "memory"); \
        _Pragma("unroll") for (int r = 0; r < 16; ++r) { const float fr_ = wsf[crow(r, hi)]; _Pragma("unroll") for (int d_ = 0; d_ < 4; ++d_) asm volatile("v_mul_f32 %0, %0, %1" : "+v"(o[d_][r]) : "v"(fr_)); asm volatile("v_mul_f32 %0, %0, %1" : "+v"(ol[r]) : "v"(fr_)); } } } while (0)
    f32x16 pA0, pA1, pB0, pB1;
    int sl_prev = 0, sl_cur = 0, sl_next = 1;
#define ROT() do { sl_prev = sl_cur; sl_cur = sl_next; sl_next = (sl_next == NSLOT - 1) ? 0 : sl_next + 1; } while (0)
    i32x8 kf0, kf1;
    kf0 = frag32(kp0, kc0); kf1 = frag32(kp0 + 32 * 64, kc0);
    MFMA8_QK(pA0, kf0, qf); MFMA8_QK(pA1, kf1, qf);
    asm volatile("s_nop 15\n\ts_nop 15\n\ts_nop 7" : "+v"(pA0), "+v"(pA1));
    CMASK(pA0, pA1, 0);
    { const float rm = rowmax(pA0, pA1) - ATT_REF_OFF; mhat = rm;
#pragma unroll
      for (int r = 0; r < 16; ++r) { pA0[r] -= rm; pA1[r] -= rm; negm[r] = -rm; }
      asm volatile("" : "+v"(negm));
#pragma unroll
      for (int r = 0; r < 16; ++r) { pA0[r] = fast_exp2(pA0[r]); pA1[r] = fast_exp2(pA1[r]); } }
    ATT_WAIT_BAR(0);
    DMA_K(3, 0); DMA_V(1, 1);
    ROT();
    kf0 = frag32(kp0 + sl_cur * KSLOT8, kc0); kf1 = frag32(kp0 + sl_cur * KSLOT8 + 32 * 64, kc0);
    ATT_WAIT_BAR(2);
    i32x8 vf[4], pf;
#define PK4(P, B) cvt_pk4_fp8(P[B], P[(B) + 1], P[(B) + 2], P[(B) + 3])
#define PIN(x) asm volatile("" : "+v"(x))
#define SUM8(P, B) do { sacc += P[B]; sacc += P[(B) + 1]; sacc += P[(B) + 2]; sacc += P[(B) + 3]; sacc += P[(B) + 4]; sacc += P[(B) + 5]; sacc += P[(B) + 6]; sacc += P[(B) + 7]; PIN(sacc); } while (0)
#define EXP8(X, B) do { X[B] = fast_exp2(X[B]); X[(B) + 1] = fast_exp2(X[(B) + 1]); X[(B) + 2] = fast_exp2(X[(B) + 2]); X[(B) + 3] = fast_exp2(X[(B) + 3]); \
        X[(B) + 4] = fast_exp2(X[(B) + 4]); X[(B) + 5] = fast_exp2(X[(B) + 5]); X[(B) + 6] = fast_exp2(X[(B) + 6]); X[(B) + 7] = fast_exp2(X[(B) + 7]); PIN(X); } while (0)
#define STEP(C0, C1, P0, P1, t, GK, GV, GL) do { ATT_SBAR(); \
    const LAS char* vp_ = vp0 + sl_prev * VSLOT; \
    const bool det_ = (((t) & 3) == 1);            \
    float sacc = 0.f; \
    MFMA8_QK(C0, kf0, qf); \
    if (det_) { SUM8(P0, 0); SUM8(P0, 8); } \
    pf[0] = PK4(P0, 0); pf[1] = PK4(P0, 4); pf[2] = PK4(P0, 8); pf[3] = PK4(P0, 12); PIN(pf); \
    vf[0] = frag32(vp_, vc0); vf[1] = frag32(vp_ + 32 * 64, vc0); ATT_SBAR(); \
    MFMA8_QK(C1, kf1, qf); \
    if (det_) { SUM8(P1, 0); SUM8(P1, 8); } \
    pf[4] = PK4(P1, 0); pf[5] = PK4(P1, 4); pf[6] = PK4(P1, 8); pf[7] = PK4(P1, 12); PIN(pf); \
    vf[2] = frag32(vp_ + 64 * 64, vc0); vf[3] = frag32(vp_ + 96 * 64, vc0); ATT_SBAR(); \
    if (GK) { DMA_K((t) + 3, sl_cur); } if (GV) { DMA_V((t) + 1, sl_next); } \
    {   \
      float st_; { auto rr = __builtin_amdgcn_permlane32_swap(__float_as_uint(sacc), __float_as_uint(sacc), false, false); st_ = __uint_as_float(rr[0]) + __uint_as_float(rr[1]); } \
      resc = false; \
      if (__builtin_expect(det_ && __any(st_ > ATT_RESC_THR), 0)) { const float dl = (st_ > ATT_RESC_MIN) ? __builtin_fmaxf(__builtin_floorf(__builtin_amdgcn_logf(st_)) - 6.f, ATT_RESC_LO) : 0.f; mhat += dl; \
        asm volatile("s_nop 15\n\ts_nop 15" ::: "memory"); \
        _Pragma("unroll") for (int r = 0; r < 16; ++r) { asm volatile("v_sub_f32 %0, %0, %1" : "+v"(C0[r]) : "v"(dl)); asm volatile("v_sub_f32 %0, %0, %1" : "+v"(C1[r]) : "v"(dl)); } \
        _Pragma("unroll") for (int r = 0; r < 16; ++r) negm[r] = -mhat; asm volatile("" : "+v"(negm)); \
        const float f = fast_exp2(-dl); if (hi == 0) wsf[r32] = f; resc = true; } } \
    asm volatile("s_nop 7" : "+v"(C0), "+v"(C1)); CMASK(C0, C1, t); \
    ATT_SBAR(); \
    MFMA8_PV8(o[0], pf, vf[0]); EXP8(C0, 0); if (GL) kf0 = frag32(kp0 + sl_next * KSLOT8, kc0); ATT_SBAR(); \
    MFMA8_PV8(o[1], pf, vf[1]); EXP8(C0, 8); ATT_SBAR(); \
    MFMA8_PV8(o[2], pf, vf[2]); EXP8(C1, 0); if (GL) kf1 = frag32(kp0 + sl_next * KSLOT8 + 32 * 64, kc0); ATT_SBAR(); \
    MFMA8_PV8(o[3], pf, vf[3]); EXP8(C1, 8); ATT_SBAR(); \
    MFMA8_PV8(ol, pf, ones8); ATT_SBAR(); \
    } while (0)
    int t = 1;
#undef CMASK
#define CMASK(P0, P1, t) do {} while (0)
    for (; t + 5 < NT; t += 2) {
        STEP(pB0, pB1, pA0, pA1, t, true, true, true);       ATT_WAIT_BAR(2); RESC(); ROT();
        STEP(pA0, pA1, pB0, pB1, t + 1, true, true, true);   ATT_WAIT_BAR(2); RESC(); ROT();
    }
#undef CMASK
#define CMASK(P0, P1, t) do { const int jb_ = (t) - (NT - 4); if (jb_ >= 0) cmask(P0, P1, jb_, qrel, hi); } while (0)
#define ENDW(tt) do { if ((tt) + 3 < NT) { ATT_WAIT_BAR(2); } else if ((tt) + 2 < NT) { ATT_WAIT_BAR(1); } else { ATT_WAIT_BAR(0); } } while (0)
    for (; t + 1 < NT; t += 2) {
        STEP(pB0, pB1, pA0, pA1, t, (t + 3 < NT), (t + 1 < NT), (t + 1 < NT));       ENDW(t);     RESC(); ROT();
        STEP(pA0, pA1, pB0, pB1, t + 1, (t + 4 < NT), (t + 2 < NT), (t + 2 < NT));   ENDW(t + 1); RESC(); ROT();
    }
    STEP(pB0, pB1, pA0, pA1, NT - 1, false, false, false); RESC();
    {
      pf[0] = PK4(pB0, 0); pf[1] = PK4(pB0, 4); pf[2] = PK4(pB0, 8); pf[3] = PK4(pB0, 12); pf[4] = PK4(pB1, 0); pf[5] = PK4(pB1, 4); pf[6] = PK4(pB1, 8); pf[7] = PK4(pB1, 12);
      const LAS char* vp_ = vp0 + sl_cur * VSLOT;
      vf[0] = frag32(vp_, vc0); vf[1] = frag32(vp_ + 32 * 64, vc0); vf[2] = frag32(vp_ + 64 * 64, vc0); vf[3] = frag32(vp_ + 96 * 64, vc0);
      asm volatile("s_nop 3" : "+v"(pf));
      MFMA8_PV8(o[0], pf, vf[0]); MFMA8_PV8(o[1], pf, vf[1]); MFMA8_PV8(o[2], pf, vf[2]); MFMA8_PV8(o[3], pf, vf[3]); MFMA8_PV8(ol, pf, ones8);
      asm volatile("s_nop 15\n\ts_nop 15\n\ts_nop 7" : "+v"(o[0]), "+v"(o[1]), "+v"(o[2]), "+v"(o[3]), "+v"(ol)); }
#undef PK4
#undef PIN
#undef SUM8
#undef EXP8
#undef STEP
#undef ENDW
#undef CMASK
#undef RESC
#undef ROT
#pragma unroll
    for (int r = 0; r < 16; ++r) { const float rl = fast_rcp(ol[r]);
#pragma unroll
        for (int d0 = 0; d0 < 4; ++d0) o[d0][r] *= rl; }
#undef DMA_K
#undef DMA_V
}

template <int MODE> __device__ __forceinline__ void attn_unit(int b, int h, int qb, const bf16_t* Q, const bf16_t* K, const unsigned char* Q8, const unsigned char* K8, const unsigned char* V, bf16_t* YAB, float* park, float lam, const float* subg, LAS char* shm) {
    const int tid = opaque_tid(), lane = tid & 63, r32 = lane & 31, hi = lane >> 5; const int wid = __builtin_amdgcn_readfirstlane(tid >> 6);
    for (int m = 0; m < 2; ++m) {
        f32x16 o[4];
        if (m == 0) attn_pass<MODE>(o, b, 2 * h, h, qb, Q, K, V, shm);
        else attn_pass8<MODE>(o, b, 2 * h + 1, h, qb, Q8, K8, V, shm);
        int lo_ = lane; asm volatile("" : "+v"(lo_));
        f32x4* pk = (f32x4*)park + (size_t)wid * 1024 + lo_;
        if (m == 0) {
#pragma unroll
            for (int d0 = 0; d0 < 4; ++d0)
#pragma unroll
                for (int j = 0; j < 4; ++j) pk[(d0 * 4 + j) * 64] = (f32x4){o[d0][4 * j], o[d0][4 * j + 1], o[d0][4 * j + 2], o[d0][4 * j + 3]};
        } else {
            float ss[16];
#pragma unroll
            for (int r = 0; r < 16; ++r) ss[r] = 0.f;
#pragma unroll
            for (int d0 = 0; d0 < 4; ++d0)
#pragma unroll
                for (int j = 0; j < 4; ++j) { const f32x4 a = pk[(d0 * 4 + j) * 64];
#pragma unroll
                    for (int e = 0; e < 4; ++e) { const float v = a[e] - lam * o[d0][4 * j + e]; o[d0][4 * j + e] = v; ss[4 * j + e] += v * v; } }
#pragma unroll
            for (int r = 0; r < 16; ++r) { float s = ss[r]; s += __shfl_xor(s, 1); s += __shfl_xor(s, 2); s += __shfl_xor(s, 4); s += __shfl_xor(s, 8); s += __shfl_xor(s, 16); ss[r] = 0.8f / sqrtf(s * (1.0f / 128.0f) + EPS); }
            float gd[4];
#pragma unroll
            for (int d0 = 0; d0 < 4; ++d0) gd[d0] = subg[d0 * 32 + r32];
            LAS bf16_t* stg = (LAS bf16_t*)(shm + L_OST) + wid * 4096;
#pragma unroll
            for (int r = 0; r < 16; ++r) { const int orow = crow(r, hi);
#pragma unroll
                for (int d0 = 0; d0 < 4; ++d0) { float y = o[d0][r] * ss[r] * gd[d0];
#if PROBE_PHASE == 51
                    if (!(__builtin_fabsf(y) < 1e30f)) y = 0.f;
#endif
                    stg[orow * 128 + d0 * 32 + r32] = (bf16_t)(cvt_pk_bf16(y, 0.f) & 0xffffu); } }
            asm volatile("s_waitcnt lgkmcnt(0)" ::: "memory");
            bf16_t* Ow = YAB + ((long)b * SEQ + qb * QB + wid * 32) * 1024 + 512 + h * 128;
#pragma unroll
            for (int i = 0; i < 8; ++i) { const int row = i * 4 + (lo_ >> 4), ch = lo_ & 15; const u32x4 v = *(const LAS u32x4*)(stg + row * 128 + ch * 8); *(u32x4*)(Ow + (long)row * 1024 + ch * 8) = v; }
        }
        asm volatile("s_waitcnt lgkmcnt(0)\n\ts_barrier" ::: "memory");
    }
}
#undef ATT_WAIT_BAR
#undef MX3
#undef ATT_SBAR
#undef ATT_MFMA
#undef MFMA8_PV
#undef MFMA8_QK
#undef MFMA8_PV8
}

#define XB_TMO      128
#define XB_XCNT(j)  (256  + 64 * (j))
#define XB_XSUB(j)  (1280 + 64 * (j))
#define XB_XGEN(j)  (2304 + 64 * (j))
#define XB_TOP      3328
#define XB_TOPGEN   3392
#define XCD_BAR_WORDS 3456
#define XB_SPIN_CAP (1u << 18)
__device__ __forceinline__ unsigned xb_ld(unsigned* p)              { return __hip_atomic_load(p, __ATOMIC_RELAXED, __HIP_MEMORY_SCOPE_AGENT); }
__device__ __forceinline__ unsigned xb_add(unsigned* p, unsigned v) { return __hip_atomic_fetch_add(p, v, __ATOMIC_RELAXED, __HIP_MEMORY_SCOPE_AGENT); }
__device__ __forceinline__ unsigned xb_xcc_id() { return (unsigned)__builtin_amdgcn_s_getreg((3 << 11) | 20) & 0xFu; }
#define XB_SPIN(cond, bar) do { unsigned _sp = 0; while (cond) { __builtin_amdgcn_s_sleep(1); \
    if ((++_sp & 255u) == 0u) { if (xb_ld(&(bar)[XB_TMO])) break; if (_sp > XB_SPIN_CAP) { atomicAdd(&(bar)[XB_TMO], 1u); break; } } } } while (0)
struct XcdBarrier { unsigned* bar; unsigned x; volatile LAS unsigned* st; };
__device__ __forceinline__ XcdBarrier xcd_barrier_post(unsigned* bar, volatile LAS unsigned* st) {
    XcdBarrier b; b.bar = bar; b.x = xb_xcc_id(); b.st = st;
    if (threadIdx.x == 0) (void)xb_add(&bar[XB_XCNT(b.x)], 1u);
    return b;
}
__device__ __forceinline__ void xcd_barrier_complete(unsigned* bar, unsigned x, unsigned& nloc, unsigned& nx) {
    const unsigned G = gridDim.x * gridDim.y * gridDim.z;
    unsigned sum, cnt, mine, sp = 0u;
    for (;;) {
        sum = 0u; cnt = 0u; mine = 0u;
#pragma unroll
        for (unsigned j = 0; j < 16; ++j) { const unsigned c = xb_ld(&bar[XB_XCNT(j)]); sum += c; cnt += (c > 0u) ? 1u : 0u; mine = (j == x) ? c : mine; }
        if (sum == G) break;
        __builtin_amdgcn_s_sleep(1);
        if ((++sp & 255u) == 0u) { if (xb_ld(&bar[XB_TMO])) break; if (sp > XB_SPIN_CAP) { atomicAdd(&bar[XB_TMO], 1u); break; } }
    }
    nloc = mine > 0u ? mine : 1u; nx = cnt > 0u ? cnt : 1u;
}
__device__ __forceinline__ void xcd_barrier(const XcdBarrier& b) {
    asm volatile("s_waitcnt vmcnt(0)" ::: "memory");
    __syncthreads();
    if (threadIdx.x == 0) {
        unsigned* bar = b.bar;
        __builtin_amdgcn_s_waitcnt(0);
        unsigned nloc = b.st[0], nx = b.st[1];
        if (nloc == 0u) { xcd_barrier_complete(bar, b.x, nloc, nx); b.st[0] = nloc; b.st[1] = nx; }
        const unsigned old = xb_add(&bar[XB_XSUB(b.x)], 1u);
        const unsigned gen = old / nloc;
        if (old + 1u == (gen + 1u) * nloc) {
            __builtin_amdgcn_fence(__ATOMIC_RELEASE, "agent");
            asm volatile("s_waitcnt vmcnt(0)" ::: "memory");
            const unsigned og = xb_add(&bar[XB_TOP], 1u);
            const unsigned tg = og / nx;
            if (og + 1u == (tg + 1u) * nx) xb_add(&bar[XB_TOPGEN], 1u);
            else XB_SPIN(xb_ld(&bar[XB_TOPGEN]) == tg, bar);
            __builtin_amdgcn_fence(__ATOMIC_ACQUIRE, "agent");
            xb_add(&bar[XB_XGEN(b.x)], 1u);
            asm volatile("s_waitcnt vmcnt(0)" ::: "memory");
        } else {
            XB_SPIN(xb_ld(&bar[XB_XGEN(b.x)]) == gen, bar);
            __builtin_amdgcn_fence(__ATOMIC_ACQUIRE, "agent");
            asm volatile("s_waitcnt vmcnt(0)" ::: "memory");
        }
    }
    __syncthreads();
}

#define GRID_BAR() xcd_barrier(bar)

__device__ __forceinline__ void phase_stagger(int cls, unsigned ticks) {
    const unsigned long long t0 = __builtin_amdgcn_s_memrealtime(); const unsigned long long want = (unsigned long long)cls * ticks;
    while (__builtin_amdgcn_s_memrealtime() - t0 < want) __builtin_amdgcn_s_sleep(8);
}

struct Args {
    const float* x; const int* pos; const float* norm_mix_g; const float* w_in; const float* gm_ln_g; const float* gm_ln_b; const float* gm_w_s; const float* gm_b_s;
    const float* lam_q1; const float* lam_k1; const float* lam_q2; const float* lam_k2; const float* subln_g; const float* w_br_a; const float* w_br_b; const float* w_out;
    const float* norm_ffn_g; const float* w_rg; const float* b_rg; const float* w_re; const float* b_re; const float* w_gate; const float* w_up; const float* w_down; const float* final_g;
    float* out; unsigned char* ws;
};

__device__ __forceinline__ int wrow_map(int rmode, int n) { return rmode == 0 ? n : rmode == 1 ? ((n >> 5) * 128 + (n & 31)) : (((n >> 3) & 1) * 128 + (n >> 4) * 8 + (n & 7)); }
__device__ __forceinline__ void transpose_item(const float* W, int ldw, int k0, int n0, bf16_t* WT, int ldt, int drow0, int dk0, const float* gk, LAS float* scr, int lane, float sc = 1.0f, int rmode = 0) {
    f32x4 v[16];
    const int kr = lane >> 4, nc = (lane & 15) * 4;
#pragma unroll
    for (int i = 0; i < 16; ++i) v[i] = *(const f32x4*)(W + (size_t)(k0 + 4 * i + kr) * ldw + n0 + nc);
    if (gk) {
#pragma unroll
        for (int i = 0; i < 16; ++i) v[i] = v[i] * gk[k0 + 4 * i + kr];
    }
    if (sc != 1.0f) {
#pragma unroll
        for (int i = 0; i < 16; ++i) v[i] = v[i] * sc;
    }
#pragma unroll
    for (int i = 0; i < 16; ++i) { LAS float* d = scr + (4 * i + kr) * 65 + nc; d[0] = v[i][0]; d[1] = v[i][1]; d[2] = v[i][2]; d[3] = v[i][3]; }
    LDS_WAIT(); asm volatile("" ::: "memory");
    const int c = lane & 7;
#pragma unroll
    for (int j = 0; j < 8; ++j) { const int n = (lane >> 3) + 8 * j; const LAS float* s = scr + (8 * c) * 65 + n;
        u32x4 o; o.x = cvt_pk_bf16(s[0 * 65], s[1 * 65]); o.y = cvt_pk_bf16(s[2 * 65], s[3 * 65]); o.z = cvt_pk_bf16(s[4 * 65], s[5 * 65]); o.w = cvt_pk_bf16(s[6 * 65], s[7 * 65]);
        *(u32x4*)(WT + (size_t)(drow0 + wrow_map(rmode, n)) * ldt + dk0 + k0 + 8 * c) = o; }
    LDS_WAIT(); asm volatile("" ::: "memory");
}
__device__ __forceinline__ void transpose_item8(const float* W, int ldw, int k0, int n0, unsigned char* WT, int ldt, int drow0, const float* gk, float sc, LAS float* scr, int lane, int rmode = 0) {
    f32x4 v[16];
    const int kr = lane >> 4, nc = (lane & 15) * 4;
#pragma unroll
    for (int i = 0; i < 16; ++i) v[i] = *(const f32x4*)(W + (size_t)(k0 + 4 * i + kr) * ldw + n0 + nc);
#pragma unroll
    for (int i = 0; i < 16; ++i) v[i] = v[i] * (gk ? gk[k0 + 4 * i + kr] * sc : sc);
#pragma unroll
    for (int i = 0; i < 16; ++i) { LAS float* d = scr + (4 * i + kr) * 65 + nc; d[0] = v[i][0]; d[1] = v[i][1]; d[2] = v[i][2]; d[3] = v[i][3]; }
    LDS_WAIT(); asm volatile("" ::: "memory");
    const int c = lane & 7;
#pragma unroll
    for (int j = 0; j < 8; ++j) { const int n = (lane >> 3) + 8 * j; const LAS float* s = scr + (8 * c) * 65 + n;
        u32x2 o; o.x = cvt_pk4_fp8(s[0 * 65], s[1 * 65], s[2 * 65], s[3 * 65]); o.y = cvt_pk4_fp8(s[4 * 65], s[5 * 65], s[6 * 65], s[7 * 65]);
        *(u32x2*)(WT + (size_t)(drow0 + wrow_map(rmode, n)) * ldt + k0 + 8 * c) = o; }
    LDS_WAIT(); asm volatile("" ::: "memory");
}
__device__ __forceinline__ void expert_item(int r, const float* w_gate, const float* w_up, const float* w_down, const float* gffn, unsigned char* W13, unsigned char* W2, LAS float* scr, int lane) {
    constexpr int I_G = 32 * 128;
    if (r < 2 * I_G) { const int up = r >= I_G; if (up) r -= I_G; const int e = r / 128, q = r % 128, kb = q / 8, nb = q % 8;
        const int n0 = 64 * nb, drow = e * 1024 + (n0 >> 7) * 256 + up * 128 + (n0 & 127);
        transpose_item8((up ? w_up : w_gate) + (size_t)e * 1024 * 512, 512, 64 * kb, n0, W13, 1024, drow, gffn, 64.f, scr, lane); return; }
    r -= 2 * I_G;
    { const int e = r / 128, q = r % 128, kb = q / 16, nb = q % 16;
        transpose_item8(w_down + (size_t)e * 512 * 1024, 1024, 64 * kb, 64 * nb, W2, 512, e * 1024 + (nb >> 2) * 256 + (nb & 3) * 32, nullptr, 32.f, scr, lane, 2); }
}
__device__ __forceinline__ void rms_row_to_bf16(const float* xrow, const float* g, bf16_t* orow, int lane) {
    const f32x4* xr = (const f32x4*)xrow + lane; const f32x4* gr = (const f32x4*)g + lane;
    f32x4 v[4]; float s = 0.f;
#pragma unroll
    for (int j = 0; j < 4; ++j) { v[j] = xr[64 * j]; s += (v[j].x * v[j].x + v[j].y * v[j].y) + (v[j].z * v[j].z + v[j].w * v[j].w); }
    const float rstd = 1.f / sqrtf(wave_sum(s) * (1.f / D) + EPS);
    u32x2* o8 = (u32x2*)orow + lane;
#pragma unroll
    for (int j = 0; j < 4; ++j) { const f32x4 gg = gr[64 * j]; u32x2 w; w.x = cvt_pk_bf16(v[j].x * rstd * gg.x, v[j].y * rstd * gg.y); w.y = cvt_pk_bf16(v[j].z * rstd * gg.z, v[j].w * rstd * gg.w); o8[64 * j] = w; }
}

__global__ void __launch_bounds__(NTHREADS, 2) fwd_kernel(Args a) {
    extern __shared__ __attribute__((aligned(16))) unsigned char lds_raw[];
    LAS unsigned char* lds = (LAS unsigned char*)lds_raw;
    volatile LAS unsigned* LCTL = (volatile LAS unsigned*)(lds + LDSCTL_OFF);
    const int tid0 = threadIdx.x;
    const int G = gridDim.x, bx = blockIdx.x;
    const int vcu = (G % 8 == 0) ? (bx % 8) * (G / 8) + bx / 8 : bx;
    unsigned char* ws = a.ws;
    unsigned* ctl = (unsigned*)(ws + WS_CTL);
    __builtin_amdgcn_s_setreg((23 << 6) | 1, 1);
    for (int u = tid0; u < (LDS_BYTES - LDSCTL_OFF) / 4; u += NTHREADS) LCTL[u] = 0u;
    __syncthreads();
    XcdBarrier bar = xcd_barrier_post(ctl + CW_BAR, LCTL);
    const int NGW = G * NWAVES;
#define PHASE_IDS() const int tid = opaque_tid(), lane = tid & 63, wave = __builtin_amdgcn_readfirstlane(tid >> 6), gw = vcu * NWAVES + wave; (void)lane; (void)gw

    bf16_t* WIN = (bf16_t*)(ws + WS_WIN); bf16_t* WBR = (bf16_t*)(ws + WS_WBR); bf16_t* WO = (bf16_t*)(ws + WS_WO); unsigned char* W13 = ws + WS_W13; unsigned char* W2 = ws + WS_W2;
    bf16_t* WRH = (bf16_t*)(ws + WS_WRH); bf16_t* WRL = (bf16_t*)(ws + WS_WRL); float* CS = (float*)(ws + WS_CS); float* SSQ = (float*)(ws + WS_SSQ); float* RSTD = (float*)(ws + WS_RSTD); float* WTS = (float*)(ws + WS_WTS);
    int* LIST = (int*)(ws + WS_LIST);
    float* PARK = (float*)(ws + WS_PARK);
    bf16_t* XN = (bf16_t*)(ws + WS_RA); bf16_t* YAB = (bf16_t*)(ws + WS_RA); unsigned char* YB8 = ws + WS_RA;
    bf16_t* UV = (bf16_t*)(ws + WS_RB); bf16_t* MG = (bf16_t*)(ws + WS_RB);
    bf16_t* Qb = (bf16_t*)(ws + WS_RC); bf16_t* Kb = Qb + (size_t)T * 512; bf16_t* XB = (bf16_t*)(ws + WS_RC); unsigned char* V8T = ws + WS_RE + 128 * MiB; unsigned char* Q8 = V8T + 32 * MiB; unsigned char* K8 = Q8 + 16 * MiB;
    bf16_t* Vb = (bf16_t*)(ws + WS_RD);
    unsigned char* G8 = ws + WS_RE; unsigned char* H8 = ws + WS_RE; unsigned char* XB8 = ws + WS_RD;

    for (int rep = 0; rep < REPS(0); ++rep) {
        PHASE_IDS();
        LAS float* scr = (LAS float*)(lds + wave * 16896);
#if LEVEL >= 1
        constexpr int I_IN = 16 * 72, I_BA = 8 * 16, I_BB = 8 * 16, I_O = 16 * 16;
        constexpr int NITEMS = I_IN + I_BA + I_BB + I_O;
        for (int it = gw; it < NITEMS; it += NGW) {
            int r = it;
            if (r < I_IN) { const int kb = r / 72, nb = r % 72; transpose_item(a.w_in, IN_COLS, 64 * kb, 64 * nb, WIN, 1024, (nb >> 2) * 256 + (nb & 3) * 32, 0, nullptr, scr, lane, (64 * nb >= 2560) ? -LOG2E : 1.0f, (64 * nb >= 2560) ? 2 : 1); continue; } r -= I_IN;
            if (r < I_BA) { const int kb = r / 16, nb = r % 16; transpose_item(a.w_br_a, 1024, 64 * kb, 64 * nb, WBR, 1024, (nb >> 2) * 256 + (nb & 3) * 32, 0, nullptr, scr, lane, 1.0f, 1); continue; } r -= I_BA;
            if (r < I_BB) { const int kb = r / 16, nb = r % 16; transpose_item(a.w_br_b, 1024, 64 * kb, 64 * nb, WBR, 1024, (nb >> 2) * 256 + (nb & 3) * 32, 512, nullptr, scr, lane, 1.0f, 1); continue; } r -= I_BB;
            { const int kb = r / 16, nb = r % 16; transpose_item(a.w_out, 1024, 64 * kb, 64 * nb, WO, 1024, (nb >> 2) * 256 + (nb & 3) * 32, 0, nullptr, scr, lane, 1.0f, 1); }
        }
#if LEVEL >= 3
        for (int i = bx * NTHREADS + tid; i < 64 * 1024; i += G * NTHREADS) { const int n = i >> 10, k = i & 1023; float v = 0.f; if (n < 4) v = a.w_rg[k * 4 + n]; else if (n < 36) v = a.w_re[k * 32 + (n - 4)];
            v *= a.norm_ffn_g[k]; const unsigned h = cvt_pk_bf16(v, 0.f) & 0xffffu; const float r = v - __uint_as_float(h << 16); WRH[i] = (bf16_t)h; WRL[i] = (bf16_t)(cvt_pk_bf16(r, 0.f) & 0xffffu); }
#endif
        for (int i = bx * NTHREADS + tid; i < T * 8; i += G * NTHREADS) { const int t = i >> 3, j = i & 7;
            const double invf = exp2(-(double)j * (18.931568569324174 / 8.0));
            const double ang = (double)a.pos[t] * invf; const double kk = rint(ang * 0.15915494309189535); const float rr = (float)(ang - kk * 6.283185307179586);
            CS[t * 16 + j] = cosf(rr); CS[t * 16 + 8 + j] = sinf(rr); }
        for (int m = gw; m < T; m += NGW) rms_row_to_bf16(a.x + (size_t)m * D, a.norm_mix_g, XN + (size_t)m * D, lane);
#endif
    }
    GRID_BAR();

#if LEVEL >= 1 && !defined(NO_P1)
#if PROBE_PHASE >= 71 && PROBE_PHASE <= 73
    {
        pg8::DenseProb P; P.init(XN, WIN, T, IN_COLS, 1024, G, bx);
        pg8::EpiInProjT<(PROBE_PHASE == 73 ? 4 : PROBE_PHASE - 70)> E{UV, Qb, Kb, Vb, G8, CS, Q8, K8};
        pg8::gemm_core<false>(lds, P, E, pg8::NoHook{});
    }
#endif
#if PROBE_PHASE == 66 || PROBE_PHASE == 67
    {
        pg8::DenseProb P; P.init(XN, WIN, T, IN_COLS, 1024, G, bx);
        pg8::EpiInProjT<PROBE_PHASE - 65> E{UV, Qb, Kb, Vb, G8, CS, Q8, K8};
        pg8::gemm_core<false, pg8::DenseProb, pg8::EpiInProjT<PROBE_PHASE - 65>, pg8::NoHook, 4>(lds, P, E, pg8::NoHook{});
    }
#endif
#if PROBE_PHASE == 64
    {
        pg8::DenseProb P; P.init(XN, WIN, T, IN_COLS, 1024, G, bx);
        pg8::EpiInProj E{UV, Qb, Kb, Vb, G8, CS, Q8, K8};
        pg8::gemm_core<false, pg8::DenseProb, pg8::EpiInProj, pg8::NoHook, 4>(lds, P, E, pg8::NoHook{});
    }
#endif
    for (int rep = 0; rep < REPS(1); ++rep) {
#ifdef STAG1
        phase_stagger(((bx >> 3) & 7) >> 1, STAG1);
#endif
        pg8::DenseProb P; P.init(XN, WIN, T, IN_COLS, 1024, G, bx);
        pg8::EpiInProj E{UV, Qb, Kb, Vb, G8, CS, Q8, K8};
        pg8::gemm_core<false>(lds, P, E, pg8::NoHook{});
    }
#if PROBE_PHASE == 11
    {
        pg8::DenseProb P; P.init(XN, WIN, T, IN_COLS, 1024, G, bx);
        pg8::gemm_core<false>(lds, P, pg8::EpiNull{}, pg8::NoHook{});
    }
#endif
#if PROBE_PHASE >= 61 && PROBE_PHASE <= 63
    {
        pg8::DenseProb P; P.init(XN, WIN, T, IN_COLS, 1024, G, bx);
        pg8::gemm_core<false, pg8::DenseProb, pg8::EpiNull, pg8::NoHook, PROBE_PHASE - 60>(lds, P, pg8::EpiNull{}, pg8::NoHook{});
    }
#endif
#if PROBE_PHASE == 31
    {
        pg8::DenseProb P; P.init(XN, WIN, T, IN_COLS, 1024, G, bx);
        pg8::gemm_core<false>(lds, P, pg8::EpiStoreOnly{(bf16_t*)(ws + WS_END)}, pg8::NoHook{});
    }
#endif
#if PROBE_PHASE == 12
    {
        pg8::DenseProbSame P; P.init(XN, WIN, T, IN_COLS, 1024, G, bx);
        pg8::gemm_core<false>(lds, P, pg8::EpiNull{}, pg8::NoHook{});
    }
#endif
#endif
    GRID_BAR();

#if LEVEL >= 1 && !defined(NO_P2A)
    for (int rep = 0; rep < REPS(2); ++rep) {
        PHASE_IDS();
        LAS bf16_t* VT = (LAS bf16_t*)lds;
        LAS float* SV = (LAS float*)(lds + 36864);
        const int r32 = lane & 31, hi = lane >> 5;
        for (int un = vcu; un < 2048; un += G) {
            const int ch = un >> 2, g = un & 3; const size_t row0 = (size_t)ch * 128;
            {
                const int s = tid >> 2, qd = tid & 3;
                const u32x4* vp = (const u32x4*)(UV + (row0 + s) * 1024 + 512 + g * 128 + qd * 32);
                float v[32]; float sm = 0.f;
#pragma unroll
                for (int j = 0; j < 4; ++j) { const u32x4 w = vp[j]; f32x4 x0, x1; pg8::unpack8(w, x0, x1);
#pragma unroll
                    for (int e = 0; e < 4; ++e) { v[8 * j + e] = x0[e]; v[8 * j + 4 + e] = x1[e]; sm += x0[e] + x1[e]; } }
                sm += __shfl_xor(sm, 1); sm += __shfl_xor(sm, 2);
                const float mu = sm * (1.0f / 128.0f); float sq = 0.f;
#pragma unroll
                for (int i = 0; i < 32; ++i) { v[i] -= mu; sq += v[i] * v[i]; }
                sq += __shfl_xor(sq, 1); sq += __shfl_xor(sq, 2);
                const float rstd = 1.0f / sqrtf(sq * (1.0f / 128.0f) + EPS);
                const float* lg = a.gm_ln_g + g * 128 + qd * 32; const float* lb = a.gm_ln_b + g * 128 + qd * 32;
#pragma unroll
                for (int i = 0; i < 32; ++i) { const float y = v[i] * rstd * lg[i] + lb[i]; VT[(qd * 32 + i) * 136 + s] = (bf16_t)(cvt_pk_bf16(y, 0.f) & 0xffffu); }
            }
            LDS_WAIT(); __syncthreads();
            {
                const int tb = wave >> 1, db0 = 2 * (wave & 1);
                f32x16 c0 = f32x16{}, c1 = f32x16{};
                const float* wrow = a.gm_w_s + ((size_t)g * 128 + tb * 32 + r32) * 128;
                const int trow = tb * 32 + r32;
                for (int ks = 0; ks <= 2 * tb + 1; ++ks) {
                    const int s0 = 16 * ks + 8 * hi;
                    const f32x4 wa = *(const f32x4*)(wrow + s0), wb = *(const f32x4*)(wrow + s0 + 4);
                    float w8[8] = {wa[0], wa[1], wa[2], wa[3], wb[0], wb[1], wb[2], wb[3]};
#pragma unroll
                    for (int j = 0; j < 8; ++j) if (s0 + j > trow) w8[j] = 0.f;
                    u32x4 aw; aw.x = cvt_pk_bf16(w8[0], w8[1]); aw.y = cvt_pk_bf16(w8[2], w8[3]); aw.z = cvt_pk_bf16(w8[4], w8[5]); aw.w = cvt_pk_bf16(w8[6], w8[7]);
                    const bf16x8 af = __builtin_bit_cast(bf16x8, aw);
                    const bf16x8 b0 = *(const LAS bf16x8*)(VT + ((db0 + 0) * 32 + r32) * 136 + s0);
                    const bf16x8 b1 = *(const LAS bf16x8*)(VT + ((db0 + 1) * 32 + r32) * 136 + s0);
                    c0 = __builtin_amdgcn_mfma_f32_32x32x16_bf16(af, b0, c0, 0, 0, 0);
                    c1 = __builtin_amdgcn_mfma_f32_32x32x16_bf16(af, b1, c1, 0, 0, 0);
                }
#pragma unroll
                for (int r = 0; r < 16; ++r) { const int t = tb * 32 + att::crow(r, hi); const float bs = a.gm_b_s[g * 128 + t];
                    SV[t * 132 + db0 * 32 + r32] = c0[r] + bs; SV[t * 132 + db0 * 32 + 32 + r32] = c1[r] + bs; }
            }
            LDS_WAIT(); __syncthreads();
            {
#pragma unroll
                for (int i = 0; i < 4; ++i) { const int t = i * 32 + (tid >> 4), dc = (tid & 15) * 8;
                    const size_t ro = (row0 + t) * 1024 + g * 128 + dc;
                    const u32x4 uw = *(const u32x4*)(UV + ro); f32x4 u0, u1; pg8::unpack8(uw, u0, u1);
                    const f32x4 s0 = *(const LAS f32x4*)(SV + t * 132 + dc), s1 = *(const LAS f32x4*)(SV + t * 132 + dc + 4);
                    *(u32x4*)(YAB + ro) = pg8::pack8(u0 * s0, u1 * s1); }
            }
            LDS_WAIT(); __syncthreads();
        }
    }
#endif
#if LEVEL >= 2
    {
        PHASE_IDS();
        LAS unsigned char* TB = (LAS unsigned char*)lds + wave * 8192;
        for (int tl = gw; tl < BATCH * 4 * (SEQ / 64); tl += NGW) {
            const int bh = tl >> 7, tt = tl & 127, b = bh >> 2, h = bh & 3;
            const bf16_t* vsrc = Vb + ((size_t)b * SEQ + tt * 64) * 512 + h * 128;
            u32x4 w[16];
#pragma unroll
            for (int i = 0; i < 16; ++i) w[i] = *(const u32x4*)(vsrc + (size_t)(i * 4 + (lane >> 4)) * 512 + (lane & 15) * 8);
#pragma unroll
            for (int i = 0; i < 16; ++i) { const int key = i * 4 + (lane >> 4), kk = key & 31, khi = (kk >> 2) & 1, j = (kk & 3) + 4 * (kk >> 3) + 16 * (key >> 5), cc = khi * 2 + (j >> 4);
                f32x4 x0, x1; pg8::unpack8(w[i], x0, x1); const unsigned q0_ = cvt_pk4_fp8(x0[0], x0[1], x0[2], x0[3]), q1_ = cvt_pk4_fp8(x1[0], x1[1], x1[2], x1[3]);
#pragma unroll
                for (int e = 0; e < 8; ++e) { const int d = (lane & 15) * 8 + e; const unsigned byte = ((e < 4 ? q0_ : q1_) >> (8 * (e & 3))) & 0xffu;
                    TB[d * 64 + ((cc ^ ((d >> 2) & 3)) * 16) + (j & 15)] = (unsigned char)byte; } }
            LDS_WAIT(); asm volatile("" ::: "memory");
            unsigned char* dst = V8T + (size_t)tl * 8192;
#pragma unroll
            for (int i = 0; i < 8; ++i) *(u32x4*)(dst + (i * 64 + lane) * 16) = *(const LAS u32x4*)(TB + (i * 64 + lane) * 16);
            LDS_WAIT(); asm volatile("" ::: "memory");
        }
    }
    GRID_BAR();
#endif
#if LEVEL >= 2 && !defined(NO_P2B)
    {
        PHASE_IDS();
        float lam;
        { const float p1 = wave_sum(a.lam_q1[lane] * a.lam_k1[lane]), p2 = wave_sum(a.lam_q2[lane] * a.lam_k2[lane]); lam = expf(p1) - expf(p2) + 0.2f; }
        const int bh = vcu >> 3, s = vcu & 7, b = bh >> 2, h = bh & 3;
        float* park = PARK + (size_t)bx * 32768;
        if (G == 256) {
            for (int ii = 0; ii < 4 * REPS(3); ++ii) { const int i = ii & 3; const int qb = (i == 0) ? s : (i == 1) ? 15 - s : (i == 2) ? 16 + s : 31 - s;
                att::attn_unit<0>(b, h, qb, Qb, Kb, Q8, K8, V8T, YAB, park, lam, a.subln_g, (LAS char*)lds);
#if LEVEL >= 3
                if (ii < 4) {
                    LAS float* scr = (LAS float*)(lds + wave * 16896);
                    for (int k = wave; k < 12; k += NWAVES) expert_item((bx * 4 + ii) * 12 + k, a.w_gate, a.w_up, a.w_down, a.norm_ffn_g, W13, W2, scr, lane);
                    LDS_WAIT(); __syncthreads();
                }
#endif
            }
#if PROBE_PHASE == 13 || PROBE_PHASE == 14 || PROBE_PHASE == 15 || PROBE_PHASE == 16
            for (int i = 0; i < 4; ++i) { const int qb = (i == 0) ? s : (i == 1) ? 15 - s : (i == 2) ? 16 + s : 31 - s;
                att::attn_unit<PROBE_PHASE - 13>(0, 0, qb, Qb, Kb, Q8, K8, V8T, (bf16_t*)(ws + WS_END), park, lam, a.subln_g, (LAS char*)lds); }
#endif
        }
    }
#elif LEVEL >= 1
    {
        PHASE_IDS();
        for (int i = bx * NTHREADS + tid; i < T * 64; i += G * NTHREADS) { const int row = i >> 6, c = i & 63; *(u32x4*)(YAB + (size_t)row * 1024 + 512 + c * 8) = (u32x4){0u, 0u, 0u, 0u}; }
    }
#endif
    GRID_BAR();

#if LEVEL >= 1 && !defined(NO_P3)
    for (int rep = 0; rep < REPS(4); ++rep) {
        pg8::PanelProb P; P.init(YAB, WBR, T, 1024, 1024, G, bx);
        pg8::EpiMerge E{G8, MG};
        pg8::gemm_core<false>(lds, P, E, pg8::HookMerge{G8});
    }
#endif
    asm volatile("s_waitcnt vmcnt(0)" ::: "memory"); __syncthreads();
#if LEVEL >= 1 && !defined(NO_P4)
    for (int rep = 0; rep < REPS(5); ++rep) {
        pg8::PanelProb P; P.init(MG, WO, T, 1024, 1024, G, bx);
        pg8::EpiX1 E{a.x, XB, XB8, SSQ};
        pg8::gemm_core<false>(lds, P, E, pg8::NoHook{});
    }
#endif
    asm volatile("s_waitcnt vmcnt(0)" ::: "memory"); __syncthreads();

#if LEVEL >= 3 && !defined(NO_P5)
    {
        PHASE_IDS();
        LAS float* LG = (LAS float*)lds;
        volatile LAS int* LCNT = (volatile LAS int*)(LCTL + 96); volatile LAS int* LBASE = (volatile LAS int*)(LCTL + 128);
        const int r32 = lane & 31, hi = lane >> 5;
        for (int tb = bx; tb < T / 256; tb += G) {
            const size_t tok0 = (size_t)tb * 256 + wave * 32;
            const bf16_t* xa = XB + (tok0 + r32) * 1024 + hi * 8;
            const bf16_t* wh0 = WRH + (size_t)r32 * 1024 + hi * 8; const bf16_t* wh1 = wh0 + 32 * 1024;
            const bf16_t* wl0 = WRL + (size_t)r32 * 1024 + hi * 8; const bf16_t* wl1 = wl0 + 32 * 1024;
            f32x16 c0 = f32x16{}, c1 = f32x16{};
#pragma unroll 4
            for (int ks = 0; ks < 64; ++ks) {
                const bf16x8 av = *(const bf16x8*)(xa + ks * 16);
                const bf16x8 h0 = *(const bf16x8*)(wh0 + ks * 16), h1 = *(const bf16x8*)(wh1 + ks * 16), l0 = *(const bf16x8*)(wl0 + ks * 16), l1 = *(const bf16x8*)(wl1 + ks * 16);
                c0 = __builtin_amdgcn_mfma_f32_32x32x16_bf16(av, h0, c0, 0, 0, 0); c1 = __builtin_amdgcn_mfma_f32_32x32x16_bf16(av, h1, c1, 0, 0, 0);
                c0 = __builtin_amdgcn_mfma_f32_32x32x16_bf16(av, l0, c0, 0, 0, 0); c1 = __builtin_amdgcn_mfma_f32_32x32x16_bf16(av, l1, c1, 0, 0, 0);
            }
#pragma unroll
            for (int r = 0; r < 16; ++r) { const int tl = wave * 32 + att::crow(r, hi); LG[tl * 37 + r32] = c0[r]; if (r32 < 4) LG[tl * 37 + 32 + r32] = c1[r]; }
            if (tid < 32) LCNT[tid] = 0;
            LDS_WAIT(); __syncthreads();
            int eid0 = 0, eid1 = 0, rk0 = 0, rk1 = 0; float w0 = 0.f, w1 = 0.f; const size_t tok = (size_t)tb * 256 + tid;
            if (tid < 256) {
                float ssq = 0.f;
#pragma unroll
                for (int j = 0; j < 16; ++j) ssq += SSQ[tok * 16 + j];
                const float rstd = 1.0f / sqrtf(ssq * (1.0f / 1024.0f) + EPS);
                RSTD[tok] = rstd;
                const LAS float* p0 = LG + tid * 37;
                float gl[4]; int grp = 0;
#pragma unroll
                for (int j = 0; j < 4; ++j) gl[j] = p0[j] * rstd + a.b_rg[j];
                float gmx = gl[0];
#pragma unroll
                for (int j = 1; j < 4; ++j) if (gl[j] > gmx) { gmx = gl[j]; grp = j; }
                float gs = 0.f;
#pragma unroll
                for (int j = 0; j < 4; ++j) gs += expf(gl[j] - gmx);
                const float gwt = 1.0f / gs;
                float el[8];
#pragma unroll
                for (int j = 0; j < 8; ++j) el[j] = p0[4 + grp * 8 + j] * rstd + a.b_re[grp * 8 + j];
                int i0 = 0; float v0 = el[0];
#pragma unroll
                for (int j = 1; j < 8; ++j) if (el[j] > v0) { v0 = el[j]; i0 = j; }
                int i1 = -1; float v1 = -INFINITY;
#pragma unroll
                for (int j = 0; j < 8; ++j) if (j != i0 && el[j] > v1) { v1 = el[j]; i1 = j; }
                const float e1 = expf(v1 - v0); w0 = gwt / (1.0f + e1); w1 = gwt * e1 / (1.0f + e1);
                eid0 = grp * 8 + i0; eid1 = grp * 8 + i1;
                rk0 = atomicAdd((int*)(LCNT + eid0), 1); rk1 = atomicAdd((int*)(LCNT + eid1), 1);
            }
            LDS_WAIT(); __syncthreads();
            if (tid < 32) LBASE[tid] = (int)__hip_atomic_fetch_add(ctl + CW_CNT + tid, (unsigned)LCNT[tid], RLX_AGENT);
            LDS_WAIT(); __syncthreads();
            if (tid < 256) {
                const int s0_ = eid0 * LISTCAP + LBASE[eid0] + rk0, s1_ = eid1 * LISTCAP + LBASE[eid1] + rk1;
                LIST[s0_] = (int)(((unsigned)(tok * 2) << 15) | (cvt_pk_bf16(w0, 0.f) & 0x7fffu)); LIST[s1_] = (int)(((unsigned)(tok * 2 + 1) << 15) | (cvt_pk_bf16(w1, 0.f) & 0x7fffu));
            }
            LDS_WAIT(); __syncthreads();
        }
    }
#endif
    GRID_BAR();
#if LEVEL >= 3
    {
        PHASE_IDS();
        volatile LAS int* BST = (volatile LAS int*)(LCTL + 16); volatile LAS int* CNT = (volatile LAS int*)(LCTL + 64);
        if (tid == 0) { int accb = 0; for (int e = 0; e < NEXP; ++e) { const int c = (int)__hip_atomic_load(ctl + CW_CNT + e, RLX_AGENT); CNT[e] = c; BST[e] = accb; accb += (c + 255) >> 8; } BST[NEXP] = accb; }
        LDS_WAIT(); __syncthreads();
    }
#if !defined(NO_P6)
    for (int rep = 0; rep < REPS(6); ++rep) {
        pg8::MoeUpProb P; P.init((const LAS int*)(LCTL + 16), (const LAS int*)(LCTL + 64), G, bx); P.A = (const char*)XB8; P.Bt = (const char*)W13; P.pitch = 1024; P.list = LIST;
        pg8::EpiMoeUp E{LIST, RSTD, H8, {}};
        pg8::gemm_core<true>(lds, P, E, pg8::HookPin<pg8::EpiMoeUp>{&E});
    }
#endif
#endif
    GRID_BAR();
#if LEVEL >= 3 && !defined(NO_P7)
    for (int rep = 0; rep < REPS(7); ++rep) {
        pg8::MoeDownProb P; P.init((const LAS int*)(LCTL + 16), (const LAS int*)(LCTL + 64), G, bx); P.A = (const char*)H8; P.Bt = (const char*)W2; P.pitch = 512;
        pg8::EpiMoeDown E{LIST, YB8, {}};
        pg8::gemm_core<true>(lds, P, E, pg8::HookPin<pg8::EpiMoeDown>{&E});
    }
#endif
    GRID_BAR();

    {
        PHASE_IDS();
        const bool tmo = (__hip_atomic_load(ctl + CW_BAR + XB_TMO, RLX_AGENT) != 0u);
        for (int m = gw; m < T; m += NGW) {
            const f32x4* gr = (const f32x4*)a.final_g + lane;
            f32x4 v[4]; float s = 0.f;
#pragma unroll
            for (int j = 0; j < 4; ++j) {
#if LEVEL >= 1
                { const u32x2 xw = *((const u32x2*)(XB + (size_t)m * D) + lane + 64 * j); v[j] = (f32x4){bf_lo(xw.x), bf_hi(xw.x), bf_lo(xw.y), bf_hi(xw.y)}; }
#else
                v[j] = ((const f32x4*)(a.x + (size_t)m * D) + lane)[64 * j];
#endif
#if LEVEL >= 3
                const unsigned y0 = *((const unsigned*)(YB8 + (size_t)(2 * m) * D) + lane + 64 * j), y1 = *((const unsigned*)(YB8 + (size_t)(2 * m + 1) * D) + lane + 64 * j);
                v[j] = v[j] + (fp8x4_to_f32(y0) + fp8x4_to_f32(y1)) * 0.0625f;
#endif
                s += (v[j].x * v[j].x + v[j].y * v[j].y) + (v[j].z * v[j].z + v[j].w * v[j].w); }
            float rstd = 1.f / sqrtf(wave_sum(s) * (1.f / D) + EPS);
            if (tmo) rstd = __builtin_nanf("");
            f32x4* o = (f32x4*)(a.out + (size_t)m * D) + lane;
#pragma unroll
            for (int j = 0; j < 4; ++j) { f32x4 ov = v[j] * rstd * gr[64 * j];
#if PROBE_PHASE == 50
#pragma unroll
                for (int e = 0; e < 4; ++e) if (!(__builtin_fabsf(ov[e]) < 1e30f)) ov[e] = 0.f;
#endif
                o[64 * j] = ov; }
        }
    }
}

extern "C" void kernel_launch(void* const* d_in, const int* in_sizes, int n_in, void* d_out, int out_size, void* d_ws, size_t ws_size, hipStream_t stream) {
    static int grid = 0;
    if (grid == 0) {
        if (n_in != 25 || in_sizes[0] != T * D || out_size != T * D || ws_size < WS_END + 64 * MiB) { fprintf(stderr, "kernel_launch: unexpected shapes (n_in %d, in0 %d, out %d, ws %zu); nothing launched\n", n_in, n_in > 0 ? in_sizes[0] : -1, out_size, ws_size); grid = -1; return; }
        int dev = 0, cus = 0, per_cu = 0;
        if (hipGetDevice(&dev) != hipSuccess || hipDeviceGetAttribute(&cus, hipDeviceAttributeMultiprocessorCount, dev) != hipSuccess) { grid = -1; return; }
        if (hipFuncSetAttribute((const void*)fwd_kernel, hipFuncAttributeMaxDynamicSharedMemorySize, LDS_BYTES) != hipSuccess) { fprintf(stderr, "kernel_launch: hipFuncSetAttribute failed\n"); grid = -1; return; }
        if (hipOccupancyMaxActiveBlocksPerMultiprocessor(&per_cu, (const void*)fwd_kernel, NTHREADS, LDS_BYTES) != hipSuccess || per_cu < 1) fprintf(stderr, "kernel_launch: occupancy query reports %d\n", per_cu);
        (void)hipGetLastError();
        grid = cus;
        if (grid != 256) fprintf(stderr, "kernel_launch: %d CUs (built for 256)\n", grid);
    }
    if (grid < 0) return;
    if (hipMemsetAsync((char*)d_ws + WS_CTL, 0, CTL_ZERO_BYTES, stream) != hipSuccess) return;
    Args a{};
    a.x = (const float*)d_in[0]; a.pos = (const int*)d_in[1]; a.norm_mix_g = (const float*)d_in[2]; a.w_in = (const float*)d_in[3]; a.gm_ln_g = (const float*)d_in[4]; a.gm_ln_b = (const float*)d_in[5];
    a.gm_w_s = (const float*)d_in[6]; a.gm_b_s = (const float*)d_in[7]; a.lam_q1 = (const float*)d_in[8]; a.lam_k1 = (const float*)d_in[9]; a.lam_q2 = (const float*)d_in[10]; a.lam_k2 = (const float*)d_in[11];
    a.subln_g = (const float*)d_in[12]; a.w_br_a = (const float*)d_in[13]; a.w_br_b = (const float*)d_in[14]; a.w_out = (const float*)d_in[15]; a.norm_ffn_g = (const float*)d_in[16];
    a.w_rg = (const float*)d_in[17]; a.b_rg = (const float*)d_in[18]; a.w_re = (const float*)d_in[19]; a.b_re = (const float*)d_in[20]; a.w_gate = (const float*)d_in[21]; a.w_up = (const float*)d_in[22];
    a.w_down = (const float*)d_in[23]; a.final_g = (const float*)d_in[24];
    a.out = (float*)d_out; a.ws = (unsigned char*)d_ws;
    hipLaunchKernelGGL(fwd_kernel, dim3(grid), dim3(NTHREADS), LDS_BYTES, stream, a);
    const hipError_t le = hipPeekAtLastError();
    if (le != hipSuccess) fprintf(stderr, "kernel_launch: launch failed: %s\n", hipGetErrorName(le));
}
```

```cpp
#include <hip/hip_runtime.h>
#include <cstdio>
#include <cstdint>

#ifndef LEVEL
#define LEVEL 3
#endif

#ifndef PROBE_PHASE
#define PROBE_PHASE -1
#endif
#define REPS(p) ((PROBE_PHASE == (p)) ? 2 : 1)
#define LAS __attribute__((address_space(3)))
#define GAS __attribute__((address_space(1)))
typedef unsigned short bf16_t;
typedef short bf16x8 __attribute__((ext_vector_type(8)));
typedef short s16x4 __attribute__((ext_vector_type(4)));
typedef float f32x2 __attribute__((ext_vector_type(2)));
typedef float f32x4 __attribute__((ext_vector_type(4)));
typedef float f32x16 __attribute__((ext_vector_type(16)));
typedef unsigned u32x2 __attribute__((ext_vector_type(2)));
typedef unsigned u32x4 __attribute__((ext_vector_type(4)));
typedef int i32x8 __attribute__((ext_vector_type(8)));
typedef short s16x16 __attribute__((ext_vector_type(16)));

constexpr int D = 1024, BATCH = 8, SEQ = 8192, T = BATCH * SEQ;
constexpr int IN_COLS = 4608;
constexpr int NEXP = 32, DEXP = 512;
constexpr int LISTCAP = T;
constexpr float EPS = 1e-6f;
constexpr float LOG2E = 1.4426950408889634f;
constexpr float C2 = 0.125f * LOG2E;
constexpr int NWAVES = 8, NTHREADS = 512;

constexpr size_t MiB = 1u << 20;
constexpr size_t WS_CTL = 0, CTL_ZERO_BYTES = 1 * MiB;
constexpr size_t WS_WIN = 2 * MiB;
constexpr size_t WS_WBR = 12 * MiB;
constexpr size_t WS_WO = 14 * MiB;
constexpr size_t WS_W13 = 16 * MiB;
constexpr size_t WS_W2 = 80 * MiB;
constexpr size_t WS_WRH = 112 * MiB;
constexpr size_t WS_WRL = 112 * MiB + 131072;
constexpr size_t WS_CS = 113 * MiB;
constexpr size_t WS_SSQ = 117 * MiB;
constexpr size_t WS_RSTD = 121 * MiB;
constexpr size_t WS_WTS = 122 * MiB;
constexpr size_t WS_LIST = 123 * MiB;
constexpr size_t WS_PARK = 131 * MiB;
constexpr size_t WS_RA = 164 * MiB;
constexpr size_t WS_RB = 292 * MiB;
constexpr size_t WS_RC = 420 * MiB;
constexpr size_t WS_RD = 548 * MiB;
constexpr size_t WS_RE = 612 * MiB;
constexpr size_t WS_END = 868 * MiB;
constexpr int CW_TMO = 0;
constexpr int CW_BAR = 4096;
constexpr int CW_CNT = 8192;

constexpr int RING_BYTES = 147456;
constexpr int LDSCTL_OFF = RING_BYTES;
constexpr int LDS_BYTES = RING_BYTES + 1024;

#define RLX_AGENT __ATOMIC_RELAXED, __HIP_MEMORY_SCOPE_AGENT
#define LDS_WAIT() asm volatile("s_waitcnt lgkmcnt(0)" ::: "memory")
#define VM_WAIT() asm volatile("s_waitcnt vmcnt(0)" ::: "memory")

__device__ __forceinline__ unsigned cvt_pk_bf16(float lo, float hi) { unsigned r; asm("v_cvt_pk_bf16_f32 %0, %1, %2" : "=v"(r) : "v"(lo), "v"(hi)); return r; }
__device__ __forceinline__ unsigned cvt_pk4_fp8(float a, float b, float c, float d) { int w; asm("v_cvt_pk_fp8_f32 %0, %1, %2" : "=v"(w) : "v"(a), "v"(b)); w = __builtin_amdgcn_cvt_pk_fp8_f32(c, d, w, true); return (unsigned)w; }
__device__ __forceinline__ unsigned cvt_pk4_u8(float a, float b, float c, float d) { unsigned w = 0; w = __builtin_amdgcn_cvt_pk_u8_f32(a, 0, w); w = __builtin_amdgcn_cvt_pk_u8_f32(b, 1, w); w = __builtin_amdgcn_cvt_pk_u8_f32(c, 2, w); w = __builtin_amdgcn_cvt_pk_u8_f32(d, 3, w); return w; }
__device__ __forceinline__ f32x4 u8x4_to_f32(unsigned w) { return (f32x4){(float)(w & 0xffu), (float)((w >> 8) & 0xffu), (float)((w >> 16) & 0xffu), (float)(w >> 24)}; }
__device__ __forceinline__ f32x4 fp8x4_to_f32(unsigned w) { const f32x2 lo = __builtin_amdgcn_cvt_pk_f32_fp8((int)w, false), hi = __builtin_amdgcn_cvt_pk_f32_fp8((int)w, true); return (f32x4){lo[0], lo[1], hi[0], hi[1]}; }
__device__ __forceinline__ float bf_lo(unsigned w) { return __uint_as_float(w << 16); }
__device__ __forceinline__ float bf_hi(unsigned w) { return __uint_as_float(w & 0xffff0000u); }
__device__ __forceinline__ float fast_exp2(float x) { return __builtin_amdgcn_exp2f(x); }
__device__ __forceinline__ float fast_rcp(float x) { return __builtin_amdgcn_rcpf(x); }
__device__ __forceinline__ float sigmoidf_(float x) { return fast_rcp(1.0f + fast_exp2(-LOG2E * x)); }
__device__ __forceinline__ float gelu_tanh(float x) {
    const float u = x * (0.7978845608028654f + 0.0356774081363001f * x * x);
    return x * fast_rcp(1.0f + fast_exp2(-2.0f * LOG2E * u));
}
__device__ __forceinline__ f32x2 pk_fma(f32x2 a, f32x2 b, f32x2 c) { return __builtin_elementwise_fma(a, b, c); }
__device__ __forceinline__ f32x2 gelu_tanh2(f32x2 x) {
    constexpr float K0 = -2.0f * LOG2E * 0.7978845608028654f, K1 = -2.0f * LOG2E * 0.0356774081363001f;
    const f32x2 z = x * pk_fma(x * x, (f32x2){K1, K1}, (f32x2){K0, K0});
    const f32x2 d = (f32x2){fast_exp2(z.x), fast_exp2(z.y)} + 1.0f;
    return x * (f32x2){fast_rcp(d.x), fast_rcp(d.y)};
}
__device__ __forceinline__ f32x2 sig255_2(f32x2 a) {
    constexpr float S = 1.0f / 255.0f;
    const f32x2 d = pk_fma((f32x2){fast_exp2(a.x), fast_exp2(a.y)}, (f32x2){S, S}, (f32x2){S, S});
    return (f32x2){fast_rcp(d.x), fast_rcp(d.y)};
}
__device__ __forceinline__ int opaque_tid() { int t = threadIdx.x; asm volatile("" : "+v"(t)); return t; }
__device__ __forceinline__ float wave_sum(float v) {
#pragma unroll
    for (int o = 1; o < 64; o <<= 1) v += __shfl_xor(v, o);
    return v;
}

namespace pg8 {
constexpr int BM = 256, BK = 64, HALF = 128, HTB = HALF * BK * 2, STAGE_BYTES = 8 * HTB, NXCD = 8, WGM = 8;
__host__ __device__ __forceinline__ int lds_byte(int r, int c) { const int st = (r >> 4) * 2 + (c >> 5), rr = r & 15, cc = c & 31, ob = rr * 64 + cc * 2; return st * 1024 + (ob ^ (((ob >> 9) & 1) << 5)); }
__host__ __device__ __forceinline__ void stage_rc(int b, int& R, int& C) { const int st = b / 1024, sb = b % 1024, swz = sb ^ (((sb >> 9) & 1) << 5); R = (st >> 1) * 16 + swz / 64; C = (st & 1) * 32 + (swz % 64) / 2; }
__host__ __device__ __forceinline__ int perm32(int rho) { const int n = rho >> 4, i = rho & 15; return 8 * (i >> 2) + 4 * n + (i & 3); }

struct Unit { int pm, pn, e, lbase, nv; };

struct DenseProb {
    static constexpr bool GATHER = false;
    const char* A; const char* Bt; int pitch  ; int nM, nN, nwg, G, c;
    __device__ __forceinline__ void init(const void* A_, const void* Bt_, int M, int N, int K_, int G_, int c_) { A = (const char*)A_; Bt = (const char*)Bt_; pitch = K_ * 2; nM = M / BM; nN = N / BM; nwg = nM * nN; G = G_; c = c_; }
    __device__ __forceinline__ bool next(int i, Unit& u) const {
        const long L = (long)i * G + c; if (L >= nwg) return false;
        int wgid = (int)L; { const int q = nwg / NXCD, r = nwg % NXCD, xcd = wgid % NXCD, off = wgid / NXCD; wgid = (xcd < r ? xcd * (q + 1) : r * (q + 1) + (xcd - r) * q) + off; }
        const int nig = WGM * nN, gid = wgid / nig, fm = gid * WGM, gsz = (nM - fm) < WGM ? (nM - fm) : WGM;
        u.pm = fm + ((wgid % nig) % gsz); u.pn = (wgid % nig) / gsz; u.e = 0; u.lbase = 0; u.nv = 256; return true;
    }
    __device__ __forceinline__ void a_offs(const Unit& u, const int (&R)[2], const int (&C)[2], unsigned (&o)[2][2]) const {
#pragma unroll
        for (int h = 0; h < 2; ++h)
#pragma unroll
            for (int i = 0; i < 2; ++i) o[h][i] = (unsigned)((u.pm * BM + h * HALF + R[i]) * pitch + C[i] * 2);
    }
    __device__ __forceinline__ const char* b_tile(const Unit& u) const { return Bt + (size_t)u.pn * BM * pitch; }
    __device__ __forceinline__ const char* a_tile(const Unit& u) const { return A + (size_t)u.pm * BM * pitch; }
};

struct PanelProb : DenseProb {
    __device__ __forceinline__ bool next(int i, Unit& u) const { if (i >= nN || c >= nM) return false; u.pm = c; u.pn = i; u.e = 0; u.lbase = 0; u.nv = 256; return true; }
};
struct MoeOrder {
    const LAS int* bstart; const LAS int* cnt; int nblk, nwg, G, c;
    __device__ __forceinline__ void init(const LAS int* bs, const LAS int* cn, int G_, int c_) { bstart = bs; cnt = cn; nblk = bs[NEXP]; nwg = nblk * 4; G = G_; c = c_; }
    __device__ __forceinline__ bool next(int i, Unit& u) const {
        const long L = (long)i * G + c; if (L >= nwg) return false;
        int wgid = (int)L; { const int q = nwg / NXCD, r = nwg % NXCD, xcd = wgid % NXCD, off = wgid / NXCD; wgid = (xcd < r ? xcd * (q + 1) : r * (q + 1) + (xcd - r) * q) + off; }
        const int gid = wgid / 32, fm = gid * 8, gsz = (nblk - fm) < 8 ? (nblk - fm) : 8, w = wgid - gid * 32;
        const int blk = fm + (w % gsz); u.pn = w / gsz; u.pm = blk;
        int e = 0;
        while (e < NEXP - 1 && blk >= bstart[e + 1]) ++e;
        const int rb = blk - bstart[e]; u.e = e; u.lbase = e * LISTCAP + rb * 256; const int rem = cnt[e] - rb * 256; u.nv = rem < 256 ? rem : 256; return true;
    }
};
struct MoeUpProb : MoeOrder {
    static constexpr bool GATHER = true;
    const char* A; const char* Bt; int pitch; const int* list;
    __device__ __forceinline__ const char* a_tile(const Unit&) const { return A; }
    __device__ __forceinline__ void a_offs(const Unit& u, const int (&R)[2], const int (&C)[2], unsigned (&o)[2][2]) const {
        unsigned w[2][2];
#pragma unroll
        for (int h = 0; h < 2; ++h)
#pragma unroll
            for (int i = 0; i < 2; ++i) { const int r = h * HALF + R[i]; w[h][i] = (unsigned)list[u.lbase + ((r < u.nv) ? r : 0)]; }
        asm volatile("" : "+v"(w[0][0]), "+v"(w[0][1]), "+v"(w[1][0]), "+v"(w[1][1]));
#pragma unroll
        for (int h = 0; h < 2; ++h)
#pragma unroll
            for (int i = 0; i < 2; ++i) { const int r = h * HALF + R[i]; const int tok = (r < u.nv) ? (int)(w[h][i] >> 16) : 0; o[h][i] = (unsigned)(tok * pitch + C[i] * 2); }
    }
    __device__ __forceinline__ const char* b_tile(const Unit& u) const { return Bt + ((size_t)u.e * 1024 + (size_t)u.pn * BM) * pitch; }
};
struct MoeDownProb : MoeOrder {
    static constexpr bool GATHER = false;
    const char* A; const char* Bt; int pitch;
    __device__ __forceinline__ const char* a_tile(const Unit& u) const { return A + (size_t)u.pm * BM * pitch; }
    __device__ __forceinline__ void a_offs(const Unit& u, const int (&R)[2], const int (&C)[2], unsigned (&o)[2][2]) const {
#pragma unroll
        for (int h = 0; h < 2; ++h)
#pragma unroll
            for (int i = 0; i < 2; ++i) o[h][i] = (unsigned)((u.pm * BM + h * HALF + R[i]) * pitch + C[i] * 2);
    }
    __device__ __forceinline__ const char* b_tile(const Unit& u) const { return Bt + ((size_t)u.e * 1024 + (size_t)u.pn * BM) * pitch; }
};

struct EpiNull { __device__ __forceinline__ void prefetch(const Unit&, int, int, int, int) const {}
    __device__ __forceinline__ void operator()(f32x4 (&acc)[2][2][4][2], const Unit&, int, int, int, int) const {
#pragma unroll
    for (int a = 0; a < 2; ++a)
#pragma unroll
        for (int b = 0; b < 2; ++b)
#pragma unroll
            for (int m = 0; m < 4; ++m) asm volatile("" :: "v"(acc[a][b][m][0]), "v"(acc[a][b][m][1])); } };
struct DenseProbSame : DenseProb {
    __device__ __forceinline__ void a_offs(const Unit&, const int (&R)[2], const int (&C)[2], unsigned (&o)[2][2]) const { Unit z{0, 0, 0, 0, 256}; DenseProb::a_offs(z, R, C, o); }
    __device__ __forceinline__ const char* b_tile(const Unit&) const { return Bt; }
};
struct NoHook { static constexpr int AT = -1; __device__ __forceinline__ void operator()(f32x4 (&)[2][2][4][2], const Unit&, int, int, int, int) const {} };

template <bool FP8, class Prob, class Epi, class Hook, int PM = 0>
__device__ __forceinline__ void gemm_core(LAS unsigned char* lds, const Prob& P, const Epi& E, const Hook& HK) {
    const int tid = opaque_tid(), wid = __builtin_amdgcn_readfirstlane(tid >> 6), lane = tid & 63, wr = wid >> 2, wc = wid & 3, fr = lane & 15, fq = lane >> 4;
    const int pitch = P.pitch, nt = pitch / (BK * 2);
    int R[2], C[2]; unsigned voffB[2], voffA[2];
#pragma unroll
    for (int i = 0; i < 2; ++i) { stage_rc(tid * 16 + i * 8192, R[i], C[i]); const int Rb = (R[i] & ~31) + perm32(R[i] & 31); voffB[i] = (unsigned)(Rb * pitch + C[i] * 2); voffA[i] = (unsigned)(R[i] * pitch + C[i] * 2); }
    const size_t kstep = (size_t)(BK * 2);
    const size_t hstep = (size_t)HALF * pitch;
    const unsigned ldsw = (unsigned)wid * 1024u;
    const int aoff = lds_byte(wr * 64 + fr, fq * 8), boff = lds_byte(wc * 32 + fr, fq * 8);
#define PG8_SA(b, h) (((b) * 2 + (h)) * HTB)
#define PG8_SB(b, h) ((4 + (b) * 2 + (h)) * HTB)
#define PG8_STAGE_B(bufoff, gbase) do { if constexpr (PM != 1) _Pragma("unroll") for (int _i = 0; _i < 2; ++_i) \
        __builtin_amdgcn_global_load_lds((const unsigned*)((const char*)(gbase) + voffB[_i]), (LAS unsigned*)(lds + (bufoff) + ldsw + _i * 8192), 16, 0, 0); } while (0)
#define PG8_STAGE_AG(bufoff, kb, va) do { if constexpr (PM != 1) _Pragma("unroll") for (int _i = 0; _i < 2; ++_i) \
        __builtin_amdgcn_global_load_lds((const unsigned*)(P.A + (kb) + (va)[_i]), (LAS unsigned*)(lds + (bufoff) + ldsw + _i * 8192), 16, 0, 0); } while (0)
#define PG8_STAGE_AD(bufoff, ubase) do { if constexpr (PM != 1) _Pragma("unroll") for (int _i = 0; _i < 2; ++_i) \
        __builtin_amdgcn_global_load_lds((const unsigned*)((const char*)(ubase) + voffA[_i]), (LAS unsigned*)(lds + (bufoff) + ldsw + _i * 8192), 16, 0, 0); } while (0)
#define PG8_STAGE_AC(bufoff, kb, h) do { if constexpr (Prob::GATHER) { PG8_STAGE_AG(bufoff, kb, cvA[h]); } else { PG8_STAGE_AD(bufoff, cA + (h) * hstep + (kb)); } } while (0)
#define PG8_STAGE_AN(bufoff, kb, h) do { if constexpr (Prob::GATHER) { PG8_STAGE_AG(bufoff, kb, v2[h]); } else { PG8_STAGE_AD(bufoff, (last ? nA : cA) + (h) * hstep + (kb)); } } while (0)
#define PG8_LDA(dst, b, h) do { _Pragma("unroll") for (int m = 0; m < 4; ++m) _Pragma("unroll") for (int k = 0; k < 2; ++k) { if constexpr (PM == 3) asm volatile("" : "=v"(dst[m][k])); else dst[m][k] = *(const LAS bf16x8*)(lds + PG8_SA(b, h) + aoff + m * 2048 + k * 1024); } } while (0)
#define PG8_LDB(dst, b, h) do { _Pragma("unroll") for (int n = 0; n < 2; ++n) _Pragma("unroll") for (int k = 0; k < 2; ++k) { if constexpr (PM == 3) asm volatile("" : "=v"(dst[n][k])); else dst[n][k] = *(const LAS bf16x8*)(lds + PG8_SB(b, h) + boff + n * 2048 + k * 1024); } } while (0)
#define PG8_CAT(x) __builtin_bit_cast(i32x8, __builtin_shufflevector((x)[0], (x)[1], 0, 1, 2, 3, 4, 5, 6, 7, 8, 9, 10, 11, 12, 13, 14, 15))
#define PG8_MMA(ai, bj, At, Bt) do { __builtin_amdgcn_s_setprio(1); \
        if constexpr (PM == 2) { _Pragma("unroll") for (int m = 0; m < 4; ++m) asm volatile("" :: "v"(At[m][0]), "v"(At[m][1])); _Pragma("unroll") for (int n = 0; n < 2; ++n) asm volatile("" :: "v"(Bt[n][0]), "v"(Bt[n][1])); } \
        else if constexpr (FP8) { _Pragma("unroll") for (int m = 0; m < 4; ++m) _Pragma("unroll") for (int n = 0; n < 2; ++n) \
            { const i32x8 bq_ = PG8_CAT(Bt[n]), aq_ = PG8_CAT(At[m]); \
              asm volatile("v_mfma_scale_f32_16x16x128_f8f6f4 %0, %1, %2, %0, %3, %3 op_sel_hi:[0,0,0]" : "+v"(acc[ai][bj][m][n]) : "v"(bq_), "v"(aq_), "v"(sc8)); } } \
        else { _Pragma("unroll") for (int m = 0; m < 4; ++m) _Pragma("unroll") for (int n = 0; n < 2; ++n) _Pragma("unroll") for (int k = 0; k < 2; ++k) \
            acc[ai][bj][m][n] = __builtin_amdgcn_mfma_f32_16x16x32_bf16(Bt[n][k], At[m][k], acc[ai][bj][m][n], 0, 0, 0); } \
        __builtin_amdgcn_s_setprio(0); } while (0)
#define PG8_WAIT_V(n) asm volatile("s_waitcnt vmcnt(" #n ")" ::: "memory")
#define PG8_WAIT_L(n) asm volatile("s_waitcnt lgkmcnt(" #n ")" ::: "memory")
#define PG8_BAR __builtin_amdgcn_s_barrier()
#define PG8_SCHED __builtin_amdgcn_sched_barrier(0)
    Unit cur, nxt; int ui = 0;
    if (!P.next(0, cur)) return;
    int sc8 = 0x7f7f7f7f; asm volatile("" : "+v"(sc8));
    f32x4 acc[2][2][4][2];
#pragma unroll
    for (int a = 0; a < 2; ++a)
#pragma unroll
        for (int b = 0; b < 2; ++b)
#pragma unroll
            for (int m = 0; m < 4; ++m)
#pragma unroll
                for (int n = 0; n < 2; ++n) acc[a][b][m][n] = (f32x4){0.f, 0.f, 0.f, 0.f};
    bf16x8 At[4][2], B0[2][2], B1[2][2];
    unsigned cvA[2][2], nvA[2][2];
    if constexpr (Prob::GATHER) P.a_offs(cur, R, C, cvA);
    const char* cA = P.a_tile(cur);
    const char* cB = P.b_tile(cur);
    PG8_STAGE_B(PG8_SB(0, 0), cB); PG8_STAGE_B(PG8_SB(0, 1), cB + hstep); PG8_STAGE_AC(PG8_SA(0, 0), 0, 0); PG8_STAGE_AC(PG8_SA(0, 1), 0, 1);
    if (wr == 1) PG8_BAR;
    PG8_WAIT_V(2); PG8_BAR;
    PG8_STAGE_B(PG8_SB(1, 0), cB + kstep); PG8_STAGE_AC(PG8_SA(1, 0), kstep, 0); PG8_STAGE_B(PG8_SB(1, 1), cB + hstep + kstep);
    PG8_WAIT_V(6); PG8_BAR;
    E.prefetch(cur, wr, wc, fr, fq);
    for (;;) {
        const bool has_next = P.next(ui + 1, nxt);
        if constexpr (Prob::GATHER) {
            if (has_next) P.a_offs(nxt, R, C, nvA);
            else {
#pragma unroll
                for (int h = 0; h < 2; ++h)
#pragma unroll
                    for (int i = 0; i < 2; ++i) nvA[h][i] = cvA[h][i];
            }
        }
        const char* nA = has_next ? P.a_tile(nxt) : cA;
        const char* nB = has_next ? P.b_tile(nxt) : cB;
        for (int t = 0; t < (PM == 4 ? 0 : nt); t += 2) {
            if (Hook::AT >= 0 && t == Hook::AT) HK(acc, cur, wr, wc, fr, fq);
            const bool last = (t == nt - 2);
            const size_t k1 = (size_t)(t + 1) * kstep;
            const size_t k2 = last ? 0 : (size_t)(t + 2) * kstep, k3 = k2 + kstep;
            const char* b2 = last ? nB : cB + (size_t)(t + 2) * kstep; const char* b3 = b2 + kstep;
            unsigned v2[2][2];
            if constexpr (Prob::GATHER) {
#pragma unroll
                for (int h = 0; h < 2; ++h)
#pragma unroll
                    for (int i = 0; i < 2; ++i) v2[h][i] = last ? nvA[h][i] : cvA[h][i];
            }
            PG8_LDB(B0, 0, 0); PG8_LDB(B1, 0, 1); PG8_SCHED; PG8_LDA(At, 0, 0); PG8_STAGE_AC(PG8_SA(1, 1), k1, 1);
            PG8_WAIT_V(8); PG8_WAIT_L(0); PG8_BAR; PG8_MMA(0, 0, At, B0); PG8_MMA(0, 1, At, B1); PG8_BAR; PG8_SCHED;
            PG8_LDA(At, 0, 1); PG8_STAGE_B(PG8_SB(0, 0), b2); PG8_STAGE_B(PG8_SB(0, 1), b2 + hstep); PG8_STAGE_AN(PG8_SA(0, 0), k2, 0);
            PG8_WAIT_V(8); PG8_WAIT_L(0); PG8_BAR; PG8_MMA(1, 0, At, B0); PG8_MMA(1, 1, At, B1); PG8_BAR; PG8_SCHED;
            PG8_LDB(B0, 1, 0); PG8_LDB(B1, 1, 1); PG8_SCHED; PG8_LDA(At, 1, 0); PG8_STAGE_AN(PG8_SA(0, 1), k2, 1);
            PG8_WAIT_V(8); PG8_WAIT_L(0); PG8_BAR; PG8_MMA(0, 0, At, B0); PG8_MMA(0, 1, At, B1); PG8_BAR; PG8_SCHED;
            PG8_LDA(At, 1, 1); PG8_STAGE_B(PG8_SB(1, 0), b3); PG8_STAGE_B(PG8_SB(1, 1), b3 + hstep); PG8_STAGE_AN(PG8_SA(1, 0), k3, 0);
            PG8_WAIT_V(8); PG8_WAIT_L(0); PG8_BAR; PG8_MMA(1, 0, At, B0); PG8_MMA(1, 1, At, B1); PG8_BAR; PG8_SCHED;
        }
        if (wr == 0) PG8_BAR;
        if constexpr (FP8) {
            asm volatile("s_nop 15\n\ts_nop 7" ::: "memory");
#pragma unroll
            for (int a = 0; a < 2; ++a)
#pragma unroll
                for (int b = 0; b < 2; ++b)
#pragma unroll
                    for (int m = 0; m < 4; ++m) asm volatile("" : "+v"(acc[a][b][m][0]), "+v"(acc[a][b][m][1]));
        }
        E(acc, cur, wr, wc, fr, fq);
        if (!has_next) break;
        E.prefetch(nxt, wr, wc, fr, fq);
#pragma unroll
        for (int a = 0; a < 2; ++a)
#pragma unroll
            for (int b = 0; b < 2; ++b)
#pragma unroll
                for (int m = 0; m < 4; ++m)
#pragma unroll
                    for (int n = 0; n < 2; ++n) acc[a][b][m][n] = (f32x4){0.f, 0.f, 0.f, 0.f};
        cur = nxt; cA = nA; cB = nB; ++ui;
        if constexpr (Prob::GATHER) {
#pragma unroll
            for (int h = 0; h < 2; ++h)
#pragma unroll
                for (int i = 0; i < 2; ++i) cvA[h][i] = nvA[h][i];
        }
        if (wr == 1) PG8_BAR;
    }
    PG8_WAIT_V(0);
    PG8_BAR;
#undef PG8_SA
#undef PG8_SB
#undef PG8_STAGE_AG
#undef PG8_STAGE_AD
#undef PG8_STAGE_AC
#undef PG8_STAGE_AN
#undef PG8_STAGE_B
#undef PG8_LDA
#undef PG8_LDB
#undef PG8_MMA
#undef PG8_CAT
#undef PG8_WAIT_V
#undef PG8_WAIT_L
#undef PG8_BAR
#undef PG8_SCHED
}

__device__ __forceinline__ void pair_store16(unsigned char* p, size_t r8, const u32x4& A, const u32x4& B) {
    u32x4 s1, s2;
    s1.x = __builtin_amdgcn_update_dpp(A.x, B.x, 0x128, 0xf, 0xc, false); s1.y = __builtin_amdgcn_update_dpp(A.y, B.y, 0x128, 0xf, 0xc, false);
    s1.z = __builtin_amdgcn_update_dpp(A.z, B.z, 0x128, 0xf, 0xc, false); s1.w = __builtin_amdgcn_update_dpp(A.w, B.w, 0x128, 0xf, 0xc, false);
    s2.x = __builtin_amdgcn_update_dpp(B.x, A.x, 0x128, 0xf, 0x3, false); s2.y = __builtin_amdgcn_update_dpp(B.y, A.y, 0x128, 0xf, 0x3, false);
    s2.z = __builtin_amdgcn_update_dpp(B.z, A.z, 0x128, 0xf, 0x3, false); s2.w = __builtin_amdgcn_update_dpp(B.w, A.w, 0x128, 0xf, 0x3, false);
    *(u32x4*)p = s1; *(u32x4*)(p + r8) = s2;
}
__device__ __forceinline__ u32x4 pack8(const f32x4& v0, const f32x4& v1) { u32x4 w; w.x = cvt_pk_bf16(v0[0], v0[1]); w.y = cvt_pk_bf16(v0[2], v0[3]); w.z = cvt_pk_bf16(v1[0], v1[1]); w.w = cvt_pk_bf16(v1[2], v1[3]); return w; }

struct EpiStoreOnly {
    bf16_t* O;
    __device__ __forceinline__ void prefetch(const Unit&, int, int, int, int) const {}
    __device__ __forceinline__ void operator()(f32x4 (&acc)[2][2][4][2], const Unit& u, int wr, int wc, int fr, int fq) const {
        const int cl0 = wc * 32 + 8 * fq; int row0 = u.pm * BM + wr * 64 + fr; asm volatile("" : "+v"(row0));
#pragma unroll
        for (int ai = 0; ai < 2; ++ai)
#pragma unroll
            for (int m = 0; m < 4; ++m) { bf16_t* rowp = O + (size_t)(row0 + ai * HALF + m * 16) * 256 + cl0;
#pragma unroll
                for (int bj = 0; bj < 2; ++bj) *(u32x4*)(rowp + bj * HALF) = pack8(acc[ai][bj][m][0], acc[ai][bj][m][1]); }
    }
};
#define EPI_ST(val, ptr) do { if constexpr (MODE == 1) { auto v_ = (val); asm volatile("" :: "v"(v_)); } else *(ptr) = (val); } while (0)
template <int MODE> struct EpiInProjT {
    bf16_t *UV, *Q, *Kb, *Vb; unsigned char* G8; const float* cs; unsigned char *Q8, *K8;
    __device__ __forceinline__ void prefetch(const Unit&, int, int, int, int) const {}
    template <class PT> __device__ __forceinline__ void st_pair(PT* p, int pitch, const u32x4& A, const u32x4& B) const {
        if constexpr (MODE == 1) { asm volatile("" :: "v"(A), "v"(B)); } else pair_store16((unsigned char*)p, (size_t)8 * pitch * sizeof(PT), A, B); }
    __device__ __forceinline__ void operator()(f32x4 (&acc)[2][2][4][2], const Unit& u, int wr, int wc, int fr, int fq) const {
        constexpr bool NOMATH = (MODE == 2);
        const int pn = u.pn; int row0 = u.pm * BM + wr * 64 + fr; asm volatile("" : "+v"(row0));
        int prow0 = row0 - (fr & 8), pcl = wc * 64 + 8 * fq + 4 * (fr & 8);
        asm volatile("" : "+v"(prow0), "+v"(pcl));
        if (pn < 4) {
#pragma unroll
            for (int ai = 0; ai < 2; ++ai)
#pragma unroll
                for (int m = 0; m < 4; ++m) { u32x4 w[2];
#pragma unroll
                    for (int bj = 0; bj < 2; ++bj) { f32x4 v0 = acc[ai][bj][m][0], v1 = acc[ai][bj][m][1];
                        if constexpr (!NOMATH) { const f32x2 a = gelu_tanh2(v0.xy), b = gelu_tanh2(v0.zw), c = gelu_tanh2(v1.xy), d = gelu_tanh2(v1.zw); v0 = (f32x4){a.x, a.y, b.x, b.y}; v1 = (f32x4){c.x, c.y, d.x, d.y}; }
                        w[bj] = pack8(v0, v1); }
                    st_pair(UV + (size_t)(prow0 + ai * HALF + m * 16) * 1024 + pn * 256 + pcl, 1024, w[0], w[1]); }
        } else if (pn < 8) {
            bf16_t* dst = (pn < 6) ? Q : Kb; const float sc = (pn < 6) ? C2 : 1.0f;
            const float sgn = (fq == 0) ? -1.0f : 1.0f; const bool rot_lane = fq < 2;
#pragma unroll
            for (int ai = 0; ai < 2; ++ai) {
                f32x4 cs4[4][4];
#pragma unroll
                for (int m = 0; m < 4; ++m) { const f32x4* cp = (const f32x4*)(cs + (size_t)(row0 + ai * HALF + m * 16) * 16);
#pragma unroll
                    for (int j = 0; j < 4; ++j) cs4[m][j] = cp[j]; }
#pragma unroll
                for (int m = 0; m < 4; ++m) { const int row = row0 + ai * HALF + m * 16; f32x4 v[2][2];
#pragma unroll
                    for (int bj = 0; bj < 2; ++bj) { v[bj][0] = acc[ai][bj][m][0]; v[bj][1] = acc[ai][bj][m][1]; }
                    if constexpr (!NOMATH) {
                        f32x4 p0, p1;
#pragma unroll
                        for (int e = 0; e < 4; ++e) { p0[e] = __shfl_xor(v[0][0][e], 16); p1[e] = __shfl_xor(v[0][1][e], 16); }
                        if (rot_lane) {
#pragma unroll
                            for (int e = 0; e < 4; ++e) { v[0][0][e] = v[0][0][e] * cs4[m][0][e] + sgn * p0[e] * cs4[m][2][e]; v[0][1][e] = v[0][1][e] * cs4[m][1][e] + sgn * p1[e] * cs4[m][3][e]; }
                        }
                    }
                    if ((wc & 1) == 0) {
                        st_pair(dst + (size_t)(prow0 + ai * HALF + m * 16) * 512 + (pn & 1) * 256 + pcl, 512, pack8(v[0][0] * sc, v[0][1] * sc), pack8(v[1][0] * sc, v[1][1] * sc));
                    } else {
                        const float s8 = (pn < 6) ? sc * 8.0f : 1.0f;
#pragma unroll
                        for (int bj = 0; bj < 2; ++bj) { const f32x4 v0 = v[bj][0] * s8, v1 = v[bj][1] * s8;
                            u32x2 q8; q8.x = cvt_pk4_fp8(v0[0], v0[1], v0[2], v0[3]); q8.y = cvt_pk4_fp8(v1[0], v1[1], v1[2], v1[3]);
                            EPI_ST(q8, (u32x2*)(((pn < 6) ? Q8 : K8) + (size_t)row * 256 + ((pn & 1) * 2 + (wc >> 1)) * 64 + bj * 32 + 8 * fq)); } } }
            }
        } else if (pn < 10) {
#pragma unroll
            for (int ai = 0; ai < 2; ++ai)
#pragma unroll
                for (int m = 0; m < 4; ++m)
                    st_pair(Vb + (size_t)(prow0 + ai * HALF + m * 16) * 512 + (pn - 8) * 256 + pcl, 512, pack8(acc[ai][0][m][0], acc[ai][0][m][1]), pack8(acc[ai][1][m][0], acc[ai][1][m][1]));
        } else {
            int gl = (fq * 16 + fr) * 16; asm volatile("" : "+v"(gl));
            unsigned char* gb = G8 + (size_t)((u.pm * 8 + (pn - 10)) * 8 + wr * 4 + wc) * 8192 + gl;
#pragma unroll
            for (int ai = 0; ai < 2; ++ai)
#pragma unroll
                for (int m = 0; m < 4; ++m) { u32x4 qq;
#pragma unroll
                    for (int bj = 0; bj < 2; ++bj) { f32x4 v0 = acc[ai][bj][m][0], v1 = acc[ai][bj][m][1];
                        if constexpr (!NOMATH) { const f32x2 a = sig255_2(v0.xy), b = sig255_2(v0.zw), c = sig255_2(v1.xy), d = sig255_2(v1.zw); v0 = (f32x4){a.x, a.y, b.x, b.y}; v1 = (f32x4){c.x, c.y, d.x, d.y}; }
                        const unsigned qa = cvt_pk4_u8(v0[0], v0[1], v0[2], v0[3]), qb = cvt_pk4_u8(v1[0], v1[1], v1[2], v1[3]);
                        if (bj == 0) { qq.x = qa; qq.y = qb; } else { qq.z = qa; qq.w = qb; } }
                    EPI_ST(qq, (u32x4*)(gb + (ai * 4 + m) * 1024)); }
        }
    }
};

#undef EPI_ST
using EpiInProj = EpiInProjT<0>;
__device__ __forceinline__ void unpack8(const u32x4& w, f32x4& a, f32x4& b) { a = (f32x4){bf_lo(w.x), bf_hi(w.x), bf_lo(w.y), bf_hi(w.y)}; b = (f32x4){bf_lo(w.z), bf_hi(w.z), bf_lo(w.w), bf_hi(w.w)}; }
struct HookMerge {
    static constexpr int AT = 8;
    const unsigned char* G8;
    __device__ __forceinline__ void operator()(f32x4 (&acc)[2][2][4][2], const Unit& u, int wr, int wc, int fr, int fq) const {
        const unsigned char* gp = G8 + (size_t)((u.pm * 8 + u.pn) * 8 + wr * 4 + wc) * 8192 + ((fq >> 1) * 16 + fr) * 16 + 8 * (fq & 1); asm volatile("" : "+v"(gp));
        u32x2 w0[2][4][2], w1[2][4][2];
#pragma unroll
        for (int ai = 0; ai < 2; ++ai)
#pragma unroll
            for (int m = 0; m < 4; ++m)
#pragma unroll
                for (int bj = 0; bj < 2; ++bj) { w0[ai][m][bj] = *(const u32x2*)(gp + (ai * 4 + m) * 1024 + bj * 512); w1[ai][m][bj] = *(const u32x2*)(gp + 4 * 65536 + (ai * 4 + m) * 1024 + bj * 512); }
#pragma unroll
        for (int ai = 0; ai < 2; ++ai)
#pragma unroll
            for (int m = 0; m < 4; ++m)
#pragma unroll
                for (int bj = 0; bj < 2; ++bj) { const f32x4 a0 = u8x4_to_f32(w0[ai][m][bj].x), a1 = u8x4_to_f32(w0[ai][m][bj].y), b0 = u8x4_to_f32(w1[ai][m][bj].x), b1 = u8x4_to_f32(w1[ai][m][bj].y);
#pragma unroll
                    for (int e = 0; e < 4; ++e) { acc[ai][bj][m][0][e] *= a0[e] * fast_rcp(fmaxf(b0[e], 0.5f)); acc[ai][bj][m][1][e] *= a1[e] * fast_rcp(fmaxf(b1[e], 0.5f)); } }
    }
};
struct EpiMerge {
    const unsigned char* G8; bf16_t* MG;
    __device__ __forceinline__ void prefetch(const Unit&, int, int, int, int) const {}
    __device__ __forceinline__ void operator()(f32x4 (&acc)[2][2][4][2], const Unit& u, int wr, int wc, int fr, int fq) const {
        const unsigned char* gp = G8 + (size_t)((u.pm * 8 + u.pn + 4) * 8 + wr * 4 + wc) * 8192 + ((fq >> 1) * 16 + fr) * 16 + 8 * (fq & 1); asm volatile("" : "+v"(gp));
        int prow0 = u.pm * BM + wr * 64 + (fr & 7), pcol = u.pn * BM + wc * 64 + 8 * fq + 4 * (fr & 8); asm volatile("" : "+v"(prow0), "+v"(pcol));
        u32x2 w1[2][4][2];
#pragma unroll
        for (int ai = 0; ai < 2; ++ai)
#pragma unroll
            for (int m = 0; m < 4; ++m)
#pragma unroll
                for (int bj = 0; bj < 2; ++bj) w1[ai][m][bj] = *(const u32x2*)(gp + (ai * 4 + m) * 1024 + bj * 512);
        const float s255 = 1.0f / 255.0f;
#pragma unroll
        for (int ai = 0; ai < 2; ++ai)
#pragma unroll
            for (int m = 0; m < 4; ++m) { u32x4 w[2];
#pragma unroll
                for (int bj = 0; bj < 2; ++bj) { f32x4 b0 = u8x4_to_f32(w1[ai][m][bj].x), b1 = u8x4_to_f32(w1[ai][m][bj].y);
#pragma unroll
                    for (int e = 0; e < 4; ++e) { b0[e] = fmaxf(b0[e], 0.5f) * s255; b1[e] = fmaxf(b1[e], 0.5f) * s255; }
                    w[bj] = pack8(acc[ai][bj][m][0] * b0, acc[ai][bj][m][1] * b1); }
                pair_store16((unsigned char*)(MG + (size_t)(prow0 + ai * HALF + m * 16) * 1024 + pcol), (size_t)8 * 1024 * 2, w[0], w[1]); }
    }
};

struct EpiX1 {
    const float* X; bf16_t* XB; unsigned char* XB8; float* ssq;
    __device__ __forceinline__ void prefetch(const Unit&, int, int, int, int) const {}
    __device__ __forceinline__ void operator()(f32x4 (&acc)[2][2][4][2], const Unit& u, int wr, int wc, int fr, int fq) const {
        const int col0 = u.pn * BM + wc * 64 + 8 * fq; int row0 = u.pm * BM + wr * 64 + fr; asm volatile("" : "+v"(row0));
#pragma unroll
        for (int ai = 0; ai < 2; ++ai) {
            f32x4 xv[4][2][2];
#pragma unroll
            for (int m = 0; m < 4; ++m) { const float* xp = X + (size_t)(row0 + ai * HALF + m * 16) * 1024 + col0;
#pragma unroll
                for (int bj = 0; bj < 2; ++bj) { xv[m][bj][0] = *(const f32x4*)(xp + bj * 32); xv[m][bj][1] = *(const f32x4*)(xp + bj * 32 + 4); } }
#pragma unroll
            for (int m = 0; m < 4; ++m) { const size_t row = (size_t)(row0 + ai * HALF + m * 16); u32x4 wb[2];
                float s = 0.f;
#pragma unroll
                for (int bj = 0; bj < 2; ++bj) { const f32x4 v0 = acc[ai][bj][m][0] + xv[m][bj][0], v1 = acc[ai][bj][m][1] + xv[m][bj][1];
                    wb[bj] = pack8(v0, v1);
                    { u32x2 q8; q8.x = cvt_pk4_fp8(v0[0], v0[1], v0[2], v0[3]); q8.y = cvt_pk4_fp8(v1[0], v1[1], v1[2], v1[3]); *(u32x2*)(XB8 + row * 1024 + col0 + bj * 32) = q8; }
                    s += (v0[0] * v0[0] + v0[1] * v0[1]) + (v0[2] * v0[2] + v0[3] * v0[3]) + (v1[0] * v1[0] + v1[1] * v1[1]) + (v1[2] * v1[2] + v1[3] * v1[3]); }
                pair_store16((unsigned char*)(XB + (row - (fr & 8)) * 1024 + col0 + 4 * (fr & 8)), (size_t)8 * 1024 * 2, wb[0], wb[1]);
                s += __shfl_xor(s, 16); s += __shfl_xor(s, 32);
                if (fq == 0) ssq[row * 16 + u.pn * 4 + wc] = s; }
        }
    }
};

struct EpiMoeUp {
    const int* list; const float* rstd; unsigned char* H8;
    mutable float rs[2][4];
    __device__ __forceinline__ void prefetch(const Unit& u, int wr, int wc, int fr, int fq) const {
        int r0 = wr * 64 + fr; asm volatile("" : "+v"(r0));
        int tok[2][4]; unsigned w[2][4];
#pragma unroll
        for (int ai = 0; ai < 2; ++ai)
#pragma unroll
            for (int m = 0; m < 4; ++m) { const int r = r0 + ai * HALF + m * 16; w[ai][m] = (unsigned)list[u.lbase + ((r < u.nv) ? r : 0)]; }
#pragma unroll
        for (int ai = 0; ai < 2; ++ai) asm volatile("" : "+v"(w[ai][0]), "+v"(w[ai][1]), "+v"(w[ai][2]), "+v"(w[ai][3]));
#pragma unroll
        for (int ai = 0; ai < 2; ++ai)
#pragma unroll
            for (int m = 0; m < 4; ++m) { const int r = r0 + ai * HALF + m * 16; tok[ai][m] = (r < u.nv) ? (int)(w[ai][m] >> 16) : 0; }
#pragma unroll
        for (int ai = 0; ai < 2; ++ai)
#pragma unroll
            for (int m = 0; m < 4; ++m) rs[ai][m] = rstd[tok[ai][m]];
    }
    __device__ __forceinline__ void pin() const {
#pragma unroll
        for (int ai = 0; ai < 2; ++ai) asm volatile("" : "+v"(rs[ai][0]), "+v"(rs[ai][1]), "+v"(rs[ai][2]), "+v"(rs[ai][3])); }
    __device__ __forceinline__ void operator()(f32x4 (&acc)[2][2][4][2], const Unit& u, int wr, int wc, int fr, int fq) const {
        const int col0 = u.pn * 128 + wc * 32 + 8 * fq; int r0 = wr * 64 + fr; asm volatile("" : "+v"(r0));
#pragma unroll
        for (int ai = 0; ai < 2; ++ai)
#pragma unroll
            for (int m = 0; m < 4; ++m) { const int r = r0 + ai * HALF + m * 16; const float rsv = rs[ai][m] * 0.015625f;
                f32x4 g0 = acc[ai][0][m][0] * rsv, g1 = acc[ai][0][m][1] * rsv, u0 = acc[ai][1][m][0] * rsv, u1 = acc[ai][1][m][1] * rsv;
#pragma unroll
                for (int e = 0; e < 4; ++e) { g0[e] = g0[e] * sigmoidf_(g0[e]) * (u0[e] * 8.f); g1[e] = g1[e] * sigmoidf_(g1[e]) * (u1[e] * 8.f); }
                u32x2 q8; q8.x = cvt_pk4_fp8(g0[0], g0[1], g0[2], g0[3]); q8.y = cvt_pk4_fp8(g1[0], g1[1], g1[2], g1[3]);
                *(u32x2*)(H8 + (size_t)(u.pm * BM + r) * 512 + col0) = q8; }
    }
};
struct EpiMoeDown {
    const int* list; unsigned char* YB8;
    mutable unsigned lw[2][4];
    __device__ __forceinline__ void prefetch(const Unit& u, int wr, int wc, int fr, int fq) const {
        int r0 = wr * 64 + fr; asm volatile("" : "+v"(r0));
#pragma unroll
        for (int ai = 0; ai < 2; ++ai)
#pragma unroll
            for (int m = 0; m < 4; ++m) { const int r = r0 + ai * HALF + m * 16; lw[ai][m] = (unsigned)list[u.lbase + ((r < u.nv) ? r : 0)]; }
    }
    __device__ __forceinline__ void pin() const {
#pragma unroll
        for (int ai = 0; ai < 2; ++ai) asm volatile("" : "+v"(lw[ai][0]), "+v"(lw[ai][1]), "+v"(lw[ai][2]), "+v"(lw[ai][3])); }
    __device__ __forceinline__ void operator()(f32x4 (&acc)[2][2][4][2], const Unit& u, int wr, int wc, int fr, int fq) const {
        int r0 = wr * 64 + fr; asm volatile("" : "+v"(r0));
        const int col0 = u.pn * BM + wc * 64 + 16 * fq;
#pragma unroll
        for (int ai = 0; ai < 2; ++ai)
#pragma unroll
            for (int m = 0; m < 4; ++m) { const unsigned word = lw[ai][m];
                if (r0 + ai * HALF + m * 16 < u.nv) { const float w = __uint_as_float((word & 0x7fffu) << 16) * 0.0625f;
                    unsigned char* op = YB8 + (size_t)(word >> 15) * 1024 + col0; u32x4 q;
                    { const f32x4 y0 = acc[ai][0][m][0] * w, y1 = acc[ai][0][m][1] * w; q.x = cvt_pk4_fp8(y0[0], y0[1], y0[2], y0[3]); q.y = cvt_pk4_fp8(y1[0], y1[1], y1[2], y1[3]); }
                    { const f32x4 y0 = acc[ai][1][m][0] * w, y1 = acc[ai][1][m][1] * w; q.z = cvt_pk4_fp8(y0[0], y0[1], y0[2], y0[3]); q.w = cvt_pk4_fp8(y1[0], y1[1], y1[2], y1[3]); }
                    *(u32x4*)op = q; } }
    }
};
template <class Epi> struct HookPin { static constexpr int AT = 2; const Epi* E;
    __device__ __forceinline__ void operator()(f32x4 (&)[2][2][4][2], const Unit&, int, int, int, int) const { E->pin(); } };
}


namespace att {
constexpr int QB = 256, KVB = 64, QP = 512  ;
#if PROBE_PHASE == 52
#define ATT_REF_OFF 0.0f
#else
#define ATT_REF_OFF 0.0f
#endif
constexpr int KSLOT = 8192, VSLOT = 8192, NSLOT = 3;
constexpr int L_K = 0, L_V = NSLOT * KSLOT, L_WS = L_V + NSLOT * VSLOT, L_OST = L_WS + NWAVES * 256, L_END = L_OST + NWAVES * 8192;
static_assert(L_END <= RING_BYTES, "attention LDS");
#if PROBE_PHASE == 40
#define ATT_RESC_THR 0.f
#define ATT_RESC_MIN 0.001f
#define ATT_RESC_LO -2.f
#else
#define ATT_RESC_THR 512.f
#define ATT_RESC_MIN 64.f
#define ATT_RESC_LO 0.f
#endif
__device__ __forceinline__ int crow(int r, int hi) { return (r & 3) + 8 * (r >> 2) + 4 * hi; }
__device__ __forceinline__ void glds16(const void* gsrc, unsigned lds_dst) { unsigned keep;
    asm volatile("s_mov_b32 %0, m0\n\ts_mov_b32 m0, %2\n\ts_nop 0\n\tglobal_load_lds_dwordx4 %1, off\n\ts_mov_b32 m0, %0" : "=&s"(keep) : "v"(gsrc), "s"(lds_dst) : "memory"); }
#define ATT_WAIT_BAR(N) asm volatile("s_waitcnt vmcnt(" #N ") lgkmcnt(0)\n\ts_barrier" ::: "memory")
#define MX3(a, b, c) __builtin_fmaxf(__builtin_fmaxf((a), (b)), (c))
#define ATT_SBAR() __builtin_amdgcn_sched_barrier(0)
#define ATT_MFMA(a, b, c) __builtin_amdgcn_mfma_f32_32x32x16_bf16(a, b, c, 0, 0, 0)
__device__ __forceinline__ float rowmax(const f32x16& p0, const f32x16& p1) {
    float a = MX3(p0[0], p0[1], p1[0]), b = MX3(p0[2], p0[3], p1[1]); a = MX3(a, p1[2], p1[3]);
#pragma unroll
    for (int r = 4; r < 16; r += 4) { a = MX3(a, p0[r], p0[r + 1]); b = MX3(b, p0[r + 2], p0[r + 3]); a = MX3(a, p1[r], p1[r + 1]); b = MX3(b, p1[r + 2], p1[r + 3]); }
    const float m = __builtin_fmaxf(a, b); auto rr = __builtin_amdgcn_permlane32_swap(__float_as_uint(m), __float_as_uint(m), false, false);
    return __builtin_fmaxf(__uint_as_float(rr[0]), __uint_as_float(rr[1])); }
__device__ __forceinline__ void cmask(f32x16& p0, f32x16& p1, int jb, int qrel, int hi) {
    const int kb = 64 * jb + 4 * hi;
#pragma unroll
    for (int r = 0; r < 16; ++r) { const int kv = kb + (r & 3) + 8 * (r >> 2); if (kv > qrel) p0[r] = -INFINITY; if (kv + 32 > qrel) p1[r] = -INFINITY; } }
typedef int i32x4 __attribute__((ext_vector_type(4)));
__device__ __forceinline__ void kload2(bf16x8* kf, const LAS char* kp, int j) { kf[2 * j] = *(const LAS bf16x8*)(kp + j * 2048); kf[2 * j + 1] = *(const LAS bf16x8*)(kp + j * 2048 + 512); }
__device__ __forceinline__ i32x8 frag32(const LAS char* row, int c0) {
    const i32x4 lo = *(const LAS i32x4*)(row + c0 * 16), hi = *(const LAS i32x4*)(row + (c0 ^ 1) * 16);
    return __builtin_shufflevector(lo, hi, 0, 1, 2, 3, 4, 5, 6, 7); }
#define MFMA8_PV(O, A, B) asm volatile("v_mfma_scale_f32_32x32x64_f8f6f4 %0, %1, %2, %0, %3, %3 op_sel_hi:[0,0,0]" : "+v"(O) : "v"(A), "v"(B), "v"(sc_1))
template <int MODE> __device__ __forceinline__ void attn_pass(f32x16 (&o)[4], int b, int hm, int h, int qb, const bf16_t* Q, const bf16_t* __restrict__ K, const unsigned char* __restrict__ V8T, LAS char* shm) {
    const int tid = opaque_tid(), lane = tid & 63, r32 = lane & 31, hi = lane >> 5; const int wid = __builtin_amdgcn_readfirstlane(tid >> 6);
    const long rowbase = (long)b * SEQ; const int q0 = qb * QB, NT = (q0 + QB) / KVB;
    const bf16_t* Qw = Q + (rowbase + q0 + wid * 32) * QP + hm * 64;
    const bf16_t* Kh = K + rowbase * QP + hm * 64;
    const unsigned lds0 = (unsigned)(uintptr_t)shm;
    LAS float* wsf = (LAS float*)(shm + L_WS) + wid * 64;
    const bf16_t* ksrc = Kh + (long)lane * QP + wid * 8;
    const unsigned char* vsrc = V8T + ((size_t)(b * 4 + h) * (SEQ / KVB)) * VSLOT + wid * 1024 + lane * 16;
    const unsigned kdst = lds0 + L_K + wid * 1024, vdst = lds0 + L_V + wid * 1024;
#define DMA_K(t, s) glds16(ksrc + (long)(t) * KVB * QP, (unsigned)__builtin_amdgcn_readfirstlane(kdst + (unsigned)(s) * KSLOT))
#define DMA_V(t, s) glds16(vsrc + (long)(t) * VSLOT, (unsigned)__builtin_amdgcn_readfirstlane(vdst + (unsigned)(s) * VSLOT))
    const LAS char* kp0 = shm + L_K + hi * 1024 + r32 * 16;
    const LAS char* vp0 = shm + L_V + r32 * 64;  const int vc0 = (2 * hi) ^ ((r32 >> 2) & 3);
    DMA_K(0, 0); DMA_V(0, 0); DMA_K(1, 1);
    bf16x8 qr[4];
#pragma unroll
    for (int d0 = 0; d0 < 4; ++d0) qr[d0] = *(const bf16x8*)(Qw + (long)r32 * QP + d0 * 16 + hi * 8);
    float mhat = 0.f, l_reg = 0.f;
    float zf = 0.f; asm volatile("" : "+v"(zf));
    int sc_1 = 0x7f7f7f7f; asm volatile("" : "+v"(sc_1));
    f32x16 negm;
#pragma unroll
    for (int r = 0; r < 16; ++r) { negm[r] = zf;
#pragma unroll
        for (int d0 = 0; d0 < 4; ++d0) o[d0][r] = zf; }
    asm volatile("" : "+v"(negm));
    const int qrel = wid * 32 + r32;
    asm volatile("" : "+v"(qr[0]), "+v"(qr[1]), "+v"(qr[2]), "+v"(qr[3]));
    LAS bf16x8* qlds = (LAS bf16x8*)(shm + L_OST + wid * 8192) + lane;
#pragma unroll
    for (int d0 = 0; d0 < 4; ++d0) qlds[d0 * 64] = qr[d0];
    DMA_K(2, 2);
    ATT_WAIT_BAR(1);
    bool resc = false;
#define CMASK(P0, P1, t) do { const int jb_ = (t) - (NT - 4); if (jb_ >= 0) cmask(P0, P1, jb_, qrel, hi); } while (0)
#define RESC() do { if (resc) { asm volatile("s_waitcnt lgkmcnt(0)\n\ts_nop 15\n\ts_nop 15\n\ts_nop 7" ::: "memory"); \
        _Pragma("unroll") for (int r = 0; r < 16; ++r) { const float fr_ = wsf[crow(r, hi)]; _Pragma("unroll") for (int d_ = 0; d_ < 4; ++d_) asm volatile("v_mul_f32 %0, %0, %1" : "+v"(o[d_][r]) : "v"(fr_)); } } } while (0)
    f32x16 pA0, pA1, pB0, pB1;
    int sl_prev = 0, sl_cur = 0, sl_next = 1;
#define ROT() do { sl_prev = sl_cur; sl_cur = sl_next; sl_next = (sl_next == NSLOT - 1) ? 0 : sl_next + 1; } while (0)
    bf16x8 kf[8];
#pragma unroll
    for (int j = 0; j < 4; ++j) kload2(kf, kp0, j);
    pA0 = ATT_MFMA(kf[0], qr[0], negm); pA1 = ATT_MFMA(kf[1], qr[0], negm);
#pragma unroll
    for (int d0 = 1; d0 < 4; ++d0) { pA0 = ATT_MFMA(kf[2 * d0], qr[d0], pA0); pA1 = ATT_MFMA(kf[2 * d0 + 1], qr[d0], pA1); }
    CMASK(pA0, pA1, 0);
    { const float rm = rowmax(pA0, pA1) - ATT_REF_OFF; mhat = rm;
#pragma unroll
      for (int r = 0; r < 16; ++r) { pA0[r] -= rm; pA1[r] -= rm; negm[r] = -rm; }
      asm volatile("" : "+v"(negm));
#pragma unroll
      for (int r = 0; r < 16; ++r) { pA0[r] = fast_exp2(pA0[r]); pA1[r] = fast_exp2(pA1[r]); } }
    ATT_WAIT_BAR(0);
    DMA_K(3, 0); DMA_V(1, 1);
    ROT();
#pragma unroll
    for (int j = 0; j < 4; ++j) kload2(kf, kp0 + sl_cur * KSLOT, j);
    ATT_WAIT_BAR(2);
    i32x8 vf[4], pf;
#define PK4(P, B) cvt_pk4_fp8(P[B], P[(B) + 1], P[(B) + 2], P[(B) + 3])
#define PIN(x) asm volatile("" : "+v"(x))
#define GAPA(MF, P, B, W) do { MF; sacc += P[B]; sacc += P[(B) + 1]; sacc += P[(B) + 2]; sacc += P[(B) + 3]; PIN(sacc); pf[W] = PK4(P, B); PIN(pf); ATT_SBAR(); } while (0)
#define EXP8(X, B) do { X[B] = fast_exp2(X[B]); X[(B) + 1] = fast_exp2(X[(B) + 1]); X[(B) + 2] = fast_exp2(X[(B) + 2]); X[(B) + 3] = fast_exp2(X[(B) + 3]); \
        X[(B) + 4] = fast_exp2(X[(B) + 4]); X[(B) + 5] = fast_exp2(X[(B) + 5]); X[(B) + 6] = fast_exp2(X[(B) + 6]); X[(B) + 7] = fast_exp2(X[(B) + 7]); PIN(X); } while (0)
#define STEP(C0, C1, P0, P1, t, GK, GV, GL) do { ATT_SBAR(); \
    const LAS char* vp_ = vp0 + sl_prev * VSLOT; \
    float sacc = 0.f; \
    bf16x8 qa_ = qlds[0], qb_ = qlds[64]; ATT_SBAR(); \
    GAPA(C0 = ATT_MFMA(kf[0], qa_, negm), P0, 0, 0); \
    GAPA(C1 = ATT_MFMA(kf[1], qa_, negm), P0, 4, 1); \
    qa_ = qlds[128]; ATT_SBAR(); \
    GAPA(C0 = ATT_MFMA(kf[2], qb_, C0), P0, 8, 2); \
    GAPA(C1 = ATT_MFMA(kf[3], qb_, C1), P0, 12, 3); \
    qb_ = qlds[192]; ATT_SBAR(); \
    vf[0] = frag32(vp_, vc0); ATT_SBAR(); GAPA(C0 = ATT_MFMA(kf[4], qa_, C0), P1, 0, 4); \
    vf[1] = frag32(vp_ + 32 * 64, vc0); ATT_SBAR(); GAPA(C1 = ATT_MFMA(kf[5], qa_, C1), P1, 4, 5); \
    vf[2] = frag32(vp_ + 64 * 64, vc0); ATT_SBAR(); GAPA(C0 = ATT_MFMA(kf[6], qb_, C0), P1, 8, 6); \
    vf[3] = frag32(vp_ + 96 * 64, vc0); ATT_SBAR(); GAPA(C1 = ATT_MFMA(kf[7], qb_, C1), P1, 12, 7); \
    l_reg += sacc; \
    if (GK) { DMA_K((t) + 3, sl_cur); } if (GV) { DMA_V((t) + 1, sl_next); } \
    CMASK(C0, C1, t); \
    {   \
      float st_; { auto rr = __builtin_amdgcn_permlane32_swap(__float_as_uint(sacc), __float_as_uint(sacc), false, false); st_ = __uint_as_float(rr[0]) + __uint_as_float(rr[1]); } \
      resc = false; \
      if (__builtin_expect(__any(st_ > ATT_RESC_THR), 0)) { const float dl = (st_ > ATT_RESC_MIN) ? __builtin_fmaxf(__builtin_floorf(__builtin_amdgcn_logf(st_)) - 6.f, ATT_RESC_LO) : 0.f; mhat += dl; \
        _Pragma("unroll") for (int r = 0; r < 16; ++r) { asm volatile("v_sub_f32 %0, %0, %1" : "+v"(C0[r]) : "v"(dl)); asm volatile("v_sub_f32 %0, %0, %1" : "+v"(C1[r]) : "v"(dl)); } \
        _Pragma("unroll") for (int r = 0; r < 16; ++r) negm[r] = -mhat; asm volatile("" : "+v"(negm)); \
        const float f = fast_exp2(-dl); l_reg *= f; if (hi == 0) wsf[r32] = f; resc = true; } } \
    ATT_SBAR(); \
    MFMA8_PV(o[0], pf, vf[0]); EXP8(C0, 0); if (GL) { kload2(kf, kp0 + sl_next * KSLOT, 0); } ATT_SBAR(); \
    MFMA8_PV(o[1], pf, vf[1]); EXP8(C0, 8); if (GL) { kload2(kf, kp0 + sl_next * KSLOT, 1); } ATT_SBAR(); \
    MFMA8_PV(o[2], pf, vf[2]); EXP8(C1, 0); if (GL) { kload2(kf, kp0 + sl_next * KSLOT, 2); } ATT_SBAR(); \
    MFMA8_PV(o[3], pf, vf[3]); EXP8(C1, 8); if (GL) { kload2(kf, kp0 + sl_next * KSLOT, 3); } ATT_SBAR(); \
    } while (0)
    int t = 1;
#undef CMASK
#define CMASK(P0, P1, t) do {} while (0)
    for (; t + 5 < NT; t += 2) {
        STEP(pB0, pB1, pA0, pA1, t, true, true, true);       if (MODE == 3) { asm volatile("s_waitcnt lgkmcnt(0)" ::: "memory"); } else { ATT_WAIT_BAR(2); } RESC(); ROT();
        STEP(pA0, pA1, pB0, pB1, t + 1, true, true, true);   if (MODE == 3) { asm volatile("s_waitcnt lgkmcnt(0)" ::: "memory"); } else { ATT_WAIT_BAR(2); } RESC(); ROT();
    }
#undef CMASK
#define CMASK(P0, P1, t) do { const int jb_ = (t) - (NT - 4); if (jb_ >= 0) cmask(P0, P1, jb_, qrel, hi); } while (0)
#define ENDW(tt) do { if ((tt) + 3 < NT) { ATT_WAIT_BAR(2); } else if ((tt) + 2 < NT) { ATT_WAIT_BAR(1); } else { ATT_WAIT_BAR(0); } } while (0)
    for (; t + 1 < NT; t += 2) {
        STEP(pB0, pB1, pA0, pA1, t, (t + 3 < NT), (t + 1 < NT), (t + 1 < NT));       ENDW(t);     RESC(); ROT();
        STEP(pA0, pA1, pB0, pB1, t + 1, (t + 4 < NT), (t + 2 < NT), (t + 2 < NT));   ENDW(t + 1); RESC(); ROT();
    }
    STEP(pB0, pB1, pA0, pA1, NT - 1, false, false, false); RESC();
    { float sacc = 0.f;
#pragma unroll
      for (int r = 0; r < 16; ++r) sacc += pB0[r] + pB1[r];
      l_reg += sacc;
      pf[0] = PK4(pB0, 0); pf[1] = PK4(pB0, 4); pf[2] = PK4(pB0, 8); pf[3] = PK4(pB0, 12); pf[4] = PK4(pB1, 0); pf[5] = PK4(pB1, 4); pf[6] = PK4(pB1, 8); pf[7] = PK4(pB1, 12);
      const LAS char* vp_ = vp0 + sl_cur * VSLOT;
      vf[0] = frag32(vp_, vc0); vf[1] = frag32(vp_ + 32 * 64, vc0); vf[2] = frag32(vp_ + 64 * 64, vc0); vf[3] = frag32(vp_ + 96 * 64, vc0);
      asm volatile("s_nop 3" : "+v"(pf));
      MFMA8_PV(o[0], pf, vf[0]); MFMA8_PV(o[1], pf, vf[1]); MFMA8_PV(o[2], pf, vf[2]); MFMA8_PV(o[3], pf, vf[3]);
      asm volatile("s_nop 15\n\ts_nop 15\n\ts_nop 7" : "+v"(o[0]), "+v"(o[1]), "+v"(o[2]), "+v"(o[3])); }
#undef PK4
#undef PIN
#undef GAPA
#undef EXP8
#undef STEP
#undef ENDW
#undef CMASK
#undef RESC
#undef ROT
    { auto rr = __builtin_amdgcn_permlane32_swap(__float_as_uint(l_reg), __float_as_uint(l_reg), false, false); l_reg = __uint_as_float(rr[0]) + __uint_as_float(rr[1]); }
    if (hi == 0) wsf[32 + r32] = l_reg;
    asm volatile("s_waitcnt lgkmcnt(0)" ::: "memory");
#pragma unroll
    for (int r = 0; r < 16; ++r) { const float rl = fast_rcp(wsf[32 + crow(r, hi)]);
#pragma unroll
        for (int d0 = 0; d0 < 4; ++d0) o[d0][r] *= rl; }
    asm volatile("s_waitcnt lgkmcnt(0)" ::: "memory");
#undef DMA_K
#undef DMA_V
}

constexpr int KSLOT8 = 4096, QP8 = 256  ;
constexpr int L_V8 = NSLOT * KSLOT8, L_WS8 = L_V8 + NSLOT * VSLOT;
static_assert(L_WS8 + NWAVES * 256 <= L_OST, "fp8 pass LDS");
#define MFMA8_QK(C, A, B) asm volatile("v_mfma_scale_f32_32x32x64_f8f6f4 %0, %1, %2, %3, %4, %5 op_sel_hi:[0,0,0]" : "=&v"(C) : "v"(A), "v"(B), "v"(negm), "v"(sc_k), "v"(sc_q))
#define MFMA8_PV8(O, A, B) asm volatile("v_mfma_scale_f32_32x32x64_f8f6f4 %0, %1, %2, %0, %3, %3 op_sel_hi:[0,0,0]" : "+v"(O) : "v"(A), "v"(B), "v"(sc_k))
template <int MODE> __device__ __forceinline__ void attn_pass8(f32x16 (&o)[4], int b, int hm, int h, int qb, const unsigned char* Q8, const unsigned char* __restrict__ K8, const unsigned char* __restrict__ V8T, LAS char* shm) {
    const int tid = opaque_tid(), lane = tid & 63, r32 = lane & 31, hi = lane >> 5; const int wid = __builtin_amdgcn_readfirstlane(tid >> 6);
    const long rowbase = (long)b * SEQ; const int q0 = qb * QB, NT = (q0 + QB) / KVB;
    const unsigned lds0 = (unsigned)(uintptr_t)shm;
    LAS float* wsf = (LAS float*)(shm + L_WS8) + wid * 64;
    const int kkey = (wid & 3) * 16 + (lane >> 2);
    const unsigned char* ksrc = K8 + (rowbase + kkey) * QP8 + h * 64 + (((lane & 3) ^ ((kkey >> 2) & 3)) * 16);
    const unsigned char* vsrc = V8T + ((size_t)(b * 4 + h) * (SEQ / KVB)) * VSLOT + wid * 1024 + lane * 16;
    const unsigned kdst = lds0 + L_K + (wid & 3) * 1024, vdst = lds0 + L_V8 + wid * 1024;
#define DMA_K(t, s) glds16(ksrc + (long)(t) * KVB * QP8, (unsigned)__builtin_amdgcn_readfirstlane(kdst + (unsigned)(s) * KSLOT8))
#define DMA_V(t, s) glds16(vsrc + (long)(t) * VSLOT, (unsigned)__builtin_amdgcn_readfirstlane(vdst + (unsigned)(s) * VSLOT))
    const int sw = (r32 >> 2) & 3;
    const LAS char* kp0 = shm + L_K + r32 * 64;  const int kc0 = (2 * hi) ^ sw;
    const LAS char* vp0 = shm + L_V8 + r32 * 64;  const int vc0 = (2 * hi) ^ sw;
    DMA_K(0, 0); DMA_V(0, 0); DMA_K(1, 1);
    i32x8 qf;
    { const unsigned char* qp = Q8 + (rowbase + q0 + wid * 32 + r32) * QP8 + h * 64 + hi * 32; const i32x4 lo = *(const i32x4*)qp, hi4 = *(const i32x4*)(qp + 16); qf = __builtin_shufflevector(lo, hi4, 0, 1, 2, 3, 4, 5, 6, 7); }
    float mhat = 0.f;
    f32x16 ol;
    float zf = 0.f; asm volatile("" : "+v"(zf));
    int sc_k = 0x7f7f7f7f, sc_q = 0x7c7c7c7c; asm volatile("" : "+v"(sc_k), "+v"(sc_q));
    f32x16 negm;
#pragma unroll
    for (int r = 0; r < 16; ++r) { negm[r] = zf;
#pragma unroll
        for (int d0 = 0; d0 < 4; ++d0) o[d0][r] = zf;
        ol[r] = zf; }
    i32x8 ones8; { int o1 = 0x38383838; asm volatile("" : "+v"(o1)); ones8 = (i32x8){o1, o1, o1, o1, o1, o1, o1, o1}; }
    asm volatile("" : "+v"(negm));
    const int qrel = wid * 32 + r32;
    asm volatile("" : "+v"(qf));
    DMA_K(2, 2);
    ATT_WAIT_BAR(1);
    bool resc = false;
#define CMASK(P0, P1, t) do { const int jb_ = (t) - (NT - 4); if (jb_ >= 0) cmask(P0, P1, jb_, qrel, hi); } while (0)
#define RESC() do { if (resc) { asm volatile("s_waitcnt lgkmcnt(0)\n\ts_nop 15\n\ts_nop 7" ::: "memory"); \
        _Pragma("unroll") for (int r = 0; r < 16; ++r) { const float fr_ = wsf[crow(r, hi)]; _Pragma("unroll") for (int d_ = 0; d_ < 4; ++d_) asm volatile("v_mul_f32 %0, %0, %1" : "+v"(o[d_][r]) : "v"(fr_)); asm volatile("v_mul_f32 %0, %0, %1" : "+v"(ol[r]) : "v"(fr_)); } } } while (0)
    f32x16 pA0, pA1, pB0, pB1;
    int sl_prev = 0, sl_cur = 0, sl_next = 1;
#define ROT() do { sl_prev = sl_cur; sl_cur = sl_next; sl_next = (sl_next == NSLOT - 1) ? 0 : sl_next + 1; } while (0)
    i32x8 kf0, kf1;
    kf0 = frag32(kp0, kc0); kf1 = frag32(kp0 + 32 * 64, kc0);
    MFMA8_QK(pA0, kf0, qf); MFMA8_QK(pA1, kf1, qf);
    asm volatile("s_nop 15\n\ts_nop 15\n\ts_nop 7" : "+v"(pA0), "+v"(pA1));
    CMASK(pA0, pA1, 0);
    { const float rm = rowmax(pA0, pA1) - ATT_REF_OFF; mhat = rm;
#pragma unroll
      for (int r = 0; r < 16; ++r) { pA0[r] -= rm; pA1[r] -= rm; negm[r] = -rm; }
      asm volatile("" : "+v"(negm));
#pragma unroll
      for (int r = 0; r < 16; ++r) { pA0[r] = fast_exp2(pA0[r]); pA1[r] = fast_exp2(pA1[r]); } }
    ATT_WAIT_BAR(0);
    DMA_K(3, 0); DMA_V(1, 1);
    ROT();
    kf0 = frag32(kp0 + sl_cur * KSLOT8, kc0); kf1 = frag32(kp0 + sl_cur * KSLOT8 + 32 * 64, kc0);
    ATT_WAIT_BAR(2);
    i32x8 vf[4], pf;
#define PK4(P, B) cvt_pk4_fp8(P[B], P[(B) + 1], P[(B) + 2], P[(B) + 3])
#define PIN(x) asm volatile("" : "+v"(x))
#define SUM8(P, B) do { sacc += P[B]; sacc += P[(B) + 1]; sacc += P[(B) + 2]; sacc += P[(B) + 3]; sacc += P[(B) + 4]; sacc += P[(B) + 5]; sacc += P[(B) + 6]; sacc += P[(B) + 7]; PIN(sacc); } while (0)
#define EXP8(X, B) do { X[B] = fast_exp2(X[B]); X[(B) + 1] = fast_exp2(X[(B) + 1]); X[(B) + 2] = fast_exp2(X[(B) + 2]); X[(B) + 3] = fast_exp2(X[(B) + 3]); \
        X[(B) + 4] = fast_exp2(X[(B) + 4]); X[(B) + 5] = fast_exp2(X[(B) + 5]); X[(B) + 6] = fast_exp2(X[(B) + 6]); X[(B) + 7] = fast_exp2(X[(B) + 7]); PIN(X); } while (0)
#define STEP(C0, C1, P0, P1, t, GK, GV, GL) do { ATT_SBAR(); \
    const LAS char* vp_ = vp0 + sl_prev * VSLOT; \
    const bool det_ = (((t) & 3) == 1);            \
    float sacc = 0.f; \
    MFMA8_QK(C0, kf0, qf); \
    if (det_) { SUM8(P0, 0); SUM8(P0, 8); } \
    pf[0] = PK4(P0, 0); pf[1] = PK4(P0, 4); pf[2] = PK4(P0, 8); pf[3] = PK4(P0, 12); PIN(pf); \
    vf[0] = frag32(vp_, vc0); vf[1] = frag32(vp_ + 32 * 64, vc0); ATT_SBAR(); \
    MFMA8_QK(C1, kf1, qf); \
    if (det_) { SUM8(P1, 0); SUM8(P1, 8); } \
    pf[4] = PK4(P1, 0); pf[5] = PK4(P1, 4); pf[6] = PK4(P1, 8); pf[7] = PK4(P1, 12); PIN(pf); \
    vf[2] = frag32(vp_ + 64 * 64, vc0); vf[3] = frag32(vp_ + 96 * 64, vc0); ATT_SBAR(); \
    if (GK) { DMA_K((t) + 3, sl_cur); } if (GV) { DMA_V((t) + 1, sl_next); } \
    {   \
      float st_; { auto rr = __builtin_amdgcn_permlane32_swap(__float_as_uint(sacc), __float_as_uint(sacc), false, false); st_ = __uint_as_float(rr[0]) + __uint_as_float(rr[1]); } \
      resc = false; \
      if (__builtin_expect(det_ && __any(st_ > ATT_RESC_THR), 0)) { const float dl = (st_ > ATT_RESC_MIN) ? __builtin_fmaxf(__builtin_floorf(__builtin_amdgcn_logf(st_)) - 6.f, ATT_RESC_LO) : 0.f; mhat += dl; \
        asm volatile("s_nop 15\n\ts_nop 15" ::: "memory"); \
        _Pragma("unroll") for (int r = 0; r < 16; ++r) { asm volatile("v_sub_f32 %0, %0, %1" : "+v"(C0[r]) : "v"(dl)); asm volatile("v_sub_f32 %0, %0, %1" : "+v"(C1[r]) : "v"(dl)); } \
        _Pragma("unroll") for (int r = 0; r < 16; ++r) negm[r] = -mhat; asm volatile("" : "+v"(negm)); \
        const float f = fast_exp2(-dl); if (hi == 0) wsf[r32] = f; resc = true; } } \
    asm volatile("s_nop 7" : "+v"(C0), "+v"(C1)); CMASK(C0, C1, t); \
    ATT_SBAR(); \
    MFMA8_PV8(o[0], pf, vf[0]); EXP8(C0, 0); if (GL) kf0 = frag32(kp0 + sl_next * KSLOT8, kc0); ATT_SBAR(); \
    MFMA8_PV8(o[1], pf, vf[1]); EXP8(C0, 8); ATT_SBAR(); \
    MFMA8_PV8(o[2], pf, vf[2]); EXP8(C1, 0); if (GL) kf1 = frag32(kp0 + sl_next * KSLOT8 + 32 * 64, kc0); ATT_SBAR(); \
    MFMA8_PV8(o[3], pf, vf[3]); EXP8(C1, 8); ATT_SBAR(); \
    MFMA8_PV8(ol, pf, ones8); ATT_SBAR(); \
    } while (0)
    int t = 1;
#undef CMASK
#define CMASK(P0, P1, t) do {} while (0)
    for (; t + 5 < NT; t += 2) {
        STEP(pB0, pB1, pA0, pA1, t, true, true, true);       ATT_WAIT_BAR(2); RESC(); ROT();
        STEP(pA0, pA1, pB0, pB1, t + 1, true, true, true);   ATT_WAIT_BAR(2); RESC(); ROT();
    }
#undef CMASK
#define CMASK(P0, P1, t) do { const int jb_ = (t) - (NT - 4); if (jb_ >= 0) cmask(P0, P1, jb_, qrel, hi); } while (0)
#define ENDW(tt) do { if ((tt) + 3 < NT) { ATT_WAIT_BAR(2); } else if ((tt) + 2 < NT) { ATT_WAIT_BAR(1); } else { ATT_WAIT_BAR(0); } } while (0)
    for (; t + 1 < NT; t += 2) {
        STEP(pB0, pB1, pA0, pA1, t, (t + 3 < NT), (t + 1 < NT), (t + 1 < NT));       ENDW(t);     RESC(); ROT();
        STEP(pA0, pA1, pB0, pB1, t + 1, (t + 4 < NT), (t + 2 < NT), (t + 2 < NT));   ENDW(t + 1); RESC(); ROT();
    }
    STEP(pB0, pB1, pA0, pA1, NT - 1, false, false, false); RESC();
    {
      pf[0] = PK4(pB0, 0); pf[1] = PK4(pB0, 4); pf[2] = PK4(pB0, 8); pf[3] = PK4(pB0, 12); pf[4] = PK4(pB1, 0); pf[5] = PK4(pB1, 4); pf[6] = PK4(pB1, 8); pf[7] = PK4(pB1, 12);
      const LAS char* vp_ = vp0 + sl_cur * VSLOT;
      vf[0] = frag32(vp_, vc0); vf[1] = frag32(vp_ + 32 * 64, vc0); vf[2] = frag32(vp_ + 64 * 64, vc0); vf[3] = frag32(vp_ + 96 * 64, vc0);
      asm volatile("s_nop 3" : "+v"(pf));
      MFMA8_PV8(o[0], pf, vf[0]); MFMA8_PV8(o[1], pf, vf[1]); MFMA8_PV8(o[2], pf, vf[2]); MFMA8_PV8(o[3], pf, vf[3]); MFMA8_PV8(ol, pf, ones8);
      asm volatile("s_nop 15\n\ts_nop 15\n\ts_nop 7" : "+v"(o[0]), "+v"(o[1]), "+v"(o[2]), "+v"(o[3]), "+v"(ol)); }
#undef PK4
#undef PIN
#undef SUM8
#undef EXP8
#undef STEP
#undef ENDW
#undef CMASK
#undef RESC
#undef ROT
#pragma unroll
    for (int r = 0; r < 16; ++r) { const float rl = fast_rcp(ol[r]);
#pragma unroll
        for (int d0 = 0; d0 < 4; ++d0) o[d0][r] *= rl; }
#undef DMA_K
#undef DMA_V
}

template <int MODE> __device__ __forceinline__ void attn_unit(int b, int h, int qb, const bf16_t* Q, const bf16_t* K, const unsigned char* Q8, const unsigned char* K8, const unsigned char* V, bf16_t* YAB, float* park, float lam, const float* subg, LAS char* shm) {
    const int tid = opaque_tid(), lane = tid & 63, r32 = lane & 31, hi = lane >> 5; const int wid = __builtin_amdgcn_readfirstlane(tid >> 6);
    for (int m = 0; m < 2; ++m) {
        f32x16 o[4];
        if (m == 0) attn_pass<MODE>(o, b, 2 * h, h, qb, Q, K, V, shm);
        else attn_pass8<MODE>(o, b, 2 * h + 1, h, qb, Q8, K8, V, shm);
        int lo_ = lane; asm volatile("" : "+v"(lo_));
        f32x4* pk = (f32x4*)park + (size_t)wid * 1024 + lo_;
        if (m == 0) {
#pragma unroll
            for (int d0 = 0; d0 < 4; ++d0)
#pragma unroll
                for (int j = 0; j < 4; ++j) pk[(d0 * 4 + j) * 64] = (f32x4){o[d0][4 * j], o[d0][4 * j + 1], o[d0][4 * j + 2], o[d0][4 * j + 3]};
        } else {
            float ss[16];
#pragma unroll
            for (int r = 0; r < 16; ++r) ss[r] = 0.f;
#pragma unroll
            for (int d0 = 0; d0 < 4; ++d0)
#pragma unroll
                for (int j = 0; j < 4; ++j) { const f32x4 a = pk[(d0 * 4 + j) * 64];
#pragma unroll
                    for (int e = 0; e < 4; ++e) { const float v = a[e] - lam * o[d0][4 * j + e]; o[d0][4 * j + e] = v; ss[4 * j + e] += v * v; } }
#pragma unroll
            for (int r = 0; r < 16; ++r) { float s = ss[r]; s += __shfl_xor(s, 1); s += __shfl_xor(s, 2); s += __shfl_xor(s, 4); s += __shfl_xor(s, 8); s += __shfl_xor(s, 16); ss[r] = 0.8f / sqrtf(s * (1.0f / 128.0f) + EPS); }
            float gd[4];
#pragma unroll
            for (int d0 = 0; d0 < 4; ++d0) gd[d0] = subg[d0 * 32 + r32];
            LAS bf16_t* stg = (LAS bf16_t*)(shm + L_OST) + wid * 4096;
#pragma unroll
            for (int r = 0; r < 16; ++r) { const int orow = crow(r, hi);
#pragma unroll
                for (int d0 = 0; d0 < 4; ++d0) { float y = o[d0][r] * ss[r] * gd[d0];
#if PROBE_PHASE == 51
                    if (!(__builtin_fabsf(y) < 1e30f)) y = 0.f;
#endif
                    stg[orow * 128 + d0 * 32 + r32] = (bf16_t)(cvt_pk_bf16(y, 0.f) & 0xffffu); } }
            asm volatile("s_waitcnt lgkmcnt(0)" ::: "memory");
            bf16_t* Ow = YAB + ((long)b * SEQ + qb * QB + wid * 32) * 1024 + 512 + h * 128;
#pragma unroll
            for (int i = 0; i < 8; ++i) { const int row = i * 4 + (lo_ >> 4), ch = lo_ & 15; const u32x4 v = *(const LAS u32x4*)(stg + row * 128 + ch * 8); *(u32x4*)(Ow + (long)row * 1024 + ch * 8) = v; }
        }
        asm volatile("s_waitcnt lgkmcnt(0)\n\ts_barrier" ::: "memory");
    }
}
#undef ATT_WAIT_BAR
#undef MX3
#undef ATT_SBAR
#undef ATT_MFMA
#undef MFMA8_PV
#undef MFMA8_QK
#undef MFMA8_PV8
}

#define XB_TMO      128
#define XB_XCNT(j)  (256  + 64 * (j))
#define XB_XSUB(j)  (1280 + 64 * (j))
#define XB_XGEN(j)  (2304 + 64 * (j))
#define XB_TOP      3328
#define XB_TOPGEN   3392
#define XCD_BAR_WORDS 3456
#define XB_SPIN_CAP (1u << 18)
__device__ __forceinline__ unsigned xb_ld(unsigned* p)              { return __hip_atomic_load(p, __ATOMIC_RELAXED, __HIP_MEMORY_SCOPE_AGENT); }
__device__ __forceinline__ unsigned xb_add(unsigned* p, unsigned v) { return __hip_atomic_fetch_add(p, v, __ATOMIC_RELAXED, __HIP_MEMORY_SCOPE_AGENT); }
__device__ __forceinline__ unsigned xb_xcc_id() { return (unsigned)__builtin_amdgcn_s_getreg((3 << 11) | 20) & 0xFu; }
#define XB_SPIN(cond, bar) do { unsigned _sp = 0; while (cond) { __builtin_amdgcn_s_sleep(1); \
    if ((++_sp & 255u) == 0u) { if (xb_ld(&(bar)[XB_TMO])) break; if (_sp > XB_SPIN_CAP) { atomicAdd(&(bar)[XB_TMO], 1u); break; } } } } while (0)
struct XcdBarrier { unsigned* bar; unsigned x; volatile LAS unsigned* st; };
__device__ __forceinline__ XcdBarrier xcd_barrier_post(unsigned* bar, volatile LAS unsigned* st) {
    XcdBarrier b; b.bar = bar; b.x = xb_xcc_id(); b.st = st;
    if (threadIdx.x == 0) (void)xb_add(&bar[XB_XCNT(b.x)], 1u);
    return b;
}
__device__ __forceinline__ void xcd_barrier_complete(unsigned* bar, unsigned x, unsigned& nloc, unsigned& nx) {
    const unsigned G = gridDim.x * gridDim.y * gridDim.z;
    unsigned sum, cnt, mine, sp = 0u;
    for (;;) {
        sum = 0u; cnt = 0u; mine = 0u;
#pragma unroll
        for (unsigned j = 0; j < 16; ++j) { const unsigned c = xb_ld(&bar[XB_XCNT(j)]); sum += c; cnt += (c > 0u) ? 1u : 0u; mine = (j == x) ? c : mine; }
        if (sum == G) break;
        __builtin_amdgcn_s_sleep(1);
        if ((++sp & 255u) == 0u) { if (xb_ld(&bar[XB_TMO])) break; if (sp > XB_SPIN_CAP) { atomicAdd(&bar[XB_TMO], 1u); break; } }
    }
    nloc = mine > 0u ? mine : 1u; nx = cnt > 0u ? cnt : 1u;
}
__device__ __forceinline__ void xcd_barrier(const XcdBarrier& b) {
    asm volatile("s_waitcnt vmcnt(0)" ::: "memory");
    __syncthreads();
    if (threadIdx.x == 0) {
        unsigned* bar = b.bar;
        __builtin_amdgcn_s_waitcnt(0);
        unsigned nloc = b.st[0], nx = b.st[1];
        if (nloc == 0u) { xcd_barrier_complete(bar, b.x, nloc, nx); b.st[0] = nloc; b.st[1] = nx; }
        const unsigned old = xb_add(&bar[XB_XSUB(b.x)], 1u);
        const unsigned gen = old / nloc;
        if (old + 1u == (gen + 1u) * nloc) {
            __builtin_amdgcn_fence(__ATOMIC_RELEASE, "agent");
            asm volatile("s_waitcnt vmcnt(0)" ::: "memory");
            const unsigned og = xb_add(&bar[XB_TOP], 1u);
            const unsigned tg = og / nx;
            if (og + 1u == (tg + 1u) * nx) xb_add(&bar[XB_TOPGEN], 1u);
            else XB_SPIN(xb_ld(&bar[XB_TOPGEN]) == tg, bar);
            __builtin_amdgcn_fence(__ATOMIC_ACQUIRE, "agent");
            xb_add(&bar[XB_XGEN(b.x)], 1u);
            asm volatile("s_waitcnt vmcnt(0)" ::: "memory");
        } else {
            XB_SPIN(xb_ld(&bar[XB_XGEN(b.x)]) == gen, bar);
            __builtin_amdgcn_fence(__ATOMIC_ACQUIRE, "agent");
            asm volatile("s_waitcnt vmcnt(0)" ::: "memory");
        }
    }
    __syncthreads();
}

#define GRID_BAR() xcd_barrier(bar)

__device__ __forceinline__ void phase_stagger(int cls, unsigned ticks) {
    const unsigned long long t0 = __builtin_amdgcn_s_memrealtime(); const unsigned long long want = (unsigned long long)cls * ticks;
    while (__builtin_amdgcn_s_memrealtime() - t0 < want) __builtin_amdgcn_s_sleep(8);
}

struct Args {
    const float* x; const int* pos; const float* norm_mix_g; const float* w_in; const float* gm_ln_g; const float* gm_ln_b; const float* gm_w_s; const float* gm_b_s;
    const float* lam_q1; const float* lam_k1; const float* lam_q2; const float* lam_k2; const float* subln_g; const float* w_br_a; const float* w_br_b; const float* w_out;
    const float* norm_ffn_g; const float* w_rg; const float* b_rg; const float* w_re; const float* b_re; const float* w_gate; const float* w_up; const float* w_down; const float* final_g;
    float* out; unsigned char* ws;
};

__device__ __forceinline__ int wrow_map(int rmode, int n) { return rmode == 0 ? n : rmode == 1 ? ((n >> 5) * 128 + (n & 31)) : (((n >> 3) & 1) * 128 + (n >> 4) * 8 + (n & 7)); }
__device__ __forceinline__ void transpose_item(const float* W, int ldw, int k0, int n0, bf16_t* WT, int ldt, int drow0, int dk0, const float* gk, LAS float* scr, int lane, float sc = 1.0f, int rmode = 0) {
    f32x4 v[16];
    const int kr = lane >> 4, nc = (lane & 15) * 4;
#pragma unroll
    for (int i = 0; i < 16; ++i) v[i] = *(const f32x4*)(W + (size_t)(k0 + 4 * i + kr) * ldw + n0 + nc);
    if (gk) {
#pragma unroll
        for (int i = 0; i < 16; ++i) v[i] = v[i] * gk[k0 + 4 * i + kr];
    }
    if (sc != 1.0f) {
#pragma unroll
        for (int i = 0; i < 16; ++i) v[i] = v[i] * sc;
    }
#pragma unroll
    for (int i = 0; i < 16; ++i) { LAS float* d = scr + (4 * i + kr) * 65 + nc; d[0] = v[i][0]; d[1] = v[i][1]; d[2] = v[i][2]; d[3] = v[i][3]; }
    LDS_WAIT(); asm volatile("" ::: "memory");
    const int c = lane & 7;
#pragma unroll
    for (int j = 0; j < 8; ++j) { const int n = (lane >> 3) + 8 * j; const LAS float* s = scr + (8 * c) * 65 + n;
        u32x4 o; o.x = cvt_pk_bf16(s[0 * 65], s[1 * 65]); o.y = cvt_pk_bf16(s[2 * 65], s[3 * 65]); o.z = cvt_pk_bf16(s[4 * 65], s[5 * 65]); o.w = cvt_pk_bf16(s[6 * 65], s[7 * 65]);
        *(u32x4*)(WT + (size_t)(drow0 + wrow_map(rmode, n)) * ldt + dk0 + k0 + 8 * c) = o; }
    LDS_WAIT(); asm volatile("" ::: "memory");
}
__device__ __forceinline__ void transpose_item8(const float* W, int ldw, int k0, int n0, unsigned char* WT, int ldt, int drow0, const float* gk, float sc, LAS float* scr, int lane, int rmode = 0) {
    f32x4 v[16];
    const int kr = lane >> 4, nc = (lane & 15) * 4;
#pragma unroll
    for (int i = 0; i < 16; ++i) v[i] = *(const f32x4*)(W + (size_t)(k0 + 4 * i + kr) * ldw + n0 + nc);
    float gs[16];
    if (gk) {
#pragma unroll
        for (int i = 0; i < 16; ++i) gs[i] = gk[k0 + 4 * i + kr];
#pragma unroll
        for (int i = 0; i < 16; ++i) gs[i] *= sc;
    } else {
#pragma unroll
        for (int i = 0; i < 16; ++i) gs[i] = sc;
    }
#pragma unroll
    for (int i = 0; i < 16; ++i) v[i] = v[i] * gs[i];
#pragma unroll
    for (int i = 0; i < 16; ++i) { LAS float* d = scr + (4 * i + kr) * 65 + nc; d[0] = v[i][0]; d[1] = v[i][1]; d[2] = v[i][2]; d[3] = v[i][3]; }
    LDS_WAIT(); asm volatile("" ::: "memory");
    const int c = lane & 7;
#pragma unroll
    for (int j = 0; j < 8; ++j) { const int n = (lane >> 3) + 8 * j; const LAS float* s = scr + (8 * c) * 65 + n;
        u32x2 o; o.x = cvt_pk4_fp8(s[0 * 65], s[1 * 65], s[2 * 65], s[3 * 65]); o.y = cvt_pk4_fp8(s[4 * 65], s[5 * 65], s[6 * 65], s[7 * 65]);
        *(u32x2*)(WT + (size_t)(drow0 + wrow_map(rmode, n)) * ldt + k0 + 8 * c) = o; }
    LDS_WAIT(); asm volatile("" ::: "memory");
}
__device__ __forceinline__ void expert_item(int r, const float* w_gate, const float* w_up, const float* w_down, const float* gffn, unsigned char* W13, unsigned char* W2, LAS float* scr, int lane) {
    constexpr int I_G = 32 * 128;
    if (r < 2 * I_G) { const int up = r >= I_G; if (up) r -= I_G; const int e = r / 128, q = r % 128, kb = q / 8, nb = q % 8;
        const int n0 = 64 * nb, drow = e * 1024 + (n0 >> 7) * 256 + up * 128 + (n0 & 127);
        transpose_item8((up ? w_up : w_gate) + (size_t)e * 1024 * 512, 512, 64 * kb, n0, W13, 1024, drow, gffn, 64.f, scr, lane); return; }
    r -= 2 * I_G;
    { const int e = r / 128, q = r % 128, kb = q / 16, nb = q % 16;
        transpose_item8(w_down + (size_t)e * 512 * 1024, 1024, 64 * kb, 64 * nb, W2, 512, e * 1024 + (nb >> 2) * 256 + (nb & 3) * 32, nullptr, 32.f, scr, lane, 2); }
}
__device__ __forceinline__ void rms_row_to_bf16(const float* xrow, const float* g, bf16_t* orow, int lane) {
    const f32x4* xr = (const f32x4*)xrow + lane; const f32x4* gr = (const f32x4*)g + lane;
    f32x4 v[4]; float s = 0.f;
#pragma unroll
    for (int j = 0; j < 4; ++j) { v[j] = xr[64 * j]; s += (v[j].x * v[j].x + v[j].y * v[j].y) + (v[j].z * v[j].z + v[j].w * v[j].w); }
    const float rstd = 1.f / sqrtf(wave_sum(s) * (1.f / D) + EPS);
    u32x2* o8 = (u32x2*)orow + lane;
#pragma unroll
    for (int j = 0; j < 4; ++j) { const f32x4 gg = gr[64 * j]; u32x2 w; w.x = cvt_pk_bf16(v[j].x * rstd * gg.x, v[j].y * rstd * gg.y); w.y = cvt_pk_bf16(v[j].z * rstd * gg.z, v[j].w * rstd * gg.w); o8[64 * j] = w; }
}

__global__ void __launch_bounds__(NTHREADS, 2) fwd_kernel(Args a) {
    extern __shared__ __attribute__((aligned(16))) unsigned char lds_raw[];
    LAS unsigned char* lds = (LAS unsigned char*)lds_raw;
    volatile LAS unsigned* LCTL = (volatile LAS unsigned*)(lds + LDSCTL_OFF);
    const int tid0 = threadIdx.x;
    const int G = gridDim.x, bx = blockIdx.x;
    const int vcu = (G % 8 == 0) ? (bx % 8) * (G / 8) + bx / 8 : bx;
    unsigned char* ws = a.ws;
    unsigned* ctl = (unsigned*)(ws + WS_CTL);
    __builtin_amdgcn_s_setreg((23 << 6) | 1, 1);
    for (int u = tid0; u < (LDS_BYTES - LDSCTL_OFF) / 4; u += NTHREADS) LCTL[u] = 0u;
    __syncthreads();
    XcdBarrier bar = xcd_barrier_post(ctl + CW_BAR, LCTL);
    const int NGW = G * NWAVES;
#define PHASE_IDS() const int tid = opaque_tid(), lane = tid & 63, wave = __builtin_amdgcn_readfirstlane(tid >> 6), gw = vcu * NWAVES + wave; (void)lane; (void)gw

    bf16_t* WIN = (bf16_t*)(ws + WS_WIN); bf16_t* WBR = (bf16_t*)(ws + WS_WBR); bf16_t* WO = (bf16_t*)(ws + WS_WO); unsigned char* W13 = ws + WS_W13; unsigned char* W2 = ws + WS_W2;
    bf16_t* WRH = (bf16_t*)(ws + WS_WRH); bf16_t* WRL = (bf16_t*)(ws + WS_WRL); float* CS = (float*)(ws + WS_CS); float* SSQ = (float*)(ws + WS_SSQ); float* RSTD = (float*)(ws + WS_RSTD); float* WTS = (float*)(ws + WS_WTS);
    int* LIST = (int*)(ws + WS_LIST);
    float* PARK = (float*)(ws + WS_PARK);
    bf16_t* XN = (bf16_t*)(ws + WS_RA); bf16_t* YAB = (bf16_t*)(ws + WS_RA); unsigned char* YB8 = ws + WS_RA;
    bf16_t* UV = (bf16_t*)(ws + WS_RB); bf16_t* MG = (bf16_t*)(ws + WS_RB);
    bf16_t* Qb = (bf16_t*)(ws + WS_RC); bf16_t* Kb = Qb + (size_t)T * 512; bf16_t* XB = (bf16_t*)(ws + WS_RC); unsigned char* V8T = ws + WS_RE + 128 * MiB; unsigned char* Q8 = V8T + 32 * MiB; unsigned char* K8 = Q8 + 16 * MiB;
    bf16_t* Vb = (bf16_t*)(ws + WS_RD);
    unsigned char* G8 = ws + WS_RE; unsigned char* H8 = ws + WS_RE; unsigned char* XB8 = ws + WS_RD;

    for (int rep = 0; rep < REPS(0); ++rep) {
        PHASE_IDS();
        LAS float* scr = (LAS float*)(lds + wave * 16896);
#if LEVEL >= 1
        constexpr int I_IN = 16 * 72, I_BA = 8 * 16, I_BB = 8 * 16, I_O = 16 * 16;
        constexpr int NITEMS = I_IN + I_BA + I_BB + I_O;
        for (int it = gw; it < NITEMS; it += NGW) {
            int r = it;
            if (r < I_IN) { const int kb = r / 72, nb = r % 72; transpose_item(a.w_in, IN_COLS, 64 * kb, 64 * nb, WIN, 1024, (nb >> 2) * 256 + (nb & 3) * 32, 0, nullptr, scr, lane, (64 * nb >= 2560) ? -LOG2E : 1.0f, (64 * nb >= 2560) ? 2 : 1); continue; } r -= I_IN;
            if (r < I_BA) { const int kb = r / 16, nb = r % 16; transpose_item(a.w_br_a, 1024, 64 * kb, 64 * nb, WBR, 1024, (nb >> 2) * 256 + (nb & 3) * 32, 0, nullptr, scr, lane, 1.0f, 1); continue; } r -= I_BA;
            if (r < I_BB) { const int kb = r / 16, nb = r % 16; transpose_item(a.w_br_b, 1024, 64 * kb, 64 * nb, WBR, 1024, (nb >> 2) * 256 + (nb & 3) * 32, 512, nullptr, scr, lane, 1.0f, 1); continue; } r -= I_BB;
            { const int kb = r / 16, nb = r % 16; transpose_item(a.w_out, 1024, 64 * kb, 64 * nb, WO, 1024, (nb >> 2) * 256 + (nb & 3) * 32, 0, nullptr, scr, lane, 1.0f, 1); }
        }
#if LEVEL >= 3
        for (int i = bx * NTHREADS + tid; i < 64 * 1024; i += G * NTHREADS) { const int n = i >> 10, k = i & 1023; float v = 0.f; if (n < 4) v = a.w_rg[k * 4 + n]; else if (n < 36) v = a.w_re[k * 32 + (n - 4)];
            v *= a.norm_ffn_g[k]; const unsigned h = cvt_pk_bf16(v, 0.f) & 0xffffu; const float r = v - __uint_as_float(h << 16); WRH[i] = (bf16_t)h; WRL[i] = (bf16_t)(cvt_pk_bf16(r, 0.f) & 0xffffu); }
#endif
        for (int i = bx * NTHREADS + tid; i < T * 8; i += G * NTHREADS) { const int t = i >> 3, j = i & 7;
            const double invf = exp2(-(double)j * (18.931568569324174 / 8.0));
            const double ang = (double)a.pos[t] * invf; const double kk = rint(ang * 0.15915494309189535); const float rr = (float)(ang - kk * 6.283185307179586);
            CS[t * 16 + j] = cosf(rr); CS[t * 16 + 8 + j] = sinf(rr); }
        for (int m = gw; m < T; m += NGW) rms_row_to_bf16(a.x + (size_t)m * D, a.norm_mix_g, XN + (size_t)m * D, lane);
#endif
    }
    GRID_BAR();

#if LEVEL >= 1 && !defined(NO_P1)
#if PROBE_PHASE >= 71 && PROBE_PHASE <= 73
    {
        pg8::DenseProb P; P.init(XN, WIN, T, IN_COLS, 1024, G, bx);
        pg8::EpiInProjT<(PROBE_PHASE == 73 ? 4 : PROBE_PHASE - 70)> E{UV, Qb, Kb, Vb, G8, CS, Q8, K8};
        pg8::gemm_core<false>(lds, P, E, pg8::NoHook{});
    }
#endif
#if PROBE_PHASE == 66 || PROBE_PHASE == 67
    {
        pg8::DenseProb P; P.init(XN, WIN, T, IN_COLS, 1024, G, bx);
        pg8::EpiInProjT<PROBE_PHASE - 65> E{UV, Qb, Kb, Vb, G8, CS, Q8, K8};
        pg8::gemm_core<false, pg8::DenseProb, pg8::EpiInProjT<PROBE_PHASE - 65>, pg8::NoHook, 4>(lds, P, E, pg8::NoHook{});
    }
#endif
#if PROBE_PHASE == 64
    {
        pg8::DenseProb P; P.init(XN, WIN, T, IN_COLS, 1024, G, bx);
        pg8::EpiInProj E{UV, Qb, Kb, Vb, G8, CS, Q8, K8};
        pg8::gemm_core<false, pg8::DenseProb, pg8::EpiInProj, pg8::NoHook, 4>(lds, P, E, pg8::NoHook{});
    }
#endif
    for (int rep = 0; rep < REPS(1); ++rep) {
#ifdef STAG1
        phase_stagger(((bx >> 3) & 7) >> 1, STAG1);
#endif
        pg8::DenseProb P; P.init(XN, WIN, T, IN_COLS, 1024, G, bx);
        pg8::EpiInProj E{UV, Qb, Kb, Vb, G8, CS, Q8, K8};
        pg8::gemm_core<false>(lds, P, E, pg8::NoHook{});
    }
#if PROBE_PHASE == 11
    {
        pg8::DenseProb P; P.init(XN, WIN, T, IN_COLS, 1024, G, bx);
        pg8::gemm_core<false>(lds, P, pg8::EpiNull{}, pg8::NoHook{});
    }
#endif
#if PROBE_PHASE >= 61 && PROBE_PHASE <= 63
    {
        pg8::DenseProb P; P.init(XN, WIN, T, IN_COLS, 1024, G, bx);
        pg8::gemm_core<false, pg8::DenseProb, pg8::EpiNull, pg8::NoHook, PROBE_PHASE - 60>(lds, P, pg8::EpiNull{}, pg8::NoHook{});
    }
#endif
#if PROBE_PHASE == 31
    {
        pg8::DenseProb P; P.init(XN, WIN, T, IN_COLS, 1024, G, bx);
        pg8::gemm_core<false>(lds, P, pg8::EpiStoreOnly{(bf16_t*)(ws + WS_END)}, pg8::NoHook{});
    }
#endif
#if PROBE_PHASE == 12
    {
        pg8::DenseProbSame P; P.init(XN, WIN, T, IN_COLS, 1024, G, bx);
        pg8::gemm_core<false>(lds, P, pg8::EpiNull{}, pg8::NoHook{});
    }
#endif
#endif
    GRID_BAR();

#if LEVEL >= 1 && !defined(NO_P2A)
    for (int rep = 0; rep < REPS(2); ++rep) {
        PHASE_IDS();
        LAS bf16_t* VT = (LAS bf16_t*)lds;
        LAS float* SV = (LAS float*)(lds + 36864);
        const int r32 = lane & 31, hi = lane >> 5;
        for (int un = vcu; un < 2048; un += G) {
            const int ch = un >> 2, g = un & 3; const size_t row0 = (size_t)ch * 128;
            {
                const int s = tid >> 2, qd = tid & 3;
                const u32x4* vp = (const u32x4*)(UV + (row0 + s) * 1024 + 512 + g * 128 + qd * 32);
                float v[32]; float sm = 0.f;
#pragma unroll
                for (int j = 0; j < 4; ++j) { const u32x4 w = vp[j]; f32x4 x0, x1; pg8::unpack8(w, x0, x1);
#pragma unroll
                    for (int e = 0; e < 4; ++e) { v[8 * j + e] = x0[e]; v[8 * j + 4 + e] = x1[e]; sm += x0[e] + x1[e]; } }
                sm += __shfl_xor(sm, 1); sm += __shfl_xor(sm, 2);
                const float mu = sm * (1.0f / 128.0f); float sq = 0.f;
#pragma unroll
                for (int i = 0; i < 32; ++i) { v[i] -= mu; sq += v[i] * v[i]; }
                sq += __shfl_xor(sq, 1); sq += __shfl_xor(sq, 2);
                const float rstd = 1.0f / sqrtf(sq * (1.0f / 128.0f) + EPS);
                const float* lg = a.gm_ln_g + g * 128 + qd * 32; const float* lb = a.gm_ln_b + g * 128 + qd * 32;
#pragma unroll
                for (int i = 0; i < 32; ++i) { const float y = v[i] * rstd * lg[i] + lb[i]; VT[(qd * 32 + i) * 136 + s] = (bf16_t)(cvt_pk_bf16(y, 0.f) & 0xffffu); }
            }
            LDS_WAIT(); __syncthreads();
            {
                const int tb = wave >> 1, db0 = 2 * (wave & 1);
                f32x16 c0 = f32x16{}, c1 = f32x16{};
                const float* wrow = a.gm_w_s + ((size_t)g * 128 + tb * 32 + r32) * 128;
                const int trow = tb * 32 + r32;
                for (int ks = 0; ks <= 2 * tb + 1; ++ks) {
                    const int s0 = 16 * ks + 8 * hi;
                    const f32x4 wa = *(const f32x4*)(wrow + s0), wb = *(const f32x4*)(wrow + s0 + 4);
                    float w8[8] = {wa[0], wa[1], wa[2], wa[3], wb[0], wb[1], wb[2], wb[3]};
#pragma unroll
                    for (int j = 0; j < 8; ++j) if (s0 + j > trow) w8[j] = 0.f;
                    u32x4 aw; aw.x = cvt_pk_bf16(w8[0], w8[1]); aw.y = cvt_pk_bf16(w8[2], w8[3]); aw.z = cvt_pk_bf16(w8[4], w8[5]); aw.w = cvt_pk_bf16(w8[6], w8[7]);
                    const bf16x8 af = __builtin_bit_cast(bf16x8, aw);
                    const bf16x8 b0 = *(const LAS bf16x8*)(VT + ((db0 + 0) * 32 + r32) * 136 + s0);
                    const bf16x8 b1 = *(const LAS bf16x8*)(VT + ((db0 + 1) * 32 + r32) * 136 + s0);
                    c0 = __builtin_amdgcn_mfma_f32_32x32x16_bf16(af, b0, c0, 0, 0, 0);
                    c1 = __builtin_amdgcn_mfma_f32_32x32x16_bf16(af, b1, c1, 0, 0, 0);
                }
#pragma unroll
                for (int r = 0; r < 16; ++r) { const int t = tb * 32 + att::crow(r, hi); const float bs = a.gm_b_s[g * 128 + t];
                    SV[t * 132 + db0 * 32 + r32] = c0[r] + bs; SV[t * 132 + db0 * 32 + 32 + r32] = c1[r] + bs; }
            }
            LDS_WAIT(); __syncthreads();
            {
#pragma unroll
                for (int i = 0; i < 4; ++i) { const int t = i * 32 + (tid >> 4), dc = (tid & 15) * 8;
                    const size_t ro = (row0 + t) * 1024 + g * 128 + dc;
                    const u32x4 uw = *(const u32x4*)(UV + ro); f32x4 u0, u1; pg8::unpack8(uw, u0, u1);
                    const f32x4 s0 = *(const LAS f32x4*)(SV + t * 132 + dc), s1 = *(const LAS f32x4*)(SV + t * 132 + dc + 4);
                    *(u32x4*)(YAB + ro) = pg8::pack8(u0 * s0, u1 * s1); }
            }
            LDS_WAIT(); __syncthreads();
        }
    }
#endif
#if LEVEL >= 2
    {
        PHASE_IDS();
        LAS unsigned char* TB = (LAS unsigned char*)lds + wave * 8192;
        for (int tl = gw; tl < BATCH * 4 * (SEQ / 64); tl += NGW) {
            const int bh = tl >> 7, tt = tl & 127, b = bh >> 2, h = bh & 3;
            const bf16_t* vsrc = Vb + ((size_t)b * SEQ + tt * 64) * 512 + h * 128;
            u32x4 w[16];
#pragma unroll
            for (int i = 0; i < 16; ++i) w[i] = *(const u32x4*)(vsrc + (size_t)(i * 4 + (lane >> 4)) * 512 + (lane & 15) * 8);
#pragma unroll
            for (int i = 0; i < 16; ++i) { const int key = i * 4 + (lane >> 4), kk = key & 31, khi = (kk >> 2) & 1, j = (kk & 3) + 4 * (kk >> 3) + 16 * (key >> 5), cc = khi * 2 + (j >> 4);
                f32x4 x0, x1; pg8::unpack8(w[i], x0, x1); const unsigned q0_ = cvt_pk4_fp8(x0[0], x0[1], x0[2], x0[3]), q1_ = cvt_pk4_fp8(x1[0], x1[1], x1[2], x1[3]);
#pragma unroll
                for (int e = 0; e < 8; ++e) { const int d = (lane & 15) * 8 + e; const unsigned byte = ((e < 4 ? q0_ : q1_) >> (8 * (e & 3))) & 0xffu;
                    TB[d * 64 + ((cc ^ ((d >> 2) & 3)) * 16) + (j & 15)] = (unsigned char)byte; } }
            LDS_WAIT(); asm volatile("" ::: "memory");
            unsigned char* dst = V8T + (size_t)tl * 8192;
#pragma unroll
            for (int i = 0; i < 8; ++i) *(u32x4*)(dst + (i * 64 + lane) * 16) = *(const LAS u32x4*)(TB + (i * 64 + lane) * 16);
            LDS_WAIT(); asm volatile("" ::: "memory");
        }
    }
    GRID_BAR();
#endif
#if LEVEL >= 2 && !defined(NO_P2B)
    {
        PHASE_IDS();
        float lam;
        { const float p1 = wave_sum(a.lam_q1[lane] * a.lam_k1[lane]), p2 = wave_sum(a.lam_q2[lane] * a.lam_k2[lane]); lam = expf(p1) - expf(p2) + 0.2f; }
        const int bh = vcu >> 3, s = vcu & 7, b = bh >> 2, h = bh & 3;
        float* park = PARK + (size_t)bx * 32768;
        if (G == 256) {
            for (int ii = 0; ii < 4 * REPS(3); ++ii) { const int i = ii & 3; const int qb = (i == 0) ? s : (i == 1) ? 15 - s : (i == 2) ? 16 + s : 31 - s;
                att::attn_unit<0>(b, h, qb, Qb, Kb, Q8, K8, V8T, YAB, park, lam, a.subln_g, (LAS char*)lds);
#if LEVEL >= 3
                if (ii < 4) {
                    LAS float* scr = (LAS float*)(lds + wave * 16896);
                    for (int k = wave; k < 12; k += NWAVES) expert_item((bx * 4 + ii) * 12 + k, a.w_gate, a.w_up, a.w_down, a.norm_ffn_g, W13, W2, scr, lane);
                    LDS_WAIT(); __syncthreads();
                }
#endif
            }
#if PROBE_PHASE == 13 || PROBE_PHASE == 14 || PROBE_PHASE == 15 || PROBE_PHASE == 16
            for (int i = 0; i < 4; ++i) { const int qb = (i == 0) ? s : (i == 1) ? 15 - s : (i == 2) ? 16 + s : 31 - s;
                att::attn_unit<PROBE_PHASE - 13>(0, 0, qb, Qb, Kb, Q8, K8, V8T, (bf16_t*)(ws + WS_END), park, lam, a.subln_g, (LAS char*)lds); }
#endif
        }
    }
#elif LEVEL >= 1
    {
        PHASE_IDS();
        for (int i = bx * NTHREADS + tid; i < T * 64; i += G * NTHREADS) { const int row = i >> 6, c = i & 63; *(u32x4*)(YAB + (size_t)row * 1024 + 512 + c * 8) = (u32x4){0u, 0u, 0u, 0u}; }
    }
#endif
    GRID_BAR();

#if LEVEL >= 1 && !defined(NO_P3)
    for (int rep = 0; rep < REPS(4); ++rep) {
        pg8::PanelProb P; P.init(YAB, WBR, T, 1024, 1024, G, bx);
        pg8::EpiMerge E{G8, MG};
        pg8::gemm_core<false>(lds, P, E, pg8::HookMerge{G8});
    }
#endif
    asm volatile("s_waitcnt vmcnt(0)" ::: "memory"); __syncthreads();
#if LEVEL >= 1 && !defined(NO_P4)
    for (int rep = 0; rep < REPS(5); ++rep) {
        pg8::PanelProb P; P.init(MG, WO, T, 1024, 1024, G, bx);
        pg8::EpiX1 E{a.x, XB, XB8, SSQ};
        pg8::gemm_core<false>(lds, P, E, pg8::NoHook{});
    }
#endif
    asm volatile("s_waitcnt vmcnt(0)" ::: "memory"); __syncthreads();

#if LEVEL >= 3 && !defined(NO_P5)
    {
        PHASE_IDS();
        LAS float* LG = (LAS float*)lds;
        volatile LAS int* LCNT = (volatile LAS int*)(LCTL + 96); volatile LAS int* LBASE = (volatile LAS int*)(LCTL + 128);
        const int r32 = lane & 31, hi = lane >> 5;
        for (int tb = bx; tb < T / 256; tb += G) {
            const size_t tok0 = (size_t)tb * 256 + wave * 32;
            const bf16_t* xa = XB + (tok0 + r32) * 1024 + hi * 8;
            const bf16_t* wh0 = WRH + (size_t)r32 * 1024 + hi * 8; const bf16_t* wh1 = wh0 + 32 * 1024;
            const bf16_t* wl0 = WRL + (size_t)r32 * 1024 + hi * 8; const bf16_t* wl1 = wl0 + 32 * 1024;
            f32x16 c0 = f32x16{}, c1 = f32x16{};
#pragma unroll 4
            for (int ks = 0; ks < 64; ++ks) {
                const bf16x8 av = *(const bf16x8*)(xa + ks * 16);
                const bf16x8 h0 = *(const bf16x8*)(wh0 + ks * 16), h1 = *(const bf16x8*)(wh1 + ks * 16), l0 = *(const bf16x8*)(wl0 + ks * 16), l1 = *(const bf16x8*)(wl1 + ks * 16);
                c0 = __builtin_amdgcn_mfma_f32_32x32x16_bf16(av, h0, c0, 0, 0, 0); c1 = __builtin_amdgcn_mfma_f32_32x32x16_bf16(av, h1, c1, 0, 0, 0);
                c0 = __builtin_amdgcn_mfma_f32_32x32x16_bf16(av, l0, c0, 0, 0, 0); c1 = __builtin_amdgcn_mfma_f32_32x32x16_bf16(av, l1, c1, 0, 0, 0);
            }
#pragma unroll
            for (int r = 0; r < 16; ++r) { const int tl = wave * 32 + att::crow(r, hi); LG[tl * 37 + r32] = c0[r]; if (r32 < 4) LG[tl * 37 + 32 + r32] = c1[r]; }
            if (tid < 32) LCNT[tid] = 0;
            LDS_WAIT(); __syncthreads();
            int eid0 = 0, eid1 = 0, rk0 = 0, rk1 = 0; float w0 = 0.f, w1 = 0.f; const size_t tok = (size_t)tb * 256 + tid;
            if (tid < 256) {
                float ssq = 0.f;
#pragma unroll
                for (int j = 0; j < 16; ++j) ssq += SSQ[tok * 16 + j];
                const float rstd = 1.0f / sqrtf(ssq * (1.0f / 1024.0f) + EPS);
                RSTD[tok] = rstd;
                const LAS float* p0 = LG + tid * 37;
                float gl[4]; int grp = 0;
#pragma unroll
                for (int j = 0; j < 4; ++j) gl[j] = p0[j] * rstd + a.b_rg[j];
                float gmx = gl[0];
#pragma unroll
                for (int j = 1; j < 4; ++j) if (gl[j] > gmx) { gmx = gl[j]; grp = j; }
                float gs = 0.f;
#pragma unroll
                for (int j = 0; j < 4; ++j) gs += expf(gl[j] - gmx);
                const float gwt = 1.0f / gs;
                float el[8];
#pragma unroll
                for (int j = 0; j < 8; ++j) el[j] = p0[4 + grp * 8 + j] * rstd + a.b_re[grp * 8 + j];
                int i0 = 0; float v0 = el[0];
#pragma unroll
                for (int j = 1; j < 8; ++j) if (el[j] > v0) { v0 = el[j]; i0 = j; }
                int i1 = -1; float v1 = -INFINITY;
#pragma unroll
                for (int j = 0; j < 8; ++j) if (j != i0 && el[j] > v1) { v1 = el[j]; i1 = j; }
                const float e1 = expf(v1 - v0); w0 = gwt / (1.0f + e1); w1 = gwt * e1 / (1.0f + e1);
                eid0 = grp * 8 + i0; eid1 = grp * 8 + i1;
                rk0 = atomicAdd((int*)(LCNT + eid0), 1); rk1 = atomicAdd((int*)(LCNT + eid1), 1);
            }
            LDS_WAIT(); __syncthreads();
            if (tid < 32) LBASE[tid] = (int)__hip_atomic_fetch_add(ctl + CW_CNT + tid, (unsigned)LCNT[tid], RLX_AGENT);
            LDS_WAIT(); __syncthreads();
            if (tid < 256) {
                const int s0_ = eid0 * LISTCAP + LBASE[eid0] + rk0, s1_ = eid1 * LISTCAP + LBASE[eid1] + rk1;
                LIST[s0_] = (int)(((unsigned)(tok * 2) << 15) | (cvt_pk_bf16(w0, 0.f) & 0x7fffu)); LIST[s1_] = (int)(((unsigned)(tok * 2 + 1) << 15) | (cvt_pk_bf16(w1, 0.f) & 0x7fffu));
            }
            LDS_WAIT(); __syncthreads();
        }
    }
#endif
    GRID_BAR();
#if LEVEL >= 3
    {
        PHASE_IDS();
        volatile LAS int* BST = (volatile LAS int*)(LCTL + 16); volatile LAS int* CNT = (volatile LAS int*)(LCTL + 64);
        if (tid == 0) { int accb = 0; for (int e = 0; e < NEXP; ++e) { const int c = (int)__hip_atomic_load(ctl + CW_CNT + e, RLX_AGENT); CNT[e] = c; BST[e] = accb; accb += (c + 255) >> 8; } BST[NEXP] = accb; }
        LDS_WAIT(); __syncthreads();
    }
#if !defined(NO_P6)
    for (int rep = 0; rep < REPS(6); ++rep) {
        pg8::MoeUpProb P; P.init((const LAS int*)(LCTL + 16), (const LAS int*)(LCTL + 64), G, bx); P.A = (const char*)XB8; P.Bt = (const char*)W13; P.pitch = 1024; P.list = LIST;
        pg8::EpiMoeUp E{LIST, RSTD, H8, {}};
        pg8::gemm_core<true>(lds, P, E, pg8::HookPin<pg8::EpiMoeUp>{&E});
    }
#endif
#endif
    GRID_BAR();
#if LEVEL >= 3 && !defined(NO_P7)
    for (int rep = 0; rep < REPS(7); ++rep) {
        pg8::MoeDownProb P; P.init((const LAS int*)(LCTL + 16), (const LAS int*)(LCTL + 64), G, bx); P.A = (const char*)H8; P.Bt = (const char*)W2; P.pitch = 512;
        pg8::EpiMoeDown E{LIST, YB8, {}};
        pg8::gemm_core<true>(lds, P, E, pg8::HookPin<pg8::EpiMoeDown>{&E});
    }
#endif
    GRID_BAR();

    {
        PHASE_IDS();
        const bool tmo = (__hip_atomic_load(ctl + CW_BAR + XB_TMO, RLX_AGENT) != 0u);
        for (int m = gw; m < T; m += NGW) {
            const f32x4* gr = (const f32x4*)a.final_g + lane;
            f32x4 v[4]; float s = 0.f;
#pragma unroll
            for (int j = 0; j < 4; ++j) {
#if LEVEL >= 1
                { const u32x2 xw = *((const u32x2*)(XB + (size_t)m * D) + lane + 64 * j); v[j] = (f32x4){bf_lo(xw.x), bf_hi(xw.x), bf_lo(xw.y), bf_hi(xw.y)}; }
#else
                v[j] = ((const f32x4*)(a.x + (size_t)m * D) + lane)[64 * j];
#endif
#if LEVEL >= 3
                const unsigned y0 = *((const unsigned*)(YB8 + (size_t)(2 * m) * D) + lane + 64 * j), y1 = *((const unsigned*)(YB8 + (size_t)(2 * m + 1) * D) + lane + 64 * j);
                v[j] = v[j] + (fp8x4_to_f32(y0) + fp8x4_to_f32(y1)) * 0.0625f;
#endif
                s += (v[j].x * v[j].x + v[j].y * v[j].y) + (v[j].z * v[j].z + v[j].w * v[j].w); }
            float rstd = 1.f / sqrtf(wave_sum(s) * (1.f / D) + EPS);
            if (tmo) rstd = __builtin_nanf("");
            f32x4* o = (f32x4*)(a.out + (size_t)m * D) + lane;
#pragma unroll
            for (int j = 0; j < 4; ++j) { f32x4 ov = v[j] * rstd * gr[64 * j];
#if PROBE_PHASE == 50
#pragma unroll
                for (int e = 0; e < 4; ++e) if (!(__builtin_fabsf(ov[e]) < 1e30f)) ov[e] = 0.f;
#endif
                o[64 * j] = ov; }
        }
    }
}

extern "C" void kernel_launch(void* const* d_in, const int* in_sizes, int n_in, void* d_out, int out_size, void* d_ws, size_t ws_size, hipStream_t stream) {
    static int grid = 0;
    if (grid == 0) {
        if (n_in != 25 || in_sizes[0] != T * D || out_size != T * D || ws_size < WS_END + 64 * MiB) { fprintf(stderr, "kernel_launch: unexpected shapes (n_in %d, in0 %d, out %d, ws %zu); nothing launched\n", n_in, n_in > 0 ? in_sizes[0] : -1, out_size, ws_size); grid = -1; return; }
        int dev = 0, cus = 0, per_cu = 0;
        if (hipGetDevice(&dev) != hipSuccess || hipDeviceGetAttribute(&cus, hipDeviceAttributeMultiprocessorCount, dev) != hipSuccess) { grid = -1; return; }
        if (hipFuncSetAttribute((const void*)fwd_kernel, hipFuncAttributeMaxDynamicSharedMemorySize, LDS_BYTES) != hipSuccess) { fprintf(stderr, "kernel_launch: hipFuncSetAttribute failed\n"); grid = -1; return; }
        if (hipOccupancyMaxActiveBlocksPerMultiprocessor(&per_cu, (const void*)fwd_kernel, NTHREADS, LDS_BYTES) != hipSuccess || per_cu < 1) fprintf(stderr, "kernel_launch: occupancy query reports %d\n", per_cu);
        (void)hipGetLastError();
        grid = cus;
        if (grid != 256) fprintf(stderr, "kernel_launch: %d CUs (built for 256)\n", grid);
    }
    if (grid < 0) return;
    if (hipMemsetAsync((char*)d_ws + WS_CTL, 0, CTL_ZERO_BYTES, stream) != hipSuccess) return;
    Args a{};
    a.x = (const float*)d_in[0]; a.pos = (const int*)d_in[1]; a.norm_mix_g = (const float*)d_in[2]; a.w_in = (const float*)d_in[3]; a.gm_ln_g = (const float*)d_in[4]; a.gm_ln_b = (const float*)d_in[5];
    a.gm_w_s = (const float*)d_in[6]; a.gm_b_s = (const float*)d_in[7]; a.lam_q1 = (const float*)d_in[8]; a.lam_k1 = (const float*)d_in[9]; a.lam_q2 = (const float*)d_in[10]; a.lam_k2 = (const float*)d_in[11];
    a.subln_g = (const float*)d_in[12]; a.w_br_a = (const float*)d_in[13]; a.w_br_b = (const float*)d_in[14]; a.w_out = (const float*)d_in[15]; a.norm_ffn_g = (const float*)d_in[16];
    a.w_rg = (const float*)d_in[17]; a.b_rg = (const float*)d_in[18]; a.w_re = (const float*)d_in[19]; a.b_re = (const float*)d_in[20]; a.w_gate = (const float*)d_in[21]; a.w_up = (const float*)d_in[22];
    a.w_down = (const float*)d_in[23]; a.final_g = (const float*)d_in[24];
    a.out = (float*)d_out; a.ws = (unsigned char*)d_ws;
    hipLaunchKernelGGL(fwd_kernel, dim3(grid), dim3(NTHREADS), LDS_BYTES, stream, a);
    const hipError_t le = hipPeekAtLastError();
    if (le != hipSuccess) fprintf(stderr, "kernel_launch: launch failed: %s\n", hipGetErrorName(le));
}
```

```cpp
#include <hip/hip_runtime.h>
#include <cstdio>
#include <cstdint>

#ifndef LEVEL
#define LEVEL 3
#endif

#ifndef PROBE_PHASE
#define PROBE_PHASE -1
#endif
#define REPS(p) ((PROBE_PHASE == (p)) ? 2 : 1)
#define LAS __attribute__((address_space(3)))
#define GAS __attribute__((address_space(1)))
typedef unsigned short bf16_t;
typedef short bf16x8 __attribute__((ext_vector_type(8)));
typedef short s16x4 __attribute__((ext_vector_type(4)));
typedef float f32x2 __attribute__((ext_vector_type(2)));
typedef float f32x4 __attribute__((ext_vector_type(4)));
typedef float f32x16 __attribute__((ext_vector_type(16)));
typedef unsigned u32x2 __attribute__((ext_vector_type(2)));
typedef unsigned u32x4 __attribute__((ext_vector_type(4)));
typedef int i32x8 __attribute__((ext_vector_type(8)));
typedef short s16x16 __attribute__((ext_vector_type(16)));

constexpr int D = 1024, BATCH = 8, SEQ = 8192, T = BATCH * SEQ;
constexpr int IN_COLS = 4608;
constexpr int NEXP = 32, DEXP = 512;
constexpr int LISTCAP = T;
constexpr float EPS = 1e-6f;
constexpr float LOG2E = 1.4426950408889634f;
constexpr float C2 = 0.125f * LOG2E;
constexpr int NWAVES = 8, NTHREADS = 512;

constexpr size_t MiB = 1u << 20;
constexpr size_t WS_CTL = 0, CTL_ZERO_BYTES = 1 * MiB;
constexpr size_t WS_WIN = 2 * MiB;
constexpr size_t WS_WBR = 12 * MiB;
constexpr size_t WS_WO = 14 * MiB;
constexpr size_t WS_W13 = 16 * MiB;
constexpr size_t WS_W2 = 80 * MiB;
constexpr size_t WS_WRH = 112 * MiB;
constexpr size_t WS_WRL = 112 * MiB + 131072;
constexpr size_t WS_CS = 113 * MiB;
constexpr size_t WS_SSQ = 117 * MiB;
constexpr size_t WS_RSTD = 121 * MiB;
constexpr size_t WS_WTS = 122 * MiB;
constexpr size_t WS_LIST = 123 * MiB;
constexpr size_t WS_PARK = 131 * MiB;
constexpr size_t WS_RA = 164 * MiB;
constexpr size_t WS_RB = 292 * MiB;
constexpr size_t WS_RC = 420 * MiB;
constexpr size_t WS_RD = 548 * MiB;
constexpr size_t WS_RE = 612 * MiB;
constexpr size_t WS_END = 868 * MiB;
constexpr int CW_TMO = 0;
constexpr int CW_BAR = 4096;
constexpr int CW_CNT = 8192;

constexpr int RING_BYTES = 147456;
constexpr int LDSCTL_OFF = RING_BYTES;
constexpr int LDS_BYTES = RING_BYTES + 1024;

#define RLX_AGENT __ATOMIC_RELAXED, __HIP_MEMORY_SCOPE_AGENT
#define LDS_WAIT() asm volatile("s_waitcnt lgkmcnt(0)" ::: "memory")
#define VM_WAIT() asm volatile("s_waitcnt vmcnt(0)" ::: "memory")

__device__ __forceinline__ unsigned cvt_pk_bf16(float lo, float hi) { unsigned r; asm("v_cvt_pk_bf16_f32 %0, %1, %2" : "=v"(r) : "v"(lo), "v"(hi)); return r; }
__device__ __forceinline__ unsigned cvt_pk4_fp8(float a, float b, float c, float d) { int w; asm("v_cvt_pk_fp8_f32 %0, %1, %2" : "=v"(w) : "v"(a), "v"(b)); w = __builtin_amdgcn_cvt_pk_fp8_f32(c, d, w, true); return (unsigned)w; }
__device__ __forceinline__ unsigned cvt_pk4_u8(float a, float b, float c, float d) { unsigned w = 0; w = __builtin_amdgcn_cvt_pk_u8_f32(a, 0, w); w = __builtin_amdgcn_cvt_pk_u8_f32(b, 1, w); w = __builtin_amdgcn_cvt_pk_u8_f32(c, 2, w); w = __builtin_amdgcn_cvt_pk_u8_f32(d, 3, w); return w; }
__device__ __forceinline__ f32x4 u8x4_to_f32(unsigned w) { return (f32x4){(float)(w & 0xffu), (float)((w >> 8) & 0xffu), (float)((w >> 16) & 0xffu), (float)(w >> 24)}; }
__device__ __forceinline__ f32x4 fp8x4_to_f32(unsigned w) { const f32x2 lo = __builtin_amdgcn_cvt_pk_f32_fp8((int)w, false), hi = __builtin_amdgcn_cvt_pk_f32_fp8((int)w, true); return (f32x4){lo[0], lo[1], hi[0], hi[1]}; }
__device__ __forceinline__ float bf_lo(unsigned w) { return __uint_as_float(w << 16); }
__device__ __forceinline__ float bf_hi(unsigned w) { return __uint_as_float(w & 0xffff0000u); }
__device__ __forceinline__ float fast_exp2(float x) { return __builtin_amdgcn_exp2f(x); }
__device__ __forceinline__ float fast_rcp(float x) { return __builtin_amdgcn_rcpf(x); }
__device__ __forceinline__ float sigmoidf_(float x) { return fast_rcp(1.0f + fast_exp2(-LOG2E * x)); }
__device__ __forceinline__ float gelu_tanh(float x) {
    const float u = x * (0.7978845608028654f + 0.0356774081363001f * x * x);
    return x * fast_rcp(1.0f + fast_exp2(-2.0f * LOG2E * u));
}
__device__ __forceinline__ f32x2 pk_fma(f32x2 a, f32x2 b, f32x2 c) { return __builtin_elementwise_fma(a, b, c); }
__device__ __forceinline__ f32x2 gelu_tanh2(f32x2 x) {
    constexpr float K0 = -2.0f * LOG2E * 0.7978845608028654f, K1 = -2.0f * LOG2E * 0.0356774081363001f;
    const f32x2 z = x * pk_fma(x * x, (f32x2){K1, K1}, (f32x2){K0, K0});
    const f32x2 d = (f32x2){fast_exp2(z.x), fast_exp2(z.y)} + 1.0f;
    return x * (f32x2){fast_rcp(d.x), fast_rcp(d.y)};
}
__device__ __forceinline__ f32x2 sig255_2(f32x2 a) {
    constexpr float S = 1.0f / 255.0f;
    const f32x2 d = pk_fma((f32x2){fast_exp2(a.x), fast_exp2(a.y)}, (f32x2){S, S}, (f32x2){S, S});
    return (f32x2){fast_rcp(d.x), fast_rcp(d.y)};
}
__device__ __forceinline__ int opaque_tid() { int t = threadIdx.x; asm volatile("" : "+v"(t)); return t; }
__device__ __forceinline__ float wave_sum(float v) {
#pragma unroll
    for (int o = 1; o < 64; o <<= 1) v += __shfl_xor(v, o);
    return v;
}

namespace pg8 {
constexpr int BM = 256, BK = 64, HALF = 128, HTB = HALF * BK * 2, STAGE_BYTES = 8 * HTB, NXCD = 8, WGM = 8;
__host__ __device__ __forceinline__ int lds_byte(int r, int c) { const int st = (r >> 4) * 2 + (c >> 5), rr = r & 15, cc = c & 31, ob = rr * 64 + cc * 2; return st * 1024 + (ob ^ (((ob >> 9) & 1) << 5)); }
__host__ __device__ __forceinline__ void stage_rc(int b, int& R, int& C) { const int st = b / 1024, sb = b % 1024, swz = sb ^ (((sb >> 9) & 1) << 5); R = (st >> 1) * 16 + swz / 64; C = (st & 1) * 32 + (swz % 64) / 2; }
__host__ __device__ __forceinline__ int perm32(int rho) { const int n = rho >> 4, i = rho & 15; return 8 * (i >> 2) + 4 * n + (i & 3); }

struct Unit { int pm, pn, e, lbase, nv; };

struct DenseProb {
    static constexpr bool GATHER = false;
    const char* A; const char* Bt; int pitch  ; int nM, nN, nwg, G, c;
    __device__ __forceinline__ void init(const void* A_, const void* Bt_, int M, int N, int K_, int G_, int c_) { A = (const char*)A_; Bt = (const char*)Bt_; pitch = K_ * 2; nM = M / BM; nN = N / BM; nwg = nM * nN; G = G_; c = c_; }
    __device__ __forceinline__ bool next(int i, Unit& u) const {
        const long L = (long)i * G + c; if (L >= nwg) return false;
        int wgid = (int)L; { const int q = nwg / NXCD, r = nwg % NXCD, xcd = wgid % NXCD, off = wgid / NXCD; wgid = (xcd < r ? xcd * (q + 1) : r * (q + 1) + (xcd - r) * q) + off; }
        const int nig = WGM * nN, gid = wgid / nig, fm = gid * WGM, gsz = (nM - fm) < WGM ? (nM - fm) : WGM;
        u.pm = fm + ((wgid % nig) % gsz); u.pn = (wgid % nig) / gsz; u.e = 0; u.lbase = 0; u.nv = 256; return true;
    }
    __device__ __forceinline__ void a_offs(const Unit& u, const int (&R)[2], const int (&C)[2], unsigned (&o)[2][2]) const {
#pragma unroll
        for (int h = 0; h < 2; ++h)
#pragma unroll
            for (int i = 0; i < 2; ++i) o[h][i] = (unsigned)((u.pm * BM + h * HALF + R[i]) * pitch + C[i] * 2);
    }
    __device__ __forceinline__ const char* b_tile(const Unit& u) const { return Bt + (size_t)u.pn * BM * pitch; }
    __device__ __forceinline__ const char* a_tile(const Unit& u) const { return A + (size_t)u.pm * BM * pitch; }
};

struct PanelProb : DenseProb {
    __device__ __forceinline__ bool next(int i, Unit& u) const { if (i >= nN || c >= nM) return false; u.pm = c; u.pn = i; u.e = 0; u.lbase = 0; u.nv = 256; return true; }
};
struct MoeOrder {
    const LAS int* bstart; const LAS int* cnt; int nblk, nwg, G, c;
    __device__ __forceinline__ void init(const LAS int* bs, const LAS int* cn, int G_, int c_) { bstart = bs; cnt = cn; nblk = bs[NEXP]; nwg = nblk * 4; G = G_; c = c_; }
    __device__ __forceinline__ bool next(int i, Unit& u) const {
        const long L = (long)i * G + c; if (L >= nwg) return false;
        int wgid = (int)L; { const int q = nwg / NXCD, r = nwg % NXCD, xcd = wgid % NXCD, off = wgid / NXCD; wgid = (xcd < r ? xcd * (q + 1) : r * (q + 1) + (xcd - r) * q) + off; }
        const int gid = wgid / 32, fm = gid * 8, gsz = (nblk - fm) < 8 ? (nblk - fm) : 8, w = wgid - gid * 32;
        const int blk = fm + (w % gsz); u.pn = w / gsz; u.pm = blk;
        int e = 0;
        while (e < NEXP - 1 && blk >= bstart[e + 1]) ++e;
        const int rb = blk - bstart[e]; u.e = e; u.lbase = e * LISTCAP + rb * 256; const int rem = cnt[e] - rb * 256; u.nv = rem < 256 ? rem : 256; return true;
    }
};
struct MoeUpProb : MoeOrder {
    static constexpr bool GATHER = true;
    const char* A; const char* Bt; int pitch; const int* list;
    __device__ __forceinline__ const char* a_tile(const Unit&) const { return A; }
    __device__ __forceinline__ void a_offs(const Unit& u, const int (&R)[2], const int (&C)[2], unsigned (&o)[2][2]) const {
        unsigned w[2][2];
#pragma unroll
        for (int h = 0; h < 2; ++h)
#pragma unroll
            for (int i = 0; i < 2; ++i) { const int r = h * HALF + R[i]; w[h][i] = (unsigned)list[u.lbase + ((r < u.nv) ? r : 0)]; }
        asm volatile("" : "+v"(w[0][0]), "+v"(w[0][1]), "+v"(w[1][0]), "+v"(w[1][1]));
#pragma unroll
        for (int h = 0; h < 2; ++h)
#pragma unroll
            for (int i = 0; i < 2; ++i) { const int r = h * HALF + R[i]; const int tok = (r < u.nv) ? (int)(w[h][i] >> 16) : 0; o[h][i] = (unsigned)(tok * pitch + C[i] * 2); }
    }
    __device__ __forceinline__ const char* b_tile(const Unit& u) const { return Bt + ((size_t)u.e * 1024 + (size_t)u.pn * BM) * pitch; }
};
struct MoeDownProb : MoeOrder {
    static constexpr bool GATHER = false;
    const char* A; const char* Bt; int pitch;
    __device__ __forceinline__ const char* a_tile(const Unit& u) const { return A + (size_t)u.pm * BM * pitch; }
    __device__ __forceinline__ void a_offs(const Unit& u, const int (&R)[2], const int (&C)[2], unsigned (&o)[2][2]) const {
#pragma unroll
        for (int h = 0; h < 2; ++h)
#pragma unroll
            for (int i = 0; i < 2; ++i) o[h][i] = (unsigned)((u.pm * BM + h * HALF + R[i]) * pitch + C[i] * 2);
    }
    __device__ __forceinline__ const char* b_tile(const Unit& u) const { return Bt + ((size_t)u.e * 1024 + (size_t)u.pn * BM) * pitch; }
};

struct EpiNull { __device__ __forceinline__ void prefetch(const Unit&, int, int, int, int) const {} __device__ __forceinline__ void stage(const Unit&, int, int, int) const {}
    __device__ __forceinline__ void operator()(f32x4 (&acc)[2][2][4][2], const Unit&, int, int, int, int) const {
#pragma unroll
    for (int a = 0; a < 2; ++a)
#pragma unroll
        for (int b = 0; b < 2; ++b)
#pragma unroll
            for (int m = 0; m < 4; ++m) asm volatile("" :: "v"(acc[a][b][m][0]), "v"(acc[a][b][m][1])); } };
struct DenseProbSame : DenseProb {
    __device__ __forceinline__ void a_offs(const Unit&, const int (&R)[2], const int (&C)[2], unsigned (&o)[2][2]) const { Unit z{0, 0, 0, 0, 256}; DenseProb::a_offs(z, R, C, o); }
    __device__ __forceinline__ const char* b_tile(const Unit&) const { return Bt; }
};
struct NoHook { static constexpr int AT = -1; __device__ __forceinline__ void operator()(f32x4 (&)[2][2][4][2], const Unit&, int, int, int, int) const {} };

template <bool FP8, class Prob, class Epi, class Hook, int PM = 0>
__device__ __forceinline__ void gemm_core(LAS unsigned char* lds, const Prob& P, const Epi& E, const Hook& HK) {
    const int tid = opaque_tid(), wid = __builtin_amdgcn_readfirstlane(tid >> 6), lane = tid & 63, wr = wid >> 2, wc = wid & 3, fr = lane & 15, fq = lane >> 4;
    const int pitch = P.pitch, nt = pitch / (BK * 2);
    int R[2], C[2]; unsigned voffB[2], voffA[2];
#pragma unroll
    for (int i = 0; i < 2; ++i) { stage_rc(tid * 16 + i * 8192, R[i], C[i]); const int Rb = (R[i] & ~31) + perm32(R[i] & 31); voffB[i] = (unsigned)(Rb * pitch + C[i] * 2); voffA[i] = (unsigned)(R[i] * pitch + C[i] * 2); }
    const size_t kstep = (size_t)(BK * 2);
    const size_t hstep = (size_t)HALF * pitch;
    const unsigned ldsw = (unsigned)wid * 1024u;
    const int aoff = lds_byte(wr * 64 + fr, fq * 8), boff = lds_byte(wc * 32 + fr, fq * 8);
#define PG8_SA(b, h) (((b) * 2 + (h)) * HTB)
#define PG8_SB(b, h) ((4 + (b) * 2 + (h)) * HTB)
#define PG8_STAGE_B(bufoff, gbase) do { if constexpr (PM != 1) _Pragma("unroll") for (int _i = 0; _i < 2; ++_i) \
        __builtin_amdgcn_global_load_lds((const unsigned*)((const char*)(gbase) + voffB[_i]), (LAS unsigned*)(lds + (bufoff) + ldsw + _i * 8192), 16, 0, 0); } while (0)
#define PG8_STAGE_AG(bufoff, kb, va) do { if constexpr (PM != 1) _Pragma("unroll") for (int _i = 0; _i < 2; ++_i) \
        __builtin_amdgcn_global_load_lds((const unsigned*)(P.A + (kb) + (va)[_i]), (LAS unsigned*)(lds + (bufoff) + ldsw + _i * 8192), 16, 0, 0); } while (0)
#define PG8_STAGE_AD(bufoff, ubase) do { if constexpr (PM != 1) _Pragma("unroll") for (int _i = 0; _i < 2; ++_i) \
        __builtin_amdgcn_global_load_lds((const unsigned*)((const char*)(ubase) + voffA[_i]), (LAS unsigned*)(lds + (bufoff) + ldsw + _i * 8192), 16, 0, 0); } while (0)
#define PG8_STAGE_AC(bufoff, kb, h) do { if constexpr (Prob::GATHER) { PG8_STAGE_AG(bufoff, kb, cvA[h]); } else { PG8_STAGE_AD(bufoff, cA + (h) * hstep + (kb)); } } while (0)
#define PG8_STAGE_AN(bufoff, kb, h) do { if constexpr (Prob::GATHER) { PG8_STAGE_AG(bufoff, kb, v2[h]); } else { PG8_STAGE_AD(bufoff, (last ? nA : cA) + (h) * hstep + (kb)); } } while (0)
#define PG8_LDA(dst, b, h) do { _Pragma("unroll") for (int m = 0; m < 4; ++m) _Pragma("unroll") for (int k = 0; k < 2; ++k) { if constexpr (PM == 3) asm volatile("" : "=v"(dst[m][k])); else dst[m][k] = *(const LAS bf16x8*)(lds + PG8_SA(b, h) + aoff + m * 2048 + k * 1024); } } while (0)
#define PG8_LDB(dst, b, h) do { _Pragma("unroll") for (int n = 0; n < 2; ++n) _Pragma("unroll") for (int k = 0; k < 2; ++k) { if constexpr (PM == 3) asm volatile("" : "=v"(dst[n][k])); else dst[n][k] = *(const LAS bf16x8*)(lds + PG8_SB(b, h) + boff + n * 2048 + k * 1024); } } while (0)
#define PG8_CAT(x) __builtin_bit_cast(i32x8, __builtin_shufflevector((x)[0], (x)[1], 0, 1, 2, 3, 4, 5, 6, 7, 8, 9, 10, 11, 12, 13, 14, 15))
#define PG8_MMA(ai, bj, At, Bt) do { __builtin_amdgcn_s_setprio(1); \
        if constexpr (PM == 2) { _Pragma("unroll") for (int m = 0; m < 4; ++m) asm volatile("" :: "v"(At[m][0]), "v"(At[m][1])); _Pragma("unroll") for (int n = 0; n < 2; ++n) asm volatile("" :: "v"(Bt[n][0]), "v"(Bt[n][1])); } \
        else if constexpr (FP8) { _Pragma("unroll") for (int m = 0; m < 4; ++m) _Pragma("unroll") for (int n = 0; n < 2; ++n) \
            { const i32x8 bq_ = PG8_CAT(Bt[n]), aq_ = PG8_CAT(At[m]); \
              asm volatile("v_mfma_scale_f32_16x16x128_f8f6f4 %0, %1, %2, %0, %3, %3 op_sel_hi:[0,0,0]" : "+v"(acc[ai][bj][m][n]) : "v"(bq_), "v"(aq_), "v"(sc8)); } } \
        else { _Pragma("unroll") for (int m = 0; m < 4; ++m) _Pragma("unroll") for (int n = 0; n < 2; ++n) _Pragma("unroll") for (int k = 0; k < 2; ++k) \
            acc[ai][bj][m][n] = __builtin_amdgcn_mfma_f32_16x16x32_bf16(Bt[n][k], At[m][k], acc[ai][bj][m][n], 0, 0, 0); } \
        __builtin_amdgcn_s_setprio(0); } while (0)
#define PG8_WAIT_V(n) asm volatile("s_waitcnt vmcnt(" #n ")" ::: "memory")
#define PG8_WAIT_L(n) asm volatile("s_waitcnt lgkmcnt(" #n ")" ::: "memory")
#define PG8_BAR __builtin_amdgcn_s_barrier()
#define PG8_SCHED __builtin_amdgcn_sched_barrier(0)
    Unit cur, nxt; int ui = 0;
    if (!P.next(0, cur)) return;
    int sc8 = 0x7f7f7f7f; asm volatile("" : "+v"(sc8));
    f32x4 acc[2][2][4][2];
#pragma unroll
    for (int a = 0; a < 2; ++a)
#pragma unroll
        for (int b = 0; b < 2; ++b)
#pragma unroll
            for (int m = 0; m < 4; ++m)
#pragma unroll
                for (int n = 0; n < 2; ++n) acc[a][b][m][n] = (f32x4){0.f, 0.f, 0.f, 0.f};
    bf16x8 At[4][2], B0[2][2], B1[2][2];
    unsigned cvA[2][2], nvA[2][2];
    if constexpr (Prob::GATHER) P.a_offs(cur, R, C, cvA);
    const char* cA = P.a_tile(cur);
    const char* cB = P.b_tile(cur);
    PG8_STAGE_B(PG8_SB(0, 0), cB); PG8_STAGE_B(PG8_SB(0, 1), cB + hstep); PG8_STAGE_AC(PG8_SA(0, 0), 0, 0); PG8_STAGE_AC(PG8_SA(0, 1), 0, 1);
    if (wr == 1) { PG8_BAR; E.stage(cur, wc, fr, fq); }
    PG8_WAIT_V(2); PG8_BAR;
    PG8_STAGE_B(PG8_SB(1, 0), cB + kstep); PG8_STAGE_AC(PG8_SA(1, 0), kstep, 0); PG8_STAGE_B(PG8_SB(1, 1), cB + hstep + kstep);
    PG8_WAIT_V(6); PG8_BAR;
    E.prefetch(cur, wr, wc, fr, fq);
    for (;;) {
        const bool has_next = P.next(ui + 1, nxt);
        if constexpr (Prob::GATHER) {
            if (has_next) P.a_offs(nxt, R, C, nvA);
            else {
#pragma unroll
                for (int h = 0; h < 2; ++h)
#pragma unroll
                    for (int i = 0; i < 2; ++i) nvA[h][i] = cvA[h][i];
            }
        }
        const char* nA = has_next ? P.a_tile(nxt) : cA;
        const char* nB = has_next ? P.b_tile(nxt) : cB;
        for (int t = 0; t < (PM == 4 ? 0 : nt); t += 2) {
            if (Hook::AT >= 0 && t == Hook::AT) HK(acc, cur, wr, wc, fr, fq);
            const bool last = (t == nt - 2);
            const size_t k1 = (size_t)(t + 1) * kstep;
            const size_t k2 = last ? 0 : (size_t)(t + 2) * kstep, k3 = k2 + kstep;
            const char* b2 = last ? nB : cB + (size_t)(t + 2) * kstep; const char* b3 = b2 + kstep;
            unsigned v2[2][2];
            if constexpr (Prob::GATHER) {
#pragma unroll
                for (int h = 0; h < 2; ++h)
#pragma unroll
                    for (int i = 0; i < 2; ++i) v2[h][i] = last ? nvA[h][i] : cvA[h][i];
            }
            PG8_LDB(B0, 0, 0); PG8_LDB(B1, 0, 1); PG8_SCHED; PG8_LDA(At, 0, 0); PG8_STAGE_AC(PG8_SA(1, 1), k1, 1);
            PG8_WAIT_V(8); PG8_WAIT_L(0); PG8_BAR; PG8_MMA(0, 0, At, B0); PG8_MMA(0, 1, At, B1); PG8_BAR; PG8_SCHED;
            PG8_LDA(At, 0, 1); PG8_STAGE_B(PG8_SB(0, 0), b2); PG8_STAGE_B(PG8_SB(0, 1), b2 + hstep); PG8_STAGE_AN(PG8_SA(0, 0), k2, 0);
            PG8_WAIT_V(8); PG8_WAIT_L(0); PG8_BAR; PG8_MMA(1, 0, At, B0); PG8_MMA(1, 1, At, B1); PG8_BAR; PG8_SCHED;
            PG8_LDB(B0, 1, 0); PG8_LDB(B1, 1, 1); PG8_SCHED; PG8_LDA(At, 1, 0); PG8_STAGE_AN(PG8_SA(0, 1), k2, 1);
            PG8_WAIT_V(8); PG8_WAIT_L(0); PG8_BAR; PG8_MMA(0, 0, At, B0); PG8_MMA(0, 1, At, B1); PG8_BAR; PG8_SCHED;
            PG8_LDA(At, 1, 1); PG8_STAGE_B(PG8_SB(1, 0), b3); PG8_STAGE_B(PG8_SB(1, 1), b3 + hstep); PG8_STAGE_AN(PG8_SA(1, 0), k3, 0);
            PG8_WAIT_V(8); PG8_WAIT_L(0); PG8_BAR; PG8_MMA(1, 0, At, B0); PG8_MMA(1, 1, At, B1); PG8_BAR; PG8_SCHED;
        }
        if (wr == 0) PG8_BAR;
        if constexpr (FP8) {
            asm volatile("s_nop 15\n\ts_nop 7" ::: "memory");
#pragma unroll
            for (int a = 0; a < 2; ++a)
#pragma unroll
                for (int b = 0; b < 2; ++b)
#pragma unroll
                    for (int m = 0; m < 4; ++m) asm volatile("" : "+v"(acc[a][b][m][0]), "+v"(acc[a][b][m][1]));
        }
        E(acc, cur, wr, wc, fr, fq);
        if (!has_next) break;
        E.prefetch(nxt, wr, wc, fr, fq);
#pragma unroll
        for (int a = 0; a < 2; ++a)
#pragma unroll
            for (int b = 0; b < 2; ++b)
#pragma unroll
                for (int m = 0; m < 4; ++m)
#pragma unroll
                    for (int n = 0; n < 2; ++n) acc[a][b][m][n] = (f32x4){0.f, 0.f, 0.f, 0.f};
        cur = nxt; cA = nA; cB = nB; ++ui;
        if constexpr (Prob::GATHER) {
#pragma unroll
            for (int h = 0; h < 2; ++h)
#pragma unroll
                for (int i = 0; i < 2; ++i) cvA[h][i] = nvA[h][i];
        }
        if (wr == 1) { PG8_BAR; E.stage(cur, wc, fr, fq); }
    }
    PG8_WAIT_V(0);
    PG8_BAR;
#undef PG8_SA
#undef PG8_SB
#undef PG8_STAGE_AG
#undef PG8_STAGE_AD
#undef PG8_STAGE_AC
#undef PG8_STAGE_AN
#undef PG8_STAGE_B
#undef PG8_LDA
#undef PG8_LDB
#undef PG8_MMA
#undef PG8_CAT
#undef PG8_WAIT_V
#undef PG8_WAIT_L
#undef PG8_BAR
#undef PG8_SCHED
}

__device__ __forceinline__ void pair_store16(unsigned char* p, size_t r8, const u32x4& A, const u32x4& B) {
    u32x4 s1, s2;
    s1.x = __builtin_amdgcn_update_dpp(A.x, B.x, 0x128, 0xf, 0xc, false); s1.y = __builtin_amdgcn_update_dpp(A.y, B.y, 0x128, 0xf, 0xc, false);
    s1.z = __builtin_amdgcn_update_dpp(A.z, B.z, 0x128, 0xf, 0xc, false); s1.w = __builtin_amdgcn_update_dpp(A.w, B.w, 0x128, 0xf, 0xc, false);
    s2.x = __builtin_amdgcn_update_dpp(B.x, A.x, 0x128, 0xf, 0x3, false); s2.y = __builtin_amdgcn_update_dpp(B.y, A.y, 0x128, 0xf, 0x3, false);
    s2.z = __builtin_amdgcn_update_dpp(B.z, A.z, 0x128, 0xf, 0x3, false); s2.w = __builtin_amdgcn_update_dpp(B.w, A.w, 0x128, 0xf, 0x3, false);
    *(u32x4*)p = s1; *(u32x4*)(p + r8) = s2;
}
__device__ __forceinline__ u32x4 pack8(const f32x4& v0, const f32x4& v1) { u32x4 w; w.x = cvt_pk_bf16(v0[0], v0[1]); w.y = cvt_pk_bf16(v0[2], v0[3]); w.z = cvt_pk_bf16(v1[0], v1[1]); w.w = cvt_pk_bf16(v1[2], v1[3]); return w; }

struct EpiStoreOnly {
    bf16_t* O;
    __device__ __forceinline__ void prefetch(const Unit&, int, int, int, int) const {}
    __device__ __forceinline__ void stage(const Unit&, int, int, int) const {}
    __device__ __forceinline__ void operator()(f32x4 (&acc)[2][2][4][2], const Unit& u, int wr, int wc, int fr, int fq) const {
        const int cl0 = wc * 32 + 8 * fq; int row0 = u.pm * BM + wr * 64 + fr; asm volatile("" : "+v"(row0));
#pragma unroll
        for (int ai = 0; ai < 2; ++ai)
#pragma unroll
            for (int m = 0; m < 4; ++m) { bf16_t* rowp = O + (size_t)(row0 + ai * HALF + m * 16) * 256 + cl0;
#pragma unroll
                for (int bj = 0; bj < 2; ++bj) *(u32x4*)(rowp + bj * HALF) = pack8(acc[ai][bj][m][0], acc[ai][bj][m][1]); }
    }
};
#define EPI_ST(val, ptr) do { if constexpr (MODE == 1) { auto v_ = (val); asm volatile("" :: "v"(v_)); } else *(ptr) = (val); } while (0)
template <int MODE> struct EpiInProjT {
    bf16_t *UV, *Q, *Kb, *Vb; unsigned char* G8; const float* cs; unsigned char *Q8, *K8; LAS unsigned char* lds;
    __device__ __forceinline__ void prefetch(const Unit&, int, int, int, int) const {}
    __device__ __forceinline__ void stage(const Unit& u, int wc, int fr, int fq) const {
        if (u.pn >= 4 && u.pn < 8) { const float* src = cs + (size_t)(u.pm * BM + wc * 64) * 16 + (fq * 16 + fr) * 4;
#pragma unroll
            for (int i = 0; i < 4; ++i) __builtin_amdgcn_global_load_lds((const unsigned*)(src + i * 256), (LAS unsigned*)(lds + STAGE_BYTES + wc * 4096 + i * 1024), 16, 0, 0); } }
    template <class PT> __device__ __forceinline__ void st_pair(PT* p, int pitch, const u32x4& A, const u32x4& B) const {
        if constexpr (MODE == 1) { asm volatile("" :: "v"(A), "v"(B)); } else pair_store16((unsigned char*)p, (size_t)8 * pitch * sizeof(PT), A, B); }
    __device__ __forceinline__ void operator()(f32x4 (&acc)[2][2][4][2], const Unit& u, int wr, int wc, int fr, int fq) const {
        constexpr bool NOMATH = (MODE == 2);
        const int pn = u.pn; int row0 = u.pm * BM + wr * 64 + fr; asm volatile("" : "+v"(row0));
        int prow0 = row0 - (fr & 8), pcl = wc * 64 + 8 * fq + 4 * (fr & 8);
        asm volatile("" : "+v"(prow0), "+v"(pcl));
        if (pn < 4) {
#pragma unroll
            for (int ai = 0; ai < 2; ++ai)
#pragma unroll
                for (int m = 0; m < 4; ++m) { u32x4 w[2];
#pragma unroll
                    for (int bj = 0; bj < 2; ++bj) { f32x4 v0 = acc[ai][bj][m][0], v1 = acc[ai][bj][m][1];
                        if constexpr (!NOMATH) { const f32x2 a = gelu_tanh2(v0.xy), b = gelu_tanh2(v0.zw), c = gelu_tanh2(v1.xy), d = gelu_tanh2(v1.zw); v0 = (f32x4){a.x, a.y, b.x, b.y}; v1 = (f32x4){c.x, c.y, d.x, d.y}; }
                        w[bj] = pack8(v0, v1); }
                    st_pair(UV + (size_t)(prow0 + ai * HALF + m * 16) * 1024 + pn * 256 + pcl, 1024, w[0], w[1]); }
        } else if (pn < 8) {
            bf16_t* dst = (pn < 6) ? Q : Kb; const float sc = (pn < 6) ? C2 : 1.0f;
            const float sgn = (fq == 0) ? -1.0f : 1.0f; const bool rot_lane = fq < 2;
#pragma unroll
            for (int ai = 0; ai < 2; ++ai) {
                f32x4 cs4[4][4];
#pragma unroll
                for (int m = 0; m < 4; ++m) { const LAS f32x4* cp = (const LAS f32x4*)(lds + STAGE_BYTES + (wr * 64 + fr + ai * HALF + m * 16) * 64);
#pragma unroll
                    for (int j = 0; j < 4; ++j) cs4[m][j] = cp[j]; }
#pragma unroll
                for (int m = 0; m < 4; ++m) { const int row = row0 + ai * HALF + m * 16; f32x4 v[2][2];
#pragma unroll
                    for (int bj = 0; bj < 2; ++bj) { v[bj][0] = acc[ai][bj][m][0]; v[bj][1] = acc[ai][bj][m][1]; }
                    if constexpr (!NOMATH) {
                        f32x4 p0, p1;
#pragma unroll
                        for (int e = 0; e < 4; ++e) { p0[e] = __shfl_xor(v[0][0][e], 16); p1[e] = __shfl_xor(v[0][1][e], 16); }
                        if (rot_lane) {
#pragma unroll
                            for (int e = 0; e < 4; ++e) { v[0][0][e] = v[0][0][e] * cs4[m][0][e] + sgn * p0[e] * cs4[m][2][e]; v[0][1][e] = v[0][1][e] * cs4[m][1][e] + sgn * p1[e] * cs4[m][3][e]; }
                        }
                    }
                    if ((wc & 1) == 0) {
                        st_pair(dst + (size_t)(prow0 + ai * HALF + m * 16) * 512 + (pn & 1) * 256 + pcl, 512, pack8(v[0][0] * sc, v[0][1] * sc), pack8(v[1][0] * sc, v[1][1] * sc));
                    } else {
                        const float s8 = (pn < 6) ? sc * 8.0f : 1.0f;
#pragma unroll
                        for (int bj = 0; bj < 2; ++bj) { const f32x4 v0 = v[bj][0] * s8, v1 = v[bj][1] * s8;
                            u32x2 q8; q8.x = cvt_pk4_fp8(v0[0], v0[1], v0[2], v0[3]); q8.y = cvt_pk4_fp8(v1[0], v1[1], v1[2], v1[3]);
                            EPI_ST(q8, (u32x2*)(((pn < 6) ? Q8 : K8) + (size_t)row * 256 + ((pn & 1) * 2 + (wc >> 1)) * 64 + bj * 32 + 8 * fq)); } } }
            }
        } else if (pn < 10) {
#pragma unroll
            for (int ai = 0; ai < 2; ++ai)
#pragma unroll
                for (int m = 0; m < 4; ++m)
                    st_pair(Vb + (size_t)(prow0 + ai * HALF + m * 16) * 512 + (pn - 8) * 256 + pcl, 512, pack8(acc[ai][0][m][0], acc[ai][0][m][1]), pack8(acc[ai][1][m][0], acc[ai][1][m][1]));
        } else {
            int gl = (fq * 16 + fr) * 16; asm volatile("" : "+v"(gl));
            unsigned char* gb = G8 + (size_t)((u.pm * 8 + (pn - 10)) * 8 + wr * 4 + wc) * 8192 + gl;
#pragma unroll
            for (int ai = 0; ai < 2; ++ai)
#pragma unroll
                for (int m = 0; m < 4; ++m) { u32x4 qq;
#pragma unroll
                    for (int bj = 0; bj < 2; ++bj) { f32x4 v0 = acc[ai][bj][m][0], v1 = acc[ai][bj][m][1];
                        if constexpr (!NOMATH) { const f32x2 a = sig255_2(v0.xy), b = sig255_2(v0.zw), c = sig255_2(v1.xy), d = sig255_2(v1.zw); v0 = (f32x4){a.x, a.y, b.x, b.y}; v1 = (f32x4){c.x, c.y, d.x, d.y}; }
                        const unsigned qa = cvt_pk4_u8(v0[0], v0[1], v0[2], v0[3]), qb = cvt_pk4_u8(v1[0], v1[1], v1[2], v1[3]);
                        if (bj == 0) { qq.x = qa; qq.y = qb; } else { qq.z = qa; qq.w = qb; } }
                    EPI_ST(qq, (u32x4*)(gb + (ai * 4 + m) * 1024)); }
        }
    }
};

#undef EPI_ST
using EpiInProj = EpiInProjT<0>;
__device__ __forceinline__ void unpack8(const u32x4& w, f32x4& a, f32x4& b) { a = (f32x4){bf_lo(w.x), bf_hi(w.x), bf_lo(w.y), bf_hi(w.y)}; b = (f32x4){bf_lo(w.z), bf_hi(w.z), bf_lo(w.w), bf_hi(w.w)}; }
struct HookMerge {
    static constexpr int AT = 8;
    const unsigned char* G8;
    __device__ __forceinline__ void operator()(f32x4 (&acc)[2][2][4][2], const Unit& u, int wr, int wc, int fr, int fq) const {
        const unsigned char* gp = G8 + (size_t)((u.pm * 8 + u.pn) * 8 + wr * 4 + wc) * 8192 + ((fq >> 1) * 16 + fr) * 16 + 8 * (fq & 1); asm volatile("" : "+v"(gp));
        u32x2 w0[2][4][2], w1[2][4][2];
#pragma unroll
        for (int ai = 0; ai < 2; ++ai)
#pragma unroll
            for (int m = 0; m < 4; ++m)
#pragma unroll
                for (int bj = 0; bj < 2; ++bj) { w0[ai][m][bj] = *(const u32x2*)(gp + (ai * 4 + m) * 1024 + bj * 512); w1[ai][m][bj] = *(const u32x2*)(gp + 4 * 65536 + (ai * 4 + m) * 1024 + bj * 512); }
#pragma unroll
        for (int ai = 0; ai < 2; ++ai)
#pragma unroll
            for (int m = 0; m < 4; ++m)
#pragma unroll
                for (int bj = 0; bj < 2; ++bj) { const f32x4 a0 = u8x4_to_f32(w0[ai][m][bj].x), a1 = u8x4_to_f32(w0[ai][m][bj].y), b0 = u8x4_to_f32(w1[ai][m][bj].x), b1 = u8x4_to_f32(w1[ai][m][bj].y);
#pragma unroll
                    for (int e = 0; e < 4; ++e) { acc[ai][bj][m][0][e] *= a0[e] * fast_rcp(fmaxf(b0[e], 0.5f)); acc[ai][bj][m][1][e] *= a1[e] * fast_rcp(fmaxf(b1[e], 0.5f)); } }
    }
};
struct EpiMerge {
    const unsigned char* G8; bf16_t* MG;
    __device__ __forceinline__ void prefetch(const Unit&, int, int, int, int) const {}
    __device__ __forceinline__ void stage(const Unit&, int, int, int) const {}
    __device__ __forceinline__ void operator()(f32x4 (&acc)[2][2][4][2], const Unit& u, int wr, int wc, int fr, int fq) const {
        const unsigned char* gp = G8 + (size_t)((u.pm * 8 + u.pn + 4) * 8 + wr * 4 + wc) * 8192 + ((fq >> 1) * 16 + fr) * 16 + 8 * (fq & 1); asm volatile("" : "+v"(gp));
        int prow0 = u.pm * BM + wr * 64 + (fr & 7), pcol = u.pn * BM + wc * 64 + 8 * fq + 4 * (fr & 8); asm volatile("" : "+v"(prow0), "+v"(pcol));
        u32x2 w1[2][4][2];
#pragma unroll
        for (int ai = 0; ai < 2; ++ai)
#pragma unroll
            for (int m = 0; m < 4; ++m)
#pragma unroll
                for (int bj = 0; bj < 2; ++bj) w1[ai][m][bj] = *(const u32x2*)(gp + (ai * 4 + m) * 1024 + bj * 512);
        const float s255 = 1.0f / 255.0f;
#pragma unroll
        for (int ai = 0; ai < 2; ++ai)
#pragma unroll
            for (int m = 0; m < 4; ++m) { u32x4 w[2];
#pragma unroll
                for (int bj = 0; bj < 2; ++bj) { f32x4 b0 = u8x4_to_f32(w1[ai][m][bj].x), b1 = u8x4_to_f32(w1[ai][m][bj].y);
#pragma unroll
                    for (int e = 0; e < 4; ++e) { b0[e] = fmaxf(b0[e], 0.5f) * s255; b1[e] = fmaxf(b1[e], 0.5f) * s255; }
                    w[bj] = pack8(acc[ai][bj][m][0] * b0, acc[ai][bj][m][1] * b1); }
                pair_store16((unsigned char*)(MG + (size_t)(prow0 + ai * HALF + m * 16) * 1024 + pcol), (size_t)8 * 1024 * 2, w[0], w[1]); }
    }
};

struct EpiX1 {
    const float* X; bf16_t* XB; unsigned char* XB8; float* ssq;
    __device__ __forceinline__ void prefetch(const Unit&, int, int, int, int) const {}
    __device__ __forceinline__ void stage(const Unit&, int, int, int) const {}
    __device__ __forceinline__ void operator()(f32x4 (&acc)[2][2][4][2], const Unit& u, int wr, int wc, int fr, int fq) const {
        const int col0 = u.pn * BM + wc * 64 + 8 * fq; int row0 = u.pm * BM + wr * 64 + fr; asm volatile("" : "+v"(row0));
#pragma unroll
        for (int ai = 0; ai < 2; ++ai) {
            f32x4 xv[4][2][2];
#pragma unroll
            for (int m = 0; m < 4; ++m) { const float* xp = X + (size_t)(row0 + ai * HALF + m * 16) * 1024 + col0;
#pragma unroll
                for (int bj = 0; bj < 2; ++bj) { xv[m][bj][0] = *(const f32x4*)(xp + bj * 32); xv[m][bj][1] = *(const f32x4*)(xp + bj * 32 + 4); } }
#pragma unroll
            for (int m = 0; m < 4; ++m) { const size_t row = (size_t)(row0 + ai * HALF + m * 16); u32x4 wb[2];
                float s = 0.f;
#pragma unroll
                for (int bj = 0; bj < 2; ++bj) { const f32x4 v0 = acc[ai][bj][m][0] + xv[m][bj][0], v1 = acc[ai][bj][m][1] + xv[m][bj][1];
                    wb[bj] = pack8(v0, v1);
                    { u32x2 q8; q8.x = cvt_pk4_fp8(v0[0], v0[1], v0[2], v0[3]); q8.y = cvt_pk4_fp8(v1[0], v1[1], v1[2], v1[3]); *(u32x2*)(XB8 + row * 1024 + col0 + bj * 32) = q8; }
                    s += (v0[0] * v0[0] + v0[1] * v0[1]) + (v0[2] * v0[2] + v0[3] * v0[3]) + (v1[0] * v1[0] + v1[1] * v1[1]) + (v1[2] * v1[2] + v1[3] * v1[3]); }
                pair_store16((unsigned char*)(XB + (row - (fr & 8)) * 1024 + col0 + 4 * (fr & 8)), (size_t)8 * 1024 * 2, wb[0], wb[1]);
                s += __shfl_xor(s, 16); s += __shfl_xor(s, 32);
                if (fq == 0) ssq[row * 16 + u.pn * 4 + wc] = s; }
        }
    }
};

struct EpiMoeUp {
    const int* list; const float* rstd; unsigned char* H8;
    __device__ __forceinline__ void stage(const Unit&, int, int, int) const {}
    mutable float rs[2][4];
    __device__ __forceinline__ void prefetch(const Unit& u, int wr, int wc, int fr, int fq) const {
        int r0 = wr * 64 + fr; asm volatile("" : "+v"(r0));
        int tok[2][4]; unsigned w[2][4];
#pragma unroll
        for (int ai = 0; ai < 2; ++ai)
#pragma unroll
            for (int m = 0; m < 4; ++m) { const int r = r0 + ai * HALF + m * 16; w[ai][m] = (unsigned)list[u.lbase + ((r < u.nv) ? r : 0)]; }
#pragma unroll
        for (int ai = 0; ai < 2; ++ai) asm volatile("" : "+v"(w[ai][0]), "+v"(w[ai][1]), "+v"(w[ai][2]), "+v"(w[ai][3]));
#pragma unroll
        for (int ai = 0; ai < 2; ++ai)
#pragma unroll
            for (int m = 0; m < 4; ++m) { const int r = r0 + ai * HALF + m * 16; tok[ai][m] = (r < u.nv) ? (int)(w[ai][m] >> 16) : 0; }
#pragma unroll
        for (int ai = 0; ai < 2; ++ai)
#pragma unroll
            for (int m = 0; m < 4; ++m) rs[ai][m] = rstd[tok[ai][m]];
    }
    __device__ __forceinline__ void pin() const {
#pragma unroll
        for (int ai = 0; ai < 2; ++ai) asm volatile("" : "+v"(rs[ai][0]), "+v"(rs[ai][1]), "+v"(rs[ai][2]), "+v"(rs[ai][3])); }
    __device__ __forceinline__ void operator()(f32x4 (&acc)[2][2][4][2], const Unit& u, int wr, int wc, int fr, int fq) const {
        const int col0 = u.pn * 128 + wc * 32 + 8 * fq; int r0 = wr * 64 + fr; asm volatile("" : "+v"(r0));
#pragma unroll
        for (int ai = 0; ai < 2; ++ai)
#pragma unroll
            for (int m = 0; m < 4; ++m) { const int r = r0 + ai * HALF + m * 16; const float rsv = rs[ai][m] * 0.015625f;
                f32x4 g0 = acc[ai][0][m][0] * rsv, g1 = acc[ai][0][m][1] * rsv, u0 = acc[ai][1][m][0] * rsv, u1 = acc[ai][1][m][1] * rsv;
#pragma unroll
                for (int e = 0; e < 4; ++e) { g0[e] = g0[e] * sigmoidf_(g0[e]) * (u0[e] * 8.f); g1[e] = g1[e] * sigmoidf_(g1[e]) * (u1[e] * 8.f); }
                u32x2 q8; q8.x = cvt_pk4_fp8(g0[0], g0[1], g0[2], g0[3]); q8.y = cvt_pk4_fp8(g1[0], g1[1], g1[2], g1[3]);
                *(u32x2*)(H8 + (size_t)(u.pm * BM + r) * 512 + col0) = q8; }
    }
};
struct EpiMoeDown {
    const int* list; unsigned char* YB8;
    __device__ __forceinline__ void stage(const Unit&, int, int, int) const {}
    mutable unsigned lw[2][4];
    __device__ __forceinline__ void prefetch(const Unit& u, int wr, int wc, int fr, int fq) const {
        int r0 = wr * 64 + fr; asm volatile("" : "+v"(r0));
#pragma unroll
        for (int ai = 0; ai < 2; ++ai)
#pragma unroll
            for (int m = 0; m < 4; ++m) { const int r = r0 + ai * HALF + m * 16; lw[ai][m] = (unsigned)list[u.lbase + ((r < u.nv) ? r : 0)]; }
    }
    __device__ __forceinline__ void pin() const {
#pragma unroll
        for (int ai = 0; ai < 2; ++ai) asm volatile("" : "+v"(lw[ai][0]), "+v"(lw[ai][1]), "+v"(lw[ai][2]), "+v"(lw[ai][3])); }
    __device__ __forceinline__ void operator()(f32x4 (&acc)[2][2][4][2], const Unit& u, int wr, int wc, int fr, int fq) const {
        int r0 = wr * 64 + fr; asm volatile("" : "+v"(r0));
        const int col0 = u.pn * BM + wc * 64 + 16 * fq;
#pragma unroll
        for (int ai = 0; ai < 2; ++ai)
#pragma unroll
            for (int m = 0; m < 4; ++m) { const unsigned word = lw[ai][m];
                if (r0 + ai * HALF + m * 16 < u.nv) { const float w = __uint_as_float((word & 0x7fffu) << 16) * 0.0625f;
                    unsigned char* op = YB8 + (size_t)(word >> 15) * 1024 + col0; u32x4 q;
                    { const f32x4 y0 = acc[ai][0][m][0] * w, y1 = acc[ai][0][m][1] * w; q.x = cvt_pk4_fp8(y0[0], y0[1], y0[2], y0[3]); q.y = cvt_pk4_fp8(y1[0], y1[1], y1[2], y1[3]); }
                    { const f32x4 y0 = acc[ai][1][m][0] * w, y1 = acc[ai][1][m][1] * w; q.z = cvt_pk4_fp8(y0[0], y0[1], y0[2], y0[3]); q.w = cvt_pk4_fp8(y1[0], y1[1], y1[2], y1[3]); }
                    *(u32x4*)op = q; } }
    }
};
template <class Epi> struct HookPin { static constexpr int AT = 2; const Epi* E;
    __device__ __forceinline__ void operator()(f32x4 (&)[2][2][4][2], const Unit&, int, int, int, int) const { E->pin(); } };
}


namespace att {
constexpr int QB = 256, KVB = 64, QP = 512  ;
#if PROBE_PHASE == 52
#define ATT_REF_OFF 0.0f
#else
#define ATT_REF_OFF 0.0f
#endif
constexpr int KSLOT = 8192, VSLOT = 8192, NSLOT = 3;
constexpr int L_K = 0, L_V = NSLOT * KSLOT, L_WS = L_V + NSLOT * VSLOT, L_OST = L_WS + NWAVES * 256, L_END = L_OST + NWAVES * 8192;
static_assert(L_END <= RING_BYTES, "attention LDS");
#if PROBE_PHASE == 40
#define ATT_RESC_THR 0.f
#define ATT_RESC_MIN 0.001f
#define ATT_RESC_LO -2.f
#else
#define ATT_RESC_THR 512.f
#define ATT_RESC_MIN 64.f
#define ATT_RESC_LO 0.f
#endif
__device__ __forceinline__ int crow(int r, int hi) { return (r & 3) + 8 * (r >> 2) + 4 * hi; }
__device__ __forceinline__ void glds16(const void* gsrc, unsigned lds_dst) { unsigned keep;
    asm volatile("s_mov_b32 %0, m0\n\ts_mov_b32 m0, %2\n\ts_nop 0\n\tglobal_load_lds_dwordx4 %1, off\n\ts_mov_b32 m0, %0" : "=&s"(keep) : "v"(gsrc), "s"(lds_dst) : "memory"); }
#define ATT_WAIT_BAR(N) asm volatile("s_waitcnt vmcnt(" #N ") lgkmcnt(0)\n\ts_barrier" ::: "memory")
#define MX3(a, b, c) __builtin_fmaxf(__builtin_fmaxf((a), (b)), (c))
#define ATT_SBAR() __builtin_amdgcn_sched_barrier(0)
#define ATT_MFMA(a, b, c) __builtin_amdgcn_mfma_f32_32x32x16_bf16(a, b, c, 0, 0, 0)
__device__ __forceinline__ float rowmax(const f32x16& p0, const f32x16& p1) {
    float a = MX3(p0[0], p0[1], p1[0]), b = MX3(p0[2], p0[3], p1[1]); a = MX3(a, p1[2], p1[3]);
#pragma unroll
    for (int r = 4; r < 16; r += 4) { a = MX3(a, p0[r], p0[r + 1]); b = MX3(b, p0[r + 2], p0[r + 3]); a = MX3(a, p1[r], p1[r + 1]); b = MX3(b, p1[r + 2], p1[r + 3]); }
    const float m = __builtin_fmaxf(a, b); auto rr = __builtin_amdgcn_permlane32_swap(__float_as_uint(m), __float_as_uint(m), false, false);
    return __builtin_fmaxf(__uint_as_float(rr[0]), __uint_as_float(rr[1])); }
__device__ __forceinline__ void cmask(f32x16& p0, f32x16& p1, int jb, int qrel, int hi) {
    const int kb = 64 * jb + 4 * hi;
#pragma unroll
    for (int r = 0; r < 16; ++r) { const int kv = kb + (r & 3) + 8 * (r >> 2); if (kv > qrel) p0[r] = -INFINITY; if (kv + 32 > qrel) p1[r] = -INFINITY; } }
typedef int i32x4 __attribute__((ext_vector_type(4)));
__device__ __forceinline__ void kload2(bf16x8* kf, const LAS char* kp, int j) { kf[2 * j] = *(const LAS bf16x8*)(kp + j * 2048); kf[2 * j + 1] = *(const LAS bf16x8*)(kp + j * 2048 + 512); }
__device__ __forceinline__ i32x8 frag32(const LAS char* row, int c0) {
    const i32x4 lo = *(const LAS i32x4*)(row + c0 * 16), hi = *(const LAS i32x4*)(row + (c0 ^ 1) * 16);
    return __builtin_shufflevector(lo, hi, 0, 1, 2, 3, 4, 5, 6, 7); }
#define MFMA8_PV(O, A, B) asm volatile("v_mfma_scale_f32_32x32x64_f8f6f4 %0, %1, %2, %0, %3, %3 op_sel_hi:[0,0,0]" : "+v"(O) : "v"(A), "v"(B), "v"(sc_1))
template <int MODE> __device__ __forceinline__ void attn_pass(f32x16 (&o)[4], int b, int hm, int h, int qb, const bf16_t* Q, const bf16_t* __restrict__ K, const unsigned char* __restrict__ V8T, LAS char* shm) {
    const int tid = opaque_tid(), lane = tid & 63, r32 = lane & 31, hi = lane >> 5; const int wid = __builtin_amdgcn_readfirstlane(tid >> 6);
    const long rowbase = (long)b * SEQ; const int q0 = qb * QB, NT = (q0 + QB) / KVB;
    const bf16_t* Qw = Q + (rowbase + q0 + wid * 32) * QP + hm * 64;
    const bf16_t* Kh = K + rowbase * QP + hm * 64;
    const unsigned lds0 = (unsigned)(uintptr_t)shm;
    LAS float* wsf = (LAS float*)(shm + L_WS) + wid * 64;
    const bf16_t* ksrc = Kh + (long)lane * QP + wid * 8;
    const unsigned char* vsrc = V8T + ((size_t)(b * 4 + h) * (SEQ / KVB)) * VSLOT + wid * 1024 + lane * 16;
    const unsigned kdst = lds0 + L_K + wid * 1024, vdst = lds0 + L_V + wid * 1024;
#define DMA_K(t, s) glds16(ksrc + (long)(t) * KVB * QP, (unsigned)__builtin_amdgcn_readfirstlane(kdst + (unsigned)(s) * KSLOT))
#define DMA_V(t, s) glds16(vsrc + (long)(t) * VSLOT, (unsigned)__builtin_amdgcn_readfirstlane(vdst + (unsigned)(s) * VSLOT))
    const LAS char* kp0 = shm + L_K + hi * 1024 + r32 * 16;
    const LAS char* vp0 = shm + L_V + r32 * 64;  const int vc0 = (2 * hi) ^ ((r32 >> 2) & 3);
    DMA_K(0, 0); DMA_V(0, 0); DMA_K(1, 1);
    bf16x8 qr[4];
#pragma unroll
    for (int d0 = 0; d0 < 4; ++d0) qr[d0] = *(const bf16x8*)(Qw + (long)r32 * QP + d0 * 16 + hi * 8);
    float mhat = 0.f, l_reg = 0.f;
    float zf = 0.f; asm volatile("" : "+v"(zf));
    int sc_1 = 0x7f7f7f7f; asm volatile("" : "+v"(sc_1));
    f32x16 negm;
#pragma unroll
    for (int r = 0; r < 16; ++r) { negm[r] = zf;
#pragma unroll
        for (int d0 = 0; d0 < 4; ++d0) o[d0][r] = zf; }
    asm volatile("" : "+v"(negm));
    const int qrel = wid * 32 + r32;
    asm volatile("" : "+v"(qr[0]), "+v"(qr[1]), "+v"(qr[2]), "+v"(qr[3]));
    LAS bf16x8* qlds = (LAS bf16x8*)(shm + L_OST + wid * 8192) + lane;
#pragma unroll
    for (int d0 = 0; d0 < 4; ++d0) qlds[d0 * 64] = qr[d0];
    DMA_K(2, 2);
    ATT_WAIT_BAR(1);
    bool resc = false;
#define CMASK(P0, P1, t) do { const int jb_ = (t) - (NT - 4); if (jb_ >= 0) cmask(P0, P1, jb_, qrel, hi); } while (0)
#define RESC() do { if (resc) { asm volatile("s_waitcnt lgkmcnt(0)\n\ts_nop 15\n\ts_nop 15\n\ts_nop 7" ::: "memory"); \
        _Pragma("unroll") for (int r = 0; r < 16; ++r) { const float fr_ = wsf[crow(r, hi)]; _Pragma("unroll") for (int d_ = 0; d_ < 4; ++d_) asm volatile("v_mul_f32 %0, %0, %1" : "+v"(o[d_][r]) : "v"(fr_)); } } } while (0)
    f32x16 pA0, pA1, pB0, pB1;
    int sl_prev = 0, sl_cur = 0, sl_next = 1;
#define ROT() do { sl_prev = sl_cur; sl_cur = sl_next; sl_next = (sl_next == NSLOT - 1) ? 0 : sl_next + 1; } while (0)
    bf16x8 kf[8];
#pragma unroll
    for (int j = 0; j < 4; ++j) kload2(kf, kp0, j);
    pA0 = ATT_MFMA(kf[0], qr[0], negm); pA1 = ATT_MFMA(kf[1], qr[0], negm);
#pragma unroll
    for (int d0 = 1; d0 < 4; ++d0) { pA0 = ATT_MFMA(kf[2 * d0], qr[d0], pA0); pA1 = ATT_MFMA(kf[2 * d0 + 1], qr[d0], pA1); }
    CMASK(pA0, pA1, 0);
    { const float rm = rowmax(pA0, pA1) - ATT_REF_OFF; mhat = rm;
#pragma unroll
      for (int r = 0; r < 16; ++r) { pA0[r] -= rm; pA1[r] -= rm; negm[r] = -rm; }
      asm volatile("" : "+v"(negm));
#pragma unroll
      for (int r = 0; r < 16; ++r) { pA0[r] = fast_exp2(pA0[r]); pA1[r] = fast_exp2(pA1[r]); } }
    ATT_WAIT_BAR(0);
    DMA_K(3, 0); DMA_V(1, 1);
    ROT();
#pragma unroll
    for (int j = 0; j < 4; ++j) kload2(kf, kp0 + sl_cur * KSLOT, j);
    ATT_WAIT_BAR(2);
    i32x8 vf[4], pf;
#define PK4(P, B) cvt_pk4_fp8(P[B], P[(B) + 1], P[(B) + 2], P[(B) + 3])
#define PIN(x) asm volatile("" : "+v"(x))
#define GAPA(MF, P, B, W) do { MF; sacc += P[B]; sacc += P[(B) + 1]; sacc += P[(B) + 2]; sacc += P[(B) + 3]; PIN(sacc); pf[W] = PK4(P, B); PIN(pf); ATT_SBAR(); } while (0)
#define EXP8(X, B) do { X[B] = fast_exp2(X[B]); X[(B) + 1] = fast_exp2(X[(B) + 1]); X[(B) + 2] = fast_exp2(X[(B) + 2]); X[(B) + 3] = fast_exp2(X[(B) + 3]); \
        X[(B) + 4] = fast_exp2(X[(B) + 4]); X[(B) + 5] = fast_exp2(X[(B) + 5]); X[(B) + 6] = fast_exp2(X[(B) + 6]); X[(B) + 7] = fast_exp2(X[(B) + 7]); PIN(X); } while (0)
#define STEP(C0, C1, P0, P1, t, GK, GV, GL) do { ATT_SBAR(); \
    const LAS char* vp_ = vp0 + sl_prev * VSLOT; \
    float sacc = 0.f; \
    bf16x8 qa_ = qlds[0], qb_ = qlds[64]; ATT_SBAR(); \
    GAPA(C0 = ATT_MFMA(kf[0], qa_, negm), P0, 0, 0); \
    GAPA(C1 = ATT_MFMA(kf[1], qa_, negm), P0, 4, 1); \
    qa_ = qlds[128]; ATT_SBAR(); \
    GAPA(C0 = ATT_MFMA(kf[2], qb_, C0), P0, 8, 2); \
    GAPA(C1 = ATT_MFMA(kf[3], qb_, C1), P0, 12, 3); \
    qb_ = qlds[192]; ATT_SBAR(); \
    vf[0] = frag32(vp_, vc0); ATT_SBAR(); GAPA(C0 = ATT_MFMA(kf[4], qa_, C0), P1, 0, 4); \
    vf[1] = frag32(vp_ + 32 * 64, vc0); ATT_SBAR(); GAPA(C1 = ATT_MFMA(kf[5], qa_, C1), P1, 4, 5); \
    vf[2] = frag32(vp_ + 64 * 64, vc0); ATT_SBAR(); GAPA(C0 = ATT_MFMA(kf[6], qb_, C0), P1, 8, 6); \
    vf[3] = frag32(vp_ + 96 * 64, vc0); ATT_SBAR(); GAPA(C1 = ATT_MFMA(kf[7], qb_, C1), P1, 12, 7); \
    l_reg += sacc; \
    if (GK) { DMA_K((t) + 3, sl_cur); } if (GV) { DMA_V((t) + 1, sl_next); } \
    CMASK(C0, C1, t); \
    {   \
      float st_; { auto rr = __builtin_amdgcn_permlane32_swap(__float_as_uint(sacc), __float_as_uint(sacc), false, false); st_ = __uint_as_float(rr[0]) + __uint_as_float(rr[1]); } \
      resc = false; \
      if (__builtin_expect(__any(st_ > ATT_RESC_THR), 0)) { const float dl = (st_ > ATT_RESC_MIN) ? __builtin_fmaxf(__builtin_floorf(__builtin_amdgcn_logf(st_)) - 6.f, ATT_RESC_LO) : 0.f; mhat += dl; \
        _Pragma("unroll") for (int r = 0; r < 16; ++r) { asm volatile("v_sub_f32 %0, %0, %1" : "+v"(C0[r]) : "v"(dl)); asm volatile("v_sub_f32 %0, %0, %1" : "+v"(C1[r]) : "v"(dl)); } \
        _Pragma("unroll") for (int r = 0; r < 16; ++r) negm[r] = -mhat; asm volatile("" : "+v"(negm)); \
        const float f = fast_exp2(-dl); l_reg *= f; if (hi == 0) wsf[r32] = f; resc = true; } } \
    ATT_SBAR(); \
    MFMA8_PV(o[0], pf, vf[0]); EXP8(C0, 0); if (GL) { kload2(kf, kp0 + sl_next * KSLOT, 0); } ATT_SBAR(); \
    MFMA8_PV(o[1], pf, vf[1]); EXP8(C0, 8); if (GL) { kload2(kf, kp0 + sl_next * KSLOT, 1); } ATT_SBAR(); \
    MFMA8_PV(o[2], pf, vf[2]); EXP8(C1, 0); if (GL) { kload2(kf, kp0 + sl_next * KSLOT, 2); } ATT_SBAR(); \
    MFMA8_PV(o[3], pf, vf[3]); EXP8(C1, 8); if (GL) { kload2(kf, kp0 + sl_next * KSLOT, 3); } ATT_SBAR(); \
    } while (0)
    int t = 1;
#undef CMASK
#define CMASK(P0, P1, t) do {} while (0)
    for (; t + 5 < NT; t += 2) {
        STEP(pB0, pB1, pA0, pA1, t, true, true, true);       if (MODE == 3) { asm volatile("s_waitcnt lgkmcnt(0)" ::: "memory"); } else { ATT_WAIT_BAR(2); } RESC(); ROT();
        STEP(pA0, pA1, pB0, pB1, t + 1, true, true, true);   if (MODE == 3) { asm volatile("s_waitcnt lgkmcnt(0)" ::: "memory"); } else { ATT_WAIT_BAR(2); } RESC(); ROT();
    }
#undef CMASK
#define CMASK(P0, P1, t) do { const int jb_ = (t) - (NT - 4); if (jb_ >= 0) cmask(P0, P1, jb_, qrel, hi); } while (0)
#define ENDW(tt) do { if ((tt) + 3 < NT) { ATT_WAIT_BAR(2); } else if ((tt) + 2 < NT) { ATT_WAIT_BAR(1); } else { ATT_WAIT_BAR(0); } } while (0)
    for (; t + 1 < NT; t += 2) {
        STEP(pB0, pB1, pA0, pA1, t, (t + 3 < NT), (t + 1 < NT), (t + 1 < NT));       ENDW(t);     RESC(); ROT();
        STEP(pA0, pA1, pB0, pB1, t + 1, (t + 4 < NT), (t + 2 < NT), (t + 2 < NT));   ENDW(t + 1); RESC(); ROT();
    }
    STEP(pB0, pB1, pA0, pA1, NT - 1, false, false, false); RESC();
    { float sacc = 0.f;
#pragma unroll
      for (int r = 0; r < 16; ++r) sacc += pB0[r] + pB1[r];
      l_reg += sacc;
      pf[0] = PK4(pB0, 0); pf[1] = PK4(pB0, 4); pf[2] = PK4(pB0, 8); pf[3] = PK4(pB0, 12); pf[4] = PK4(pB1, 0); pf[5] = PK4(pB1, 4); pf[6] = PK4(pB1, 8); pf[7] = PK4(pB1, 12);
      const LAS char* vp_ = vp0 + sl_cur * VSLOT;
      vf[0] = frag32(vp_, vc0); vf[1] = frag32(vp_ + 32 * 64, vc0); vf[2] = frag32(vp_ + 64 * 64, vc0); vf[3] = frag32(vp_ + 96 * 64, vc0);
      asm volatile("s_nop 3" : "+v"(pf));
      MFMA8_PV(o[0], pf, vf[0]); MFMA8_PV(o[1], pf, vf[1]); MFMA8_PV(o[2], pf, vf[2]); MFMA8_PV(o[3], pf, vf[3]);
      asm volatile("s_nop 15\n\ts_nop 15\n\ts_nop 7" : "+v"(o[0]), "+v"(o[1]), "+v"(o[2]), "+v"(o[3])); }
#undef PK4
#undef PIN
#undef GAPA
#undef EXP8
#undef STEP
#undef ENDW
#undef CMASK
#undef RESC
#undef ROT
    { auto rr = __builtin_amdgcn_permlane32_swap(__float_as_uint(l_reg), __float_as_uint(l_reg), false, false); l_reg = __uint_as_float(rr[0]) + __uint_as_float(rr[1]); }
    if (hi == 0) wsf[32 + r32] = l_reg;
    asm volatile("s_waitcnt lgkmcnt(0)" ::: "memory");
#pragma unroll
    for (int r = 0; r < 16; ++r) { const float rl = fast_rcp(wsf[32 + crow(r, hi)]);
#pragma unroll
        for (int d0 = 0; d0 < 4; ++d0) o[d0][r] *= rl; }
    asm volatile("s_waitcnt lgkmcnt(0)" ::: "memory");
#undef DMA_K
#undef DMA_V
}

constexpr int KSLOT8 = 4096, QP8 = 256  ;
constexpr int L_V8 = NSLOT * KSLOT8, L_WS8 = L_V8 + NSLOT * VSLOT;
static_assert(L_WS8 + NWAVES * 256 <= L_OST, "fp8 pass LDS");
#define MFMA8_QK(C, A, B) asm volatile("v_mfma_scale_f32_32x32x64_f8f6f4 %0, %1, %2, %3, %4, %5 op_sel_hi:[0,0,0]" : "=&v"(C) : "v"(A), "v"(B), "v"(negm), "v"(sc_k), "v"(sc_q))
#define MFMA8_PV8(O, A, B) asm volatile("v_mfma_scale_f32_32x32x64_f8f6f4 %0, %1, %2, %0, %3, %3 op_sel_hi:[0,0,0]" : "+v"(O) : "v"(A), "v"(B), "v"(sc_k))
template <int MODE> __device__ __forceinline__ void attn_pass8(f32x16 (&o)[4], int b, int hm, int h, int qb, const unsigned char* Q8, const unsigned char* __restrict__ K8, const unsigned char* __restrict__ V8T, LAS char* shm) {
    const int tid = opaque_tid(), lane = tid & 63, r32 = lane & 31, hi = lane >> 5; const int wid = __builtin_amdgcn_readfirstlane(tid >> 6);
    const long rowbase = (long)b * SEQ; const int q0 = qb * QB, NT = (q0 + QB) / KVB;
    const unsigned lds0 = (unsigned)(uintptr_t)shm;
    LAS float* wsf = (LAS float*)(shm + L_WS8) + wid * 64;
    const int kkey = (wid & 3) * 16 + (lane >> 2);
    const unsigned char* ksrc = K8 + (rowbase + kkey) * QP8 + h * 64 + (((lane & 3) ^ ((kkey >> 2) & 3)) * 16);
    const unsigned char* vsrc = V8T + ((size_t)(b * 4 + h) * (SEQ / KVB)) * VSLOT + wid * 1024 + lane * 16;
    const unsigned kdst = lds0 + L_K + (wid & 3) * 1024, vdst = lds0 + L_V8 + wid * 1024;
#define DMA_K(t, s) glds16(ksrc + (long)(t) * KVB * QP8, (unsigned)__builtin_amdgcn_readfirstlane(kdst + (unsigned)(s) * KSLOT8))
#define DMA_V(t, s) glds16(vsrc + (long)(t) * VSLOT, (unsigned)__builtin_amdgcn_readfirstlane(vdst + (unsigned)(s) * VSLOT))
    const int sw = (r32 >> 2) & 3;
    const LAS char* kp0 = shm + L_K + r32 * 64;  const int kc0 = (2 * hi) ^ sw;
    const LAS char* vp0 = shm + L_V8 + r32 * 64;  const int vc0 = (2 * hi) ^ sw;
    DMA_K(0, 0); DMA_V(0, 0); DMA_K(1, 1);
    i32x8 qf;
    { const unsigned char* qp = Q8 + (rowbase + q0 + wid * 32 + r32) * QP8 + h * 64 + hi * 32; const i32x4 lo = *(const i32x4*)qp, hi4 = *(const i32x4*)(qp + 16); qf = __builtin_shufflevector(lo, hi4, 0, 1, 2, 3, 4, 5, 6, 7); }
    float mhat = 0.f;
    f32x16 ol;
    float zf = 0.f; asm volatile("" : "+v"(zf));
    int sc_k = 0x7f7f7f7f, sc_q = 0x7c7c7c7c; asm volatile("" : "+v"(sc_k), "+v"(sc_q));
    f32x16 negm;
#pragma unroll
    for (int r = 0; r < 16; ++r) { negm[r] = zf;
#pragma unroll
        for (int d0 = 0; d0 < 4; ++d0) o[d0][r] = zf;
        ol[r] = zf; }
    i32x8 ones8; { int o1 = 0x38383838; asm volatile("" : "+v"(o1)); ones8 = (i32x8){o1, o1, o1, o1, o1, o1, o1, o1}; }
    asm volatile("" : "+v"(negm));
    const int qrel = wid * 32 + r32;
    asm volatile("" : "+v"(qf));
    DMA_K(2, 2);
    ATT_WAIT_BAR(1);
    bool resc = false;
#define CMASK(P0, P1, t) do { const int jb_ = (t) - (NT - 4); if (jb_ >= 0) cmask(P0, P1, jb_, qrel, hi); } while (0)
#define RESC() do { if (resc) { asm volatile("s_waitcnt lgkmcnt(0)\n\ts_nop 15\n\ts_nop 7" ::: "memory"); \
        _Pragma("unroll") for (int r = 0; r < 16; ++r) { const float fr_ = wsf[crow(r, hi)]; _Pragma("unroll") for (int d_ = 0; d_ < 4; ++d_) asm volatile("v_mul_f32 %0, %0, %1" : "+v"(o[d_][r]) : "v"(fr_)); asm volatile("v_mul_f32 %0, %0, %1" : "+v"(ol[r]) : "v"(fr_)); } } } while (0)
    f32x16 pA0, pA1, pB0, pB1;
    int sl_prev = 0, sl_cur = 0, sl_next = 1;
#define ROT() do { sl_prev = sl_cur; sl_cur = sl_next; sl_next = (sl_next == NSLOT - 1) ? 0 : sl_next + 1; } while (0)
    i32x8 kf0, kf1;
    kf0 = frag32(kp0, kc0); kf1 = frag32(kp0 + 32 * 64, kc0);
    MFMA8_QK(pA0, kf0, qf); MFMA8_QK(pA1, kf1, qf);
    asm volatile("s_nop 15\n\ts_nop 15\n\ts_nop 7" : "+v"(pA0), "+v"(pA1));
    CMASK(pA0, pA1, 0);
    { const float rm = rowmax(pA0, pA1) - ATT_REF_OFF; mhat = rm;
#pragma unroll
      for (int r = 0; r < 16; ++r) { pA0[r] -= rm; pA1[r] -= rm; negm[r] = -rm; }
      asm volatile("" : "+v"(negm));
#pragma unroll
      for (int r = 0; r < 16; ++r) { pA0[r] = fast_exp2(pA0[r]); pA1[r] = fast_exp2(pA1[r]); } }
    ATT_WAIT_BAR(0);
    DMA_K(3, 0); DMA_V(1, 1);
    ROT();
    kf0 = frag32(kp0 + sl_cur * KSLOT8, kc0); kf1 = frag32(kp0 + sl_cur * KSLOT8 + 32 * 64, kc0);
    ATT_WAIT_BAR(2);
    i32x8 vf[4], pf;
#define PK4(P, B) cvt_pk4_fp8(P[B], P[(B) + 1], P[(B) + 2], P[(B) + 3])
#define PIN(x) asm volatile("" : "+v"(x))
#define SUM8(P, B) do { sacc += P[B]; sacc += P[(B) + 1]; sacc += P[(B) + 2]; sacc += P[(B) + 3]; sacc += P[(B) + 4]; sacc += P[(B) + 5]; sacc += P[(B) + 6]; sacc += P[(B) + 7]; PIN(sacc); } while (0)
#define EXP8(X, B) do { X[B] = fast_exp2(X[B]); X[(B) + 1] = fast_exp2(X[(B) + 1]); X[(B) + 2] = fast_exp2(X[(B) + 2]); X[(B) + 3] = fast_exp2(X[(B) + 3]); \
        X[(B) + 4] = fast_exp2(X[(B) + 4]); X[(B) + 5] = fast_exp2(X[(B) + 5]); X[(B) + 6] = fast_exp2(X[(B) + 6]); X[(B) + 7] = fast_exp2(X[(B) + 7]); PIN(X); } while (0)
#define STEP(C0, C1, P0, P1, t, GK, GV, GL) do { ATT_SBAR(); \
    const LAS char* vp_ = vp0 + sl_prev * VSLOT; \
    const bool det_ = (((t) & 3) == 1);            \
    float sacc = 0.f; \
    MFMA8_QK(C0, kf0, qf); \
    if (det_) { SUM8(P0, 0); SUM8(P0, 8); } \
    pf[0] = PK4(P0, 0); pf[1] = PK4(P0, 4); pf[2] = PK4(P0, 8); pf[3] = PK4(P0, 12); PIN(pf); \
    vf[0] = frag32(vp_, vc0); vf[1] = frag32(vp_ + 32 * 64, vc0); ATT_SBAR(); \
    MFMA8_QK(C1, kf1, qf); \
    if (det_) { SUM8(P1, 0); SUM8(P1, 8); } \
    pf[4] = PK4(P1, 0); pf[5] = PK4(P1, 4); pf[6] = PK4(P1, 8); pf[7] = PK4(P1, 12); PIN(pf); \
    vf[2] = frag32(vp_ + 64 * 64, vc0); vf[3] = frag32(vp_ + 96 * 64, vc0); ATT_SBAR(); \
    if (GK) { DMA_K((t) + 3, sl_cur); } if (GV) { DMA_V((t) + 1, sl_next); } \
    {   \
      float st_; { auto rr = __builtin_amdgcn_permlane32_swap(__float_as_uint(sacc), __float_as_uint(sacc), false, false); st_ = __uint_as_float(rr[0]) + __uint_as_float(rr[1]); } \
      resc = false; \
      if (__builtin_expect(det_ && __any(st_ > ATT_RESC_THR), 0)) { const float dl = (st_ > ATT_RESC_MIN) ? __builtin_fmaxf(__builtin_floorf(__builtin_amdgcn_logf(st_)) - 6.f, ATT_RESC_LO) : 0.f; mhat += dl; \
        asm volatile("s_nop 15\n\ts_nop 15" ::: "memory"); \
        _Pragma("unroll") for (int r = 0; r < 16; ++r) { asm volatile("v_sub_f32 %0, %0, %1" : "+v"(C0[r]) : "v"(dl)); asm volatile("v_sub_f32 %0, %0, %1" : "+v"(C1[r]) : "v"(dl)); } \
        _Pragma("unroll") for (int r = 0; r < 16; ++r) negm[r] = -mhat; asm volatile("" : "+v"(negm)); \
        const float f = fast_exp2(-dl); if (hi == 0) wsf[r32] = f; resc = true; } } \
    asm volatile("s_nop 7" : "+v"(C0), "+v"(C1)); CMASK(C0, C1, t); \
    ATT_SBAR(); \
    MFMA8_PV8(o[0], pf, vf[0]); EXP8(C0, 0); if (GL) kf0 = frag32(kp0 + sl_next * KSLOT8, kc0); ATT_SBAR(); \
    MFMA8_PV8(o[1], pf, vf[1]); EXP8(C0, 8); ATT_SBAR(); \
    MFMA8_PV8(o[2], pf, vf[2]); EXP8(C1, 0); if (GL) kf1 = frag32(kp0 + sl_next * KSLOT8 + 32 * 64, kc0); ATT_SBAR(); \
    MFMA8_PV8(o[3], pf, vf[3]); EXP8(C1, 8); ATT_SBAR(); \
    MFMA8_PV8(ol, pf, ones8); ATT_SBAR(); \
    } while (0)
    int t = 1;
#undef CMASK
#define CMASK(P0, P1, t) do {} while (0)
    for (; t + 5 < NT; t += 2) {
        STEP(pB0, pB1, pA0, pA1, t, true, true, true);       ATT_WAIT_BAR(2); RESC(); ROT();
        STEP(pA0, pA1, pB0, pB1, t + 1, true, true, true);   ATT_WAIT_BAR(2); RESC(); ROT();
    }
#undef CMASK
#define CMASK(P0, P1, t) do { const int jb_ = (t) - (NT - 4); if (jb_ >= 0) cmask(P0, P1, jb_, qrel, hi); } while (0)
#define ENDW(tt) do { if ((tt) + 3 < NT) { ATT_WAIT_BAR(2); } else if ((tt) + 2 < NT) { ATT_WAIT_BAR(1); } else { ATT_WAIT_BAR(0); } } while (0)
    for (; t + 1 < NT; t += 2) {
        STEP(pB0, pB1, pA0, pA1, t, (t + 3 < NT), (t + 1 < NT), (t + 1 < NT));       ENDW(t);     RESC(); ROT();
        STEP(pA0, pA1, pB0, pB1, t + 1, (t + 4 < NT), (t + 2 < NT), (t + 2 < NT));   ENDW(t + 1); RESC(); ROT();
    }
    STEP(pB0, pB1, pA0, pA1, NT - 1, false, false, false); RESC();
    {
      pf[0] = PK4(pB0, 0); pf[1] = PK4(pB0, 4); pf[2] = PK4(pB0, 8); pf[3] = PK4(pB0, 12); pf[4] = PK4(pB1, 0); pf[5] = PK4(pB1, 4); pf[6] = PK4(pB1, 8); pf[7] = PK4(pB1, 12);
      const LAS char* vp_ = vp0 + sl_cur * VSLOT;
      vf[0] = frag32(vp_, vc0); vf[1] = frag32(vp_ + 32 * 64, vc0); vf[2] = frag32(vp_ + 64 * 64, vc0); vf[3] = frag32(vp_ + 96 * 64, vc0);
      asm volatile("s_nop 3" : "+v"(pf));
      MFMA8_PV8(o[0], pf, vf[0]); MFMA8_PV8(o[1], pf, vf[1]); MFMA8_PV8(o[2], pf, vf[2]); MFMA8_PV8(o[3], pf, vf[3]); MFMA8_PV8(ol, pf, ones8);
      asm volatile("s_nop 15\n\ts_nop 15\n\ts_nop 7" : "+v"(o[0]), "+v"(o[1]), "+v"(o[2]), "+v"(o[3]), "+v"(ol)); }
#undef PK4
#undef PIN
#undef SUM8
#undef EXP8
#undef STEP
#undef ENDW
#undef CMASK
#undef RESC
#undef ROT
#pragma unroll
    for (int r = 0; r < 16; ++r) { const float rl = fast_rcp(ol[r]);
#pragma unroll
        for (int d0 = 0; d0 < 4; ++d0) o[d0][r] *= rl; }
#undef DMA_K
#undef DMA_V
}

template <int MODE> __device__ __forceinline__ void attn_unit(int b, int h, int qb, const bf16_t* Q, const bf16_t* K, const unsigned char* Q8, const unsigned char* K8, const unsigned char* V, bf16_t* YAB, float* park, float lam, const float* subg, LAS char* shm) {
    const int tid = opaque_tid(), lane = tid & 63, r32 = lane & 31, hi = lane >> 5; const int wid = __builtin_amdgcn_readfirstlane(tid >> 6);
    for (int m = 0; m < 2; ++m) {
        f32x16 o[4];
        if (m == 0) attn_pass<MODE>(o, b, 2 * h, h, qb, Q, K, V, shm);
        else attn_pass8<MODE>(o, b, 2 * h + 1, h, qb, Q8, K8, V, shm);
        int lo_ = lane; asm volatile("" : "+v"(lo_));
        f32x4* pk = (f32x4*)park + (size_t)wid * 1024 + lo_;
        if (m == 0) {
#pragma unroll
            for (int d0 = 0; d0 < 4; ++d0)
#pragma unroll
                for (int j = 0; j < 4; ++j) pk[(d0 * 4 + j) * 64] = (f32x4){o[d0][4 * j], o[d0][4 * j + 1], o[d0][4 * j + 2], o[d0][4 * j + 3]};
        } else {
            float ss[16];
#pragma unroll
            for (int r = 0; r < 16; ++r) ss[r] = 0.f;
#pragma unroll
            for (int d0 = 0; d0 < 4; ++d0)
#pragma unroll
                for (int j = 0; j < 4; ++j) { const f32x4 a = pk[(d0 * 4 + j) * 64];
#pragma unroll
                    for (int e = 0; e < 4; ++e) { const float v = a[e] - lam * o[d0][4 * j + e]; o[d0][4 * j + e] = v; ss[4 * j + e] += v * v; } }
#pragma unroll
            for (int r = 0; r < 16; ++r) { float s = ss[r]; s += __shfl_xor(s, 1); s += __shfl_xor(s, 2); s += __shfl_xor(s, 4); s += __shfl_xor(s, 8); s += __shfl_xor(s, 16); ss[r] = 0.8f / sqrtf(s * (1.0f / 128.0f) + EPS); }
            float gd[4];
#pragma unroll
            for (int d0 = 0; d0 < 4; ++d0) gd[d0] = subg[d0 * 32 + r32];
            LAS bf16_t* stg = (LAS bf16_t*)(shm + L_OST) + wid * 4096;
#pragma unroll
            for (int r = 0; r < 16; ++r) { const int orow = crow(r, hi);
#pragma unroll
                for (int d0 = 0; d0 < 4; ++d0) { float y = o[d0][r] * ss[r] * gd[d0];
#if PROBE_PHASE == 51
                    if (!(__builtin_fabsf(y) < 1e30f)) y = 0.f;
#endif
                    stg[orow * 128 + d0 * 32 + r32] = (bf16_t)(cvt_pk_bf16(y, 0.f) & 0xffffu); } }
            asm volatile("s_waitcnt lgkmcnt(0)" ::: "memory");
            bf16_t* Ow = YAB + ((long)b * SEQ + qb * QB + wid * 32) * 1024 + 512 + h * 128;
#pragma unroll
            for (int i = 0; i < 8; ++i) { const int row = i * 4 + (lo_ >> 4), ch = lo_ & 15; const u32x4 v = *(const LAS u32x4*)(stg + row * 128 + ch * 8); *(u32x4*)(Ow + (long)row * 1024 + ch * 8) = v; }
        }
        asm volatile("s_waitcnt lgkmcnt(0)\n\ts_barrier" ::: "memory");
    }
}
#undef ATT_WAIT_BAR
#undef MX3
#undef ATT_SBAR
#undef ATT_MFMA
#undef MFMA8_PV
#undef MFMA8_QK
#undef MFMA8_PV8
}

#define XB_TMO      128
#define XB_XCNT(j)  (256  + 64 * (j))
#define XB_XSUB(j)  (1280 + 64 * (j))
#define XB_XGEN(j)  (2304 + 64 * (j))
#define XB_TOP      3328
#define XB_TOPGEN   3392
#define XCD_BAR_WORDS 3456
#define XB_SPIN_CAP (1u << 18)
__device__ __forceinline__ unsigned xb_ld(unsigned* p)              { return __hip_atomic_load(p, __ATOMIC_RELAXED, __HIP_MEMORY_SCOPE_AGENT); }
__device__ __forceinline__ unsigned xb_add(unsigned* p, unsigned v) { return __hip_atomic_fetch_add(p, v, __ATOMIC_RELAXED, __HIP_MEMORY_SCOPE_AGENT); }
__device__ __forceinline__ unsigned xb_xcc_id() { return (unsigned)__builtin_amdgcn_s_getreg((3 << 11) | 20) & 0xFu; }
#define XB_SPIN(cond, bar) do { unsigned _sp = 0; while (cond) { __builtin_amdgcn_s_sleep(1); \
    if ((++_sp & 255u) == 0u) { if (xb_ld(&(bar)[XB_TMO])) break; if (_sp > XB_SPIN_CAP) { atomicAdd(&(bar)[XB_TMO], 1u); break; } } } } while (0)
struct XcdBarrier { unsigned* bar; unsigned x; volatile LAS unsigned* st; };
__device__ __forceinline__ XcdBarrier xcd_barrier_post(unsigned* bar, volatile LAS unsigned* st) {
    XcdBarrier b; b.bar = bar; b.x = xb_xcc_id(); b.st = st;
    if (threadIdx.x == 0) (void)xb_add(&bar[XB_XCNT(b.x)], 1u);
    return b;
}
__device__ __forceinline__ void xcd_barrier_complete(unsigned* bar, unsigned x, unsigned& nloc, unsigned& nx) {
    const unsigned G = gridDim.x * gridDim.y * gridDim.z;
    unsigned sum, cnt, mine, sp = 0u;
    for (;;) {
        sum = 0u; cnt = 0u; mine = 0u;
#pragma unroll
        for (unsigned j = 0; j < 16; ++j) { const unsigned c = xb_ld(&bar[XB_XCNT(j)]); sum += c; cnt += (c > 0u) ? 1u : 0u; mine = (j == x) ? c : mine; }
        if (sum == G) break;
        __builtin_amdgcn_s_sleep(1);
        if ((++sp & 255u) == 0u) { if (xb_ld(&bar[XB_TMO])) break; if (sp > XB_SPIN_CAP) { atomicAdd(&bar[XB_TMO], 1u); break; } }
    }
    nloc = mine > 0u ? mine : 1u; nx = cnt > 0u ? cnt : 1u;
}
__device__ __forceinline__ void xcd_barrier(const XcdBarrier& b) {
    asm volatile("s_waitcnt vmcnt(0)" ::: "memory");
    __syncthreads();
    if (threadIdx.x == 0) {
        unsigned* bar = b.bar;
        __builtin_amdgcn_s_waitcnt(0);
        unsigned nloc = b.st[0], nx = b.st[1];
        if (nloc == 0u) { xcd_barrier_complete(bar, b.x, nloc, nx); b.st[0] = nloc; b.st[1] = nx; }
        const unsigned old = xb_add(&bar[XB_XSUB(b.x)], 1u);
        const unsigned gen = old / nloc;
        if (old + 1u == (gen + 1u) * nloc) {
            __builtin_amdgcn_fence(__ATOMIC_RELEASE, "agent");
            asm volatile("s_waitcnt vmcnt(0)" ::: "memory");
            const unsigned og = xb_add(&bar[XB_TOP], 1u);
            const unsigned tg = og / nx;
            if (og + 1u == (tg + 1u) * nx) xb_add(&bar[XB_TOPGEN], 1u);
            else XB_SPIN(xb_ld(&bar[XB_TOPGEN]) == tg, bar);
            __builtin_amdgcn_fence(__ATOMIC_ACQUIRE, "agent");
            xb_add(&bar[XB_XGEN(b.x)], 1u);
            asm volatile("s_waitcnt vmcnt(0)" ::: "memory");
        } else {
            XB_SPIN(xb_ld(&bar[XB_XGEN(b.x)]) == gen, bar);
            __builtin_amdgcn_fence(__ATOMIC_ACQUIRE, "agent");
            asm volatile("s_waitcnt vmcnt(0)" ::: "memory");
        }
    }
    __syncthreads();
}

#define GRID_BAR() xcd_barrier(bar)

__device__ __forceinline__ void phase_stagger(int cls, unsigned ticks) {
    const unsigned long long t0 = __builtin_amdgcn_s_memrealtime(); const unsigned long long want = (unsigned long long)cls * ticks;
    while (__builtin_amdgcn_s_memrealtime() - t0 < want) __builtin_amdgcn_s_sleep(8);
}

struct Args {
    const float* x; const int* pos; const float* norm_mix_g; const float* w_in; const float* gm_ln_g; const float* gm_ln_b; const float* gm_w_s; const float* gm_b_s;
    const float* lam_q1; const float* lam_k1; const float* lam_q2; const float* lam_k2; const float* subln_g; const float* w_br_a; const float* w_br_b; const float* w_out;
    const float* norm_ffn_g; const float* w_rg; const float* b_rg; const float* w_re; const float* b_re; const float* w_gate; const float* w_up; const float* w_down; const float* final_g;
    float* out; unsigned char* ws;
};

__device__ __forceinline__ int wrow_map(int rmode, int n) { return rmode == 0 ? n : rmode == 1 ? ((n >> 5) * 128 + (n & 31)) : (((n >> 3) & 1) * 128 + (n >> 4) * 8 + (n & 7)); }
__device__ __forceinline__ void transpose_item(const float* W, int ldw, int k0, int n0, bf16_t* WT, int ldt, int drow0, int dk0, const float* gk, LAS float* scr, int lane, float sc = 1.0f, int rmode = 0) {
    f32x4 v[16];
    const int kr = lane >> 4, nc = (lane & 15) * 4;
#pragma unroll
    for (int i = 0; i < 16; ++i) v[i] = *(const f32x4*)(W + (size_t)(k0 + 4 * i + kr) * ldw + n0 + nc);
    if (gk) {
#pragma unroll
        for (int i = 0; i < 16; ++i) v[i] = v[i] * gk[k0 + 4 * i + kr];
    }
    if (sc != 1.0f) {
#pragma unroll
        for (int i = 0; i < 16; ++i) v[i] = v[i] * sc;
    }
#pragma unroll
    for (int i = 0; i < 16; ++i) { LAS float* d = scr + (4 * i + kr) * 65 + nc; d[0] = v[i][0]; d[1] = v[i][1]; d[2] = v[i][2]; d[3] = v[i][3]; }
    LDS_WAIT(); asm volatile("" ::: "memory");
    const int c = lane & 7;
#pragma unroll
    for (int j = 0; j < 8; ++j) { const int n = (lane >> 3) + 8 * j; const LAS float* s = scr + (8 * c) * 65 + n;
        u32x4 o; o.x = cvt_pk_bf16(s[0 * 65], s[1 * 65]); o.y = cvt_pk_bf16(s[2 * 65], s[3 * 65]); o.z = cvt_pk_bf16(s[4 * 65], s[5 * 65]); o.w = cvt_pk_bf16(s[6 * 65], s[7 * 65]);
        *(u32x4*)(WT + (size_t)(drow0 + wrow_map(rmode, n)) * ldt + dk0 + k0 + 8 * c) = o; }
    LDS_WAIT(); asm volatile("" ::: "memory");
}
__device__ __forceinline__ void transpose_item8(const float* W, int ldw, int k0, int n0, unsigned char* WT, int ldt, int drow0, const float* gk, float sc, LAS float* scr, int lane, int rmode = 0) {
    f32x4 v[16];
    const int kr = lane >> 4, nc = (lane & 15) * 4;
#pragma unroll
    for (int i = 0; i < 16; ++i) v[i] = *(const f32x4*)(W + (size_t)(k0 + 4 * i + kr) * ldw + n0 + nc);
    float gs[16];
    if (gk) {
#pragma unroll
        for (int i = 0; i < 16; ++i) gs[i] = gk[k0 + 4 * i + kr];
#pragma unroll
        for (int i = 0; i < 16; ++i) gs[i] *= sc;
    } else {
#pragma unroll
        for (int i = 0; i < 16; ++i) gs[i] = sc;
    }
#pragma unroll
    for (int i = 0; i < 16; ++i) v[i] = v[i] * gs[i];
#pragma unroll
    for (int i = 0; i < 16; ++i) { LAS float* d = scr + (4 * i + kr) * 65 + nc; d[0] = v[i][0]; d[1] = v[i][1]; d[2] = v[i][2]; d[3] = v[i][3]; }
    LDS_WAIT(); asm volatile("" ::: "memory");
    const int c = lane & 7;
#pragma unroll
    for (int j = 0; j < 8; ++j) { const int n = (lane >> 3) + 8 * j; const LAS float* s = scr + (8 * c) * 65 + n;
        u32x2 o; o.x = cvt_pk4_fp8(s[0 * 65], s[1 * 65], s[2 * 65], s[3 * 65]); o.y = cvt_pk4_fp8(s[4 * 65], s[5 * 65], s[6 * 65], s[7 * 65]);
        *(u32x2*)(WT + (size_t)(drow0 + wrow_map(rmode, n)) * ldt + k0 + 8 * c) = o; }
    LDS_WAIT(); asm volatile("" ::: "memory");
}
__device__ __forceinline__ void expert_item(int r, const float* w_gate, const float* w_up, const float* w_down, const float* gffn, unsigned char* W13, unsigned char* W2, LAS float* scr, int lane) {
    constexpr int I_G = 32 * 128;
    if (r < 2 * I_G) { const int up = r >= I_G; if (up) r -= I_G; const int e = r / 128, q = r % 128, kb = q / 8, nb = q % 8;
        const int n0 = 64 * nb, drow = e * 1024 + (n0 >> 7) * 256 + up * 128 + (n0 & 127);
        transpose_item8((up ? w_up : w_gate) + (size_t)e * 1024 * 512, 512, 64 * kb, n0, W13, 1024, drow, gffn, 64.f, scr, lane); return; }
    r -= 2 * I_G;
    { const int e = r / 128, q = r % 128, kb = q / 16, nb = q % 16;
        transpose_item8(w_down + (size_t)e * 512 * 1024, 1024, 64 * kb, 64 * nb, W2, 512, e * 1024 + (nb >> 2) * 256 + (nb & 3) * 32, nullptr, 32.f, scr, lane, 2); }
}
__device__ __forceinline__ void rms_row_to_bf16(const float* xrow, const float* g, bf16_t* orow, int lane) {
    const f32x4* xr = (const f32x4*)xrow + lane; const f32x4* gr = (const f32x4*)g + lane;
    f32x4 v[4]; float s = 0.f;
#pragma unroll
    for (int j = 0; j < 4; ++j) { v[j] = xr[64 * j]; s += (v[j].x * v[j].x + v[j].y * v[j].y) + (v[j].z * v[j].z + v[j].w * v[j].w); }
    const float rstd = 1.f / sqrtf(wave_sum(s) * (1.f / D) + EPS);
    u32x2* o8 = (u32x2*)orow + lane;
#pragma unroll
    for (int j = 0; j < 4; ++j) { const f32x4 gg = gr[64 * j]; u32x2 w; w.x = cvt_pk_bf16(v[j].x * rstd * gg.x, v[j].y * rstd * gg.y); w.y = cvt_pk_bf16(v[j].z * rstd * gg.z, v[j].w * rstd * gg.w); o8[64 * j] = w; }
}

__global__ void __launch_bounds__(NTHREADS, 2) fwd_kernel(Args a) {
    extern __shared__ __attribute__((aligned(16))) unsigned char lds_raw[];
    LAS unsigned char* lds = (LAS unsigned char*)lds_raw;
    volatile LAS unsigned* LCTL = (volatile LAS unsigned*)(lds + LDSCTL_OFF);
    const int tid0 = threadIdx.x;
    const int G = gridDim.x, bx = blockIdx.x;
    const int vcu = (G % 8 == 0) ? (bx % 8) * (G / 8) + bx / 8 : bx;
    unsigned char* ws = a.ws;
    unsigned* ctl = (unsigned*)(ws + WS_CTL);
    __builtin_amdgcn_s_setreg((23 << 6) | 1, 1);
    for (int u = tid0; u < (LDS_BYTES - LDSCTL_OFF) / 4; u += NTHREADS) LCTL[u] = 0u;
    __syncthreads();
    XcdBarrier bar = xcd_barrier_post(ctl + CW_BAR, LCTL);
    const int NGW = G * NWAVES;
#define PHASE_IDS() const int tid = opaque_tid(), lane = tid & 63, wave = __builtin_amdgcn_readfirstlane(tid >> 6), gw = vcu * NWAVES + wave; (void)lane; (void)gw

    bf16_t* WIN = (bf16_t*)(ws + WS_WIN); bf16_t* WBR = (bf16_t*)(ws + WS_WBR); bf16_t* WO = (bf16_t*)(ws + WS_WO); unsigned char* W13 = ws + WS_W13; unsigned char* W2 = ws + WS_W2;
    bf16_t* WRH = (bf16_t*)(ws + WS_WRH); bf16_t* WRL = (bf16_t*)(ws + WS_WRL); float* CS = (float*)(ws + WS_CS); float* SSQ = (float*)(ws + WS_SSQ); float* RSTD = (float*)(ws + WS_RSTD); float* WTS = (float*)(ws + WS_WTS);
    int* LIST = (int*)(ws + WS_LIST);
    float* PARK = (float*)(ws + WS_PARK);
    bf16_t* XN = (bf16_t*)(ws + WS_RA); bf16_t* YAB = (bf16_t*)(ws + WS_RA); unsigned char* YB8 = ws + WS_RA;
    bf16_t* UV = (bf16_t*)(ws + WS_RB); bf16_t* MG = (bf16_t*)(ws + WS_RB);
    bf16_t* Qb = (bf16_t*)(ws + WS_RC); bf16_t* Kb = Qb + (size_t)T * 512; bf16_t* XB = (bf16_t*)(ws + WS_RC); unsigned char* V8T = ws + WS_RE + 128 * MiB; unsigned char* Q8 = V8T + 32 * MiB; unsigned char* K8 = Q8 + 16 * MiB;
    bf16_t* Vb = (bf16_t*)(ws + WS_RD);
    unsigned char* G8 = ws + WS_RE; unsigned char* H8 = ws + WS_RE; unsigned char* XB8 = ws + WS_RD;

    for (int rep = 0; rep < REPS(0); ++rep) {
        PHASE_IDS();
        LAS float* scr = (LAS float*)(lds + wave * 16896);
#if LEVEL >= 1
        constexpr int I_IN = 16 * 72, I_BA = 8 * 16, I_BB = 8 * 16, I_O = 16 * 16;
        constexpr int NITEMS = I_IN + I_BA + I_BB + I_O;
        for (int it = gw; it < NITEMS; it += NGW) {
            int r = it;
            if (r < I_IN) { const int kb = r / 72, nb = r % 72; transpose_item(a.w_in, IN_COLS, 64 * kb, 64 * nb, WIN, 1024, (nb >> 2) * 256 + (nb & 3) * 32, 0, nullptr, scr, lane, (64 * nb >= 2560) ? -LOG2E : 1.0f, (64 * nb >= 2560) ? 2 : 1); continue; } r -= I_IN;
            if (r < I_BA) { const int kb = r / 16, nb = r % 16; transpose_item(a.w_br_a, 1024, 64 * kb, 64 * nb, WBR, 1024, (nb >> 2) * 256 + (nb & 3) * 32, 0, nullptr, scr, lane, 1.0f, 1); continue; } r -= I_BA;
            if (r < I_BB) { const int kb = r / 16, nb = r % 16; transpose_item(a.w_br_b, 1024, 64 * kb, 64 * nb, WBR, 1024, (nb >> 2) * 256 + (nb & 3) * 32, 512, nullptr, scr, lane, 1.0f, 1); continue; } r -= I_BB;
            { const int kb = r / 16, nb = r % 16; transpose_item(a.w_out, 1024, 64 * kb, 64 * nb, WO, 1024, (nb >> 2) * 256 + (nb & 3) * 32, 0, nullptr, scr, lane, 1.0f, 1); }
        }
#if LEVEL >= 3
        for (int i = bx * NTHREADS + tid; i < 64 * 1024; i += G * NTHREADS) { const int n = i >> 10, k = i & 1023; float v = 0.f; if (n < 4) v = a.w_rg[k * 4 + n]; else if (n < 36) v = a.w_re[k * 32 + (n - 4)];
            v *= a.norm_ffn_g[k]; const unsigned h = cvt_pk_bf16(v, 0.f) & 0xffffu; const float r = v - __uint_as_float(h << 16); WRH[i] = (bf16_t)h; WRL[i] = (bf16_t)(cvt_pk_bf16(r, 0.f) & 0xffffu); }
#endif
        for (int i = bx * NTHREADS + tid; i < T * 8; i += G * NTHREADS) { const int t = i >> 3, j = i & 7;
            const double invf = exp2(-(double)j * (18.931568569324174 / 8.0));
            const double ang = (double)a.pos[t] * invf; const double kk = rint(ang * 0.15915494309189535); const float rr = (float)(ang - kk * 6.283185307179586);
            CS[t * 16 + j] = cosf(rr); CS[t * 16 + 8 + j] = sinf(rr); }
        for (int m = gw; m < T; m += NGW) rms_row_to_bf16(a.x + (size_t)m * D, a.norm_mix_g, XN + (size_t)m * D, lane);
#endif
    }
    GRID_BAR();

#if LEVEL >= 1 && !defined(NO_P1)
#if PROBE_PHASE >= 71 && PROBE_PHASE <= 73
    {
        pg8::DenseProb P; P.init(XN, WIN, T, IN_COLS, 1024, G, bx);
        pg8::EpiInProjT<(PROBE_PHASE == 73 ? 4 : PROBE_PHASE - 70)> E{UV, Qb, Kb, Vb, G8, CS, Q8, K8, lds};
        pg8::gemm_core<false>(lds, P, E, pg8::NoHook{});
    }
#endif
#if PROBE_PHASE == 66 || PROBE_PHASE == 67
    {
        pg8::DenseProb P; P.init(XN, WIN, T, IN_COLS, 1024, G, bx);
        pg8::EpiInProjT<PROBE_PHASE - 65> E{UV, Qb, Kb, Vb, G8, CS, Q8, K8, lds};
        pg8::gemm_core<false, pg8::DenseProb, pg8::EpiInProjT<PROBE_PHASE - 65>, pg8::NoHook, 4>(lds, P, E, pg8::NoHook{});
    }
#endif
#if PROBE_PHASE == 64
    {
        pg8::DenseProb P; P.init(XN, WIN, T, IN_COLS, 1024, G, bx);
        pg8::EpiInProj E{UV, Qb, Kb, Vb, G8, CS, Q8, K8, lds};
        pg8::gemm_core<false, pg8::DenseProb, pg8::EpiInProj, pg8::NoHook, 4>(lds, P, E, pg8::NoHook{});
    }
#endif
    for (int rep = 0; rep < REPS(1); ++rep) {
#ifdef STAG1
        phase_stagger(((bx >> 3) & 7) >> 1, STAG1);
#endif
        pg8::DenseProb P; P.init(XN, WIN, T, IN_COLS, 1024, G, bx);
        pg8::EpiInProj E{UV, Qb, Kb, Vb, G8, CS, Q8, K8, lds};
        pg8::gemm_core<false>(lds, P, E, pg8::NoHook{});
    }
#if PROBE_PHASE == 11
    {
        pg8::DenseProb P; P.init(XN, WIN, T, IN_COLS, 1024, G, bx);
        pg8::gemm_core<false>(lds, P, pg8::EpiNull{}, pg8::NoHook{});
    }
#endif
#if PROBE_PHASE >= 61 && PROBE_PHASE <= 63
    {
        pg8::DenseProb P; P.init(XN, WIN, T, IN_COLS, 1024, G, bx);
        pg8::gemm_core<false, pg8::DenseProb, pg8::EpiNull, pg8::NoHook, PROBE_PHASE - 60>(lds, P, pg8::EpiNull{}, pg8::NoHook{});
    }
#endif
#if PROBE_PHASE == 31
    {
        pg8::DenseProb P; P.init(XN, WIN, T, IN_COLS, 1024, G, bx);
        pg8::gemm_core<false>(lds, P, pg8::EpiStoreOnly{(bf16_t*)(ws + WS_END)}, pg8::NoHook{});
    }
#endif
#if PROBE_PHASE == 12
    {
        pg8::DenseProbSame P; P.init(XN, WIN, T, IN_COLS, 1024, G, bx);
        pg8::gemm_core<false>(lds, P, pg8::EpiNull{}, pg8::NoHook{});
    }
#endif
#endif
    GRID_BAR();

#if LEVEL >= 1 && !defined(NO_P2A)
    for (int rep = 0; rep < REPS(2); ++rep) {
        PHASE_IDS();
        LAS bf16_t* VT = (LAS bf16_t*)lds;
        LAS float* SV = (LAS float*)(lds + 36864);
        const int r32 = lane & 31, hi = lane >> 5;
        for (int un = vcu; un < 2048; un += G) {
            const int ch = un >> 2, g = un & 3; const size_t row0 = (size_t)ch * 128;
            {
                const int s = tid >> 2, qd = tid & 3;
                const u32x4* vp = (const u32x4*)(UV + (row0 + s) * 1024 + 512 + g * 128 + qd * 32);
                float v[32]; float sm = 0.f;
#pragma unroll
                for (int j = 0; j < 4; ++j) { const u32x4 w = vp[j]; f32x4 x0, x1; pg8::unpack8(w, x0, x1);
#pragma unroll
                    for (int e = 0; e < 4; ++e) { v[8 * j + e] = x0[e]; v[8 * j + 4 + e] = x1[e]; sm += x0[e] + x1[e]; } }
                sm += __shfl_xor(sm, 1); sm += __shfl_xor(sm, 2);
                const float mu = sm * (1.0f / 128.0f); float sq = 0.f;
#pragma unroll
                for (int i = 0; i < 32; ++i) { v[i] -= mu; sq += v[i] * v[i]; }
                sq += __shfl_xor(sq, 1); sq += __shfl_xor(sq, 2);
                const float rstd = 1.0f / sqrtf(sq * (1.0f / 128.0f) + EPS);
                const float* lg = a.gm_ln_g + g * 128 + qd * 32; const float* lb = a.gm_ln_b + g * 128 + qd * 32;
#pragma unroll
                for (int i = 0; i < 32; ++i) { const float y = v[i] * rstd * lg[i] + lb[i]; VT[(qd * 32 + i) * 136 + s] = (bf16_t)(cvt_pk_bf16(y, 0.f) & 0xffffu); }
            }
            LDS_WAIT(); __syncthreads();
            {
                const int tb = wave >> 1, db0 = 2 * (wave & 1);
                f32x16 c0 = f32x16{}, c1 = f32x16{};
                const float* wrow = a.gm_w_s + ((size_t)g * 128 + tb * 32 + r32) * 128;
                const int trow = tb * 32 + r32;
                for (int ks = 0; ks <= 2 * tb + 1; ++ks) {
                    const int s0 = 16 * ks + 8 * hi;
                    const f32x4 wa = *(const f32x4*)(wrow + s0), wb = *(const f32x4*)(wrow + s0 + 4);
                    float w8[8] = {wa[0], wa[1], wa[2], wa[3], wb[0], wb[1], wb[2], wb[3]};
#pragma unroll
                    for (int j = 0; j < 8; ++j) if (s0 + j > trow) w8[j] = 0.f;
                    u32x4 aw; aw.x = cvt_pk_bf16(w8[0], w8[1]); aw.y = cvt_pk_bf16(w8[2], w8[3]); aw.z = cvt_pk_bf16(w8[4], w8[5]); aw.w = cvt_pk_bf16(w8[6], w8[7]);
                    const bf16x8 af = __builtin_bit_cast(bf16x8, aw);
                    const bf16x8 b0 = *(const LAS bf16x8*)(VT + ((db0 + 0) * 32 + r32) * 136 + s0);
                    const bf16x8 b1 = *(const LAS bf16x8*)(VT + ((db0 + 1) * 32 + r32) * 136 + s0);
                    c0 = __builtin_amdgcn_mfma_f32_32x32x16_bf16(af, b0, c0, 0, 0, 0);
                    c1 = __builtin_amdgcn_mfma_f32_32x32x16_bf16(af, b1, c1, 0, 0, 0);
                }
#pragma unroll
                for (int r = 0; r < 16; ++r) { const int t = tb * 32 + att::crow(r, hi); const float bs = a.gm_b_s[g * 128 + t];
                    SV[t * 132 + db0 * 32 + r32] = c0[r] + bs; SV[t * 132 + db0 * 32 + 32 + r32] = c1[r] + bs; }
            }
            LDS_WAIT(); __syncthreads();
            {
#pragma unroll
                for (int i = 0; i < 4; ++i) { const int t = i * 32 + (tid >> 4), dc = (tid & 15) * 8;
                    const size_t ro = (row0 + t) * 1024 + g * 128 + dc;
                    const u32x4 uw = *(const u32x4*)(UV + ro); f32x4 u0, u1; pg8::unpack8(uw, u0, u1);
                    const f32x4 s0 = *(const LAS f32x4*)(SV + t * 132 + dc), s1 = *(const LAS f32x4*)(SV + t * 132 + dc + 4);
                    *(u32x4*)(YAB + ro) = pg8::pack8(u0 * s0, u1 * s1); }
            }
            LDS_WAIT(); __syncthreads();
        }
    }
#endif
#if LEVEL >= 2
    {
        PHASE_IDS();
        LAS unsigned char* TB = (LAS unsigned char*)lds + wave * 8192;
        for (int tl = gw; tl < BATCH * 4 * (SEQ / 64); tl += NGW) {
            const int bh = tl >> 7, tt = tl & 127, b = bh >> 2, h = bh & 3;
            const bf16_t* vsrc = Vb + ((size_t)b * SEQ + tt * 64) * 512 + h * 128;
            u32x4 w[16];
#pragma unroll
            for (int i = 0; i < 16; ++i) w[i] = *(const u32x4*)(vsrc + (size_t)(i * 4 + (lane >> 4)) * 512 + (lane & 15) * 8);
#pragma unroll
            for (int i = 0; i < 16; ++i) { const int key = i * 4 + (lane >> 4), kk = key & 31, khi = (kk >> 2) & 1, j = (kk & 3) + 4 * (kk >> 3) + 16 * (key >> 5), cc = khi * 2 + (j >> 4);
                f32x4 x0, x1; pg8::unpack8(w[i], x0, x1); const unsigned q0_ = cvt_pk4_fp8(x0[0], x0[1], x0[2], x0[3]), q1_ = cvt_pk4_fp8(x1[0], x1[1], x1[2], x1[3]);
#pragma unroll
                for (int e = 0; e < 8; ++e) { const int d = (lane & 15) * 8 + e; const unsigned byte = ((e < 4 ? q0_ : q1_) >> (8 * (e & 3))) & 0xffu;
                    TB[d * 64 + ((cc ^ ((d >> 2) & 3)) * 16) + (j & 15)] = (unsigned char)byte; } }
            LDS_WAIT(); asm volatile("" ::: "memory");
            unsigned char* dst = V8T + (size_t)tl * 8192;
#pragma unroll
            for (int i = 0; i < 8; ++i) *(u32x4*)(dst + (i * 64 + lane) * 16) = *(const LAS u32x4*)(TB + (i * 64 + lane) * 16);
            LDS_WAIT(); asm volatile("" ::: "memory");
        }
    }
    GRID_BAR();
#endif
#if LEVEL >= 2 && !defined(NO_P2B)
    {
        PHASE_IDS();
        float lam;
        { const float p1 = wave_sum(a.lam_q1[lane] * a.lam_k1[lane]), p2 = wave_sum(a.lam_q2[lane] * a.lam_k2[lane]); lam = expf(p1) - expf(p2) + 0.2f; }
        const int bh = vcu >> 3, s = vcu & 7, b = bh >> 2, h = bh & 3;
        float* park = PARK + (size_t)bx * 32768;
        if (G == 256) {
            for (int ii = 0; ii < 4 * REPS(3); ++ii) { const int i = ii & 3; const int qb = (i == 0) ? s : (i == 1) ? 15 - s : (i == 2) ? 16 + s : 31 - s;
                att::attn_unit<0>(b, h, qb, Qb, Kb, Q8, K8, V8T, YAB, park, lam, a.subln_g, (LAS char*)lds);
#if LEVEL >= 3
                if (ii < 4) {
                    LAS float* scr = (LAS float*)(lds + wave * 16896);
                    for (int k = wave; k < 12; k += NWAVES) expert_item((bx * 4 + ii) * 12 + k, a.w_gate, a.w_up, a.w_down, a.norm_ffn_g, W13, W2, scr, lane);
                    LDS_WAIT(); __syncthreads();
                }
#endif
            }
#if PROBE_PHASE == 13 || PROBE_PHASE == 14 || PROBE_PHASE == 15 || PROBE_PHASE == 16
            for (int i = 0; i < 4; ++i) { const int qb = (i == 0) ? s : (i == 1) ? 15 - s : (i == 2) ? 16 + s : 31 - s;
                att::attn_unit<PROBE_PHASE - 13>(0, 0, qb, Qb, Kb, Q8, K8, V8T, (bf16_t*)(ws + WS_END), park, lam, a.subln_g, (LAS char*)lds); }
#endif
        }
    }
#elif LEVEL >= 1
    {
        PHASE_IDS();
        for (int i = bx * NTHREADS + tid; i < T * 64; i += G * NTHREADS) { const int row = i >> 6, c = i & 63; *(u32x4*)(YAB + (size_t)row * 1024 + 512 + c * 8) = (u32x4){0u, 0u, 0u, 0u}; }
    }
#endif
    GRID_BAR();

#if LEVEL >= 1 && !defined(NO_P3)
    for (int rep = 0; rep < REPS(4); ++rep) {
        pg8::PanelProb P; P.init(YAB, WBR, T, 1024, 1024, G, bx);
        pg8::EpiMerge E{G8, MG};
        pg8::gemm_core<false>(lds, P, E, pg8::HookMerge{G8});
    }
#endif
    asm volatile("s_waitcnt vmcnt(0)" ::: "memory"); __syncthreads();
#if LEVEL >= 1 && !defined(NO_P4)
    for (int rep = 0; rep < REPS(5); ++rep) {
        pg8::PanelProb P; P.init(MG, WO, T, 1024, 1024, G, bx);
        pg8::EpiX1 E{a.x, XB, XB8, SSQ};
        pg8::gemm_core<false>(lds, P, E, pg8::NoHook{});
    }
#endif
    asm volatile("s_waitcnt vmcnt(0)" ::: "memory"); __syncthreads();

#if LEVEL >= 3 && !defined(NO_P5)
    {
        PHASE_IDS();
        LAS float* LG = (LAS float*)lds;
        volatile LAS int* LCNT = (volatile LAS int*)(LCTL + 96); volatile LAS int* LBASE = (volatile LAS int*)(LCTL + 128);
        const int r32 = lane & 31, hi = lane >> 5;
        for (int tb = bx; tb < T / 256; tb += G) {
            const size_t tok0 = (size_t)tb * 256 + wave * 32;
            const bf16_t* xa = XB + (tok0 + r32) * 1024 + hi * 8;
            const bf16_t* wh0 = WRH + (size_t)r32 * 1024 + hi * 8; const bf16_t* wh1 = wh0 + 32 * 1024;
            const bf16_t* wl0 = WRL + (size_t)r32 * 1024 + hi * 8; const bf16_t* wl1 = wl0 + 32 * 1024;
            f32x16 c0 = f32x16{}, c1 = f32x16{};
#pragma unroll 4
            for (int ks = 0; ks < 64; ++ks) {
                const bf16x8 av = *(const bf16x8*)(xa + ks * 16);
                const bf16x8 h0 = *(const bf16x8*)(wh0 + ks * 16), h1 = *(const bf16x8*)(wh1 + ks * 16), l0 = *(const bf16x8*)(wl0 + ks * 16), l1 = *(const bf16x8*)(wl1 + ks * 16);
                c0 = __builtin_amdgcn_mfma_f32_32x32x16_bf16(av, h0, c0, 0, 0, 0); c1 = __builtin_amdgcn_mfma_f32_32x32x16_bf16(av, h1, c1, 0, 0, 0);
                c0 = __builtin_amdgcn_mfma_f32_32x32x16_bf16(av, l0, c0, 0, 0, 0); c1 = __builtin_amdgcn_mfma_f32_32x32x16_bf16(av, l1, c1, 0, 0, 0);
            }
#pragma unroll
            for (int r = 0; r < 16; ++r) { const int tl = wave * 32 + att::crow(r, hi); LG[tl * 37 + r32] = c0[r]; if (r32 < 4) LG[tl * 37 + 32 + r32] = c1[r]; }
            if (tid < 32) LCNT[tid] = 0;
            LDS_WAIT(); __syncthreads();
            int eid0 = 0, eid1 = 0, rk0 = 0, rk1 = 0; float w0 = 0.f, w1 = 0.f; const size_t tok = (size_t)tb * 256 + tid;
            if (tid < 256) {
                float ssq = 0.f;
#pragma unroll
                for (int j = 0; j < 16; ++j) ssq += SSQ[tok * 16 + j];
                const float rstd = 1.0f / sqrtf(ssq * (1.0f / 1024.0f) + EPS);
                RSTD[tok] = rstd;
                const LAS float* p0 = LG + tid * 37;
                float gl[4]; int grp = 0;
#pragma unroll
                for (int j = 0; j < 4; ++j) gl[j] = p0[j] * rstd + a.b_rg[j];
                float gmx = gl[0];
#pragma unroll
                for (int j = 1; j < 4; ++j) if (gl[j] > gmx) { gmx = gl[j]; grp = j; }
                float gs = 0.f;
#pragma unroll
                for (int j = 0; j < 4; ++j) gs += expf(gl[j] - gmx);
                const float gwt = 1.0f / gs;
                float el[8];
#pragma unroll
                for (int j = 0; j < 8; ++j) el[j] = p0[4 + grp * 8 + j] * rstd + a.b_re[grp * 8 + j];
                int i0 = 0; float v0 = el[0];
#pragma unroll
                for (int j = 1; j < 8; ++j) if (el[j] > v0) { v0 = el[j]; i0 = j; }
                int i1 = -1; float v1 = -INFINITY;
#pragma unroll
                for (int j = 0; j < 8; ++j) if (j != i0 && el[j] > v1) { v1 = el[j]; i1 = j; }
                const float e1 = expf(v1 - v0); w0 = gwt / (1.0f + e1); w1 = gwt * e1 / (1.0f + e1);
                eid0 = grp * 8 + i0; eid1 = grp * 8 + i1;
                rk0 = atomicAdd((int*)(LCNT + eid0), 1); rk1 = atomicAdd((int*)(LCNT + eid1), 1);
            }
            LDS_WAIT(); __syncthreads();
            if (tid < 32) LBASE[tid] = (int)__hip_atomic_fetch_add(ctl + CW_CNT + tid, (unsigned)LCNT[tid], RLX_AGENT);
            LDS_WAIT(); __syncthreads();
            if (tid < 256) {
                const int s0_ = eid0 * LISTCAP + LBASE[eid0] + rk0, s1_ = eid1 * LISTCAP + LBASE[eid1] + rk1;
                LIST[s0_] = (int)(((unsigned)(tok * 2) << 15) | (cvt_pk_bf16(w0, 0.f) & 0x7fffu)); LIST[s1_] = (int)(((unsigned)(tok * 2 + 1) << 15) | (cvt_pk_bf16(w1, 0.f) & 0x7fffu));
            }
            LDS_WAIT(); __syncthreads();
        }
    }
#endif
    GRID_BAR();
#if LEVEL >= 3
    {
        PHASE_IDS();
        volatile LAS int* BST = (volatile LAS int*)(LCTL + 16); volatile LAS int* CNT = (volatile LAS int*)(LCTL + 64);
        if (tid == 0) { int accb = 0; for (int e = 0; e < NEXP; ++e) { const int c = (int)__hip_atomic_load(ctl + CW_CNT + e, RLX_AGENT); CNT[e] = c; BST[e] = accb; accb += (c + 255) >> 8; } BST[NEXP] = accb; }
        LDS_WAIT(); __syncthreads();
    }
#if !defined(NO_P6)
    for (int rep = 0; rep < REPS(6); ++rep) {
        pg8::MoeUpProb P; P.init((const LAS int*)(LCTL + 16), (const LAS int*)(LCTL + 64), G, bx); P.A = (const char*)XB8; P.Bt = (const char*)W13; P.pitch = 1024; P.list = LIST;
        pg8::EpiMoeUp E{LIST, RSTD, H8, {}};
        pg8::gemm_core<true>(lds, P, E, pg8::HookPin<pg8::EpiMoeUp>{&E});
    }
#endif
#endif
    GRID_BAR();
#if LEVEL >= 3 && !defined(NO_P7)
    for (int rep = 0; rep < REPS(7); ++rep) {
        pg8::MoeDownProb P; P.init((const LAS int*)(LCTL + 16), (const LAS int*)(LCTL + 64), G, bx); P.A = (const char*)H8; P.Bt = (const char*)W2; P.pitch = 512;
        pg8::EpiMoeDown E{LIST, YB8, {}};
        pg8::gemm_core<true>(lds, P, E, pg8::HookPin<pg8::EpiMoeDown>{&E});
    }
#endif
    GRID_BAR();

    {
        PHASE_IDS();
        const bool tmo = (__hip_atomic_load(ctl + CW_BAR + XB_TMO, RLX_AGENT) != 0u);
        for (int m = gw; m < T; m += NGW) {
            const f32x4* gr = (const f32x4*)a.final_g + lane;
            f32x4 v[4]; float s = 0.f;
#pragma unroll
            for (int j = 0; j < 4; ++j) {
#if LEVEL >= 1
                { const u32x2 xw = *((const u32x2*)(XB + (size_t)m * D) + lane + 64 * j); v[j] = (f32x4){bf_lo(xw.x), bf_hi(xw.x), bf_lo(xw.y), bf_hi(xw.y)}; }
#else
                v[j] = ((const f32x4*)(a.x + (size_t)m * D) + lane)[64 * j];
#endif
#if LEVEL >= 3
                const unsigned y0 = *((const unsigned*)(YB8 + (size_t)(2 * m) * D) + lane + 64 * j), y1 = *((const unsigned*)(YB8 + (size_t)(2 * m + 1) * D) + lane + 64 * j);
                v[j] = v[j] + (fp8x4_to_f32(y0) + fp8x4_to_f32(y1)) * 0.0625f;
#endif
                s += (v[j].x * v[j].x + v[j].y * v[j].y) + (v[j].z * v[j].z + v[j].w * v[j].w); }
            float rstd = 1.f / sqrtf(wave_sum(s) * (1.f / D) + EPS);
            if (tmo) rstd = __builtin_nanf("");
            f32x4* o = (f32x4*)(a.out + (size_t)m * D) + lane;
#pragma unroll
            for (int j = 0; j < 4; ++j) { f32x4 ov = v[j] * rstd * gr[64 * j];
#if PROBE_PHASE == 50
#pragma unroll
                for (int e = 0; e < 4; ++e) if (!(__builtin_fabsf(ov[e]) < 1e30f)) ov[e] = 0.f;
#endif
                o[64 * j] = ov; }
        }
    }
}

extern "C" void kernel_launch(void* const* d_in, const int* in_sizes, int n_in, void* d_out, int out_size, void* d_ws, size_t ws_size, hipStream_t stream) {
    static int grid = 0;
    if (grid == 0) {
        if (n_in != 25 || in_sizes[0] != T * D || out_size != T * D || ws_size < WS_END + 64 * MiB) { fprintf(stderr, "kernel_launch: unexpected shapes (n_in %d, in0 %d, out %d, ws %zu); nothing launched\n", n_in, n_in > 0 ? in_sizes[0] : -1, out_size, ws_size); grid = -1; return; }
        int dev = 0, cus = 0, per_cu = 0;
        if (hipGetDevice(&dev) != hipSuccess || hipDeviceGetAttribute(&cus, hipDeviceAttributeMultiprocessorCount, dev) != hipSuccess) { grid = -1; return; }
        if (hipFuncSetAttribute((const void*)fwd_kernel, hipFuncAttributeMaxDynamicSharedMemorySize, LDS_BYTES) != hipSuccess) { fprintf(stderr, "kernel_launch: hipFuncSetAttribute failed\n"); grid = -1; return; }
        if (hipOccupancyMaxActiveBlocksPerMultiprocessor(&per_cu, (const void*)fwd_kernel, NTHREADS, LDS_BYTES) != hipSuccess || per_cu < 1) fprintf(stderr, "kernel_launch: occupancy query reports %d\n", per_cu);
        (void)hipGetLastError();
        grid = cus;
        if (grid != 256) fprintf(stderr, "kernel_launch: %d CUs (built for 256)\n", grid);
    }
    if (grid < 0) return;
    if (hipMemsetAsync((char*)d_ws + WS_CTL, 0, CTL_ZERO_BYTES, stream) != hipSuccess) return;
    Args a{};
    a.x = (const float*)d_in[0]; a.pos = (const int*)d_in[1]; a.norm_mix_g = (const float*)d_in[2]; a.w_in = (const float*)d_in[3]; a.gm_ln_g = (const float*)d_in[4]; a.gm_ln_b = (const float*)d_in[5];
    a.gm_w_s = (const float*)d_in[6]; a.gm_b_s = (const float*)d_in[7]; a.lam_q1 = (const float*)d_in[8]; a.lam_k1 = (const float*)d_in[9]; a.lam_q2 = (const float*)d_in[10]; a.lam_k2 = (const float*)d_in[11];
    a.subln_g = (const float*)d_in[12]; a.w_br_a = (const float*)d_in[13]; a.w_br_b = (const float*)d_in[14]; a.w_out = (const float*)d_in[15]; a.norm_ffn_g = (const float*)d_in[16];
    a.w_rg = (const float*)d_in[17]; a.b_rg = (const float*)d_in[18]; a.w_re = (const float*)d_in[19]; a.b_re = (const float*)d_in[20]; a.w_gate = (const float*)d_in[21]; a.w_up = (const float*)d_in[22];
    a.w_down = (const float*)d_in[23]; a.final_g = (const float*)d_in[24];
    a.out = (float*)d_out; a.ws = (unsigned char*)d_ws;
    hipLaunchKernelGGL(fwd_kernel, dim3(grid), dim3(NTHREADS), LDS_BYTES, stream, a);
    const hipError_t le = hipPeekAtLastError();
    if (le != hipSuccess) fprintf(stderr, "kernel_launch: launch failed: %s\n", hipGetErrorName(le));
}
```

```cpp
#include <hip/hip_runtime.h>
#include <cstdio>
#include <cstdint>

#ifndef LEVEL
#define LEVEL 3
#endif

#ifndef PROBE_PHASE
#define PROBE_PHASE -1
#endif
#define REPS(p) ((PROBE_PHASE == (p)) ? 2 : 1)
#define LAS __attribute__((address_space(3)))
#define GAS __attribute__((address_space(1)))
typedef unsigned short bf16_t;
typedef short bf16x8 __attribute__((ext_vector_type(8)));
typedef short s16x4 __attribute__((ext_vector_type(4)));
typedef float f32x2 __attribute__((ext_vector_type(2)));
typedef float f32x4 __attribute__((ext_vector_type(4)));
typedef float f32x16 __attribute__((ext_vector_type(16)));
typedef unsigned u32x2 __attribute__((ext_vector_type(2)));
typedef unsigned u32x4 __attribute__((ext_vector_type(4)));
typedef int i32x8 __attribute__((ext_vector_type(8)));
typedef short s16x16 __attribute__((ext_vector_type(16)));

constexpr int D = 1024, BATCH = 8, SEQ = 8192, T = BATCH * SEQ;
constexpr int IN_COLS = 4608;
constexpr int NEXP = 32, DEXP = 512;
constexpr int LISTCAP = T;
constexpr float EPS = 1e-6f;
constexpr float LOG2E = 1.4426950408889634f;
constexpr float C2 = 0.125f * LOG2E;
constexpr int NWAVES = 8, NTHREADS = 512;

constexpr size_t MiB = 1u << 20;
constexpr size_t WS_CTL = 0, CTL_ZERO_BYTES = 1 * MiB;
constexpr size_t WS_WIN = 2 * MiB;
constexpr size_t WS_WBR = 12 * MiB;
constexpr size_t WS_WO = 14 * MiB;
constexpr size_t WS_W13 = 16 * MiB;
constexpr size_t WS_W2 = 80 * MiB;
constexpr size_t WS_WRH = 112 * MiB;
constexpr size_t WS_WRL = 112 * MiB + 131072;
constexpr size_t WS_CS = 113 * MiB;
constexpr size_t WS_SSQ = 117 * MiB;
constexpr size_t WS_RSTD = 121 * MiB;
constexpr size_t WS_WTS = 122 * MiB;
constexpr size_t WS_LIST = 123 * MiB;
constexpr size_t WS_PARK = 131 * MiB;
constexpr size_t WS_RA = 164 * MiB;
constexpr size_t WS_RB = 292 * MiB;
constexpr size_t WS_RC = 420 * MiB;
constexpr size_t WS_RD = 548 * MiB;
constexpr size_t WS_RE = 612 * MiB;
constexpr size_t WS_END = 868 * MiB;
constexpr int CW_TMO = 0;
constexpr int CW_BAR = 4096;
constexpr int CW_CNT = 8192;

constexpr int RING_BYTES = 147456;
constexpr int LDSCTL_OFF = RING_BYTES;
constexpr int LDS_BYTES = RING_BYTES + 1024;

#define RLX_AGENT __ATOMIC_RELAXED, __HIP_MEMORY_SCOPE_AGENT
#define LDS_WAIT() asm volatile("s_waitcnt lgkmcnt(0)" ::: "memory")
#define VM_WAIT() asm volatile("s_waitcnt vmcnt(0)" ::: "memory")

__device__ __forceinline__ unsigned cvt_pk_bf16(float lo, float hi) { unsigned r; asm("v_cvt_pk_bf16_f32 %0, %1, %2" : "=v"(r) : "v"(lo), "v"(hi)); return r; }
__device__ __forceinline__ unsigned cvt_pk4_fp8(float a, float b, float c, float d) { int w; asm("v_cvt_pk_fp8_f32 %0, %1, %2" : "=v"(w) : "v"(a), "v"(b)); w = __builtin_amdgcn_cvt_pk_fp8_f32(c, d, w, true); return (unsigned)w; }
__device__ __forceinline__ unsigned cvt_pk4_u8(float a, float b, float c, float d) { unsigned w = 0; w = __builtin_amdgcn_cvt_pk_u8_f32(a, 0, w); w = __builtin_amdgcn_cvt_pk_u8_f32(b, 1, w); w = __builtin_amdgcn_cvt_pk_u8_f32(c, 2, w); w = __builtin_amdgcn_cvt_pk_u8_f32(d, 3, w); return w; }
__device__ __forceinline__ f32x4 u8x4_to_f32(unsigned w) { return (f32x4){(float)(w & 0xffu), (float)((w >> 8) & 0xffu), (float)((w >> 16) & 0xffu), (float)(w >> 24)}; }
__device__ __forceinline__ f32x4 fp8x4_to_f32(unsigned w) { const f32x2 lo = __builtin_amdgcn_cvt_pk_f32_fp8((int)w, false), hi = __builtin_amdgcn_cvt_pk_f32_fp8((int)w, true); return (f32x4){lo[0], lo[1], hi[0], hi[1]}; }
__device__ __forceinline__ float bf_lo(unsigned w) { return __uint_as_float(w << 16); }
__device__ __forceinline__ float bf_hi(unsigned w) { return __uint_as_float(w & 0xffff0000u); }
__device__ __forceinline__ float fast_exp2(float x) { return __builtin_amdgcn_exp2f(x); }
__device__ __forceinline__ float fast_rcp(float x) { return __builtin_amdgcn_rcpf(x); }
__device__ __forceinline__ float sigmoidf_(float x) { return fast_rcp(1.0f + fast_exp2(-LOG2E * x)); }
__device__ __forceinline__ float gelu_tanh(float x) {
    const float u = x * (0.7978845608028654f + 0.0356774081363001f * x * x);
    return x * fast_rcp(1.0f + fast_exp2(-2.0f * LOG2E * u));
}
__device__ __forceinline__ f32x2 pk_fma(f32x2 a, f32x2 b, f32x2 c) { return __builtin_elementwise_fma(a, b, c); }
__device__ __forceinline__ f32x2 gelu_tanh2(f32x2 x) {
    constexpr float K0 = -2.0f * LOG2E * 0.7978845608028654f, K1 = -2.0f * LOG2E * 0.0356774081363001f;
    const f32x2 z = x * pk_fma(x * x, (f32x2){K1, K1}, (f32x2){K0, K0});
    const f32x2 d = (f32x2){fast_exp2(z.x), fast_exp2(z.y)} + 1.0f;
    return x * (f32x2){fast_rcp(d.x), fast_rcp(d.y)};
}
__device__ __forceinline__ f32x2 sig255_2(f32x2 a) {
    constexpr float S = 1.0f / 255.0f;
    const f32x2 d = pk_fma((f32x2){fast_exp2(a.x), fast_exp2(a.y)}, (f32x2){S, S}, (f32x2){S, S});
    return (f32x2){fast_rcp(d.x), fast_rcp(d.y)};
}
__device__ __forceinline__ int opaque_tid() { int t = threadIdx.x; asm volatile("" : "+v"(t)); return t; }
__device__ __forceinline__ float wave_sum(float v) {
#pragma unroll
    for (int o = 1; o < 64; o <<= 1) v += __shfl_xor(v, o);
    return v;
}

namespace pg8 {
constexpr int BM = 256, BK = 64, HALF = 128, HTB = HALF * BK * 2, STAGE_BYTES = 8 * HTB, NXCD = 8, WGM = 8;
__host__ __device__ __forceinline__ int lds_byte(int r, int c) { const int st = (r >> 4) * 2 + (c >> 5), rr = r & 15, cc = c & 31, ob = rr * 64 + cc * 2; return st * 1024 + (ob ^ (((ob >> 9) & 1) << 5)); }
__host__ __device__ __forceinline__ void stage_rc(int b, int& R, int& C) { const int st = b / 1024, sb = b % 1024, swz = sb ^ (((sb >> 9) & 1) << 5); R = (st >> 1) * 16 + swz / 64; C = (st & 1) * 32 + (swz % 64) / 2; }
__host__ __device__ __forceinline__ int perm32(int rho) { const int n = rho >> 4, i = rho & 15; return 8 * (i >> 2) + 4 * n + (i & 3); }

struct Unit { int pm, pn, e, lbase, nv; };

struct DenseProb {
    static constexpr bool GATHER = false;
    const char* A; const char* Bt; int pitch  ; int nM, nN, nwg, G, c;
    __device__ __forceinline__ void init(const void* A_, const void* Bt_, int M, int N, int K_, int G_, int c_) { A = (const char*)A_; Bt = (const char*)Bt_; pitch = K_ * 2; nM = M / BM; nN = N / BM; nwg = nM * nN; G = G_; c = c_; }
    __device__ __forceinline__ bool next(int i, Unit& u) const {
        const long L = (long)i * G + c; if (L >= nwg) return false;
        int wgid = (int)L; { const int q = nwg / NXCD, r = nwg % NXCD, xcd = wgid % NXCD, off = wgid / NXCD; wgid = (xcd < r ? xcd * (q + 1) : r * (q + 1) + (xcd - r) * q) + off; }
        const int nig = WGM * nN, gid = wgid / nig, fm = gid * WGM, gsz = (nM - fm) < WGM ? (nM - fm) : WGM;
        u.pm = fm + ((wgid % nig) % gsz); u.pn = (wgid % nig) / gsz; u.e = 0; u.lbase = 0; u.nv = 256; return true;
    }
    __device__ __forceinline__ void a_offs(const Unit& u, const int (&R)[2], const int (&C)[2], unsigned (&o)[2][2]) const {
#pragma unroll
        for (int h = 0; h < 2; ++h)
#pragma unroll
            for (int i = 0; i < 2; ++i) o[h][i] = (unsigned)((u.pm * BM + h * HALF + R[i]) * pitch + C[i] * 2);
    }
    __device__ __forceinline__ const char* b_tile(const Unit& u) const { return Bt + (size_t)u.pn * BM * pitch; }
    __device__ __forceinline__ const char* a_tile(const Unit& u) const { return A + (size_t)u.pm * BM * pitch; }
};

struct PanelProb : DenseProb {
    __device__ __forceinline__ bool next(int i, Unit& u) const { if (i >= nN || c >= nM) return false; u.pm = c; u.pn = i; u.e = 0; u.lbase = 0; u.nv = 256; return true; }
};
struct MoeOrder {
    const LAS int* bstart; const LAS int* cnt; int nblk, nwg, G, c;
    __device__ __forceinline__ void init(const LAS int* bs, const LAS int* cn, int G_, int c_) { bstart = bs; cnt = cn; nblk = bs[NEXP]; nwg = nblk * 4; G = G_; c = c_; }
    __device__ __forceinline__ bool next(int i, Unit& u) const {
        const long L = (long)i * G + c; if (L >= nwg) return false;
        int wgid = (int)L; { const int q = nwg / NXCD, r = nwg % NXCD, xcd = wgid % NXCD, off = wgid / NXCD; wgid = (xcd < r ? xcd * (q + 1) : r * (q + 1) + (xcd - r) * q) + off; }
        const int gid = wgid / 32, fm = gid * 8, gsz = (nblk - fm) < 8 ? (nblk - fm) : 8, w = wgid - gid * 32;
        const int blk = fm + (w % gsz); u.pn = w / gsz; u.pm = blk;
        int e = 0;
        while (e < NEXP - 1 && blk >= bstart[e + 1]) ++e;
        const int rb = blk - bstart[e]; u.e = e; u.lbase = e * LISTCAP + rb * 256; const int rem = cnt[e] - rb * 256; u.nv = rem < 256 ? rem : 256; return true;
    }
};
struct MoeUpProb : MoeOrder {
    static constexpr bool GATHER = true;
    const char* A; const char* Bt; int pitch; const int* list;
    __device__ __forceinline__ const char* a_tile(const Unit&) const { return A; }
    __device__ __forceinline__ void a_offs(const Unit& u, const int (&R)[2], const int (&C)[2], unsigned (&o)[2][2]) const {
        unsigned w[2][2];
#pragma unroll
        for (int h = 0; h < 2; ++h)
#pragma unroll
            for (int i = 0; i < 2; ++i) { const int r = h * HALF + R[i]; w[h][i] = (unsigned)list[u.lbase + ((r < u.nv) ? r : 0)]; }
        asm volatile("" : "+v"(w[0][0]), "+v"(w[0][1]), "+v"(w[1][0]), "+v"(w[1][1]));
#pragma unroll
        for (int h = 0; h < 2; ++h)
#pragma unroll
            for (int i = 0; i < 2; ++i) { const int r = h * HALF + R[i]; const int tok = (r < u.nv) ? (int)(w[h][i] >> 16) : 0; o[h][i] = (unsigned)(tok * pitch + C[i] * 2); }
    }
    __device__ __forceinline__ const char* b_tile(const Unit& u) const { return Bt + ((size_t)u.e * 1024 + (size_t)u.pn * BM) * pitch; }
};
struct MoeDownProb : MoeOrder {
    static constexpr bool GATHER = false;
    const char* A; const char* Bt; int pitch;
    __device__ __forceinline__ const char* a_tile(const Unit& u) const { return A + (size_t)u.pm * BM * pitch; }
    __device__ __forceinline__ void a_offs(const Unit& u, const int (&R)[2], const int (&C)[2], unsigned (&o)[2][2]) const {
#pragma unroll
        for (int h = 0; h < 2; ++h)
#pragma unroll
            for (int i = 0; i < 2; ++i) o[h][i] = (unsigned)((u.pm * BM + h * HALF + R[i]) * pitch + C[i] * 2);
    }
    __device__ __forceinline__ const char* b_tile(const Unit& u) const { return Bt + ((size_t)u.e * 1024 + (size_t)u.pn * BM) * pitch; }
};

struct EpiNull { __device__ __forceinline__ void prefetch(const Unit&, int, int, int, int) const {} __device__ __forceinline__ void stage(const Unit&, int, int, int) const {}
    __device__ __forceinline__ void operator()(f32x4 (&acc)[2][2][4][2], const Unit&, int, int, int, int) const {
#pragma unroll
    for (int a = 0; a < 2; ++a)
#pragma unroll
        for (int b = 0; b < 2; ++b)
#pragma unroll
            for (int m = 0; m < 4; ++m) asm volatile("" :: "v"(acc[a][b][m][0]), "v"(acc[a][b][m][1])); } };
struct DenseProbSame : DenseProb {
    __device__ __forceinline__ void a_offs(const Unit&, const int (&R)[2], const int (&C)[2], unsigned (&o)[2][2]) const { Unit z{0, 0, 0, 0, 256}; DenseProb::a_offs(z, R, C, o); }
    __device__ __forceinline__ const char* b_tile(const Unit&) const { return Bt; }
};
struct NoHook { static constexpr int AT = -1; __device__ __forceinline__ void operator()(f32x4 (&)[2][2][4][2], const Unit&, int, int, int, int) const {} };

template <bool FP8, class Prob, class Epi, class Hook, int PM = 0>
__device__ __forceinline__ void gemm_core(LAS unsigned char* lds, const Prob& P, const Epi& E, const Hook& HK) {
    const int tid = opaque_tid(), wid = __builtin_amdgcn_readfirstlane(tid >> 6), lane = tid & 63, wr = wid >> 2, wc = wid & 3, fr = lane & 15, fq = lane >> 4;
    const int pitch = P.pitch, nt = pitch / (BK * 2);
    int R[2], C[2]; unsigned voffB[2], voffA[2];
#pragma unroll
    for (int i = 0; i < 2; ++i) { stage_rc(tid * 16 + i * 8192, R[i], C[i]); const int Rb = (R[i] & ~31) + perm32(R[i] & 31); voffB[i] = (unsigned)(Rb * pitch + C[i] * 2); voffA[i] = (unsigned)(R[i] * pitch + C[i] * 2); }
    const size_t kstep = (size_t)(BK * 2);
    const size_t hstep = (size_t)HALF * pitch;
    const unsigned ldsw = (unsigned)wid * 1024u;
    const int aoff = lds_byte(wr * 64 + fr, fq * 8), boff = lds_byte(wc * 32 + fr, fq * 8);
#define PG8_SA(b, h) (((b) * 2 + (h)) * HTB)
#define PG8_SB(b, h) ((4 + (b) * 2 + (h)) * HTB)
#define PG8_STAGE_B(bufoff, gbase) do { if constexpr (PM != 1) _Pragma("unroll") for (int _i = 0; _i < 2; ++_i) \
        __builtin_amdgcn_global_load_lds((const unsigned*)((const char*)(gbase) + voffB[_i]), (LAS unsigned*)(lds + (bufoff) + ldsw + _i * 8192), 16, 0, 0); } while (0)
#define PG8_STAGE_AG(bufoff, kb, va) do { if constexpr (PM != 1) _Pragma("unroll") for (int _i = 0; _i < 2; ++_i) \
        __builtin_amdgcn_global_load_lds((const unsigned*)(P.A + (kb) + (va)[_i]), (LAS unsigned*)(lds + (bufoff) + ldsw + _i * 8192), 16, 0, 0); } while (0)
#define PG8_STAGE_AD(bufoff, ubase) do { if constexpr (PM != 1) _Pragma("unroll") for (int _i = 0; _i < 2; ++_i) \
        __builtin_amdgcn_global_load_lds((const unsigned*)((const char*)(ubase) + voffA[_i]), (LAS unsigned*)(lds + (bufoff) + ldsw + _i * 8192), 16, 0, 0); } while (0)
#define PG8_STAGE_AC(bufoff, kb, h) do { if constexpr (Prob::GATHER) { PG8_STAGE_AG(bufoff, kb, cvA[h]); } else { PG8_STAGE_AD(bufoff, cA + (h) * hstep + (kb)); } } while (0)
#define PG8_STAGE_AN(bufoff, kb, h) do { if constexpr (Prob::GATHER) { PG8_STAGE_AG(bufoff, kb, v2[h]); } else { PG8_STAGE_AD(bufoff, (last ? nA : cA) + (h) * hstep + (kb)); } } while (0)
#define PG8_LDA(dst, b, h) do { _Pragma("unroll") for (int m = 0; m < 4; ++m) _Pragma("unroll") for (int k = 0; k < 2; ++k) { if constexpr (PM == 3) asm volatile("" : "=v"(dst[m][k])); else dst[m][k] = *(const LAS bf16x8*)(lds + PG8_SA(b, h) + aoff + m * 2048 + k * 1024); } } while (0)
#define PG8_LDB(dst, b, h) do { _Pragma("unroll") for (int n = 0; n < 2; ++n) _Pragma("unroll") for (int k = 0; k < 2; ++k) { if constexpr (PM == 3) asm volatile("" : "=v"(dst[n][k])); else dst[n][k] = *(const LAS bf16x8*)(lds + PG8_SB(b, h) + boff + n * 2048 + k * 1024); } } while (0)
#define PG8_CAT(x) __builtin_bit_cast(i32x8, __builtin_shufflevector((x)[0], (x)[1], 0, 1, 2, 3, 4, 5, 6, 7, 8, 9, 10, 11, 12, 13, 14, 15))
#define PG8_MMA(ai, bj, At, Bt) do { __builtin_amdgcn_s_setprio(1); \
        if constexpr (PM == 2) { _Pragma("unroll") for (int m = 0; m < 4; ++m) asm volatile("" :: "v"(At[m][0]), "v"(At[m][1])); _Pragma("unroll") for (int n = 0; n < 2; ++n) asm volatile("" :: "v"(Bt[n][0]), "v"(Bt[n][1])); } \
        else if constexpr (FP8) { _Pragma("unroll") for (int m = 0; m < 4; ++m) _Pragma("unroll") for (int n = 0; n < 2; ++n) \
            { const i32x8 bq_ = PG8_CAT(Bt[n]), aq_ = PG8_CAT(At[m]); \
              asm volatile("v_mfma_scale_f32_16x16x128_f8f6f4 %0, %1, %2, %0, %3, %3 op_sel_hi:[0,0,0]" : "+v"(acc[ai][bj][m][n]) : "v"(bq_), "v"(aq_), "v"(sc8)); } } \
        else { _Pragma("unroll") for (int m = 0; m < 4; ++m) _Pragma("unroll") for (int n = 0; n < 2; ++n) _Pragma("unroll") for (int k = 0; k < 2; ++k) \
            acc[ai][bj][m][n] = __builtin_amdgcn_mfma_f32_16x16x32_bf16(Bt[n][k], At[m][k], acc[ai][bj][m][n], 0, 0, 0); } \
        __builtin_amdgcn_s_setprio(0); } while (0)
#define PG8_WAIT_V(n) asm volatile("s_waitcnt vmcnt(" #n ")" ::: "memory")
#define PG8_WAIT_L(n) asm volatile("s_waitcnt lgkmcnt(" #n ")" ::: "memory")
#define PG8_BAR __builtin_amdgcn_s_barrier()
#define PG8_SCHED __builtin_amdgcn_sched_barrier(0)
    Unit cur, nxt; int ui = 0;
    if (!P.next(0, cur)) return;
    int sc8 = 0x7f7f7f7f; asm volatile("" : "+v"(sc8));
    f32x4 acc[2][2][4][2];
#pragma unroll
    for (int a = 0; a < 2; ++a)
#pragma unroll
        for (int b = 0; b < 2; ++b)
#pragma unroll
            for (int m = 0; m < 4; ++m)
#pragma unroll
                for (int n = 0; n < 2; ++n) acc[a][b][m][n] = (f32x4){0.f, 0.f, 0.f, 0.f};
    bf16x8 At[4][2], B0[2][2], B1[2][2];
    unsigned cvA[2][2], nvA[2][2];
    if constexpr (Prob::GATHER) P.a_offs(cur, R, C, cvA);
    const char* cA = P.a_tile(cur);
    const char* cB = P.b_tile(cur);
    PG8_STAGE_B(PG8_SB(0, 0), cB); PG8_STAGE_B(PG8_SB(0, 1), cB + hstep); PG8_STAGE_AC(PG8_SA(0, 0), 0, 0); PG8_STAGE_AC(PG8_SA(0, 1), 0, 1);
    if (wr == 1) { PG8_BAR; E.stage(cur, wc, fr, fq); }
    PG8_WAIT_V(2); PG8_BAR;
    PG8_STAGE_B(PG8_SB(1, 0), cB + kstep); PG8_STAGE_AC(PG8_SA(1, 0), kstep, 0); PG8_STAGE_B(PG8_SB(1, 1), cB + hstep + kstep);
    PG8_WAIT_V(6); PG8_BAR;
    E.prefetch(cur, wr, wc, fr, fq);
    for (;;) {
        const bool has_next = P.next(ui + 1, nxt);
        if constexpr (Prob::GATHER) {
            if (has_next) P.a_offs(nxt, R, C, nvA);
            else {
#pragma unroll
                for (int h = 0; h < 2; ++h)
#pragma unroll
                    for (int i = 0; i < 2; ++i) nvA[h][i] = cvA[h][i];
            }
        }
        const char* nA = has_next ? P.a_tile(nxt) : cA;
        const char* nB = has_next ? P.b_tile(nxt) : cB;
        for (int t = 0; t < (PM == 4 ? 0 : nt); t += 2) {
            if (Hook::AT >= 0 && t == Hook::AT) HK(acc, cur, wr, wc, fr, fq);
            const bool last = (t == nt - 2);
            const size_t k1 = (size_t)(t + 1) * kstep;
            const size_t k2 = last ? 0 : (size_t)(t + 2) * kstep, k3 = k2 + kstep;
            const char* b2 = last ? nB : cB + (size_t)(t + 2) * kstep; const char* b3 = b2 + kstep;
            unsigned v2[2][2];
            if constexpr (Prob::GATHER) {
#pragma unroll
                for (int h = 0; h < 2; ++h)
#pragma unroll
                    for (int i = 0; i < 2; ++i) v2[h][i] = last ? nvA[h][i] : cvA[h][i];
            }
            PG8_LDB(B0, 0, 0); PG8_LDB(B1, 0, 1); PG8_SCHED; PG8_LDA(At, 0, 0); PG8_STAGE_AC(PG8_SA(1, 1), k1, 1);
            PG8_WAIT_V(8); PG8_WAIT_L(0); PG8_BAR; PG8_MMA(0, 0, At, B0); PG8_MMA(0, 1, At, B1); PG8_BAR; PG8_SCHED;
            PG8_LDA(At, 0, 1); PG8_STAGE_B(PG8_SB(0, 0), b2); PG8_STAGE_B(PG8_SB(0, 1), b2 + hstep); PG8_STAGE_AN(PG8_SA(0, 0), k2, 0);
            PG8_WAIT_V(8); PG8_WAIT_L(0); PG8_BAR; PG8_MMA(1, 0, At, B0); PG8_MMA(1, 1, At, B1); PG8_BAR; PG8_SCHED;
            PG8_LDB(B0, 1, 0); PG8_LDB(B1, 1, 1); PG8_SCHED; PG8_LDA(At, 1, 0); PG8_STAGE_AN(PG8_SA(0, 1), k2, 1);
            PG8_WAIT_V(8); PG8_WAIT_L(0); PG8_BAR; PG8_MMA(0, 0, At, B0); PG8_MMA(0, 1, At, B1); PG8_BAR; PG8_SCHED;
            PG8_LDA(At, 1, 1); PG8_STAGE_B(PG8_SB(1, 0), b3); PG8_STAGE_B(PG8_SB(1, 1), b3 + hstep); PG8_STAGE_AN(PG8_SA(1, 0), k3, 0);
            PG8_WAIT_V(8); PG8_WAIT_L(0); PG8_BAR; PG8_MMA(1, 0, At, B0); PG8_MMA(1, 1, At, B1); PG8_BAR; PG8_SCHED;
        }
        if (wr == 0) PG8_BAR;
        if constexpr (FP8) {
            asm volatile("s_nop 15\n\ts_nop 7" ::: "memory");
#pragma unroll
            for (int a = 0; a < 2; ++a)
#pragma unroll
                for (int b = 0; b < 2; ++b)
#pragma unroll
                    for (int m = 0; m < 4; ++m) asm volatile("" : "+v"(acc[a][b][m][0]), "+v"(acc[a][b][m][1]));
        }
        E(acc, cur, wr, wc, fr, fq);
        if (!has_next) break;
        E.prefetch(nxt, wr, wc, fr, fq);
#pragma unroll
        for (int a = 0; a < 2; ++a)
#pragma unroll
            for (int b = 0; b < 2; ++b)
#pragma unroll
                for (int m = 0; m < 4; ++m)
#pragma unroll
                    for (int n = 0; n < 2; ++n) acc[a][b][m][n] = (f32x4){0.f, 0.f, 0.f, 0.f};
        cur = nxt; cA = nA; cB = nB; ++ui;
        if constexpr (Prob::GATHER) {
#pragma unroll
            for (int h = 0; h < 2; ++h)
#pragma unroll
                for (int i = 0; i < 2; ++i) cvA[h][i] = nvA[h][i];
        }
        if (wr == 1) { PG8_BAR; E.stage(cur, wc, fr, fq); }
    }
    PG8_WAIT_V(0);
    PG8_BAR;
#undef PG8_SA
#undef PG8_SB
#undef PG8_STAGE_AG
#undef PG8_STAGE_AD
#undef PG8_STAGE_AC
#undef PG8_STAGE_AN
#undef PG8_STAGE_B
#undef PG8_LDA
#undef PG8_LDB
#undef PG8_MMA
#undef PG8_CAT
#undef PG8_WAIT_V
#undef PG8_WAIT_L
#undef PG8_BAR
#undef PG8_SCHED
}

__device__ __forceinline__ void pair_store16(unsigned char* p, size_t r8, const u32x4& A, const u32x4& B) {
    u32x4 s1, s2;
    s1.x = __builtin_amdgcn_update_dpp(A.x, B.x, 0x128, 0xf, 0xc, false); s1.y = __builtin_amdgcn_update_dpp(A.y, B.y, 0x128, 0xf, 0xc, false);
    s1.z = __builtin_amdgcn_update_dpp(A.z, B.z, 0x128, 0xf, 0xc, false); s1.w = __builtin_amdgcn_update_dpp(A.w, B.w, 0x128, 0xf, 0xc, false);
    s2.x = __builtin_amdgcn_update_dpp(B.x, A.x, 0x128, 0xf, 0x3, false); s2.y = __builtin_amdgcn_update_dpp(B.y, A.y, 0x128, 0xf, 0x3, false);
    s2.z = __builtin_amdgcn_update_dpp(B.z, A.z, 0x128, 0xf, 0x3, false); s2.w = __builtin_amdgcn_update_dpp(B.w, A.w, 0x128, 0xf, 0x3, false);
    *(u32x4*)p = s1; *(u32x4*)(p + r8) = s2;
}
__device__ __forceinline__ u32x4 pack8(const f32x4& v0, const f32x4& v1) { u32x4 w; w.x = cvt_pk_bf16(v0[0], v0[1]); w.y = cvt_pk_bf16(v0[2], v0[3]); w.z = cvt_pk_bf16(v1[0], v1[1]); w.w = cvt_pk_bf16(v1[2], v1[3]); return w; }

struct EpiStoreOnly {
    bf16_t* O;
    __device__ __forceinline__ void prefetch(const Unit&, int, int, int, int) const {}
    __device__ __forceinline__ void stage(const Unit&, int, int, int) const {}
    __device__ __forceinline__ void operator()(f32x4 (&acc)[2][2][4][2], const Unit& u, int wr, int wc, int fr, int fq) const {
        const int cl0 = wc * 32 + 8 * fq; int row0 = u.pm * BM + wr * 64 + fr; asm volatile("" : "+v"(row0));
#pragma unroll
        for (int ai = 0; ai < 2; ++ai)
#pragma unroll
            for (int m = 0; m < 4; ++m) { bf16_t* rowp = O + (size_t)(row0 + ai * HALF + m * 16) * 256 + cl0;
#pragma unroll
                for (int bj = 0; bj < 2; ++bj) *(u32x4*)(rowp + bj * HALF) = pack8(acc[ai][bj][m][0], acc[ai][bj][m][1]); }
    }
};
#define EPI_ST(val, ptr) do { if constexpr (MODE == 1) { auto v_ = (val); asm volatile("" :: "v"(v_)); } else *(ptr) = (val); } while (0)
template <int MODE> struct EpiInProjT {
    bf16_t *UV, *Q, *Kb, *Vb; unsigned char* G8; const float* cs; unsigned char *Q8, *K8; LAS unsigned char* lds;
    __device__ __forceinline__ void prefetch(const Unit&, int, int, int, int) const {}
    __device__ __forceinline__ void stage(const Unit& u, int wc, int fr, int fq) const {
        if (u.pn >= 4 && u.pn < 8) { const float* src = cs + (size_t)(u.pm * BM + wc * 64) * 16 + (fq * 16 + fr) * 4;
#pragma unroll
            for (int i = 0; i < 4; ++i) __builtin_amdgcn_global_load_lds((const unsigned*)(src + i * 256), (LAS unsigned*)(lds + STAGE_BYTES + wc * 4096 + i * 1024), 16, 0, 0); } }
    template <class PT> __device__ __forceinline__ void st_pair(PT* p, int pitch, const u32x4& A, const u32x4& B) const {
        if constexpr (MODE == 1) { asm volatile("" :: "v"(A), "v"(B)); } else pair_store16((unsigned char*)p, (size_t)8 * pitch * sizeof(PT), A, B); }
    __device__ __forceinline__ void operator()(f32x4 (&acc)[2][2][4][2], const Unit& u, int wr, int wc, int fr, int fq) const {
        constexpr bool NOMATH = (MODE == 2);
        const int pn = u.pn; int row0 = u.pm * BM + wr * 64 + fr; asm volatile("" : "+v"(row0));
        int prow0 = row0 - (fr & 8), pcl = wc * 64 + 8 * fq + 4 * (fr & 8);
        asm volatile("" : "+v"(prow0), "+v"(pcl));
        if (pn < 4) {
#pragma unroll
            for (int ai = 0; ai < 2; ++ai)
#pragma unroll
                for (int m = 0; m < 4; ++m) { u32x4 w[2];
#pragma unroll
                    for (int bj = 0; bj < 2; ++bj) { f32x4 v0 = acc[ai][bj][m][0], v1 = acc[ai][bj][m][1];
                        if constexpr (!NOMATH) { const f32x2 a = gelu_tanh2(v0.xy), b = gelu_tanh2(v0.zw), c = gelu_tanh2(v1.xy), d = gelu_tanh2(v1.zw); v0 = (f32x4){a.x, a.y, b.x, b.y}; v1 = (f32x4){c.x, c.y, d.x, d.y}; }
                        w[bj] = pack8(v0, v1); }
                    st_pair(UV + (size_t)(prow0 + ai * HALF + m * 16) * 1024 + pn * 256 + pcl, 1024, w[0], w[1]); }
        } else if (pn < 8) {
            bf16_t* dst = (pn < 6) ? Q : Kb; const float sc = (pn < 6) ? C2 : 1.0f;
            const float sgn = (fq == 0) ? -1.0f : 1.0f; const bool rot_lane = fq < 2;
#pragma unroll
            for (int ai = 0; ai < 2; ++ai) {
                f32x4 cs4[4][4];
#pragma unroll
                for (int m = 0; m < 4; ++m) { const LAS f32x4* cp = (const LAS f32x4*)(lds + STAGE_BYTES + (wr * 64 + fr + ai * HALF + m * 16) * 64);
#pragma unroll
                    for (int j = 0; j < 4; ++j) cs4[m][j] = cp[j]; }
#pragma unroll
                for (int m = 0; m < 4; ++m) { const int row = row0 + ai * HALF + m * 16; f32x4 v[2][2];
#pragma unroll
                    for (int bj = 0; bj < 2; ++bj) { v[bj][0] = acc[ai][bj][m][0]; v[bj][1] = acc[ai][bj][m][1]; }
                    if constexpr (!NOMATH) {
                        f32x4 p0, p1;
#pragma unroll
                        for (int e = 0; e < 4; ++e) { p0[e] = __shfl_xor(v[0][0][e], 16); p1[e] = __shfl_xor(v[0][1][e], 16); }
                        if (rot_lane) {
#pragma unroll
                            for (int e = 0; e < 4; ++e) { v[0][0][e] = v[0][0][e] * cs4[m][0][e] + sgn * p0[e] * cs4[m][2][e]; v[0][1][e] = v[0][1][e] * cs4[m][1][e] + sgn * p1[e] * cs4[m][3][e]; }
                        }
                    }
                    if ((wc & 1) == 0) {
                        st_pair(dst + (size_t)(prow0 + ai * HALF + m * 16) * 512 + (pn & 1) * 256 + pcl, 512, pack8(v[0][0] * sc, v[0][1] * sc), pack8(v[1][0] * sc, v[1][1] * sc));
                    } else {
                        const float s8 = (pn < 6) ? sc * 8.0f : 1.0f;
#pragma unroll
                        for (int bj = 0; bj < 2; ++bj) { const f32x4 v0 = v[bj][0] * s8, v1 = v[bj][1] * s8;
                            u32x2 q8; q8.x = cvt_pk4_fp8(v0[0], v0[1], v0[2], v0[3]); q8.y = cvt_pk4_fp8(v1[0], v1[1], v1[2], v1[3]);
                            EPI_ST(q8, (u32x2*)(((pn < 6) ? Q8 : K8) + (size_t)row * 256 + ((pn & 1) * 2 + (wc >> 1)) * 64 + bj * 32 + 8 * fq)); } } }
            }
        } else if (pn < 10) {
#pragma unroll
            for (int ai = 0; ai < 2; ++ai)
#pragma unroll
                for (int m = 0; m < 4; ++m)
                    st_pair(Vb + (size_t)(prow0 + ai * HALF + m * 16) * 512 + (pn - 8) * 256 + pcl, 512, pack8(acc[ai][0][m][0], acc[ai][0][m][1]), pack8(acc[ai][1][m][0], acc[ai][1][m][1]));
        } else {
            int gl = (fq * 16 + fr) * 16; asm volatile("" : "+v"(gl));
            unsigned char* gb = G8 + (size_t)((u.pm * 8 + (pn - 10)) * 8 + wr * 4 + wc) * 8192 + gl;
#pragma unroll
            for (int ai = 0; ai < 2; ++ai)
#pragma unroll
                for (int m = 0; m < 4; ++m) { u32x4 qq;
#pragma unroll
                    for (int bj = 0; bj < 2; ++bj) { f32x4 v0 = acc[ai][bj][m][0], v1 = acc[ai][bj][m][1];
                        if constexpr (!NOMATH) { const f32x2 a = sig255_2(v0.xy), b = sig255_2(v0.zw), c = sig255_2(v1.xy), d = sig255_2(v1.zw); v0 = (f32x4){a.x, a.y, b.x, b.y}; v1 = (f32x4){c.x, c.y, d.x, d.y}; }
                        const unsigned qa = cvt_pk4_u8(v0[0], v0[1], v0[2], v0[3]), qb = cvt_pk4_u8(v1[0], v1[1], v1[2], v1[3]);
                        if (bj == 0) { qq.x = qa; qq.y = qb; } else { qq.z = qa; qq.w = qb; } }
                    EPI_ST(qq, (u32x4*)(gb + (ai * 4 + m) * 1024)); }
        }
    }
};

#undef EPI_ST
using EpiInProj = EpiInProjT<0>;
__device__ __forceinline__ void unpack8(const u32x4& w, f32x4& a, f32x4& b) { a = (f32x4){bf_lo(w.x), bf_hi(w.x), bf_lo(w.y), bf_hi(w.y)}; b = (f32x4){bf_lo(w.z), bf_hi(w.z), bf_lo(w.w), bf_hi(w.w)}; }
struct HookMerge {
    static constexpr int AT = 8;
    const unsigned char* G8;
    __device__ __forceinline__ void operator()(f32x4 (&acc)[2][2][4][2], const Unit& u, int wr, int wc, int fr, int fq) const {
        const unsigned char* gp = G8 + (size_t)((u.pm * 8 + u.pn) * 8 + wr * 4 + wc) * 8192 + ((fq >> 1) * 16 + fr) * 16 + 8 * (fq & 1); asm volatile("" : "+v"(gp));
        u32x2 w0[2][4][2], w1[2][4][2];
#pragma unroll
        for (int ai = 0; ai < 2; ++ai)
#pragma unroll
            for (int m = 0; m < 4; ++m)
#pragma unroll
                for (int bj = 0; bj < 2; ++bj) { w0[ai][m][bj] = *(const u32x2*)(gp + (ai * 4 + m) * 1024 + bj * 512); w1[ai][m][bj] = *(const u32x2*)(gp + 4 * 65536 + (ai * 4 + m) * 1024 + bj * 512); }
#pragma unroll
        for (int ai = 0; ai < 2; ++ai)
#pragma unroll
            for (int m = 0; m < 4; ++m)
#pragma unroll
                for (int bj = 0; bj < 2; ++bj) { const f32x4 a0 = u8x4_to_f32(w0[ai][m][bj].x), a1 = u8x4_to_f32(w0[ai][m][bj].y), b0 = u8x4_to_f32(w1[ai][m][bj].x), b1 = u8x4_to_f32(w1[ai][m][bj].y);
#pragma unroll
                    for (int e = 0; e < 4; ++e) { acc[ai][bj][m][0][e] *= a0[e] * fast_rcp(fmaxf(b0[e], 0.5f)); acc[ai][bj][m][1][e] *= a1[e] * fast_rcp(fmaxf(b1[e], 0.5f)); } }
    }
};
struct EpiMerge {
    const unsigned char* G8; bf16_t* MG;
    __device__ __forceinline__ void prefetch(const Unit&, int, int, int, int) const {}
    __device__ __forceinline__ void stage(const Unit&, int, int, int) const {}
    __device__ __forceinline__ void operator()(f32x4 (&acc)[2][2][4][2], const Unit& u, int wr, int wc, int fr, int fq) const {
        const unsigned char* gp = G8 + (size_t)((u.pm * 8 + u.pn + 4) * 8 + wr * 4 + wc) * 8192 + ((fq >> 1) * 16 + fr) * 16 + 8 * (fq & 1); asm volatile("" : "+v"(gp));
        int prow0 = u.pm * BM + wr * 64 + (fr & 7), pcol = u.pn * BM + wc * 64 + 8 * fq + 4 * (fr & 8); asm volatile("" : "+v"(prow0), "+v"(pcol));
        u32x2 w1[2][4][2];
#pragma unroll
        for (int ai = 0; ai < 2; ++ai)
#pragma unroll
            for (int m = 0; m < 4; ++m)
#pragma unroll
                for (int bj = 0; bj < 2; ++bj) w1[ai][m][bj] = *(const u32x2*)(gp + (ai * 4 + m) * 1024 + bj * 512);
        const float s255 = 1.0f / 255.0f;
#pragma unroll
        for (int ai = 0; ai < 2; ++ai)
#pragma unroll
            for (int m = 0; m < 4; ++m) { u32x4 w[2];
#pragma unroll
                for (int bj = 0; bj < 2; ++bj) { f32x4 b0 = u8x4_to_f32(w1[ai][m][bj].x), b1 = u8x4_to_f32(w1[ai][m][bj].y);
#pragma unroll
                    for (int e = 0; e < 4; ++e) { b0[e] = fmaxf(b0[e], 0.5f) * s255; b1[e] = fmaxf(b1[e], 0.5f) * s255; }
                    w[bj] = pack8(acc[ai][bj][m][0] * b0, acc[ai][bj][m][1] * b1); }
                pair_store16((unsigned char*)(MG + (size_t)(prow0 + ai * HALF + m * 16) * 1024 + pcol), (size_t)8 * 1024 * 2, w[0], w[1]); }
    }
};

struct EpiX1 {
    const float* X; bf16_t* XB; unsigned char* XB8; float* ssq;
    __device__ __forceinline__ void prefetch(const Unit&, int, int, int, int) const {}
    __device__ __forceinline__ void stage(const Unit&, int, int, int) const {}
    __device__ __forceinline__ void operator()(f32x4 (&acc)[2][2][4][2], const Unit& u, int wr, int wc, int fr, int fq) const {
        const int col0 = u.pn * BM + wc * 64 + 8 * fq; int row0 = u.pm * BM + wr * 64 + fr; asm volatile("" : "+v"(row0));
#pragma unroll
        for (int ai = 0; ai < 2; ++ai) {
            f32x4 xv[4][2][2];
#pragma unroll
            for (int m = 0; m < 4; ++m) { const float* xp = X + (size_t)(row0 + ai * HALF + m * 16) * 1024 + col0;
#pragma unroll
                for (int bj = 0; bj < 2; ++bj) { xv[m][bj][0] = *(const f32x4*)(xp + bj * 32); xv[m][bj][1] = *(const f32x4*)(xp + bj * 32 + 4); } }
#pragma unroll
            for (int m = 0; m < 4; ++m) { const size_t row = (size_t)(row0 + ai * HALF + m * 16); u32x4 wb[2];
                float s = 0.f;
#pragma unroll
                for (int bj = 0; bj < 2; ++bj) { const f32x4 v0 = acc[ai][bj][m][0] + xv[m][bj][0], v1 = acc[ai][bj][m][1] + xv[m][bj][1];
                    wb[bj] = pack8(v0, v1);
                    { u32x2 q8; q8.x = cvt_pk4_fp8(v0[0], v0[1], v0[2], v0[3]); q8.y = cvt_pk4_fp8(v1[0], v1[1], v1[2], v1[3]); *(u32x2*)(XB8 + row * 1024 + col0 + bj * 32) = q8; }
                    s += (v0[0] * v0[0] + v0[1] * v0[1]) + (v0[2] * v0[2] + v0[3] * v0[3]) + (v1[0] * v1[0] + v1[1] * v1[1]) + (v1[2] * v1[2] + v1[3] * v1[3]); }
                pair_store16((unsigned char*)(XB + (row - (fr & 8)) * 1024 + col0 + 4 * (fr & 8)), (size_t)8 * 1024 * 2, wb[0], wb[1]);
                s += __shfl_xor(s, 16); s += __shfl_xor(s, 32);
                if (fq == 0) ssq[row * 16 + u.pn * 4 + wc] = s; }
        }
    }
};

struct EpiMoeUp {
    const int* list; const float* rstd; unsigned char* H8;
    __device__ __forceinline__ void stage(const Unit&, int, int, int) const {}
    mutable float rs[2][4];
    __device__ __forceinline__ void prefetch(const Unit& u, int wr, int wc, int fr, int fq) const {
        int r0 = wr * 64 + fr; asm volatile("" : "+v"(r0));
        int tok[2][4]; unsigned w[2][4];
#pragma unroll
        for (int ai = 0; ai < 2; ++ai)
#pragma unroll
            for (int m = 0; m < 4; ++m) { const int r = r0 + ai * HALF + m * 16; w[ai][m] = (unsigned)list[u.lbase + ((r < u.nv) ? r : 0)]; }
#pragma unroll
        for (int ai = 0; ai < 2; ++ai) asm volatile("" : "+v"(w[ai][0]), "+v"(w[ai][1]), "+v"(w[ai][2]), "+v"(w[ai][3]));
#pragma unroll
        for (int ai = 0; ai < 2; ++ai)
#pragma unroll
            for (int m = 0; m < 4; ++m) { const int r = r0 + ai * HALF + m * 16; tok[ai][m] = (r < u.nv) ? (int)(w[ai][m] >> 16) : 0; }
#pragma unroll
        for (int ai = 0; ai < 2; ++ai)
#pragma unroll
            for (int m = 0; m < 4; ++m) rs[ai][m] = rstd[tok[ai][m]];
    }
    __device__ __forceinline__ void pin() const {
#pragma unroll
        for (int ai = 0; ai < 2; ++ai) asm volatile("" : "+v"(rs[ai][0]), "+v"(rs[ai][1]), "+v"(rs[ai][2]), "+v"(rs[ai][3])); }
    __device__ __forceinline__ void operator()(f32x4 (&acc)[2][2][4][2], const Unit& u, int wr, int wc, int fr, int fq) const {
        const int col0 = u.pn * 128 + wc * 32 + 8 * fq; int r0 = wr * 64 + fr; asm volatile("" : "+v"(r0));
#pragma unroll
        for (int ai = 0; ai < 2; ++ai)
#pragma unroll
            for (int m = 0; m < 4; ++m) { const int r = r0 + ai * HALF + m * 16; const float rsv = rs[ai][m] * 0.015625f;
                f32x4 g0 = acc[ai][0][m][0] * rsv, g1 = acc[ai][0][m][1] * rsv, u0 = acc[ai][1][m][0] * rsv, u1 = acc[ai][1][m][1] * rsv;
#pragma unroll
                for (int e = 0; e < 4; ++e) { g0[e] = g0[e] * sigmoidf_(g0[e]) * (u0[e] * 8.f); g1[e] = g1[e] * sigmoidf_(g1[e]) * (u1[e] * 8.f); }
                u32x2 q8; q8.x = cvt_pk4_fp8(g0[0], g0[1], g0[2], g0[3]); q8.y = cvt_pk4_fp8(g1[0], g1[1], g1[2], g1[3]);
                *(u32x2*)(H8 + (size_t)(u.pm * BM + r) * 512 + col0) = q8; }
    }
};
struct EpiMoeDown {
    const int* list; unsigned char* YB8;
    __device__ __forceinline__ void stage(const Unit&, int, int, int) const {}
    mutable unsigned lw[2][4];
    __device__ __forceinline__ void prefetch(const Unit& u, int wr, int wc, int fr, int fq) const {
        int r0 = wr * 64 + fr; asm volatile("" : "+v"(r0));
#pragma unroll
        for (int ai = 0; ai < 2; ++ai)
#pragma unroll
            for (int m = 0; m < 4; ++m) { const int r = r0 + ai * HALF + m * 16; lw[ai][m] = (unsigned)list[u.lbase + ((r < u.nv) ? r : 0)]; }
    }
    __device__ __forceinline__ void pin() const {
#pragma unroll
        for (int ai = 0; ai < 2; ++ai) asm volatile("" : "+v"(lw[ai][0]), "+v"(lw[ai][1]), "+v"(lw[ai][2]), "+v"(lw[ai][3])); }
    __device__ __forceinline__ void operator()(f32x4 (&acc)[2][2][4][2], const Unit& u, int wr, int wc, int fr, int fq) const {
        int r0 = wr * 64 + fr; asm volatile("" : "+v"(r0));
        const int col0 = u.pn * BM + wc * 64 + 16 * fq;
#pragma unroll
        for (int ai = 0; ai < 2; ++ai)
#pragma unroll
            for (int m = 0; m < 4; ++m) { const unsigned word = lw[ai][m];
                if (r0 + ai * HALF + m * 16 < u.nv) { const float w = __uint_as_float((word & 0x7fffu) << 16) * 0.0625f;
                    unsigned char* op = YB8 + (size_t)(word >> 15) * 1024 + col0; u32x4 q;
                    { const f32x4 y0 = acc[ai][0][m][0] * w, y1 = acc[ai][0][m][1] * w; q.x = cvt_pk4_fp8(y0[0], y0[1], y0[2], y0[3]); q.y = cvt_pk4_fp8(y1[0], y1[1], y1[2], y1[3]); }
                    { const f32x4 y0 = acc[ai][1][m][0] * w, y1 = acc[ai][1][m][1] * w; q.z = cvt_pk4_fp8(y0[0], y0[1], y0[2], y0[3]); q.w = cvt_pk4_fp8(y1[0], y1[1], y1[2], y1[3]); }
                    *(u32x4*)op = q; } }
    }
};
template <class Epi> struct HookPin { static constexpr int AT = 2; const Epi* E;
    __device__ __forceinline__ void operator()(f32x4 (&)[2][2][4][2], const Unit&, int, int, int, int) const { E->pin(); } };
}


namespace att {
constexpr int QB = 256, KVB = 64, QP = 512  ;
#if PROBE_PHASE == 52
#define ATT_REF_OFF 0.0f
#else
#define ATT_REF_OFF 0.0f
#endif
constexpr int KSLOT = 8192, VSLOT = 8192, NSLOT = 3;
constexpr int L_K = 0, L_V = NSLOT * KSLOT, L_WS = L_V + NSLOT * VSLOT, L_OST = L_WS + NWAVES * 256, L_END = L_OST + NWAVES * 8192;
static_assert(L_END <= RING_BYTES, "attention LDS");
#if PROBE_PHASE == 40
#define ATT_RESC_THR 0.f
#define ATT_RESC_MIN 0.001f
#define ATT_RESC_LO -2.f
#else
#define ATT_RESC_THR 512.f
#define ATT_RESC_MIN 64.f
#define ATT_RESC_LO 0.f
#endif
__device__ __forceinline__ int crow(int r, int hi) { return (r & 3) + 8 * (r >> 2) + 4 * hi; }
__device__ __forceinline__ void glds16(const void* gsrc, unsigned lds_dst) { unsigned keep;
    asm volatile("s_mov_b32 %0, m0\n\ts_mov_b32 m0, %2\n\ts_nop 0\n\tglobal_load_lds_dwordx4 %1, off\n\ts_mov_b32 m0, %0" : "=&s"(keep) : "v"(gsrc), "s"(lds_dst) : "memory"); }
#define ATT_WAIT_BAR(N) asm volatile("s_waitcnt vmcnt(" #N ") lgkmcnt(0)\n\ts_barrier" ::: "memory")
#define MX3(a, b, c) __builtin_fmaxf(__builtin_fmaxf((a), (b)), (c))
#define ATT_SBAR() __builtin_amdgcn_sched_barrier(0)
#define ATT_MFMA(a, b, c) __builtin_amdgcn_mfma_f32_32x32x16_bf16(a, b, c, 0, 0, 0)
__device__ __forceinline__ float rowmax(const f32x16& p0, const f32x16& p1) {
    float a = MX3(p0[0], p0[1], p1[0]), b = MX3(p0[2], p0[3], p1[1]); a = MX3(a, p1[2], p1[3]);
#pragma unroll
    for (int r = 4; r < 16; r += 4) { a = MX3(a, p0[r], p0[r + 1]); b = MX3(b, p0[r + 2], p0[r + 3]); a = MX3(a, p1[r], p1[r + 1]); b = MX3(b, p1[r + 2], p1[r + 3]); }
    const float m = __builtin_fmaxf(a, b); auto rr = __builtin_amdgcn_permlane32_swap(__float_as_uint(m), __float_as_uint(m), false, false);
    return __builtin_fmaxf(__uint_as_float(rr[0]), __uint_as_float(rr[1])); }
__device__ __forceinline__ void cmask(f32x16& p0, f32x16& p1, int jb, int qrel, int hi) {
    const int kb = 64 * jb + 4 * hi;
#pragma unroll
    for (int r = 0; r < 16; ++r) { const int kv = kb + (r & 3) + 8 * (r >> 2); if (kv > qrel) p0[r] = -INFINITY; if (kv + 32 > qrel) p1[r] = -INFINITY; } }
typedef int i32x4 __attribute__((ext_vector_type(4)));
__device__ __forceinline__ void kload2(bf16x8* kf, const LAS char* kp, int j) { kf[2 * j] = *(const LAS bf16x8*)(kp + j * 2048); kf[2 * j + 1] = *(const LAS bf16x8*)(kp + j * 2048 + 512); }
__device__ __forceinline__ i32x8 frag32(const LAS char* row, int c0) {
    const i32x4 lo = *(const LAS i32x4*)(row + c0 * 16), hi = *(const LAS i32x4*)(row + (c0 ^ 1) * 16);
    return __builtin_shufflevector(lo, hi, 0, 1, 2, 3, 4, 5, 6, 7); }
#define MFMA8_PV(O, A, B) asm volatile("v_mfma_scale_f32_32x32x64_f8f6f4 %0, %1, %2, %0, %3, %3 op_sel_hi:[0,0,0]" : "+v"(O) : "v"(A), "v"(B), "v"(sc_1))
template <int MODE> __device__ __forceinline__ void attn_pass(f32x16 (&o)[4], int b, int hm, int h, int qb, const bf16_t* Q, const bf16_t* __restrict__ K, const unsigned char* __restrict__ V8T, LAS char* shm) {
    const int tid = opaque_tid(), lane = tid & 63, r32 = lane & 31, hi = lane >> 5; const int wid = __builtin_amdgcn_readfirstlane(tid >> 6);
    const long rowbase = (long)b * SEQ; const int q0 = qb * QB, NT = (q0 + QB) / KVB;
    const bf16_t* Qw = Q + (rowbase + q0 + wid * 32) * QP + hm * 64;
    const bf16_t* Kh = K + rowbase * QP + hm * 64;
    const unsigned lds0 = (unsigned)(uintptr_t)shm;
    LAS float* wsf = (LAS float*)(shm + L_WS) + wid * 64;
    const bf16_t* ksrc = Kh + (long)lane * QP + wid * 8;
    const unsigned char* vsrc = V8T + ((size_t)(b * 4 + h) * (SEQ / KVB)) * VSLOT + wid * 1024 + lane * 16;
    const unsigned kdst = lds0 + L_K + wid * 1024, vdst = lds0 + L_V + wid * 1024;
#define DMA_K(t, s) glds16(ksrc + (long)(t) * KVB * QP, (unsigned)__builtin_amdgcn_readfirstlane(kdst + (unsigned)(s) * KSLOT))
#define DMA_V(t, s) glds16(vsrc + (long)(t) * VSLOT, (unsigned)__builtin_amdgcn_readfirstlane(vdst + (unsigned)(s) * VSLOT))
    const LAS char* kp0 = shm + L_K + hi * 1024 + r32 * 16;
    const LAS char* vp0 = shm + L_V + r32 * 64;  const int vc0 = (2 * hi) ^ ((r32 >> 2) & 3);
    DMA_K(0, 0); DMA_V(0, 0); DMA_K(1, 1);
    bf16x8 qr[4];
#pragma unroll
    for (int d0 = 0; d0 < 4; ++d0) qr[d0] = *(const bf16x8*)(Qw + (long)r32 * QP + d0 * 16 + hi * 8);
    float mhat = 0.f, l_reg = 0.f;
    float zf = 0.f; asm volatile("" : "+v"(zf));
    int sc_1 = 0x7f7f7f7f; asm volatile("" : "+v"(sc_1));
    f32x16 negm;
#pragma unroll
    for (int r = 0; r < 16; ++r) { negm[r] = zf;
#pragma unroll
        for (int d0 = 0; d0 < 4; ++d0) o[d0][r] = zf; }
    asm volatile("" : "+v"(negm));
    const int qrel = wid * 32 + r32;
    asm volatile("" : "+v"(qr[0]), "+v"(qr[1]), "+v"(qr[2]), "+v"(qr[3]));
    LAS bf16x8* qlds = (LAS bf16x8*)(shm + L_OST + wid * 8192) + lane;
#pragma unroll
    for (int d0 = 0; d0 < 4; ++d0) qlds[d0 * 64] = qr[d0];
    DMA_K(2, 2);
    ATT_WAIT_BAR(1);
    bool resc = false;
#define CMASK(P0, P1, t) do { const int jb_ = (t) - (NT - 4); if (jb_ >= 0) cmask(P0, P1, jb_, qrel, hi); } while (0)
#define RESC() do { if (resc) { asm volatile("s_waitcnt lgkmcnt(0)\n\ts_nop 15\n\ts_nop 15\n\ts_nop 7" ::: "memory"); \
        _Pragma("unroll") for (int r = 0; r < 16; ++r) { const float fr_ = wsf[crow(r, hi)]; _Pragma("unroll") for (int d_ = 0; d_ < 4; ++d_) asm volatile("v_mul_f32 %0, %0, %1" : "+v"(o[d_][r]) : "v"(fr_)); } } } while (0)
    f32x16 pA0, pA1, pB0, pB1;
    int sl_prev = 0, sl_cur = 0, sl_next = 1;
#define ROT() do { sl_prev = sl_cur; sl_cur = sl_next; sl_next = (sl_next == NSLOT - 1) ? 0 : sl_next + 1; } while (0)
    bf16x8 kf[8];
#pragma unroll
    for (int j = 0; j < 4; ++j) kload2(kf, kp0, j);
    pA0 = ATT_MFMA(kf[0], qr[0], negm); pA1 = ATT_MFMA(kf[1], qr[0], negm);
#pragma unroll
    for (int d0 = 1; d0 < 4; ++d0) { pA0 = ATT_MFMA(kf[2 * d0], qr[d0], pA0); pA1 = ATT_MFMA(kf[2 * d0 + 1], qr[d0], pA1); }
    CMASK(pA0, pA1, 0);
    { const float rm = rowmax(pA0, pA1) - ATT_REF_OFF; mhat = rm;
#pragma unroll
      for (int r = 0; r < 16; ++r) { pA0[r] -= rm; pA1[r] -= rm; negm[r] = -rm; }
      asm volatile("" : "+v"(negm));
#pragma unroll
      for (int r = 0; r < 16; ++r) { pA0[r] = fast_exp2(pA0[r]); pA1[r] = fast_exp2(pA1[r]); } }
    ATT_WAIT_BAR(0);
    DMA_K(3, 0); DMA_V(1, 1);
    ROT();
#pragma unroll
    for (int j = 0; j < 4; ++j) kload2(kf, kp0 + sl_cur * KSLOT, j);
    ATT_WAIT_BAR(2);
    i32x8 vf[4], pf;
#define PK4(P, B) cvt_pk4_fp8(P[B], P[(B) + 1], P[(B) + 2], P[(B) + 3])
#define PIN(x) asm volatile("" : "+v"(x))
#define GAPA(MF, P, B, W) do { MF; sacc += P[B]; sacc += P[(B) + 1]; sacc += P[(B) + 2]; sacc += P[(B) + 3]; PIN(sacc); pf[W] = PK4(P, B); PIN(pf); ATT_SBAR(); } while (0)
#define EXP8(X, B) do { X[B] = fast_exp2(X[B]); X[(B) + 1] = fast_exp2(X[(B) + 1]); X[(B) + 2] = fast_exp2(X[(B) + 2]); X[(B) + 3] = fast_exp2(X[(B) + 3]); \
        X[(B) + 4] = fast_exp2(X[(B) + 4]); X[(B) + 5] = fast_exp2(X[(B) + 5]); X[(B) + 6] = fast_exp2(X[(B) + 6]); X[(B) + 7] = fast_exp2(X[(B) + 7]); PIN(X); } while (0)
#define STEP(C0, C1, P0, P1, t, GK, GV, GL) do { ATT_SBAR(); \
    const LAS char* vp_ = vp0 + sl_prev * VSLOT; \
    float sacc = 0.f; \
    bf16x8 qa_ = qlds[0], qb_ = qlds[64]; ATT_SBAR(); \
    GAPA(C0 = ATT_MFMA(kf[0], qa_, negm), P0, 0, 0); \
    GAPA(C1 = ATT_MFMA(kf[1], qa_, negm), P0, 4, 1); \
    qa_ = qlds[128]; ATT_SBAR(); \
    GAPA(C0 = ATT_MFMA(kf[2], qb_, C0), P0, 8, 2); \
    GAPA(C1 = ATT_MFMA(kf[3], qb_, C1), P0, 12, 3); \
    qb_ = qlds[192]; ATT_SBAR(); \
    vf[0] = frag32(vp_, vc0); ATT_SBAR(); GAPA(C0 = ATT_MFMA(kf[4], qa_, C0), P1, 0, 4); \
    vf[1] = frag32(vp_ + 32 * 64, vc0); ATT_SBAR(); GAPA(C1 = ATT_MFMA(kf[5], qa_, C1), P1, 4, 5); \
    vf[2] = frag32(vp_ + 64 * 64, vc0); ATT_SBAR(); GAPA(C0 = ATT_MFMA(kf[6], qb_, C0), P1, 8, 6); \
    vf[3] = frag32(vp_ + 96 * 64, vc0); ATT_SBAR(); GAPA(C1 = ATT_MFMA(kf[7], qb_, C1), P1, 12, 7); \
    l_reg += sacc; \
    if (GK) { DMA_K((t) + 3, sl_cur); } if (GV) { DMA_V((t) + 1, sl_next); } \
    CMASK(C0, C1, t); \
    {   \
      float st_; { auto rr = __builtin_amdgcn_permlane32_swap(__float_as_uint(sacc), __float_as_uint(sacc), false, false); st_ = __uint_as_float(rr[0]) + __uint_as_float(rr[1]); } \
      resc = false; \
      if (__builtin_expect(__any(st_ > ATT_RESC_THR), 0)) { const float dl = (st_ > ATT_RESC_MIN) ? __builtin_fmaxf(__builtin_floorf(__builtin_amdgcn_logf(st_)) - 6.f, ATT_RESC_LO) : 0.f; mhat += dl; \
        _Pragma("unroll") for (int r = 0; r < 16; ++r) { asm volatile("v_sub_f32 %0, %0, %1" : "+v"(C0[r]) : "v"(dl)); asm volatile("v_sub_f32 %0, %0, %1" : "+v"(C1[r]) : "v"(dl)); } \
        _Pragma("unroll") for (int r = 0; r < 16; ++r) negm[r] = -mhat; asm volatile("" : "+v"(negm)); \
        const float f = fast_exp2(-dl); l_reg *= f; if (hi == 0) wsf[r32] = f; resc = true; } } \
    ATT_SBAR(); \
    MFMA8_PV(o[0], pf, vf[0]); EXP8(C0, 0); if (GL) { kload2(kf, kp0 + sl_next * KSLOT, 0); } ATT_SBAR(); \
    MFMA8_PV(o[1], pf, vf[1]); EXP8(C0, 8); if (GL) { kload2(kf, kp0 + sl_next * KSLOT, 1); } ATT_SBAR(); \
    MFMA8_PV(o[2], pf, vf[2]); EXP8(C1, 0); if (GL) { kload2(kf, kp0 + sl_next * KSLOT, 2); } ATT_SBAR(); \
    MFMA8_PV(o[3], pf, vf[3]); EXP8(C1, 8); if (GL) { kload2(kf, kp0 + sl_next * KSLOT, 3); } ATT_SBAR(); \
    } while (0)
    int t = 1;
#undef CMASK
#define CMASK(P0, P1, t) do {} while (0)
    for (; t + 5 < NT; t += 2) {
        STEP(pB0, pB1, pA0, pA1, t, true, true, true);       if (MODE == 3) { asm volatile("s_waitcnt lgkmcnt(0)" ::: "memory"); } else { ATT_WAIT_BAR(2); } RESC(); ROT();
        STEP(pA0, pA1, pB0, pB1, t + 1, true, true, true);   if (MODE == 3) { asm volatile("s_waitcnt lgkmcnt(0)" ::: "memory"); } else { ATT_WAIT_BAR(2); } RESC(); ROT();
    }
#undef CMASK
#define CMASK(P0, P1, t) do { const int jb_ = (t) - (NT - 4); if (jb_ >= 0) cmask(P0, P1, jb_, qrel, hi); } while (0)
#define ENDW(tt) do { if ((tt) + 3 < NT) { ATT_WAIT_BAR(2); } else if ((tt) + 2 < NT) { ATT_WAIT_BAR(1); } else { ATT_WAIT_BAR(0); } } while (0)
    for (; t + 1 < NT; t += 2) {
        STEP(pB0, pB1, pA0, pA1, t, (t + 3 < NT), (t + 1 < NT), (t + 1 < NT));       ENDW(t);     RESC(); ROT();
        STEP(pA0, pA1, pB0, pB1, t + 1, (t + 4 < NT), (t + 2 < NT), (t + 2 < NT));   ENDW(t + 1); RESC(); ROT();
    }
    STEP(pB0, pB1, pA0, pA1, NT - 1, false, false, false); RESC();
    { float sacc = 0.f;
#pragma unroll
      for (int r = 0; r < 16; ++r) sacc += pB0[r] + pB1[r];
      l_reg += sacc;
      pf[0] = PK4(pB0, 0); pf[1] = PK4(pB0, 4); pf[2] = PK4(pB0, 8); pf[3] = PK4(pB0, 12); pf[4] = PK4(pB1, 0); pf[5] = PK4(pB1, 4); pf[6] = PK4(pB1, 8); pf[7] = PK4(pB1, 12);
      const LAS char* vp_ = vp0 + sl_cur * VSLOT;
      vf[0] = frag32(vp_, vc0); vf[1] = frag32(vp_ + 32 * 64, vc0); vf[2] = frag32(vp_ + 64 * 64, vc0); vf[3] = frag32(vp_ + 96 * 64, vc0);
      asm volatile("s_nop 3" : "+v"(pf));
      MFMA8_PV(o[0], pf, vf[0]); MFMA8_PV(o[1], pf, vf[1]); MFMA8_PV(o[2], pf, vf[2]); MFMA8_PV(o[3], pf, vf[3]);
      asm volatile("s_nop 15\n\ts_nop 15\n\ts_nop 7" : "+v"(o[0]), "+v"(o[1]), "+v"(o[2]), "+v"(o[3])); }
#undef PK4
#undef PIN
#undef GAPA
#undef EXP8
#undef STEP
#undef ENDW
#undef CMASK
#undef RESC
#undef ROT
    { auto rr = __builtin_amdgcn_permlane32_swap(__float_as_uint(l_reg), __float_as_uint(l_reg), false, false); l_reg = __uint_as_float(rr[0]) + __uint_as_float(rr[1]); }
    if (hi == 0) wsf[32 + r32] = l_reg;
    asm volatile("s_waitcnt lgkmcnt(0)" ::: "memory");
#pragma unroll
    for (int r = 0; r < 16; ++r) { const float rl = fast_rcp(wsf[32 + crow(r, hi)]);
#pragma unroll
        for (int d0 = 0; d0 < 4; ++d0) o[d0][r] *= rl; }
    asm volatile("s_waitcnt lgkmcnt(0)" ::: "memory");
#undef DMA_K
#undef DMA_V
}

constexpr int KSLOT8 = 4096, QP8 = 256  ;
constexpr int L_V8 = NSLOT * KSLOT8, L_WS8 = L_V8 + NSLOT * VSLOT;
static_assert(L_WS8 + NWAVES * 256 <= L_OST, "fp8 pass LDS");
#define MFMA8_QK(C, A, B) asm volatile("v_mfma_scale_f32_32x32x64_f8f6f4 %0, %1, %2, %3, %4, %5 op_sel_hi:[0,0,0]" : "=&v"(C) : "v"(A), "v"(B), "v"(negm), "v"(sc_k), "v"(sc_q))
#define MFMA8_PV8(O, A, B) asm volatile("v_mfma_scale_f32_32x32x64_f8f6f4 %0, %1, %2, %0, %3, %3 op_sel_hi:[0,0,0]" : "+v"(O) : "v"(A), "v"(B), "v"(sc_k))
template <int MODE> __device__ __forceinline__ void attn_pass8(f32x16 (&o)[4], int b, int hm, int h, int qb, const unsigned char* Q8, const unsigned char* __restrict__ K8, const unsigned char* __restrict__ V8T, LAS char* shm) {
    const int tid = opaque_tid(), lane = tid & 63, r32 = lane & 31, hi = lane >> 5; const int wid = __builtin_amdgcn_readfirstlane(tid >> 6);
    const long rowbase = (long)b * SEQ; const int q0 = qb * QB, NT = (q0 + QB) / KVB;
    const unsigned lds0 = (unsigned)(uintptr_t)shm;
    LAS float* wsf = (LAS float*)(shm + L_WS8) + wid * 64;
    const int kkey = (wid & 3) * 16 + (lane >> 2);
    const unsigned char* ksrc = K8 + (rowbase + kkey) * QP8 + h * 64 + (((lane & 3) ^ ((kkey >> 2) & 3)) * 16);
    const unsigned char* vsrc = V8T + ((size_t)(b * 4 + h) * (SEQ / KVB)) * VSLOT + wid * 1024 + lane * 16;
    const unsigned kdst = lds0 + L_K + (wid & 3) * 1024, vdst = lds0 + L_V8 + wid * 1024;
#define DMA_K(t, s) glds16(ksrc + (long)(t) * KVB * QP8, (unsigned)__builtin_amdgcn_readfirstlane(kdst + (unsigned)(s) * KSLOT8))
#define DMA_V(t, s) glds16(vsrc + (long)(t) * VSLOT, (unsigned)__builtin_amdgcn_readfirstlane(vdst + (unsigned)(s) * VSLOT))
    const int sw = (r32 >> 2) & 3;
    const LAS char* kp0 = shm + L_K + r32 * 64;  const int kc0 = (2 * hi) ^ sw;
    const LAS char* vp0 = shm + L_V8 + r32 * 64;  const int vc0 = (2 * hi) ^ sw;
    DMA_K(0, 0); DMA_V(0, 0); DMA_K(1, 1);
    i32x8 qf;
    { const unsigned char* qp = Q8 + (rowbase + q0 + wid * 32 + r32) * QP8 + h * 64 + hi * 32; const i32x4 lo = *(const i32x4*)qp, hi4 = *(const i32x4*)(qp + 16); qf = __builtin_shufflevector(lo, hi4, 0, 1, 2, 3, 4, 5, 6, 7); }
    float mhat = 0.f;
    f32x16 ol;
    float zf = 0.f; asm volatile("" : "+v"(zf));
    int sc_k = 0x7f7f7f7f, sc_q = 0x7c7c7c7c; asm volatile("" : "+v"(sc_k), "+v"(sc_q));
    f32x16 negm;
#pragma unroll
    for (int r = 0; r < 16; ++r) { negm[r] = zf;
#pragma unroll
        for (int d0 = 0; d0 < 4; ++d0) o[d0][r] = zf;
        ol[r] = zf; }
    i32x8 ones8; { int o1 = 0x38383838; asm volatile("" : "+v"(o1)); ones8 = (i32x8){o1, o1, o1, o1, o1, o1, o1, o1}; }
    asm volatile("" : "+v"(negm));
    const int qrel = wid * 32 + r32;
    asm volatile("" : "+v"(qf));
    DMA_K(2, 2);
    ATT_WAIT_BAR(1);
    bool resc = false;
#define CMASK(P0, P1, t) do { const int jb_ = (t) - (NT - 4); if (jb_ >= 0) cmask(P0, P1, jb_, qrel, hi); } while (0)
#define RESC() do { if (resc) { asm volatile("s_waitcnt lgkmcnt(0)\n\ts_nop 15\n\ts_nop 7" ::: "memory"); \
        _Pragma("unroll") for (int r = 0; r < 16; ++r) { const float fr_ = wsf[crow(r, hi)]; _Pragma("unroll") for (int d_ = 0; d_ < 4; ++d_) asm volatile("v_mul_f32 %0, %0, %1" : "+v"(o[d_][r]) : "v"(fr_)); asm volatile("v_mul_f32 %0, %0, %1" : "+v"(ol[r]) : "v"(fr_)); } } } while (0)
    f32x16 pA0, pA1, pB0, pB1;
    int sl_prev = 0, sl_cur = 0, sl_next = 1;
#define ROT() do { sl_prev = sl_cur; sl_cur = sl_next; sl_next = (sl_next == NSLOT - 1) ? 0 : sl_next + 1; } while (0)
    i32x8 kf0, kf1;
    kf0 = frag32(kp0, kc0); kf1 = frag32(kp0 + 32 * 64, kc0);
    MFMA8_QK(pA0, kf0, qf); MFMA8_QK(pA1, kf1, qf);
    asm volatile("s_nop 15\n\ts_nop 15\n\ts_nop 7" : "+v"(pA0), "+v"(pA1));
    CMASK(pA0, pA1, 0);
    { const float rm = rowmax(pA0, pA1) - ATT_REF_OFF; mhat = rm;
#pragma unroll
      for (int r = 0; r < 16; ++r) { pA0[r] -= rm; pA1[r] -= rm; negm[r] = -rm; }
      asm volatile("" : "+v"(negm));
#pragma unroll
      for (int r = 0; r < 16; ++r) { pA0[r] = fast_exp2(pA0[r]); pA1[r] = fast_exp2(pA1[r]); } }
    ATT_WAIT_BAR(0);
    DMA_K(3, 0); DMA_V(1, 1);
    ROT();
    kf0 = frag32(kp0 + sl_cur * KSLOT8, kc0); kf1 = frag32(kp0 + sl_cur * KSLOT8 + 32 * 64, kc0);
    ATT_WAIT_BAR(2);
    i32x8 vf[4], pf;
#define PK4(P, B) cvt_pk4_fp8(P[B], P[(B) + 1], P[(B) + 2], P[(B) + 3])
#define PIN(x) asm volatile("" : "+v"(x))
#define SUM8(P, B) do { sacc += P[B]; sacc += P[(B) + 1]; sacc += P[(B) + 2]; sacc += P[(B) + 3]; sacc += P[(B) + 4]; sacc += P[(B) + 5]; sacc += P[(B) + 6]; sacc += P[(B) + 7]; PIN(sacc); } while (0)
#define EXP8(X, B) do { X[B] = fast_exp2(X[B]); X[(B) + 1] = fast_exp2(X[(B) + 1]); X[(B) + 2] = fast_exp2(X[(B) + 2]); X[(B) + 3] = fast_exp2(X[(B) + 3]); \
        X[(B) + 4] = fast_exp2(X[(B) + 4]); X[(B) + 5] = fast_exp2(X[(B) + 5]); X[(B) + 6] = fast_exp2(X[(B) + 6]); X[(B) + 7] = fast_exp2(X[(B) + 7]); PIN(X); } while (0)
#define STEP(C0, C1, P0, P1, t, GK, GV, GL) do { ATT_SBAR(); \
    const LAS char* vp_ = vp0 + sl_prev * VSLOT; \
    const bool det_ = (((t) & 3) == 1);            \
    float sacc = 0.f; \
    MFMA8_QK(C0, kf0, qf); \
    if (det_) { SUM8(P0, 0); SUM8(P0, 8); } \
    pf[0] = PK4(P0, 0); pf[1] = PK4(P0, 4); pf[2] = PK4(P0, 8); pf[3] = PK4(P0, 12); PIN(pf); \
    vf[0] = frag32(vp_, vc0); vf[1] = frag32(vp_ + 32 * 64, vc0); ATT_SBAR(); \
    MFMA8_QK(C1, kf1, qf); \
    if (det_) { SUM8(P1, 0); SUM8(P1, 8); } \
    pf[4] = PK4(P1, 0); pf[5] = PK4(P1, 4); pf[6] = PK4(P1, 8); pf[7] = PK4(P1, 12); PIN(pf); \
    vf[2] = frag32(vp_ + 64 * 64, vc0); vf[3] = frag32(vp_ + 96 * 64, vc0); ATT_SBAR(); \
    if (GK) { DMA_K((t) + 3, sl_cur); } if (GV) { DMA_V((t) + 1, sl_next); } \
    {   \
      float st_; { auto rr = __builtin_amdgcn_permlane32_swap(__float_as_uint(sacc), __float_as_uint(sacc), false, false); st_ = __uint_as_float(rr[0]) + __uint_as_float(rr[1]); } \
      resc = false; \
      if (__builtin_expect(det_ && __any(st_ > ATT_RESC_THR), 0)) { const float dl = (st_ > ATT_RESC_MIN) ? __builtin_fmaxf(__builtin_floorf(__builtin_amdgcn_logf(st_)) - 6.f, ATT_RESC_LO) : 0.f; mhat += dl; \
        asm volatile("s_nop 15\n\ts_nop 15" ::: "memory"); \
        _Pragma("unroll") for (int r = 0; r < 16; ++r) { asm volatile("v_sub_f32 %0, %0, %1" : "+v"(C0[r]) : "v"(dl)); asm volatile("v_sub_f32 %0, %0, %1" : "+v"(C1[r]) : "v"(dl)); } \
        _Pragma("unroll") for (int r = 0; r < 16; ++r) negm[r] = -mhat; asm volatile("" : "+v"(negm)); \
        const float f = fast_exp2(-dl); if (hi == 0) wsf[r32] = f; resc = true; } } \
    asm volatile("s_nop 7" : "+v"(C0), "+v"(C1)); CMASK(C0, C1, t); \
    ATT_SBAR(); \
    MFMA8_PV8(o[0], pf, vf[0]); EXP8(C0, 0); if (GL) kf0 = frag32(kp0 + sl_next * KSLOT8, kc0); ATT_SBAR(); \
    MFMA8_PV8(o[1], pf, vf[1]); EXP8(C0, 8); ATT_SBAR(); \
    MFMA8_PV8(o[2], pf, vf[2]); EXP8(C1, 0); if (GL) kf1 = frag32(kp0 + sl_next * KSLOT8 + 32 * 64, kc0); ATT_SBAR(); \
    MFMA8_PV8(o[3], pf, vf[3]); EXP8(C1, 8); ATT_SBAR(); \
    MFMA8_PV8(ol, pf, ones8); ATT_SBAR(); \
    } while (0)
    int t = 1;
#undef CMASK
#define CMASK(P0, P1, t) do {} while (0)
    for (; t + 5 < NT; t += 2) {
        STEP(pB0, pB1, pA0, pA1, t, true, true, true);       ATT_WAIT_BAR(2); RESC(); ROT();
        STEP(pA0, pA1, pB0, pB1, t + 1, true, true, true);   ATT_WAIT_BAR(2); RESC(); ROT();
    }
#undef CMASK
#define CMASK(P0, P1, t) do { const int jb_ = (t) - (NT - 4); if (jb_ >= 0) cmask(P0, P1, jb_, qrel, hi); } while (0)
#define ENDW(tt) do { if ((tt) + 3 < NT) { ATT_WAIT_BAR(2); } else if ((tt) + 2 < NT) { ATT_WAIT_BAR(1); } else { ATT_WAIT_BAR(0); } } while (0)
    for (; t + 1 < NT; t += 2) {
        STEP(pB0, pB1, pA0, pA1, t, (t + 3 < NT), (t + 1 < NT), (t + 1 < NT));       ENDW(t);     RESC(); ROT();
        STEP(pA0, pA1, pB0, pB1, t + 1, (t + 4 < NT), (t + 2 < NT), (t + 2 < NT));   ENDW(t + 1); RESC(); ROT();
    }
    STEP(pB0, pB1, pA0, pA1, NT - 1, false, false, false); RESC();
    {
      pf[0] = PK4(pB0, 0); pf[1] = PK4(pB0, 4); pf[2] = PK4(pB0, 8); pf[3] = PK4(pB0, 12); pf[4] = PK4(pB1, 0); pf[5] = PK4(pB1, 4); pf[6] = PK4(pB1, 8); pf[7] = PK4(pB1, 12);
      const LAS char* vp_ = vp0 + sl_cur * VSLOT;
      vf[0] = frag32(vp_, vc0); vf[1] = frag32(vp_ + 32 * 64, vc0); vf[2] = frag32(vp_ + 64 * 64, vc0); vf[3] = frag32(vp_ + 96 * 64, vc0);
      asm volatile("s_nop 3" : "+v"(pf));
      MFMA8_PV8(o[0], pf, vf[0]); MFMA8_PV8(o[1], pf, vf[1]); MFMA8_PV8(o[2], pf, vf[2]); MFMA8_PV8(o[3], pf, vf[3]); MFMA8_PV8(ol, pf, ones8);
      asm volatile("s_nop 15\n\ts_nop 15\n\ts_nop 7" : "+v"(o[0]), "+v"(o[1]), "+v"(o[2]), "+v"(o[3]), "+v"(ol)); }
#undef PK4
#undef PIN
#undef SUM8
#undef EXP8
#undef STEP
#undef ENDW
#undef CMASK
#undef RESC
#undef ROT
#pragma unroll
    for (int r = 0; r < 16; ++r) { const float rl = fast_rcp(ol[r]);
#pragma unroll
        for (int d0 = 0; d0 < 4; ++d0) o[d0][r] *= rl; }
#undef DMA_K
#undef DMA_V
}

template <int MODE> __device__ __forceinline__ void attn_unit(int b, int h, int qb, const bf16_t* Q, const bf16_t* K, const unsigned char* Q8, const unsigned char* K8, const unsigned char* V, bf16_t* YAB, float* park, float lam, const float* subg, LAS char* shm) {
    const int tid = opaque_tid(), lane = tid & 63, r32 = lane & 31, hi = lane >> 5; const int wid = __builtin_amdgcn_readfirstlane(tid >> 6);
    for (int m = 0; m < 2; ++m) {
        f32x16 o[4];
        if (m == 0) attn_pass<MODE>(o, b, 2 * h, h, qb, Q, K, V, shm);
        else attn_pass8<MODE>(o, b, 2 * h + 1, h, qb, Q8, K8, V, shm);
        int lo_ = lane; asm volatile("" : "+v"(lo_));
        f32x4* pk = (f32x4*)park + (size_t)wid * 1024 + lo_;
        if (m == 0) {
#pragma unroll
            for (int d0 = 0; d0 < 4; ++d0)
#pragma unroll
                for (int j = 0; j < 4; ++j) pk[(d0 * 4 + j) * 64] = (f32x4){o[d0][4 * j], o[d0][4 * j + 1], o[d0][4 * j + 2], o[d0][4 * j + 3]};
        } else {
            float ss[16];
#pragma unroll
            for (int r = 0; r < 16; ++r) ss[r] = 0.f;
            f32x4 pa[16];
#pragma unroll
            for (int i = 0; i < 16; ++i) pa[i] = pk[i * 64];
#pragma unroll
            for (int i = 0; i < 16; i += 4) asm volatile("" : "+v"(pa[i]), "+v"(pa[i + 1]), "+v"(pa[i + 2]), "+v"(pa[i + 3]));
#pragma unroll
            for (int d0 = 0; d0 < 4; ++d0)
#pragma unroll
                for (int j = 0; j < 4; ++j) { const f32x4 a = pa[d0 * 4 + j];
#pragma unroll
                    for (int e = 0; e < 4; ++e) { const float v = a[e] - lam * o[d0][4 * j + e]; o[d0][4 * j + e] = v; ss[4 * j + e] += v * v; } }
#pragma unroll
            for (int r = 0; r < 16; ++r) { float s = ss[r]; s += __shfl_xor(s, 1); s += __shfl_xor(s, 2); s += __shfl_xor(s, 4); s += __shfl_xor(s, 8); s += __shfl_xor(s, 16); ss[r] = 0.8f / sqrtf(s * (1.0f / 128.0f) + EPS); }
            float gd[4];
#pragma unroll
            for (int d0 = 0; d0 < 4; ++d0) gd[d0] = subg[d0 * 32 + r32];
            LAS bf16_t* stg = (LAS bf16_t*)(shm + L_OST) + wid * 4096;
#pragma unroll
            for (int r = 0; r < 16; ++r) { const int orow = crow(r, hi);
#pragma unroll
                for (int d0 = 0; d0 < 4; ++d0) { float y = o[d0][r] * ss[r] * gd[d0];
#if PROBE_PHASE == 51
                    if (!(__builtin_fabsf(y) < 1e30f)) y = 0.f;
#endif
                    stg[orow * 128 + d0 * 32 + r32] = (bf16_t)(cvt_pk_bf16(y, 0.f) & 0xffffu); } }
            asm volatile("s_waitcnt lgkmcnt(0)" ::: "memory");
            bf16_t* Ow = YAB + ((long)b * SEQ + qb * QB + wid * 32) * 1024 + 512 + h * 128;
#pragma unroll
            for (int i = 0; i < 8; ++i) { const int row = i * 4 + (lo_ >> 4), ch = lo_ & 15; const u32x4 v = *(const LAS u32x4*)(stg + row * 128 + ch * 8); *(u32x4*)(Ow + (long)row * 1024 + ch * 8) = v; }
        }
        asm volatile("s_waitcnt lgkmcnt(0)\n\ts_barrier" ::: "memory");
    }
}
#undef ATT_WAIT_BAR
#undef MX3
#undef ATT_SBAR
#undef ATT_MFMA
#undef MFMA8_PV
#undef MFMA8_QK
#undef MFMA8_PV8
}

#define XB_TMO      128
#define XB_XCNT(j)  (256  + 64 * (j))
#define XB_XSUB(j)  (1280 + 64 * (j))
#define XB_XGEN(j)  (2304 + 64 * (j))
#define XB_TOP      3328
#define XB_TOPGEN   3392
#define XCD_BAR_WORDS 3456
#define XB_SPIN_CAP (1u << 18)
__device__ __forceinline__ unsigned xb_ld(unsigned* p)              { return __hip_atomic_load(p, __ATOMIC_RELAXED, __HIP_MEMORY_SCOPE_AGENT); }
__device__ __forceinline__ unsigned xb_add(unsigned* p, unsigned v) { return __hip_atomic_fetch_add(p, v, __ATOMIC_RELAXED, __HIP_MEMORY_SCOPE_AGENT); }
__device__ __forceinline__ unsigned xb_xcc_id() { return (unsigned)__builtin_amdgcn_s_getreg((3 << 11) | 20) & 0xFu; }
#define XB_SPIN(cond, bar) do { unsigned _sp = 0; while (cond) { __builtin_amdgcn_s_sleep(1); \
    if ((++_sp & 255u) == 0u) { if (xb_ld(&(bar)[XB_TMO])) break; if (_sp > XB_SPIN_CAP) { atomicAdd(&(bar)[XB_TMO], 1u); break; } } } } while (0)
struct XcdBarrier { unsigned* bar; unsigned x; volatile LAS unsigned* st; };
__device__ __forceinline__ XcdBarrier xcd_barrier_post(unsigned* bar, volatile LAS unsigned* st) {
    XcdBarrier b; b.bar = bar; b.x = xb_xcc_id(); b.st = st;
    if (threadIdx.x == 0) (void)xb_add(&bar[XB_XCNT(b.x)], 1u);
    return b;
}
__device__ __forceinline__ void xcd_barrier_complete(unsigned* bar, unsigned x, unsigned& nloc, unsigned& nx) {
    const unsigned G = gridDim.x * gridDim.y * gridDim.z;
    unsigned sum, cnt, mine, sp = 0u;
    for (;;) {
        sum = 0u; cnt = 0u; mine = 0u;
#pragma unroll
        for (unsigned j = 0; j < 16; ++j) { const unsigned c = xb_ld(&bar[XB_XCNT(j)]); sum += c; cnt += (c > 0u) ? 1u : 0u; mine = (j == x) ? c : mine; }
        if (sum == G) break;
        __builtin_amdgcn_s_sleep(1);
        if ((++sp & 255u) == 0u) { if (xb_ld(&bar[XB_TMO])) break; if (sp > XB_SPIN_CAP) { atomicAdd(&bar[XB_TMO], 1u); break; } }
    }
    nloc = mine > 0u ? mine : 1u; nx = cnt > 0u ? cnt : 1u;
}
__device__ __forceinline__ void xcd_barrier(const XcdBarrier& b) {
    asm volatile("s_waitcnt vmcnt(0)" ::: "memory");
    __syncthreads();
    if (threadIdx.x == 0) {
        unsigned* bar = b.bar;
        __builtin_amdgcn_s_waitcnt(0);
        unsigned nloc = b.st[0], nx = b.st[1];
        if (nloc == 0u) { xcd_barrier_complete(bar, b.x, nloc, nx); b.st[0] = nloc; b.st[1] = nx; }
        const unsigned old = xb_add(&bar[XB_XSUB(b.x)], 1u);
        const unsigned gen = old / nloc;
        if (old + 1u == (gen + 1u) * nloc) {
            __builtin_amdgcn_fence(__ATOMIC_RELEASE, "agent");
            asm volatile("s_waitcnt vmcnt(0)" ::: "memory");
            const unsigned og = xb_add(&bar[XB_TOP], 1u);
            const unsigned tg = og / nx;
            if (og + 1u == (tg + 1u) * nx) xb_add(&bar[XB_TOPGEN], 1u);
            else XB_SPIN(xb_ld(&bar[XB_TOPGEN]) == tg, bar);
            __builtin_amdgcn_fence(__ATOMIC_ACQUIRE, "agent");
            xb_add(&bar[XB_XGEN(b.x)], 1u);
            asm volatile("s_waitcnt vmcnt(0)" ::: "memory");
        } else {
            XB_SPIN(xb_ld(&bar[XB_XGEN(b.x)]) == gen, bar);
            __builtin_amdgcn_fence(__ATOMIC_ACQUIRE, "agent");
            asm volatile("s_waitcnt vmcnt(0)" ::: "memory");
        }
    }
    __syncthreads();
}

#define GRID_BAR() xcd_barrier(bar)

__device__ __forceinline__ void phase_stagger(int cls, unsigned ticks) {
    const unsigned long long t0 = __builtin_amdgcn_s_memrealtime(); const unsigned long long want = (unsigned long long)cls * ticks;
    while (__builtin_amdgcn_s_memrealtime() - t0 < want) __builtin_amdgcn_s_sleep(8);
}

struct Args {
    const float* x; const int* pos; const float* norm_mix_g; const float* w_in; const float* gm_ln_g; const float* gm_ln_b; const float* gm_w_s; const float* gm_b_s;
    const float* lam_q1; const float* lam_k1; const float* lam_q2; const float* lam_k2; const float* subln_g; const float* w_br_a; const float* w_br_b; const float* w_out;
    const float* norm_ffn_g; const float* w_rg; const float* b_rg; const float* w_re; const float* b_re; const float* w_gate; const float* w_up; const float* w_down; const float* final_g;
    float* out; unsigned char* ws;
};

__device__ __forceinline__ int wrow_map(int rmode, int n) { return rmode == 0 ? n : rmode == 1 ? ((n >> 5) * 128 + (n & 31)) : (((n >> 3) & 1) * 128 + (n >> 4) * 8 + (n & 7)); }
__device__ __forceinline__ void transpose_item(const float* W, int ldw, int k0, int n0, bf16_t* WT, int ldt, int drow0, int dk0, const float* gk, LAS float* scr, int lane, float sc = 1.0f, int rmode = 0) {
    f32x4 v[16];
    const int kr = lane >> 4, nc = (lane & 15) * 4;
#pragma unroll
    for (int i = 0; i < 16; ++i) v[i] = *(const f32x4*)(W + (size_t)(k0 + 4 * i + kr) * ldw + n0 + nc);
    if (gk) {
#pragma unroll
        for (int i = 0; i < 16; ++i) v[i] = v[i] * gk[k0 + 4 * i + kr];
    }
    if (sc != 1.0f) {
#pragma unroll
        for (int i = 0; i < 16; ++i) v[i] = v[i] * sc;
    }
#pragma unroll
    for (int i = 0; i < 16; ++i) { LAS float* d = scr + (4 * i + kr) * 65 + nc; d[0] = v[i][0]; d[1] = v[i][1]; d[2] = v[i][2]; d[3] = v[i][3]; }
    LDS_WAIT(); asm volatile("" ::: "memory");
    const int c = lane & 7;
#pragma unroll
    for (int j = 0; j < 8; ++j) { const int n = (lane >> 3) + 8 * j; const LAS float* s = scr + (8 * c) * 65 + n;
        u32x4 o; o.x = cvt_pk_bf16(s[0 * 65], s[1 * 65]); o.y = cvt_pk_bf16(s[2 * 65], s[3 * 65]); o.z = cvt_pk_bf16(s[4 * 65], s[5 * 65]); o.w = cvt_pk_bf16(s[6 * 65], s[7 * 65]);
        *(u32x4*)(WT + (size_t)(drow0 + wrow_map(rmode, n)) * ldt + dk0 + k0 + 8 * c) = o; }
    LDS_WAIT(); asm volatile("" ::: "memory");
}
__device__ __forceinline__ void transpose_item8(const float* W, int ldw, int k0, int n0, unsigned char* WT, int ldt, int drow0, const float* gk, float sc, LAS float* scr, int lane, int rmode = 0) {
    f32x4 v[16];
    const int kr = lane >> 4, nc = (lane & 15) * 4;
#pragma unroll
    for (int i = 0; i < 16; ++i) v[i] = *(const f32x4*)(W + (size_t)(k0 + 4 * i + kr) * ldw + n0 + nc);
    float gs[16];
    if (gk) {
#pragma unroll
        for (int i = 0; i < 16; ++i) gs[i] = gk[k0 + 4 * i + kr];
#pragma unroll
        for (int i = 0; i < 16; ++i) gs[i] *= sc;
    } else {
#pragma unroll
        for (int i = 0; i < 16; ++i) gs[i] = sc;
    }
#pragma unroll
    for (int i = 0; i < 16; ++i) v[i] = v[i] * gs[i];
#pragma unroll
    for (int i = 0; i < 16; ++i) { LAS float* d = scr + (4 * i + kr) * 65 + nc; d[0] = v[i][0]; d[1] = v[i][1]; d[2] = v[i][2]; d[3] = v[i][3]; }
    LDS_WAIT(); asm volatile("" ::: "memory");
    const int c = lane & 7;
#pragma unroll
    for (int j = 0; j < 8; ++j) { const int n = (lane >> 3) + 8 * j; const LAS float* s = scr + (8 * c) * 65 + n;
        u32x2 o; o.x = cvt_pk4_fp8(s[0 * 65], s[1 * 65], s[2 * 65], s[3 * 65]); o.y = cvt_pk4_fp8(s[4 * 65], s[5 * 65], s[6 * 65], s[7 * 65]);
        *(u32x2*)(WT + (size_t)(drow0 + wrow_map(rmode, n)) * ldt + k0 + 8 * c) = o; }
    LDS_WAIT(); asm volatile("" ::: "memory");
}
__device__ __forceinline__ void expert_item(int r, const float* w_gate, const float* w_up, const float* w_down, const float* gffn, unsigned char* W13, unsigned char* W2, LAS float* scr, int lane) {
    constexpr int I_G = 32 * 128;
    if (r < 2 * I_G) { const int up = r >= I_G; if (up) r -= I_G; const int e = r / 128, q = r % 128, kb = q / 8, nb = q % 8;
        const int n0 = 64 * nb, drow = e * 1024 + (n0 >> 7) * 256 + up * 128 + (n0 & 127);
        transpose_item8((up ? w_up : w_gate) + (size_t)e * 1024 * 512, 512, 64 * kb, n0, W13, 1024, drow, gffn, 64.f, scr, lane); return; }
    r -= 2 * I_G;
    { const int e = r / 128, q = r % 128, kb = q / 16, nb = q % 16;
        transpose_item8(w_down + (size_t)e * 512 * 1024, 1024, 64 * kb, 64 * nb, W2, 512, e * 1024 + (nb >> 2) * 256 + (nb & 3) * 32, nullptr, 32.f, scr, lane, 2); }
}
__device__ __forceinline__ void rms_row_to_bf16(const float* xrow, const float* g, bf16_t* orow, int lane) {
    const f32x4* xr = (const f32x4*)xrow + lane; const f32x4* gr = (const f32x4*)g + lane;
    f32x4 v[4]; float s = 0.f;
#pragma unroll
    for (int j = 0; j < 4; ++j) { v[j] = xr[64 * j]; s += (v[j].x * v[j].x + v[j].y * v[j].y) + (v[j].z * v[j].z + v[j].w * v[j].w); }
    const float rstd = 1.f / sqrtf(wave_sum(s) * (1.f / D) + EPS);
    u32x2* o8 = (u32x2*)orow + lane;
#pragma unroll
    for (int j = 0; j < 4; ++j) { const f32x4 gg = gr[64 * j]; u32x2 w; w.x = cvt_pk_bf16(v[j].x * rstd * gg.x, v[j].y * rstd * gg.y); w.y = cvt_pk_bf16(v[j].z * rstd * gg.z, v[j].w * rstd * gg.w); o8[64 * j] = w; }
}

__global__ void __launch_bounds__(NTHREADS, 2) fwd_kernel(Args a) {
    extern __shared__ __attribute__((aligned(16))) unsigned char lds_raw[];
    LAS unsigned char* lds = (LAS unsigned char*)lds_raw;
    volatile LAS unsigned* LCTL = (volatile LAS unsigned*)(lds + LDSCTL_OFF);
    const int tid0 = threadIdx.x;
    const int G = gridDim.x, bx = blockIdx.x;
    const int vcu = (G % 8 == 0) ? (bx % 8) * (G / 8) + bx / 8 : bx;
    unsigned char* ws = a.ws;
    unsigned* ctl = (unsigned*)(ws + WS_CTL);
    __builtin_amdgcn_s_setreg((23 << 6) | 1, 1);
    for (int u = tid0; u < (LDS_BYTES - LDSCTL_OFF) / 4; u += NTHREADS) LCTL[u] = 0u;
    __syncthreads();
    XcdBarrier bar = xcd_barrier_post(ctl + CW_BAR, LCTL);
    const int NGW = G * NWAVES;
#define PHASE_IDS() const int tid = opaque_tid(), lane = tid & 63, wave = __builtin_amdgcn_readfirstlane(tid >> 6), gw = vcu * NWAVES + wave; (void)lane; (void)gw

    bf16_t* WIN = (bf16_t*)(ws + WS_WIN); bf16_t* WBR = (bf16_t*)(ws + WS_WBR); bf16_t* WO = (bf16_t*)(ws + WS_WO); unsigned char* W13 = ws + WS_W13; unsigned char* W2 = ws + WS_W2;
    bf16_t* WRH = (bf16_t*)(ws + WS_WRH); bf16_t* WRL = (bf16_t*)(ws + WS_WRL); float* CS = (float*)(ws + WS_CS); float* SSQ = (float*)(ws + WS_SSQ); float* RSTD = (float*)(ws + WS_RSTD); float* WTS = (float*)(ws + WS_WTS);
    int* LIST = (int*)(ws + WS_LIST);
    float* PARK = (float*)(ws + WS_PARK);
    bf16_t* XN = (bf16_t*)(ws + WS_RA); bf16_t* YAB = (bf16_t*)(ws + WS_RA); unsigned char* YB8 = ws + WS_RA;
    bf16_t* UV = (bf16_t*)(ws + WS_RB); bf16_t* MG = (bf16_t*)(ws + WS_RB);
    bf16_t* Qb = (bf16_t*)(ws + WS_RC); bf16_t* Kb = Qb + (size_t)T * 512; bf16_t* XB = (bf16_t*)(ws + WS_RC); unsigned char* V8T = ws + WS_RE + 128 * MiB; unsigned char* Q8 = V8T + 32 * MiB; unsigned char* K8 = Q8 + 16 * MiB;
    bf16_t* Vb = (bf16_t*)(ws + WS_RD);
    unsigned char* G8 = ws + WS_RE; unsigned char* H8 = ws + WS_RE; unsigned char* XB8 = ws + WS_RD;

    for (int rep = 0; rep < REPS(0); ++rep) {
        PHASE_IDS();
        LAS float* scr = (LAS float*)(lds + wave * 16896);
#if LEVEL >= 1
        constexpr int I_IN = 16 * 72, I_BA = 8 * 16, I_BB = 8 * 16, I_O = 16 * 16;
        constexpr int NITEMS = I_IN + I_BA + I_BB + I_O;
        for (int it = gw; it < NITEMS; it += NGW) {
            int r = it;
            if (r < I_IN) { const int kb = r / 72, nb = r % 72; transpose_item(a.w_in, IN_COLS, 64 * kb, 64 * nb, WIN, 1024, (nb >> 2) * 256 + (nb & 3) * 32, 0, nullptr, scr, lane, (64 * nb >= 2560) ? -LOG2E : 1.0f, (64 * nb >= 2560) ? 2 : 1); continue; } r -= I_IN;
            if (r < I_BA) { const int kb = r / 16, nb = r % 16; transpose_item(a.w_br_a, 1024, 64 * kb, 64 * nb, WBR, 1024, (nb >> 2) * 256 + (nb & 3) * 32, 0, nullptr, scr, lane, 1.0f, 1); continue; } r -= I_BA;
            if (r < I_BB) { const int kb = r / 16, nb = r % 16; transpose_item(a.w_br_b, 1024, 64 * kb, 64 * nb, WBR, 1024, (nb >> 2) * 256 + (nb & 3) * 32, 512, nullptr, scr, lane, 1.0f, 1); continue; } r -= I_BB;
            { const int kb = r / 16, nb = r % 16; transpose_item(a.w_out, 1024, 64 * kb, 64 * nb, WO, 1024, (nb >> 2) * 256 + (nb & 3) * 32, 0, nullptr, scr, lane, 1.0f, 1); }
        }
#if LEVEL >= 3
        for (int i = bx * NTHREADS + tid; i < 64 * 1024; i += G * NTHREADS) { const int n = i >> 10, k = i & 1023; float v = 0.f; if (n < 4) v = a.w_rg[k * 4 + n]; else if (n < 36) v = a.w_re[k * 32 + (n - 4)];
            v *= a.norm_ffn_g[k]; const unsigned h = cvt_pk_bf16(v, 0.f) & 0xffffu; const float r = v - __uint_as_float(h << 16); WRH[i] = (bf16_t)h; WRL[i] = (bf16_t)(cvt_pk_bf16(r, 0.f) & 0xffffu); }
#endif
        for (int i = bx * NTHREADS + tid; i < T * 8; i += G * NTHREADS) { const int t = i >> 3, j = i & 7;
            const double invf = exp2(-(double)j * (18.931568569324174 / 8.0));
            const double ang = (double)a.pos[t] * invf; const double kk = rint(ang * 0.15915494309189535); const float rr = (float)(ang - kk * 6.283185307179586);
            CS[t * 16 + j] = cosf(rr); CS[t * 16 + 8 + j] = sinf(rr); }
        for (int m = gw; m < T; m += NGW) rms_row_to_bf16(a.x + (size_t)m * D, a.norm_mix_g, XN + (size_t)m * D, lane);
#endif
    }
    GRID_BAR();

#if LEVEL >= 1 && !defined(NO_P1)
#if PROBE_PHASE >= 71 && PROBE_PHASE <= 73
    {
        pg8::DenseProb P; P.init(XN, WIN, T, IN_COLS, 1024, G, bx);
        pg8::EpiInProjT<(PROBE_PHASE == 73 ? 4 : PROBE_PHASE - 70)> E{UV, Qb, Kb, Vb, G8, CS, Q8, K8, lds};
        pg8::gemm_core<false>(lds, P, E, pg8::NoHook{});
    }
#endif
#if PROBE_PHASE == 66 || PROBE_PHASE == 67
    {
        pg8::DenseProb P; P.init(XN, WIN, T, IN_COLS, 1024, G, bx);
        pg8::EpiInProjT<PROBE_PHASE - 65> E{UV, Qb, Kb, Vb, G8, CS, Q8, K8, lds};
        pg8::gemm_core<false, pg8::DenseProb, pg8::EpiInProjT<PROBE_PHASE - 65>, pg8::NoHook, 4>(lds, P, E, pg8::NoHook{});
    }
#endif
#if PROBE_PHASE == 64
    {
        pg8::DenseProb P; P.init(XN, WIN, T, IN_COLS, 1024, G, bx);
        pg8::EpiInProj E{UV, Qb, Kb, Vb, G8, CS, Q8, K8, lds};
        pg8::gemm_core<false, pg8::DenseProb, pg8::EpiInProj, pg8::NoHook, 4>(lds, P, E, pg8::NoHook{});
    }
#endif
    for (int rep = 0; rep < REPS(1); ++rep) {
#ifdef STAG1
        phase_stagger(((bx >> 3) & 7) >> 1, STAG1);
#endif
        pg8::DenseProb P; P.init(XN, WIN, T, IN_COLS, 1024, G, bx);
        pg8::EpiInProj E{UV, Qb, Kb, Vb, G8, CS, Q8, K8, lds};
        pg8::gemm_core<false>(lds, P, E, pg8::NoHook{});
    }
#if PROBE_PHASE == 11
    {
        pg8::DenseProb P; P.init(XN, WIN, T, IN_COLS, 1024, G, bx);
        pg8::gemm_core<false>(lds, P, pg8::EpiNull{}, pg8::NoHook{});
    }
#endif
#if PROBE_PHASE >= 61 && PROBE_PHASE <= 63
    {
        pg8::DenseProb P; P.init(XN, WIN, T, IN_COLS, 1024, G, bx);
        pg8::gemm_core<false, pg8::DenseProb, pg8::EpiNull, pg8::NoHook, PROBE_PHASE - 60>(lds, P, pg8::EpiNull{}, pg8::NoHook{});
    }
#endif
#if PROBE_PHASE == 31
    {
        pg8::DenseProb P; P.init(XN, WIN, T, IN_COLS, 1024, G, bx);
        pg8::gemm_core<false>(lds, P, pg8::EpiStoreOnly{(bf16_t*)(ws + WS_END)}, pg8::NoHook{});
    }
#endif
#if PROBE_PHASE == 12
    {
        pg8::DenseProbSame P; P.init(XN, WIN, T, IN_COLS, 1024, G, bx);
        pg8::gemm_core<false>(lds, P, pg8::EpiNull{}, pg8::NoHook{});
    }
#endif
#endif
    GRID_BAR();

#if LEVEL >= 1 && !defined(NO_P2A)
    for (int rep = 0; rep < REPS(2); ++rep) {
        PHASE_IDS();
        LAS bf16_t* VT = (LAS bf16_t*)lds;
        LAS float* SV = (LAS float*)(lds + 36864);
        const int r32 = lane & 31, hi = lane >> 5;
        for (int un = vcu; un < 2048; un += G) {
            const int ch = un >> 2, g = un & 3; const size_t row0 = (size_t)ch * 128;
            {
                const int s = tid >> 2, qd = tid & 3;
                const u32x4* vp = (const u32x4*)(UV + (row0 + s) * 1024 + 512 + g * 128 + qd * 32);
                float v[32]; float sm = 0.f;
#pragma unroll
                for (int j = 0; j < 4; ++j) { const u32x4 w = vp[j]; f32x4 x0, x1; pg8::unpack8(w, x0, x1);
#pragma unroll
                    for (int e = 0; e < 4; ++e) { v[8 * j + e] = x0[e]; v[8 * j + 4 + e] = x1[e]; sm += x0[e] + x1[e]; } }
                sm += __shfl_xor(sm, 1); sm += __shfl_xor(sm, 2);
                const float mu = sm * (1.0f / 128.0f); float sq = 0.f;
#pragma unroll
                for (int i = 0; i < 32; ++i) { v[i] -= mu; sq += v[i] * v[i]; }
                sq += __shfl_xor(sq, 1); sq += __shfl_xor(sq, 2);
                const float rstd = 1.0f / sqrtf(sq * (1.0f / 128.0f) + EPS);
                const float* lg = a.gm_ln_g + g * 128 + qd * 32; const float* lb = a.gm_ln_b + g * 128 + qd * 32;
#pragma unroll
                for (int i = 0; i < 32; ++i) { const float y = v[i] * rstd * lg[i] + lb[i]; VT[(qd * 32 + i) * 136 + s] = (bf16_t)(cvt_pk_bf16(y, 0.f) & 0xffffu); }
            }
            LDS_WAIT(); __syncthreads();
            {
                const int tb = wave >> 1, db0 = 2 * (wave & 1);
                f32x16 c0 = f32x16{}, c1 = f32x16{};
                const float* wrow = a.gm_w_s + ((size_t)g * 128 + tb * 32 + r32) * 128;
                const int trow = tb * 32 + r32;
                for (int ks = 0; ks <= 2 * tb + 1; ++ks) {
                    const int s0 = 16 * ks + 8 * hi;
                    const f32x4 wa = *(const f32x4*)(wrow + s0), wb = *(const f32x4*)(wrow + s0 + 4);
                    float w8[8] = {wa[0], wa[1], wa[2], wa[3], wb[0], wb[1], wb[2], wb[3]};
#pragma unroll
                    for (int j = 0; j < 8; ++j) if (s0 + j > trow) w8[j] = 0.f;
                    u32x4 aw; aw.x = cvt_pk_bf16(w8[0], w8[1]); aw.y = cvt_pk_bf16(w8[2], w8[3]); aw.z = cvt_pk_bf16(w8[4], w8[5]); aw.w = cvt_pk_bf16(w8[6], w8[7]);
                    const bf16x8 af = __builtin_bit_cast(bf16x8, aw);
                    const bf16x8 b0 = *(const LAS bf16x8*)(VT + ((db0 + 0) * 32 + r32) * 136 + s0);
                    const bf16x8 b1 = *(const LAS bf16x8*)(VT + ((db0 + 1) * 32 + r32) * 136 + s0);
                    c0 = __builtin_amdgcn_mfma_f32_32x32x16_bf16(af, b0, c0, 0, 0, 0);
                    c1 = __builtin_amdgcn_mfma_f32_32x32x16_bf16(af, b1, c1, 0, 0, 0);
                }
#pragma unroll
                for (int r = 0; r < 16; ++r) { const int t = tb * 32 + att::crow(r, hi); const float bs = a.gm_b_s[g * 128 + t];
                    SV[t * 132 + db0 * 32 + r32] = c0[r] + bs; SV[t * 132 + db0 * 32 + 32 + r32] = c1[r] + bs; }
            }
            LDS_WAIT(); __syncthreads();
            {
#pragma unroll
                for (int i = 0; i < 4; ++i) { const int t = i * 32 + (tid >> 4), dc = (tid & 15) * 8;
                    const size_t ro = (row0 + t) * 1024 + g * 128 + dc;
                    const u32x4 uw = *(const u32x4*)(UV + ro); f32x4 u0, u1; pg8::unpack8(uw, u0, u1);
                    const f32x4 s0 = *(const LAS f32x4*)(SV + t * 132 + dc), s1 = *(const LAS f32x4*)(SV + t * 132 + dc + 4);
                    *(u32x4*)(YAB + ro) = pg8::pack8(u0 * s0, u1 * s1); }
            }
            LDS_WAIT(); __syncthreads();
        }
    }
#endif
#if LEVEL >= 2
    {
        PHASE_IDS();
        LAS unsigned char* TB = (LAS unsigned char*)lds + wave * 8192;
        for (int tl = gw; tl < BATCH * 4 * (SEQ / 64); tl += NGW) {
            const int bh = tl >> 7, tt = tl & 127, b = bh >> 2, h = bh & 3;
            const bf16_t* vsrc = Vb + ((size_t)b * SEQ + tt * 64) * 512 + h * 128;
            u32x4 w[16];
#pragma unroll
            for (int i = 0; i < 16; ++i) w[i] = *(const u32x4*)(vsrc + (size_t)(i * 4 + (lane >> 4)) * 512 + (lane & 15) * 8);
#pragma unroll
            for (int i = 0; i < 16; ++i) { const int key = i * 4 + (lane >> 4), kk = key & 31, khi = (kk >> 2) & 1, j = (kk & 3) + 4 * (kk >> 3) + 16 * (key >> 5), cc = khi * 2 + (j >> 4);
                f32x4 x0, x1; pg8::unpack8(w[i], x0, x1); const unsigned q0_ = cvt_pk4_fp8(x0[0], x0[1], x0[2], x0[3]), q1_ = cvt_pk4_fp8(x1[0], x1[1], x1[2], x1[3]);
#pragma unroll
                for (int e = 0; e < 8; ++e) { const int d = (lane & 15) * 8 + e; const unsigned byte = ((e < 4 ? q0_ : q1_) >> (8 * (e & 3))) & 0xffu;
                    TB[d * 64 + ((cc ^ ((d >> 2) & 3)) * 16) + (j & 15)] = (unsigned char)byte; } }
            LDS_WAIT(); asm volatile("" ::: "memory");
            unsigned char* dst = V8T + (size_t)tl * 8192;
#pragma unroll
            for (int i = 0; i < 8; ++i) *(u32x4*)(dst + (i * 64 + lane) * 16) = *(const LAS u32x4*)(TB + (i * 64 + lane) * 16);
            LDS_WAIT(); asm volatile("" ::: "memory");
        }
    }
    GRID_BAR();
#endif
#if LEVEL >= 2 && !defined(NO_P2B)
    {
        PHASE_IDS();
        float lam;
        { const float p1 = wave_sum(a.lam_q1[lane] * a.lam_k1[lane]), p2 = wave_sum(a.lam_q2[lane] * a.lam_k2[lane]); lam = expf(p1) - expf(p2) + 0.2f; }
        const int bh = vcu >> 3, s = vcu & 7, b = bh >> 2, h = bh & 3;
        float* park = PARK + (size_t)bx * 32768;
        if (G == 256) {
            for (int ii = 0; ii < 4 * REPS(3); ++ii) { const int i = ii & 3; const int qb = (i == 0) ? s : (i == 1) ? 15 - s : (i == 2) ? 16 + s : 31 - s;
                att::attn_unit<0>(b, h, qb, Qb, Kb, Q8, K8, V8T, YAB, park, lam, a.subln_g, (LAS char*)lds);
#if LEVEL >= 3
                if (ii < 4) {
                    LAS float* scr = (LAS float*)(lds + wave * 16896);
                    for (int k = wave; k < 12; k += NWAVES) expert_item((bx * 4 + ii) * 12 + k, a.w_gate, a.w_up, a.w_down, a.norm_ffn_g, W13, W2, scr, lane);
                    LDS_WAIT(); __syncthreads();
                }
#endif
            }
#if PROBE_PHASE == 13 || PROBE_PHASE == 14 || PROBE_PHASE == 15 || PROBE_PHASE == 16
            for (int i = 0; i < 4; ++i) { const int qb = (i == 0) ? s : (i == 1) ? 15 - s : (i == 2) ? 16 + s : 31 - s;
                att::attn_unit<PROBE_PHASE - 13>(0, 0, qb, Qb, Kb, Q8, K8, V8T, (bf16_t*)(ws + WS_END), park, lam, a.subln_g, (LAS char*)lds); }
#endif
        }
    }
#elif LEVEL >= 1
    {
        PHASE_IDS();
        for (int i = bx * NTHREADS + tid; i < T * 64; i += G * NTHREADS) { const int row = i >> 6, c = i & 63; *(u32x4*)(YAB + (size_t)row * 1024 + 512 + c * 8) = (u32x4){0u, 0u, 0u, 0u}; }
    }
#endif
    GRID_BAR();

#if LEVEL >= 1 && !defined(NO_P3)
    for (int rep = 0; rep < REPS(4); ++rep) {
        pg8::PanelProb P; P.init(YAB, WBR, T, 1024, 1024, G, bx);
        pg8::EpiMerge E{G8, MG};
        pg8::gemm_core<false>(lds, P, E, pg8::HookMerge{G8});
    }
#endif
    asm volatile("s_waitcnt vmcnt(0)" ::: "memory"); __syncthreads();
#if LEVEL >= 1 && !defined(NO_P4)
    for (int rep = 0; rep < REPS(5); ++rep) {
        pg8::PanelProb P; P.init(MG, WO, T, 1024, 1024, G, bx);
        pg8::EpiX1 E{a.x, XB, XB8, SSQ};
        pg8::gemm_core<false>(lds, P, E, pg8::NoHook{});
    }
#endif
    asm volatile("s_waitcnt vmcnt(0)" ::: "memory"); __syncthreads();

#if LEVEL >= 3 && !defined(NO_P5)
    {
        PHASE_IDS();
        LAS float* LG = (LAS float*)lds;
        volatile LAS int* LCNT = (volatile LAS int*)(LCTL + 96); volatile LAS int* LBASE = (volatile LAS int*)(LCTL + 128);
        const int r32 = lane & 31, hi = lane >> 5;
        for (int tb = bx; tb < T / 256; tb += G) {
            const size_t tok0 = (size_t)tb * 256 + wave * 32;
            const bf16_t* xa = XB + (tok0 + r32) * 1024 + hi * 8;
            const bf16_t* wh0 = WRH + (size_t)r32 * 1024 + hi * 8; const bf16_t* wh1 = wh0 + 32 * 1024;
            const bf16_t* wl0 = WRL + (size_t)r32 * 1024 + hi * 8; const bf16_t* wl1 = wl0 + 32 * 1024;
            f32x16 c0 = f32x16{}, c1 = f32x16{};
#pragma unroll 4
            for (int ks = 0; ks < 64; ++ks) {
                const bf16x8 av = *(const bf16x8*)(xa + ks * 16);
                const bf16x8 h0 = *(const bf16x8*)(wh0 + ks * 16), h1 = *(const bf16x8*)(wh1 + ks * 16), l0 = *(const bf16x8*)(wl0 + ks * 16), l1 = *(const bf16x8*)(wl1 + ks * 16);
                c0 = __builtin_amdgcn_mfma_f32_32x32x16_bf16(av, h0, c0, 0, 0, 0); c1 = __builtin_amdgcn_mfma_f32_32x32x16_bf16(av, h1, c1, 0, 0, 0);
                c0 = __builtin_amdgcn_mfma_f32_32x32x16_bf16(av, l0, c0, 0, 0, 0); c1 = __builtin_amdgcn_mfma_f32_32x32x16_bf16(av, l1, c1, 0, 0, 0);
            }
#pragma unroll
            for (int r = 0; r < 16; ++r) { const int tl = wave * 32 + att::crow(r, hi); LG[tl * 37 + r32] = c0[r]; if (r32 < 4) LG[tl * 37 + 32 + r32] = c1[r]; }
            if (tid < 32) LCNT[tid] = 0;
            LDS_WAIT(); __syncthreads();
            int eid0 = 0, eid1 = 0, rk0 = 0, rk1 = 0; float w0 = 0.f, w1 = 0.f; const size_t tok = (size_t)tb * 256 + tid;
            if (tid < 256) {
                float ssq = 0.f;
#pragma unroll
                for (int j = 0; j < 16; ++j) ssq += SSQ[tok * 16 + j];
                const float rstd = 1.0f / sqrtf(ssq * (1.0f / 1024.0f) + EPS);
                RSTD[tok] = rstd;
                const LAS float* p0 = LG + tid * 37;
                float gl[4]; int grp = 0;
#pragma unroll
                for (int j = 0; j < 4; ++j) gl[j] = p0[j] * rstd + a.b_rg[j];
                float gmx = gl[0];
#pragma unroll
                for (int j = 1; j < 4; ++j) if (gl[j] > gmx) { gmx = gl[j]; grp = j; }
                float gs = 0.f;
#pragma unroll
                for (int j = 0; j < 4; ++j) gs += expf(gl[j] - gmx);
                const float gwt = 1.0f / gs;
                float el[8];
#pragma unroll
                for (int j = 0; j < 8; ++j) el[j] = p0[4 + grp * 8 + j] * rstd + a.b_re[grp * 8 + j];
                int i0 = 0; float v0 = el[0];
#pragma unroll
                for (int j = 1; j < 8; ++j) if (el[j] > v0) { v0 = el[j]; i0 = j; }
                int i1 = -1; float v1 = -INFINITY;
#pragma unroll
                for (int j = 0; j < 8; ++j) if (j != i0 && el[j] > v1) { v1 = el[j]; i1 = j; }
                const float e1 = expf(v1 - v0); w0 = gwt / (1.0f + e1); w1 = gwt * e1 / (1.0f + e1);
                eid0 = grp * 8 + i0; eid1 = grp * 8 + i1;
                rk0 = atomicAdd((int*)(LCNT + eid0), 1); rk1 = atomicAdd((int*)(LCNT + eid1), 1);
            }
            LDS_WAIT(); __syncthreads();
            if (tid < 32) LBASE[tid] = (int)__hip_atomic_fetch_add(ctl + CW_CNT + tid, (unsigned)LCNT[tid], RLX_AGENT);
            LDS_WAIT(); __syncthreads();
            if (tid < 256) {
                const int s0_ = eid0 * LISTCAP + LBASE[eid0] + rk0, s1_ = eid1 * LISTCAP + LBASE[eid1] + rk1;
                LIST[s0_] = (int)(((unsigned)(tok * 2) << 15) | (cvt_pk_bf16(w0, 0.f) & 0x7fffu)); LIST[s1_] = (int)(((unsigned)(tok * 2 + 1) << 15) | (cvt_pk_bf16(w1, 0.f) & 0x7fffu));
            }
            LDS_WAIT(); __syncthreads();
        }
    }
#endif
    GRID_BAR();
#if LEVEL >= 3
    {
        PHASE_IDS();
        volatile LAS int* BST = (volatile LAS int*)(LCTL + 16); volatile LAS int* CNT = (volatile LAS int*)(LCTL + 64);
        if (tid == 0) { int accb = 0; for (int e = 0; e < NEXP; ++e) { const int c = (int)__hip_atomic_load(ctl + CW_CNT + e, RLX_AGENT); CNT[e] = c; BST[e] = accb; accb += (c + 255) >> 8; } BST[NEXP] = accb; }
        LDS_WAIT(); __syncthreads();
    }
#if !defined(NO_P6)
    for (int rep = 0; rep < REPS(6); ++rep) {
        pg8::MoeUpProb P; P.init((const LAS int*)(LCTL + 16), (const LAS int*)(LCTL + 64), G, bx); P.A = (const char*)XB8; P.Bt = (const char*)W13; P.pitch = 1024; P.list = LIST;
        pg8::EpiMoeUp E{LIST, RSTD, H8, {}};
        pg8::gemm_core<true>(lds, P, E, pg8::HookPin<pg8::EpiMoeUp>{&E});
    }
#endif
#endif
    GRID_BAR();
#if LEVEL >= 3 && !defined(NO_P7)
    for (int rep = 0; rep < REPS(7); ++rep) {
        pg8::MoeDownProb P; P.init((const LAS int*)(LCTL + 16), (const LAS int*)(LCTL + 64), G, bx); P.A = (const char*)H8; P.Bt = (const char*)W2; P.pitch = 512;
        pg8::EpiMoeDown E{LIST, YB8, {}};
        pg8::gemm_core<true>(lds, P, E, pg8::HookPin<pg8::EpiMoeDown>{&E});
    }
#endif
    GRID_BAR();

    {
        PHASE_IDS();
        const bool tmo = (__hip_atomic_load(ctl + CW_BAR + XB_TMO, RLX_AGENT) != 0u);
        for (int m = gw; m < T; m += NGW) {
            const f32x4* gr = (const f32x4*)a.final_g + lane;
            f32x4 v[4]; float s = 0.f;
#pragma unroll
            for (int j = 0; j < 4; ++j) {
#if LEVEL >= 1
                { const u32x2 xw = *((const u32x2*)(XB + (size_t)m * D) + lane + 64 * j); v[j] = (f32x4){bf_lo(xw.x), bf_hi(xw.x), bf_lo(xw.y), bf_hi(xw.y)}; }
#else
                v[j] = ((const f32x4*)(a.x + (size_t)m * D) + lane)[64 * j];
#endif
#if LEVEL >= 3
                const unsigned y0 = *((const unsigned*)(YB8 + (size_t)(2 * m) * D) + lane + 64 * j), y1 = *((const unsigned*)(YB8 + (size_t)(2 * m + 1) * D) + lane + 64 * j);
                v[j] = v[j] + (fp8x4_to_f32(y0) + fp8x4_to_f32(y1)) * 0.0625f;
#endif
                s += (v[j].x * v[j].x + v[j].y * v[j].y) + (v[j].z * v[j].z + v[j].w * v[j].w); }
            float rstd = 1.f / sqrtf(wave_sum(s) * (1.f / D) + EPS);
            if (tmo) rstd = __builtin_nanf("");
            f32x4* o = (f32x4*)(a.out + (size_t)m * D) + lane;
#pragma unroll
            for (int j = 0; j < 4; ++j) { f32x4 ov = v[j] * rstd * gr[64 * j];
#if PROBE_PHASE == 50
#pragma unroll
                for (int e = 0; e < 4; ++e) if (!(__builtin_fabsf(ov[e]) < 1e30f)) ov[e] = 0.f;
#endif
                o[64 * j] = ov; }
        }
    }
}

extern "C" void kernel_launch(void* const* d_in, const int* in_sizes, int n_in, void* d_out, int out_size, void* d_ws, size_t ws_size, hipStream_t stream) {
    static int grid = 0;
    if (grid == 0) {
        if (n_in != 25 || in_sizes[0] != T * D || out_size != T * D || ws_size < WS_END + 64 * MiB) { fprintf(stderr, "kernel_launch: unexpected shapes (n_in %d, in0 %d, out %d, ws %zu); nothing launched\n", n_in, n_in > 0 ? in_sizes[0] : -1, out_size, ws_size); grid = -1; return; }
        int dev = 0, cus = 0, per_cu = 0;
        if (hipGetDevice(&dev) != hipSuccess || hipDeviceGetAttribute(&cus, hipDeviceAttributeMultiprocessorCount, dev) != hipSuccess) { grid = -1; return; }
        if (hipFuncSetAttribute((const void*)fwd_kernel, hipFuncAttributeMaxDynamicSharedMemorySize, LDS_BYTES) != hipSuccess) { fprintf(stderr, "kernel_launch: hipFuncSetAttribute failed\n"); grid = -1; return; }
        if (hipOccupancyMaxActiveBlocksPerMultiprocessor(&per_cu, (const void*)fwd_kernel, NTHREADS, LDS_BYTES) != hipSuccess || per_cu < 1) fprintf(stderr, "kernel_launch: occupancy query reports %d\n", per_cu);
        (void)hipGetLastError();
        grid = cus;
        if (grid != 256) fprintf(stderr, "kernel_launch: %d CUs (built for 256)\n", grid);
    }
    if (grid < 0) return;
    if (hipMemsetAsync((char*)d_ws + WS_CTL, 0, CTL_ZERO_BYTES, stream) != hipSuccess) return;
    Args a{};
    a.x = (const float*)d_in[0]; a.pos = (const int*)d_in[1]; a.norm_mix_g = (const float*)d_in[2]; a.w_in = (const float*)d_in[3]; a.gm_ln_g = (const float*)d_in[4]; a.gm_ln_b = (const float*)d_in[5];
    a.gm_w_s = (const float*)d_in[6]; a.gm_b_s = (const float*)d_in[7]; a.lam_q1 = (const float*)d_in[8]; a.lam_k1 = (const float*)d_in[9]; a.lam_q2 = (const float*)d_in[10]; a.lam_k2 = (const float*)d_in[11];
    a.subln_g = (const float*)d_in[12]; a.w_br_a = (const float*)d_in[13]; a.w_br_b = (const float*)d_in[14]; a.w_out = (const float*)d_in[15]; a.norm_ffn_g = (const float*)d_in[16];
    a.w_rg = (const float*)d_in[17]; a.b_rg = (const float*)d_in[18]; a.w_re = (const float*)d_in[19]; a.b_re = (const float*)d_in[20]; a.w_gate = (const float*)d_in[21]; a.w_up = (const float*)d_in[22];
    a.w_down = (const float*)d_in[23]; a.final_g = (const float*)d_in[24];
    a.out = (float*)d_out; a.ws = (unsigned char*)d_ws;
    hipLaunchKernelGGL(fwd_kernel, dim3(grid), dim3(NTHREADS), LDS_BYTES, stream, a);
    const hipError_t le = hipPeekAtLastError();
    if (le != hipSuccess) fprintf(stderr, "kernel_launch: launch failed: %s\n", hipGetErrorName(le));
}
```

```cpp
#include <hip/hip_runtime.h>
#include <cstdio>
#include <cstdint>

#ifndef LEVEL
#define LEVEL 3
#endif

#ifndef PROBE_PHASE
#define PROBE_PHASE -1
#endif
#define REPS(p) ((PROBE_PHASE == (p)) ? 2 : 1)
#define LAS __attribute__((address_space(3)))
#define GAS __attribute__((address_space(1)))
typedef unsigned short bf16_t;
typedef short bf16x8 __attribute__((ext_vector_type(8)));
typedef short s16x4 __attribute__((ext_vector_type(4)));
typedef float f32x2 __attribute__((ext_vector_type(2)));
typedef float f32x4 __attribute__((ext_vector_type(4)));
typedef float f32x16 __attribute__((ext_vector_type(16)));
typedef unsigned u32x2 __attribute__((ext_vector_type(2)));
typedef unsigned u32x4 __attribute__((ext_vector_type(4)));
typedef int i32x8 __attribute__((ext_vector_type(8)));
typedef short s16x16 __attribute__((ext_vector_type(16)));

constexpr int D = 1024, BATCH = 8, SEQ = 8192, T = BATCH * SEQ;
constexpr int IN_COLS = 4608;
constexpr int NEXP = 32, DEXP = 512;
constexpr int LISTCAP = T;
constexpr float EPS = 1e-6f;
constexpr float LOG2E = 1.4426950408889634f;
constexpr float C2 = 0.125f * LOG2E;
constexpr int NWAVES = 8, NTHREADS = 512;

constexpr size_t MiB = 1u << 20;
constexpr size_t WS_CTL = 0, CTL_ZERO_BYTES = 1 * MiB;
constexpr size_t WS_WIN = 2 * MiB;
constexpr size_t WS_WBR = 12 * MiB;
constexpr size_t WS_WO = 14 * MiB;
constexpr size_t WS_W13 = 16 * MiB;
constexpr size_t WS_W2 = 80 * MiB;
constexpr size_t WS_WRH = 112 * MiB;
constexpr size_t WS_WRL = 112 * MiB + 131072;
constexpr size_t WS_CS = 113 * MiB;
constexpr size_t WS_SSQ = 117 * MiB;
constexpr size_t WS_RSTD = 121 * MiB;
constexpr size_t WS_WTS = 122 * MiB;
constexpr size_t WS_LIST = 123 * MiB;
constexpr size_t WS_PARK = 131 * MiB;
constexpr size_t WS_RA = 164 * MiB;
constexpr size_t WS_RB = 292 * MiB;
constexpr size_t WS_RC = 420 * MiB;
constexpr size_t WS_RD = 548 * MiB;
constexpr size_t WS_RE = 612 * MiB;
constexpr size_t WS_END = 868 * MiB;
constexpr int CW_TMO = 0;
constexpr int CW_BAR = 4096;
constexpr int CW_CNT = 8192;

constexpr int RING_BYTES = 147456;
constexpr int LDSCTL_OFF = RING_BYTES;
constexpr int LDS_BYTES = RING_BYTES + 1024;

#define RLX_AGENT __ATOMIC_RELAXED, __HIP_MEMORY_SCOPE_AGENT
#define LDS_WAIT() asm volatile("s_waitcnt lgkmcnt(0)" ::: "memory")
#define VM_WAIT() asm volatile("s_waitcnt vmcnt(0)" ::: "memory")

__device__ __forceinline__ unsigned cvt_pk_bf16(float lo, float hi) { unsigned r; asm("v_cvt_pk_bf16_f32 %0, %1, %2" : "=v"(r) : "v"(lo), "v"(hi)); return r; }
__device__ __forceinline__ unsigned cvt_pk4_fp8(float a, float b, float c, float d) { int w; asm("v_cvt_pk_fp8_f32 %0, %1, %2" : "=v"(w) : "v"(a), "v"(b)); w = __builtin_amdgcn_cvt_pk_fp8_f32(c, d, w, true); return (unsigned)w; }
__device__ __forceinline__ unsigned cvt_pk4_u8(float a, float b, float c, float d) { unsigned w = 0; w = __builtin_amdgcn_cvt_pk_u8_f32(a, 0, w); w = __builtin_amdgcn_cvt_pk_u8_f32(b, 1, w); w = __builtin_amdgcn_cvt_pk_u8_f32(c, 2, w); w = __builtin_amdgcn_cvt_pk_u8_f32(d, 3, w); return w; }
__device__ __forceinline__ f32x4 u8x4_to_f32(unsigned w) { return (f32x4){(float)(w & 0xffu), (float)((w >> 8) & 0xffu), (float)((w >> 16) & 0xffu), (float)(w >> 24)}; }
__device__ __forceinline__ f32x4 fp8x4_to_f32(unsigned w) { const f32x2 lo = __builtin_amdgcn_cvt_pk_f32_fp8((int)w, false), hi = __builtin_amdgcn_cvt_pk_f32_fp8((int)w, true); return (f32x4){lo[0], lo[1], hi[0], hi[1]}; }
__device__ __forceinline__ float bf_lo(unsigned w) { return __uint_as_float(w << 16); }
__device__ __forceinline__ float bf_hi(unsigned w) { return __uint_as_float(w & 0xffff0000u); }
__device__ __forceinline__ float fast_exp2(float x) { return __builtin_amdgcn_exp2f(x); }
__device__ __forceinline__ float fast_rcp(float x) { return __builtin_amdgcn_rcpf(x); }
__device__ __forceinline__ float sigmoidf_(float x) { return fast_rcp(1.0f + fast_exp2(-LOG2E * x)); }
__device__ __forceinline__ float gelu_tanh(float x) {
    const float u = x * (0.7978845608028654f + 0.0356774081363001f * x * x);
    return x * fast_rcp(1.0f + fast_exp2(-2.0f * LOG2E * u));
}
__device__ __forceinline__ f32x2 pk_fma(f32x2 a, f32x2 b, f32x2 c) { return __builtin_elementwise_fma(a, b, c); }
__device__ __forceinline__ f32x2 gelu_tanh2(f32x2 x) {
    constexpr float K0 = -2.0f * LOG2E * 0.7978845608028654f, K1 = -2.0f * LOG2E * 0.0356774081363001f;
    const f32x2 z = x * pk_fma(x * x, (f32x2){K1, K1}, (f32x2){K0, K0});
    const f32x2 d = (f32x2){fast_exp2(z.x), fast_exp2(z.y)} + 1.0f;
    return x * (f32x2){fast_rcp(d.x), fast_rcp(d.y)};
}
__device__ __forceinline__ f32x2 sig255_2(f32x2 a) {
    constexpr float S = 1.0f / 255.0f;
    const f32x2 d = pk_fma((f32x2){fast_exp2(a.x), fast_exp2(a.y)}, (f32x2){S, S}, (f32x2){S, S});
    return (f32x2){fast_rcp(d.x), fast_rcp(d.y)};
}
__device__ __forceinline__ int opaque_tid() { int t = threadIdx.x; asm volatile("" : "+v"(t)); return t; }
__device__ __forceinline__ float wave_sum(float v) {
#pragma unroll
    for (int o = 1; o < 64; o <<= 1) v += __shfl_xor(v, o);
    return v;
}

namespace pg8 {
constexpr int BM = 256, BK = 64, HALF = 128, HTB = HALF * BK * 2, STAGE_BYTES = 8 * HTB, NXCD = 8, WGM = 8;
__host__ __device__ __forceinline__ int lds_byte(int r, int c) { const int st = (r >> 4) * 2 + (c >> 5), rr = r & 15, cc = c & 31, ob = rr * 64 + cc * 2; return st * 1024 + (ob ^ (((ob >> 9) & 1) << 5)); }
__host__ __device__ __forceinline__ void stage_rc(int b, int& R, int& C) { const int st = b / 1024, sb = b % 1024, swz = sb ^ (((sb >> 9) & 1) << 5); R = (st >> 1) * 16 + swz / 64; C = (st & 1) * 32 + (swz % 64) / 2; }
__host__ __device__ __forceinline__ int perm32(int rho) { const int n = rho >> 4, i = rho & 15; return 8 * (i >> 2) + 4 * n + (i & 3); }

struct Unit { int pm, pn, e, lbase, nv; };

struct DenseProb {
    static constexpr bool GATHER = false;
    const char* A; const char* Bt; int pitch  ; int nM, nN, nwg, G, c;
    __device__ __forceinline__ void init(const void* A_, const void* Bt_, int M, int N, int K_, int G_, int c_) { A = (const char*)A_; Bt = (const char*)Bt_; pitch = K_ * 2; nM = M / BM; nN = N / BM; nwg = nM * nN; G = G_; c = c_; }
    __device__ __forceinline__ bool next(int i, Unit& u) const {
        const long L = (long)i * G + c; if (L >= nwg) return false;
        int wgid = (int)L; { const int q = nwg / NXCD, r = nwg % NXCD, xcd = wgid % NXCD, off = wgid / NXCD; wgid = (xcd < r ? xcd * (q + 1) : r * (q + 1) + (xcd - r) * q) + off; }
        const int nig = WGM * nN, gid = wgid / nig, fm = gid * WGM, gsz = (nM - fm) < WGM ? (nM - fm) : WGM;
        u.pm = fm + ((wgid % nig) % gsz); u.pn = (wgid % nig) / gsz; u.e = 0; u.lbase = 0; u.nv = 256; return true;
    }
    __device__ __forceinline__ void a_offs(const Unit& u, const int (&R)[2], const int (&C)[2], unsigned (&o)[2][2]) const {
#pragma unroll
        for (int h = 0; h < 2; ++h)
#pragma unroll
            for (int i = 0; i < 2; ++i) o[h][i] = (unsigned)((u.pm * BM + h * HALF + R[i]) * pitch + C[i] * 2);
    }
    __device__ __forceinline__ const char* b_tile(const Unit& u) const { return Bt + (size_t)u.pn * BM * pitch; }
    __device__ __forceinline__ const char* a_tile(const Unit& u) const { return A + (size_t)u.pm * BM * pitch; }
};

struct PanelProb : DenseProb {
    __device__ __forceinline__ bool next(int i, Unit& u) const { if (i >= nN || c >= nM) return false; u.pm = c; u.pn = i; u.e = 0; u.lbase = 0; u.nv = 256; return true; }
};
struct MoeOrder {
    const LAS int* bstart; const LAS int* cnt; int nblk, nwg, G, c;
    __device__ __forceinline__ void init(const LAS int* bs, const LAS int* cn, int G_, int c_) { bstart = bs; cnt = cn; nblk = bs[NEXP]; nwg = nblk * 4; G = G_; c = c_; }
    __device__ __forceinline__ bool next(int i, Unit& u) const {
        const long L = (long)i * G + c; if (L >= nwg) return false;
        int wgid = (int)L; { const int q = nwg / NXCD, r = nwg % NXCD, xcd = wgid % NXCD, off = wgid / NXCD; wgid = (xcd < r ? xcd * (q + 1) : r * (q + 1) + (xcd - r) * q) + off; }
        const int gid = wgid / 32, fm = gid * 8, gsz = (nblk - fm) < 8 ? (nblk - fm) : 8, w = wgid - gid * 32;
        const int blk = fm + (w % gsz); u.pn = w / gsz; u.pm = blk;
        int e = 0;
        while (e < NEXP - 1 && blk >= bstart[e + 1]) ++e;
        const int rb = blk - bstart[e]; u.e = e; u.lbase = e * LISTCAP + rb * 256; const int rem = cnt[e] - rb * 256; u.nv = rem < 256 ? rem : 256; return true;
    }
};
struct MoeUpProb : MoeOrder {
    static constexpr bool GATHER = true;
    const char* A; const char* Bt; int pitch; const int* list;
    __device__ __forceinline__ const char* a_tile(const Unit&) const { return A; }
    __device__ __forceinline__ void a_offs(const Unit& u, const int (&R)[2], const int (&C)[2], unsigned (&o)[2][2]) const {
        unsigned w[2][2];
#pragma unroll
        for (int h = 0; h < 2; ++h)
#pragma unroll
            for (int i = 0; i < 2; ++i) { const int r = h * HALF + R[i]; w[h][i] = (unsigned)list[u.lbase + ((r < u.nv) ? r : 0)]; }
        asm volatile("" : "+v"(w[0][0]), "+v"(w[0][1]), "+v"(w[1][0]), "+v"(w[1][1]));
#pragma unroll
        for (int h = 0; h < 2; ++h)
#pragma unroll
            for (int i = 0; i < 2; ++i) { const int r = h * HALF + R[i]; const int tok = (r < u.nv) ? (int)(w[h][i] >> 16) : 0; o[h][i] = (unsigned)(tok * pitch + C[i] * 2); }
    }
    __device__ __forceinline__ const char* b_tile(const Unit& u) const { return Bt + ((size_t)u.e * 1024 + (size_t)u.pn * BM) * pitch; }
};
struct MoeDownProb : MoeOrder {
    static constexpr bool GATHER = false;
    const char* A; const char* Bt; int pitch;
    __device__ __forceinline__ const char* a_tile(const Unit& u) const { return A + (size_t)u.pm * BM * pitch; }
    __device__ __forceinline__ void a_offs(const Unit& u, const int (&R)[2], const int (&C)[2], unsigned (&o)[2][2]) const {
#pragma unroll
        for (int h = 0; h < 2; ++h)
#pragma unroll
            for (int i = 0; i < 2; ++i) o[h][i] = (unsigned)((u.pm * BM + h * HALF + R[i]) * pitch + C[i] * 2);
    }
    __device__ __forceinline__ const char* b_tile(const Unit& u) const { return Bt + ((size_t)u.e * 1024 + (size_t)u.pn * BM) * pitch; }
};

struct EpiNull { __device__ __forceinline__ void prefetch(const Unit&, int, int, int, int) const {} __device__ __forceinline__ void stage(const Unit&, int, int, int) const {}
    __device__ __forceinline__ void operator()(f32x4 (&acc)[2][2][4][2], const Unit&, int, int, int, int) const {
#pragma unroll
    for (int a = 0; a < 2; ++a)
#pragma unroll
        for (int b = 0; b < 2; ++b)
#pragma unroll
            for (int m = 0; m < 4; ++m) asm volatile("" :: "v"(acc[a][b][m][0]), "v"(acc[a][b][m][1])); } };
struct DenseProbSame : DenseProb {
    __device__ __forceinline__ void a_offs(const Unit&, const int (&R)[2], const int (&C)[2], unsigned (&o)[2][2]) const { Unit z{0, 0, 0, 0, 256}; DenseProb::a_offs(z, R, C, o); }
    __device__ __forceinline__ const char* b_tile(const Unit&) const { return Bt; }
};
struct NoHook { static constexpr int AT = -1; __device__ __forceinline__ void operator()(f32x4 (&)[2][2][4][2], const Unit&, int, int, int, int) const {} };

template <bool FP8, class Prob, class Epi, class Hook, int PM = 0>
__device__ __forceinline__ void gemm_core(LAS unsigned char* lds, const Prob& P, const Epi& E, const Hook& HK) {
    const int tid = opaque_tid(), wid = __builtin_amdgcn_readfirstlane(tid >> 6), lane = tid & 63, wr = wid >> 2, wc = wid & 3, fr = lane & 15, fq = lane >> 4;
    const int pitch = P.pitch, nt = pitch / (BK * 2);
    int R[2], C[2]; unsigned voffB[2], voffA[2];
#pragma unroll
    for (int i = 0; i < 2; ++i) { stage_rc(tid * 16 + i * 8192, R[i], C[i]); const int Rb = (R[i] & ~31) + perm32(R[i] & 31); voffB[i] = (unsigned)(Rb * pitch + C[i] * 2); voffA[i] = (unsigned)(R[i] * pitch + C[i] * 2); }
    const size_t kstep = (size_t)(BK * 2);
    const size_t hstep = (size_t)HALF * pitch;
    const unsigned ldsw = (unsigned)wid * 1024u;
    const int aoff = lds_byte(wr * 64 + fr, fq * 8), boff = lds_byte(wc * 32 + fr, fq * 8);
#define PG8_SA(b, h) (((b) * 2 + (h)) * HTB)
#define PG8_SB(b, h) ((4 + (b) * 2 + (h)) * HTB)
#define PG8_STAGE_B(bufoff, gbase) do { if constexpr (PM != 1) _Pragma("unroll") for (int _i = 0; _i < 2; ++_i) \
        __builtin_amdgcn_global_load_lds((const unsigned*)((const char*)(gbase) + voffB[_i]), (LAS unsigned*)(lds + (bufoff) + ldsw + _i * 8192), 16, 0, 0); } while (0)
#define PG8_STAGE_AG(bufoff, kb, va) do { if constexpr (PM != 1) _Pragma("unroll") for (int _i = 0; _i < 2; ++_i) \
        __builtin_amdgcn_global_load_lds((const unsigned*)(P.A + (kb) + (va)[_i]), (LAS unsigned*)(lds + (bufoff) + ldsw + _i * 8192), 16, 0, 0); } while (0)
#define PG8_STAGE_AD(bufoff, ubase) do { if constexpr (PM != 1) _Pragma("unroll") for (int _i = 0; _i < 2; ++_i) \
        __builtin_amdgcn_global_load_lds((const unsigned*)((const char*)(ubase) + voffA[_i]), (LAS unsigned*)(lds + (bufoff) + ldsw + _i * 8192), 16, 0, 0); } while (0)
#define PG8_STAGE_AC(bufoff, kb, h) do { if constexpr (Prob::GATHER) { PG8_STAGE_AG(bufoff, kb, cvA[h]); } else { PG8_STAGE_AD(bufoff, cA + (h) * hstep + (kb)); } } while (0)
#define PG8_STAGE_AN(bufoff, kb, h) do { if constexpr (Prob::GATHER) { PG8_STAGE_AG(bufoff, kb, v2[h]); } else { PG8_STAGE_AD(bufoff, (last ? nA : cA) + (h) * hstep + (kb)); } } while (0)
#define PG8_LDA(dst, b, h) do { _Pragma("unroll") for (int m = 0; m < 4; ++m) _Pragma("unroll") for (int k = 0; k < 2; ++k) { if constexpr (PM == 3) asm volatile("" : "=v"(dst[m][k])); else dst[m][k] = *(const LAS bf16x8*)(lds + PG8_SA(b, h) + aoff + m * 2048 + k * 1024); } } while (0)
#define PG8_LDB(dst, b, h) do { _Pragma("unroll") for (int n = 0; n < 2; ++n) _Pragma("unroll") for (int k = 0; k < 2; ++k) { if constexpr (PM == 3) asm volatile("" : "=v"(dst[n][k])); else dst[n][k] = *(const LAS bf16x8*)(lds + PG8_SB(b, h) + boff + n * 2048 + k * 1024); } } while (0)
#define PG8_CAT(x) __builtin_bit_cast(i32x8, __builtin_shufflevector((x)[0], (x)[1], 0, 1, 2, 3, 4, 5, 6, 7, 8, 9, 10, 11, 12, 13, 14, 15))
#define PG8_MMA(ai, bj, At, Bt) do { __builtin_amdgcn_s_setprio(1); \
        if constexpr (PM == 2) { _Pragma("unroll") for (int m = 0; m < 4; ++m) asm volatile("" :: "v"(At[m][0]), "v"(At[m][1])); _Pragma("unroll") for (int n = 0; n < 2; ++n) asm volatile("" :: "v"(Bt[n][0]), "v"(Bt[n][1])); } \
        else if constexpr (FP8) { _Pragma("unroll") for (int m = 0; m < 4; ++m) _Pragma("unroll") for (int n = 0; n < 2; ++n) \
            { const i32x8 bq_ = PG8_CAT(Bt[n]), aq_ = PG8_CAT(At[m]); \
              asm volatile("v_mfma_scale_f32_16x16x128_f8f6f4 %0, %1, %2, %0, %3, %3 op_sel_hi:[0,0,0]" : "+v"(acc[ai][bj][m][n]) : "v"(bq_), "v"(aq_), "v"(sc8)); } } \
        else { _Pragma("unroll") for (int m = 0; m < 4; ++m) _Pragma("unroll") for (int n = 0; n < 2; ++n) _Pragma("unroll") for (int k = 0; k < 2; ++k) \
            acc[ai][bj][m][n] = __builtin_amdgcn_mfma_f32_16x16x32_bf16(Bt[n][k], At[m][k], acc[ai][bj][m][n], 0, 0, 0); } \
        __builtin_amdgcn_s_setprio(0); } while (0)
#define PG8_WAIT_V(n) asm volatile("s_waitcnt vmcnt(" #n ")" ::: "memory")
#define PG8_WAIT_L(n) asm volatile("s_waitcnt lgkmcnt(" #n ")" ::: "memory")
#define PG8_BAR __builtin_amdgcn_s_barrier()
#define PG8_SCHED __builtin_amdgcn_sched_barrier(0)
    Unit cur, nxt; int ui = 0;
    if (!P.next(0, cur)) return;
    int sc8 = 0x7f7f7f7f; asm volatile("" : "+v"(sc8));
    f32x4 acc[2][2][4][2];
#pragma unroll
    for (int a = 0; a < 2; ++a)
#pragma unroll
        for (int b = 0; b < 2; ++b)
#pragma unroll
            for (int m = 0; m < 4; ++m)
#pragma unroll
                for (int n = 0; n < 2; ++n) acc[a][b][m][n] = (f32x4){0.f, 0.f, 0.f, 0.f};
    bf16x8 At[4][2], B0[2][2], B1[2][2];
    unsigned cvA[2][2], nvA[2][2];
    if constexpr (Prob::GATHER) P.a_offs(cur, R, C, cvA);
    const char* cA = P.a_tile(cur);
    const char* cB = P.b_tile(cur);
    PG8_STAGE_B(PG8_SB(0, 0), cB); PG8_STAGE_B(PG8_SB(0, 1), cB + hstep); PG8_STAGE_AC(PG8_SA(0, 0), 0, 0); PG8_STAGE_AC(PG8_SA(0, 1), 0, 1);
    if (wr == 1) { PG8_BAR; E.stage(cur, wc, fr, fq); }
    PG8_WAIT_V(2); PG8_BAR;
    PG8_STAGE_B(PG8_SB(1, 0), cB + kstep); PG8_STAGE_AC(PG8_SA(1, 0), kstep, 0); PG8_STAGE_B(PG8_SB(1, 1), cB + hstep + kstep);
    PG8_WAIT_V(6); PG8_BAR;
    E.prefetch(cur, wr, wc, fr, fq);
    for (;;) {
        const bool has_next = P.next(ui + 1, nxt);
        if constexpr (Prob::GATHER) {
            if (has_next) P.a_offs(nxt, R, C, nvA);
            else {
#pragma unroll
                for (int h = 0; h < 2; ++h)
#pragma unroll
                    for (int i = 0; i < 2; ++i) nvA[h][i] = cvA[h][i];
            }
        }
        const char* nA = has_next ? P.a_tile(nxt) : cA;
        const char* nB = has_next ? P.b_tile(nxt) : cB;
        for (int t = 0; t < (PM == 4 ? 0 : nt); t += 2) {
            if (Hook::AT >= 0 && t == Hook::AT) HK(acc, cur, wr, wc, fr, fq);
            const bool last = (t == nt - 2);
            const size_t k1 = (size_t)(t + 1) * kstep;
            const size_t k2 = last ? 0 : (size_t)(t + 2) * kstep, k3 = k2 + kstep;
            const char* b2 = last ? nB : cB + (size_t)(t + 2) * kstep; const char* b3 = b2 + kstep;
            unsigned v2[2][2];
            if constexpr (Prob::GATHER) {
#pragma unroll
                for (int h = 0; h < 2; ++h)
#pragma unroll
                    for (int i = 0; i < 2; ++i) v2[h][i] = last ? nvA[h][i] : cvA[h][i];
            }
            PG8_LDB(B0, 0, 0); PG8_LDB(B1, 0, 1); PG8_SCHED; PG8_LDA(At, 0, 0); PG8_STAGE_AC(PG8_SA(1, 1), k1, 1);
            PG8_WAIT_V(8); PG8_WAIT_L(0); PG8_BAR; PG8_MMA(0, 0, At, B0); PG8_MMA(0, 1, At, B1); PG8_BAR; PG8_SCHED;
            PG8_LDA(At, 0, 1); PG8_STAGE_B(PG8_SB(0, 0), b2); PG8_STAGE_B(PG8_SB(0, 1), b2 + hstep); PG8_STAGE_AN(PG8_SA(0, 0), k2, 0);
            PG8_WAIT_V(8); PG8_WAIT_L(0); PG8_BAR; PG8_MMA(1, 0, At, B0); PG8_MMA(1, 1, At, B1); PG8_BAR; PG8_SCHED;
            PG8_LDB(B0, 1, 0); PG8_LDB(B1, 1, 1); PG8_SCHED; PG8_LDA(At, 1, 0); PG8_STAGE_AN(PG8_SA(0, 1), k2, 1);
            PG8_WAIT_V(8); PG8_WAIT_L(0); PG8_BAR; PG8_MMA(0, 0, At, B0); PG8_MMA(0, 1, At, B1); PG8_BAR; PG8_SCHED;
            PG8_LDA(At, 1, 1); PG8_STAGE_B(PG8_SB(1, 0), b3); PG8_STAGE_B(PG8_SB(1, 1), b3 + hstep); PG8_STAGE_AN(PG8_SA(1, 0), k3, 0);
            PG8_WAIT_V(8); PG8_WAIT_L(0); PG8_BAR; PG8_MMA(1, 0, At, B0); PG8_MMA(1, 1, At, B1); PG8_BAR; PG8_SCHED;
        }
        if (wr == 0) PG8_BAR;
        if constexpr (FP8) {
            asm volatile("s_nop 15\n\ts_nop 7" ::: "memory");
#pragma unroll
            for (int a = 0; a < 2; ++a)
#pragma unroll
                for (int b = 0; b < 2; ++b)
#pragma unroll
                    for (int m = 0; m < 4; ++m) asm volatile("" : "+v"(acc[a][b][m][0]), "+v"(acc[a][b][m][1]));
        }
        E(acc, cur, wr, wc, fr, fq);
        if (!has_next) break;
        E.prefetch(nxt, wr, wc, fr, fq);
#pragma unroll
        for (int a = 0; a < 2; ++a)
#pragma unroll
            for (int b = 0; b < 2; ++b)
#pragma unroll
                for (int m = 0; m < 4; ++m)
#pragma unroll
                    for (int n = 0; n < 2; ++n) acc[a][b][m][n] = (f32x4){0.f, 0.f, 0.f, 0.f};
        cur = nxt; cA = nA; cB = nB; ++ui;
        if constexpr (Prob::GATHER) {
#pragma unroll
            for (int h = 0; h < 2; ++h)
#pragma unroll
                for (int i = 0; i < 2; ++i) cvA[h][i] = nvA[h][i];
        }
        if (wr == 1) { PG8_BAR; E.stage(cur, wc, fr, fq); }
    }
    PG8_WAIT_V(0);
    PG8_BAR;
#undef PG8_SA
#undef PG8_SB
#undef PG8_STAGE_AG
#undef PG8_STAGE_AD
#undef PG8_STAGE_AC
#undef PG8_STAGE_AN
#undef PG8_STAGE_B
#undef PG8_LDA
#undef PG8_LDB
#undef PG8_MMA
#undef PG8_CAT
#undef PG8_WAIT_V
#undef PG8_WAIT_L
#undef PG8_BAR
#undef PG8_SCHED
}

__device__ __forceinline__ void pair_store16(unsigned char* p, size_t r8, const u32x4& A, const u32x4& B) {
    u32x4 s1, s2;
    s1.x = __builtin_amdgcn_update_dpp(A.x, B.x, 0x128, 0xf, 0xc, false); s1.y = __builtin_amdgcn_update_dpp(A.y, B.y, 0x128, 0xf, 0xc, false);
    s1.z = __builtin_amdgcn_update_dpp(A.z, B.z, 0x128, 0xf, 0xc, false); s1.w = __builtin_amdgcn_update_dpp(A.w, B.w, 0x128, 0xf, 0xc, false);
    s2.x = __builtin_amdgcn_update_dpp(B.x, A.x, 0x128, 0xf, 0x3, false); s2.y = __builtin_amdgcn_update_dpp(B.y, A.y, 0x128, 0xf, 0x3, false);
    s2.z = __builtin_amdgcn_update_dpp(B.z, A.z, 0x128, 0xf, 0x3, false); s2.w = __builtin_amdgcn_update_dpp(B.w, A.w, 0x128, 0xf, 0x3, false);
    *(u32x4*)p = s1; *(u32x4*)(p + r8) = s2;
}
__device__ __forceinline__ u32x4 pack8(const f32x4& v0, const f32x4& v1) { u32x4 w; w.x = cvt_pk_bf16(v0[0], v0[1]); w.y = cvt_pk_bf16(v0[2], v0[3]); w.z = cvt_pk_bf16(v1[0], v1[1]); w.w = cvt_pk_bf16(v1[2], v1[3]); return w; }

struct EpiStoreOnly {
    bf16_t* O;
    __device__ __forceinline__ void prefetch(const Unit&, int, int, int, int) const {}
    __device__ __forceinline__ void stage(const Unit&, int, int, int) const {}
    __device__ __forceinline__ void operator()(f32x4 (&acc)[2][2][4][2], const Unit& u, int wr, int wc, int fr, int fq) const {
        const int cl0 = wc * 32 + 8 * fq; int row0 = u.pm * BM + wr * 64 + fr; asm volatile("" : "+v"(row0));
#pragma unroll
        for (int ai = 0; ai < 2; ++ai)
#pragma unroll
            for (int m = 0; m < 4; ++m) { bf16_t* rowp = O + (size_t)(row0 + ai * HALF + m * 16) * 256 + cl0;
#pragma unroll
                for (int bj = 0; bj < 2; ++bj) *(u32x4*)(rowp + bj * HALF) = pack8(acc[ai][bj][m][0], acc[ai][bj][m][1]); }
    }
};
#define EPI_ST(val, ptr) do { if constexpr (MODE == 1) { auto v_ = (val); asm volatile("" :: "v"(v_)); } else *(ptr) = (val); } while (0)
template <int MODE> struct EpiInProjT {
    bf16_t *UV, *Q, *Kb, *Vb; unsigned char* G8; const float* cs; unsigned char *Q8, *K8; LAS unsigned char* lds;
    __device__ __forceinline__ void prefetch(const Unit&, int, int, int, int) const {}
    __device__ __forceinline__ void stage(const Unit& u, int wc, int fr, int fq) const {
        if (u.pn >= 4 && u.pn < 8) { const float* src = cs + (size_t)(u.pm * BM + wc * 64) * 16 + (fq * 16 + fr) * 4;
#pragma unroll
            for (int i = 0; i < 4; ++i) __builtin_amdgcn_global_load_lds((const unsigned*)(src + i * 256), (LAS unsigned*)(lds + STAGE_BYTES + wc * 4096 + i * 1024), 16, 0, 0); } }
    template <class PT> __device__ __forceinline__ void st_pair(PT* p, int pitch, const u32x4& A, const u32x4& B) const {
        if constexpr (MODE == 1) { asm volatile("" :: "v"(A), "v"(B)); } else pair_store16((unsigned char*)p, (size_t)8 * pitch * sizeof(PT), A, B); }
    __device__ __forceinline__ void operator()(f32x4 (&acc)[2][2][4][2], const Unit& u, int wr, int wc, int fr, int fq) const {
        constexpr bool NOMATH = (MODE == 2);
        const int pn = u.pn; int row0 = u.pm * BM + wr * 64 + fr; asm volatile("" : "+v"(row0));
        int prow0 = row0 - (fr & 8), pcl = wc * 64 + 8 * fq + 4 * (fr & 8);
        asm volatile("" : "+v"(prow0), "+v"(pcl));
        if (pn < 4) {
#pragma unroll
            for (int ai = 0; ai < 2; ++ai)
#pragma unroll
                for (int m = 0; m < 4; ++m) { u32x4 w[2];
#pragma unroll
                    for (int bj = 0; bj < 2; ++bj) { f32x4 v0 = acc[ai][bj][m][0], v1 = acc[ai][bj][m][1];
                        if constexpr (!NOMATH) { const f32x2 a = gelu_tanh2(v0.xy), b = gelu_tanh2(v0.zw), c = gelu_tanh2(v1.xy), d = gelu_tanh2(v1.zw); v0 = (f32x4){a.x, a.y, b.x, b.y}; v1 = (f32x4){c.x, c.y, d.x, d.y}; }
                        w[bj] = pack8(v0, v1); }
                    st_pair(UV + (size_t)(prow0 + ai * HALF + m * 16) * 1024 + pn * 256 + pcl, 1024, w[0], w[1]); }
        } else if (pn < 8) {
            bf16_t* dst = (pn < 6) ? Q : Kb; const float sc = (pn < 6) ? C2 : 1.0f;
            const float sgn = (fq == 0) ? -1.0f : 1.0f; const bool rot_lane = fq < 2;
#pragma unroll
            for (int ai = 0; ai < 2; ++ai) {
                f32x4 cs4[4][4];
#pragma unroll
                for (int m = 0; m < 4; ++m) { const LAS f32x4* cp = (const LAS f32x4*)(lds + STAGE_BYTES + (wr * 64 + fr + ai * HALF + m * 16) * 64);
#pragma unroll
                    for (int j = 0; j < 4; ++j) cs4[m][j] = cp[j]; }
#pragma unroll
                for (int m = 0; m < 4; ++m) { const int row = row0 + ai * HALF + m * 16; f32x4 v[2][2];
#pragma unroll
                    for (int bj = 0; bj < 2; ++bj) { v[bj][0] = acc[ai][bj][m][0]; v[bj][1] = acc[ai][bj][m][1]; }
                    if constexpr (!NOMATH) {
                        f32x4 p0, p1;
#pragma unroll
                        for (int e = 0; e < 4; ++e) { p0[e] = __shfl_xor(v[0][0][e], 16); p1[e] = __shfl_xor(v[0][1][e], 16); }
                        if (rot_lane) {
#pragma unroll
                            for (int e = 0; e < 4; ++e) { v[0][0][e] = v[0][0][e] * cs4[m][0][e] + sgn * p0[e] * cs4[m][2][e]; v[0][1][e] = v[0][1][e] * cs4[m][1][e] + sgn * p1[e] * cs4[m][3][e]; }
                        }
                    }
                    if ((wc & 1) == 0) {
                        st_pair(dst + (size_t)(prow0 + ai * HALF + m * 16) * 512 + (pn & 1) * 256 + pcl, 512, pack8(v[0][0] * sc, v[0][1] * sc), pack8(v[1][0] * sc, v[1][1] * sc));
                    } else {
                        const float s8 = (pn < 6) ? sc * 8.0f : 1.0f;
#pragma unroll
                        for (int bj = 0; bj < 2; ++bj) { const f32x4 v0 = v[bj][0] * s8, v1 = v[bj][1] * s8;
                            u32x2 q8; q8.x = cvt_pk4_fp8(v0[0], v0[1], v0[2], v0[3]); q8.y = cvt_pk4_fp8(v1[0], v1[1], v1[2], v1[3]);
                            EPI_ST(q8, (u32x2*)(((pn < 6) ? Q8 : K8) + (size_t)row * 256 + ((pn & 1) * 2 + (wc >> 1)) * 64 + bj * 32 + 8 * fq)); } } }
            }
        } else if (pn < 10) {
#pragma unroll
            for (int ai = 0; ai < 2; ++ai)
#pragma unroll
                for (int m = 0; m < 4; ++m)
                    st_pair(Vb + (size_t)(prow0 + ai * HALF + m * 16) * 512 + (pn - 8) * 256 + pcl, 512, pack8(acc[ai][0][m][0], acc[ai][0][m][1]), pack8(acc[ai][1][m][0], acc[ai][1][m][1]));
        } else {
            int gl = (fq * 16 + fr) * 16; asm volatile("" : "+v"(gl));
            unsigned char* gb = G8 + (size_t)((u.pm * 8 + (pn - 10)) * 8 + wr * 4 + wc) * 8192 + gl;
#pragma unroll
            for (int ai = 0; ai < 2; ++ai)
#pragma unroll
                for (int m = 0; m < 4; ++m) { u32x4 qq;
#pragma unroll
                    for (int bj = 0; bj < 2; ++bj) { f32x4 v0 = acc[ai][bj][m][0], v1 = acc[ai][bj][m][1];
                        if constexpr (!NOMATH) { const f32x2 a = sig255_2(v0.xy), b = sig255_2(v0.zw), c = sig255_2(v1.xy), d = sig255_2(v1.zw); v0 = (f32x4){a.x, a.y, b.x, b.y}; v1 = (f32x4){c.x, c.y, d.x, d.y}; }
                        const unsigned qa = cvt_pk4_u8(v0[0], v0[1], v0[2], v0[3]), qb = cvt_pk4_u8(v1[0], v1[1], v1[2], v1[3]);
                        if (bj == 0) { qq.x = qa; qq.y = qb; } else { qq.z = qa; qq.w = qb; } }
                    EPI_ST(qq, (u32x4*)(gb + (ai * 4 + m) * 1024)); }
        }
    }
};

#undef EPI_ST
using EpiInProj = EpiInProjT<0>;
__device__ __forceinline__ void unpack8(const u32x4& w, f32x4& a, f32x4& b) { a = (f32x4){bf_lo(w.x), bf_hi(w.x), bf_lo(w.y), bf_hi(w.y)}; b = (f32x4){bf_lo(w.z), bf_hi(w.z), bf_lo(w.w), bf_hi(w.w)}; }
struct HookMerge {
    static constexpr int AT = 8;
    const unsigned char* G8;
    __device__ __forceinline__ void operator()(f32x4 (&acc)[2][2][4][2], const Unit& u, int wr, int wc, int fr, int fq) const {
        const unsigned char* gp = G8 + (size_t)((u.pm * 8 + u.pn) * 8 + wr * 4 + wc) * 8192 + ((fq >> 1) * 16 + fr) * 16 + 8 * (fq & 1); asm volatile("" : "+v"(gp));
        u32x2 w0[2][4][2], w1[2][4][2];
#pragma unroll
        for (int ai = 0; ai < 2; ++ai)
#pragma unroll
            for (int m = 0; m < 4; ++m)
#pragma unroll
                for (int bj = 0; bj < 2; ++bj) { w0[ai][m][bj] = *(const u32x2*)(gp + (ai * 4 + m) * 1024 + bj * 512); w1[ai][m][bj] = *(const u32x2*)(gp + 4 * 65536 + (ai * 4 + m) * 1024 + bj * 512); }
#pragma unroll
        for (int ai = 0; ai < 2; ++ai)
#pragma unroll
            for (int m = 0; m < 4; ++m)
#pragma unroll
                for (int bj = 0; bj < 2; ++bj) { const f32x4 a0 = u8x4_to_f32(w0[ai][m][bj].x), a1 = u8x4_to_f32(w0[ai][m][bj].y), b0 = u8x4_to_f32(w1[ai][m][bj].x), b1 = u8x4_to_f32(w1[ai][m][bj].y);
#pragma unroll
                    for (int e = 0; e < 4; ++e) { acc[ai][bj][m][0][e] *= a0[e] * fast_rcp(fmaxf(b0[e], 0.5f)); acc[ai][bj][m][1][e] *= a1[e] * fast_rcp(fmaxf(b1[e], 0.5f)); } }
    }
};
struct EpiMerge {
    const unsigned char* G8; bf16_t* MG;
    __device__ __forceinline__ void prefetch(const Unit&, int, int, int, int) const {}
    __device__ __forceinline__ void stage(const Unit&, int, int, int) const {}
    __device__ __forceinline__ void operator()(f32x4 (&acc)[2][2][4][2], const Unit& u, int wr, int wc, int fr, int fq) const {
        const unsigned char* gp = G8 + (size_t)((u.pm * 8 + u.pn + 4) * 8 + wr * 4 + wc) * 8192 + ((fq >> 1) * 16 + fr) * 16 + 8 * (fq & 1); asm volatile("" : "+v"(gp));
        int prow0 = u.pm * BM + wr * 64 + (fr & 7), pcol = u.pn * BM + wc * 64 + 8 * fq + 4 * (fr & 8); asm volatile("" : "+v"(prow0), "+v"(pcol));
        u32x2 w1[2][4][2];
#pragma unroll
        for (int ai = 0; ai < 2; ++ai)
#pragma unroll
            for (int m = 0; m < 4; ++m)
#pragma unroll
                for (int bj = 0; bj < 2; ++bj) w1[ai][m][bj] = *(const u32x2*)(gp + (ai * 4 + m) * 1024 + bj * 512);
        const float s255 = 1.0f / 255.0f;
#pragma unroll
        for (int ai = 0; ai < 2; ++ai)
#pragma unroll
            for (int m = 0; m < 4; ++m) { u32x4 w[2];
#pragma unroll
                for (int bj = 0; bj < 2; ++bj) { f32x4 b0 = u8x4_to_f32(w1[ai][m][bj].x), b1 = u8x4_to_f32(w1[ai][m][bj].y);
#pragma unroll
                    for (int e = 0; e < 4; ++e) { b0[e] = fmaxf(b0[e], 0.5f) * s255; b1[e] = fmaxf(b1[e], 0.5f) * s255; }
                    w[bj] = pack8(acc[ai][bj][m][0] * b0, acc[ai][bj][m][1] * b1); }
                pair_store16((unsigned char*)(MG + (size_t)(prow0 + ai * HALF + m * 16) * 1024 + pcol), (size_t)8 * 1024 * 2, w[0], w[1]); }
    }
};

struct EpiX1 {
    const float* X; bf16_t* XB; unsigned char* XB8; float* ssq;
    __device__ __forceinline__ void prefetch(const Unit&, int, int, int, int) const {}
    __device__ __forceinline__ void stage(const Unit&, int, int, int) const {}
    __device__ __forceinline__ void operator()(f32x4 (&acc)[2][2][4][2], const Unit& u, int wr, int wc, int fr, int fq) const {
        const int col0 = u.pn * BM + wc * 64 + 8 * fq; int row0 = u.pm * BM + wr * 64 + fr; asm volatile("" : "+v"(row0));
#pragma unroll
        for (int ai = 0; ai < 2; ++ai) {
            f32x4 xv[4][2][2];
#pragma unroll
            for (int m = 0; m < 4; ++m) { const float* xp = X + (size_t)(row0 + ai * HALF + m * 16) * 1024 + col0;
#pragma unroll
                for (int bj = 0; bj < 2; ++bj) { xv[m][bj][0] = *(const f32x4*)(xp + bj * 32); xv[m][bj][1] = *(const f32x4*)(xp + bj * 32 + 4); } }
#pragma unroll
            for (int m = 0; m < 4; ++m) { const size_t row = (size_t)(row0 + ai * HALF + m * 16); u32x4 wb[2];
                float s = 0.f;
#pragma unroll
                for (int bj = 0; bj < 2; ++bj) { const f32x4 v0 = acc[ai][bj][m][0] + xv[m][bj][0], v1 = acc[ai][bj][m][1] + xv[m][bj][1];
                    wb[bj] = pack8(v0, v1);
                    { u32x2 q8; q8.x = cvt_pk4_fp8(v0[0], v0[1], v0[2], v0[3]); q8.y = cvt_pk4_fp8(v1[0], v1[1], v1[2], v1[3]); *(u32x2*)(XB8 + row * 1024 + col0 + bj * 32) = q8; }
                    s += (v0[0] * v0[0] + v0[1] * v0[1]) + (v0[2] * v0[2] + v0[3] * v0[3]) + (v1[0] * v1[0] + v1[1] * v1[1]) + (v1[2] * v1[2] + v1[3] * v1[3]); }
                pair_store16((unsigned char*)(XB + (row - (fr & 8)) * 1024 + col0 + 4 * (fr & 8)), (size_t)8 * 1024 * 2, wb[0], wb[1]);
                s += __shfl_xor(s, 16); s += __shfl_xor(s, 32);
                if (fq == 0) ssq[row * 16 + u.pn * 4 + wc] = s; }
        }
    }
};

struct EpiMoeUp {
    const int* list; const float* rstd; unsigned char* H8;
    __device__ __forceinline__ void stage(const Unit&, int, int, int) const {}
    mutable float rs[2][4];
    __device__ __forceinline__ void prefetch(const Unit& u, int wr, int wc, int fr, int fq) const {
        int r0 = wr * 64 + fr; asm volatile("" : "+v"(r0));
        int tok[2][4]; unsigned w[2][4];
#pragma unroll
        for (int ai = 0; ai < 2; ++ai)
#pragma unroll
            for (int m = 0; m < 4; ++m) { const int r = r0 + ai * HALF + m * 16; w[ai][m] = (unsigned)list[u.lbase + ((r < u.nv) ? r : 0)]; }
#pragma unroll
        for (int ai = 0; ai < 2; ++ai) asm volatile("" : "+v"(w[ai][0]), "+v"(w[ai][1]), "+v"(w[ai][2]), "+v"(w[ai][3]));
#pragma unroll
        for (int ai = 0; ai < 2; ++ai)
#pragma unroll
            for (int m = 0; m < 4; ++m) { const int r = r0 + ai * HALF + m * 16; tok[ai][m] = (r < u.nv) ? (int)(w[ai][m] >> 16) : 0; }
#pragma unroll
        for (int ai = 0; ai < 2; ++ai)
#pragma unroll
            for (int m = 0; m < 4; ++m) rs[ai][m] = rstd[tok[ai][m]];
    }
    __device__ __forceinline__ void pin() const {
#pragma unroll
        for (int ai = 0; ai < 2; ++ai) asm volatile("" : "+v"(rs[ai][0]), "+v"(rs[ai][1]), "+v"(rs[ai][2]), "+v"(rs[ai][3])); }
    __device__ __forceinline__ void operator()(f32x4 (&acc)[2][2][4][2], const Unit& u, int wr, int wc, int fr, int fq) const {
        const int col0 = u.pn * 128 + wc * 32 + 8 * fq; int r0 = wr * 64 + fr; asm volatile("" : "+v"(r0));
#pragma unroll
        for (int ai = 0; ai < 2; ++ai)
#pragma unroll
            for (int m = 0; m < 4; ++m) { const int r = r0 + ai * HALF + m * 16; const float rsv = rs[ai][m] * 0.015625f;
                f32x4 g0 = acc[ai][0][m][0] * rsv, g1 = acc[ai][0][m][1] * rsv, u0 = acc[ai][1][m][0] * rsv, u1 = acc[ai][1][m][1] * rsv;
#pragma unroll
                for (int e = 0; e < 4; ++e) { g0[e] = g0[e] * sigmoidf_(g0[e]) * (u0[e] * 8.f); g1[e] = g1[e] * sigmoidf_(g1[e]) * (u1[e] * 8.f); }
                u32x2 q8; q8.x = cvt_pk4_fp8(g0[0], g0[1], g0[2], g0[3]); q8.y = cvt_pk4_fp8(g1[0], g1[1], g1[2], g1[3]);
                *(u32x2*)(H8 + (size_t)(u.pm * BM + r) * 512 + col0) = q8; }
    }
};
struct EpiMoeDown {
    const int* list; unsigned char* YB8;
    __device__ __forceinline__ void stage(const Unit&, int, int, int) const {}
    mutable unsigned lw[2][4];
    __device__ __forceinline__ void prefetch(const Unit& u, int wr, int wc, int fr, int fq) const {
        int r0 = wr * 64 + fr; asm volatile("" : "+v"(r0));
#pragma unroll
        for (int ai = 0; ai < 2; ++ai)
#pragma unroll
            for (int m = 0; m < 4; ++m) { const int r = r0 + ai * HALF + m * 16; lw[ai][m] = (unsigned)list[u.lbase + ((r < u.nv) ? r : 0)]; }
    }
    __device__ __forceinline__ void pin() const {
#pragma unroll
        for (int ai = 0; ai < 2; ++ai) asm volatile("" : "+v"(lw[ai][0]), "+v"(lw[ai][1]), "+v"(lw[ai][2]), "+v"(lw[ai][3])); }
    __device__ __forceinline__ void operator()(f32x4 (&acc)[2][2][4][2], const Unit& u, int wr, int wc, int fr, int fq) const {
        int r0 = wr * 64 + fr; asm volatile("" : "+v"(r0));
        const int col0 = u.pn * BM + wc * 64 + 16 * fq;
#pragma unroll
        for (int ai = 0; ai < 2; ++ai)
#pragma unroll
            for (int m = 0; m < 4; ++m) { const unsigned word = lw[ai][m];
                if (r0 + ai * HALF + m * 16 < u.nv) { const float w = __uint_as_float((word & 0x7fffu) << 16) * 0.0625f;
                    unsigned char* op = YB8 + (size_t)(word >> 15) * 1024 + col0; u32x4 q;
                    { const f32x4 y0 = acc[ai][0][m][0] * w, y1 = acc[ai][0][m][1] * w; q.x = cvt_pk4_fp8(y0[0], y0[1], y0[2], y0[3]); q.y = cvt_pk4_fp8(y1[0], y1[1], y1[2], y1[3]); }
                    { const f32x4 y0 = acc[ai][1][m][0] * w, y1 = acc[ai][1][m][1] * w; q.z = cvt_pk4_fp8(y0[0], y0[1], y0[2], y0[3]); q.w = cvt_pk4_fp8(y1[0], y1[1], y1[2], y1[3]); }
                    *(u32x4*)op = q; } }
    }
};
template <class Epi> struct HookPin { static constexpr int AT = 2; const Epi* E;
    __device__ __forceinline__ void operator()(f32x4 (&)[2][2][4][2], const Unit&, int, int, int, int) const { E->pin(); } };
}


namespace att {
constexpr int QB = 256, KVB = 64, QP = 512  ;
#if PROBE_PHASE == 52
#define ATT_REF_OFF 0.0f
#else
#define ATT_REF_OFF 0.0f
#endif
constexpr int KSLOT = 8192, VSLOT = 8192, NSLOT = 3;
constexpr int L_K = 0, L_V = NSLOT * KSLOT, L_WS = L_V + NSLOT * VSLOT, L_OST = L_WS + NWAVES * 256, L_END = L_OST + NWAVES * 8192;
static_assert(L_END <= RING_BYTES, "attention LDS");
#if PROBE_PHASE == 40
#define ATT_RESC_THR 0.f
#define ATT_RESC_MIN 0.001f
#define ATT_RESC_LO -2.f
#else
#define ATT_RESC_THR 512.f
#define ATT_RESC_MIN 64.f
#define ATT_RESC_LO 0.f
#endif
__device__ __forceinline__ int crow(int r, int hi) { return (r & 3) + 8 * (r >> 2) + 4 * hi; }
__device__ __forceinline__ void glds16(const void* gsrc, unsigned lds_dst) { unsigned keep;
    asm volatile("s_mov_b32 %0, m0\n\ts_mov_b32 m0, %2\n\ts_nop 0\n\tglobal_load_lds_dwordx4 %1, off\n\ts_mov_b32 m0, %0" : "=&s"(keep) : "v"(gsrc), "s"(lds_dst) : "memory"); }
#define ATT_WAIT_BAR(N) asm volatile("s_waitcnt vmcnt(" #N ") lgkmcnt(0)\n\ts_barrier" ::: "memory")
#define MX3(a, b, c) __builtin_fmaxf(__builtin_fmaxf((a), (b)), (c))
#define ATT_SBAR() __builtin_amdgcn_sched_barrier(0)
#define ATT_MFMA(a, b, c) __builtin_amdgcn_mfma_f32_32x32x16_bf16(a, b, c, 0, 0, 0)
__device__ __forceinline__ float rowmax(const f32x16& p0, const f32x16& p1) {
    float a = MX3(p0[0], p0[1], p1[0]), b = MX3(p0[2], p0[3], p1[1]); a = MX3(a, p1[2], p1[3]);
#pragma unroll
    for (int r = 4; r < 16; r += 4) { a = MX3(a, p0[r], p0[r + 1]); b = MX3(b, p0[r + 2], p0[r + 3]); a = MX3(a, p1[r], p1[r + 1]); b = MX3(b, p1[r + 2], p1[r + 3]); }
    const float m = __builtin_fmaxf(a, b); auto rr = __builtin_amdgcn_permlane32_swap(__float_as_uint(m), __float_as_uint(m), false, false);
    return __builtin_fmaxf(__uint_as_float(rr[0]), __uint_as_float(rr[1])); }
__device__ __forceinline__ void cmask(f32x16& p0, f32x16& p1, int jb, int qrel, int hi) {
    const int kb = 64 * jb + 4 * hi;
#pragma unroll
    for (int r = 0; r < 16; ++r) { const int kv = kb + (r & 3) + 8 * (r >> 2); if (kv > qrel) p0[r] = -INFINITY; if (kv + 32 > qrel) p1[r] = -INFINITY; } }
typedef int i32x4 __attribute__((ext_vector_type(4)));
__device__ __forceinline__ void kload2(bf16x8* kf, const LAS char* kp, int j) { kf[2 * j] = *(const LAS bf16x8*)(kp + j * 2048); kf[2 * j + 1] = *(const LAS bf16x8*)(kp + j * 2048 + 512); }
__device__ __forceinline__ i32x8 frag32(const LAS char* row, int c0) {
    const i32x4 lo = *(const LAS i32x4*)(row + c0 * 16), hi = *(const LAS i32x4*)(row + (c0 ^ 1) * 16);
    return __builtin_shufflevector(lo, hi, 0, 1, 2, 3, 4, 5, 6, 7); }
#define MFMA8_PV(O, A, B) asm volatile("v_mfma_scale_f32_32x32x64_f8f6f4 %0, %1, %2, %0, %3, %3 op_sel_hi:[0,0,0]" : "+v"(O) : "v"(A), "v"(B), "v"(sc_1))
template <int MODE> __device__ __forceinline__ void attn_pass(f32x16 (&o)[4], int b, int hm, int h, int qb, const bf16_t* Q, const bf16_t* __restrict__ K, const unsigned char* __restrict__ V8T, LAS char* shm) {
    const int tid = opaque_tid(), lane = tid & 63, r32 = lane & 31, hi = lane >> 5; const int wid = __builtin_amdgcn_readfirstlane(tid >> 6);
    const long rowbase = (long)b * SEQ; const int q0 = qb * QB, NT = (q0 + QB) / KVB;
    const bf16_t* Qw = Q + (rowbase + q0 + wid * 32) * QP + hm * 64;
    const bf16_t* Kh = K + rowbase * QP + hm * 64;
    const unsigned lds0 = (unsigned)(uintptr_t)shm;
    LAS float* wsf = (LAS float*)(shm + L_WS) + wid * 64;
    const bf16_t* ksrc = Kh + (long)lane * QP + wid * 8;
    const unsigned char* vsrc = V8T + ((size_t)(b * 4 + h) * (SEQ / KVB)) * VSLOT + wid * 1024 + lane * 16;
    const unsigned kdst = lds0 + L_K + wid * 1024, vdst = lds0 + L_V + wid * 1024;
#define DMA_K(t, s) glds16(ksrc + (long)(t) * KVB * QP, (unsigned)__builtin_amdgcn_readfirstlane(kdst + (unsigned)(s) * KSLOT))
#define DMA_V(t, s) glds16(vsrc + (long)(t) * VSLOT, (unsigned)__builtin_amdgcn_readfirstlane(vdst + (unsigned)(s) * VSLOT))
    const LAS char* kp0 = shm + L_K + hi * 1024 + r32 * 16;
    const LAS char* vp0 = shm + L_V + r32 * 64;  const int vc0 = (2 * hi) ^ ((r32 >> 2) & 3);
    DMA_K(0, 0); DMA_V(0, 0); DMA_K(1, 1);
    bf16x8 qr[4];
#pragma unroll
    for (int d0 = 0; d0 < 4; ++d0) qr[d0] = *(const bf16x8*)(Qw + (long)r32 * QP + d0 * 16 + hi * 8);
    float mhat = 0.f, l_reg = 0.f;
    float zf = 0.f; asm volatile("" : "+v"(zf));
    int sc_1 = 0x7f7f7f7f; asm volatile("" : "+v"(sc_1));
    f32x16 negm;
#pragma unroll
    for (int r = 0; r < 16; ++r) { negm[r] = zf;
#pragma unroll
        for (int d0 = 0; d0 < 4; ++d0) o[d0][r] = zf; }
    asm volatile("" : "+v"(negm));
    const int qrel = wid * 32 + r32;
    asm volatile("" : "+v"(qr[0]), "+v"(qr[1]), "+v"(qr[2]), "+v"(qr[3]));
    LAS bf16x8* qlds = (LAS bf16x8*)(shm + L_OST + wid * 8192) + lane;
#pragma unroll
    for (int d0 = 0; d0 < 4; ++d0) qlds[d0 * 64] = qr[d0];
    DMA_K(2, 2);
    ATT_WAIT_BAR(1);
    bool resc = false;
#define CMASK(P0, P1, t) do { const int jb_ = (t) - (NT - 4); if (jb_ >= 0) cmask(P0, P1, jb_, qrel, hi); } while (0)
#define RESC() do { if (resc) { asm volatile("s_waitcnt lgkmcnt(0)\n\ts_nop 15\n\ts_nop 15\n\ts_nop 7" ::: "memory"); \
        _Pragma("unroll") for (int r = 0; r < 16; ++r) { const float fr_ = wsf[crow(r, hi)]; _Pragma("unroll") for (int d_ = 0; d_ < 4; ++d_) asm volatile("v_mul_f32 %0, %0, %1" : "+v"(o[d_][r]) : "v"(fr_)); } } } while (0)
    f32x16 pA0, pA1, pB0, pB1;
    int sl_prev = 0, sl_cur = 0, sl_next = 1;
#define ROT() do { sl_prev = sl_cur; sl_cur = sl_next; sl_next = (sl_next == NSLOT - 1) ? 0 : sl_next + 1; } while (0)
    bf16x8 kf[8];
#pragma unroll
    for (int j = 0; j < 4; ++j) kload2(kf, kp0, j);
    pA0 = ATT_MFMA(kf[0], qr[0], negm); pA1 = ATT_MFMA(kf[1], qr[0], negm);
#pragma unroll
    for (int d0 = 1; d0 < 4; ++d0) { pA0 = ATT_MFMA(kf[2 * d0], qr[d0], pA0); pA1 = ATT_MFMA(kf[2 * d0 + 1], qr[d0], pA1); }
    CMASK(pA0, pA1, 0);
    { const float rm = rowmax(pA0, pA1) - ATT_REF_OFF; mhat = rm;
#pragma unroll
      for (int r = 0; r < 16; ++r) { pA0[r] -= rm; pA1[r] -= rm; negm[r] = -rm; }
      asm volatile("" : "+v"(negm));
#pragma unroll
      for (int r = 0; r < 16; ++r) { pA0[r] = fast_exp2(pA0[r]); pA1[r] = fast_exp2(pA1[r]); } }
    ATT_WAIT_BAR(0);
    DMA_K(3, 0); DMA_V(1, 1);
    ROT();
#pragma unroll
    for (int j = 0; j < 4; ++j) kload2(kf, kp0 + sl_cur * KSLOT, j);
    ATT_WAIT_BAR(2);
    i32x8 vf[4], pf;
#define PK4(P, B) cvt_pk4_fp8(P[B], P[(B) + 1], P[(B) + 2], P[(B) + 3])
#define PIN(x) asm volatile("" : "+v"(x))
#define GAPA(MF, P, B, W) do { MF; sacc += P[B]; sacc += P[(B) + 1]; sacc += P[(B) + 2]; sacc += P[(B) + 3]; PIN(sacc); pf[W] = PK4(P, B); PIN(pf); ATT_SBAR(); } while (0)
#define EXP8(X, B) do { X[B] = fast_exp2(X[B]); X[(B) + 1] = fast_exp2(X[(B) + 1]); X[(B) + 2] = fast_exp2(X[(B) + 2]); X[(B) + 3] = fast_exp2(X[(B) + 3]); \
        X[(B) + 4] = fast_exp2(X[(B) + 4]); X[(B) + 5] = fast_exp2(X[(B) + 5]); X[(B) + 6] = fast_exp2(X[(B) + 6]); X[(B) + 7] = fast_exp2(X[(B) + 7]); PIN(X); } while (0)
#define STEP(C0, C1, P0, P1, t, GK, GV, GL) do { ATT_SBAR(); \
    const LAS char* vp_ = vp0 + sl_prev * VSLOT; \
    float sacc = 0.f; \
    bf16x8 qa_ = qlds[0], qb_ = qlds[64]; ATT_SBAR(); \
    GAPA(C0 = ATT_MFMA(kf[0], qa_, negm), P0, 0, 0); \
    GAPA(C1 = ATT_MFMA(kf[1], qa_, negm), P0, 4, 1); \
    qa_ = qlds[128]; ATT_SBAR(); \
    GAPA(C0 = ATT_MFMA(kf[2], qb_, C0), P0, 8, 2); \
    GAPA(C1 = ATT_MFMA(kf[3], qb_, C1), P0, 12, 3); \
    qb_ = qlds[192]; ATT_SBAR(); \
    vf[0] = frag32(vp_, vc0); ATT_SBAR(); GAPA(C0 = ATT_MFMA(kf[4], qa_, C0), P1, 0, 4); \
    vf[1] = frag32(vp_ + 32 * 64, vc0); ATT_SBAR(); GAPA(C1 = ATT_MFMA(kf[5], qa_, C1), P1, 4, 5); \
    vf[2] = frag32(vp_ + 64 * 64, vc0); ATT_SBAR(); GAPA(C0 = ATT_MFMA(kf[6], qb_, C0), P1, 8, 6); \
    vf[3] = frag32(vp_ + 96 * 64, vc0); ATT_SBAR(); GAPA(C1 = ATT_MFMA(kf[7], qb_, C1), P1, 12, 7); \
    l_reg += sacc; \
    if (GK) { DMA_K((t) + 3, sl_cur); } if (GV) { DMA_V((t) + 1, sl_next); } \
    CMASK(C0, C1, t); \
    {   \
      float st_; { auto rr = __builtin_amdgcn_permlane32_swap(__float_as_uint(sacc), __float_as_uint(sacc), false, false); st_ = __uint_as_float(rr[0]) + __uint_as_float(rr[1]); } \
      resc = false; \
      if (__builtin_expect(__any(st_ > ATT_RESC_THR), 0)) { const float dl = (st_ > ATT_RESC_MIN) ? __builtin_fmaxf(__builtin_floorf(__builtin_amdgcn_logf(st_)) - 6.f, ATT_RESC_LO) : 0.f; mhat += dl; \
        _Pragma("unroll") for (int r = 0; r < 16; ++r) { asm volatile("v_sub_f32 %0, %0, %1" : "+v"(C0[r]) : "v"(dl)); asm volatile("v_sub_f32 %0, %0, %1" : "+v"(C1[r]) : "v"(dl)); } \
        _Pragma("unroll") for (int r = 0; r < 16; ++r) negm[r] = -mhat; asm volatile("" : "+v"(negm)); \
        const float f = fast_exp2(-dl); l_reg *= f; if (hi == 0) wsf[r32] = f; resc = true; } } \
    ATT_SBAR(); \
    MFMA8_PV(o[0], pf, vf[0]); EXP8(C0, 0); if (GL) { kload2(kf, kp0 + sl_next * KSLOT, 0); } ATT_SBAR(); \
    MFMA8_PV(o[1], pf, vf[1]); EXP8(C0, 8); if (GL) { kload2(kf, kp0 + sl_next * KSLOT, 1); } ATT_SBAR(); \
    MFMA8_PV(o[2], pf, vf[2]); EXP8(C1, 0); if (GL) { kload2(kf, kp0 + sl_next * KSLOT, 2); } ATT_SBAR(); \
    MFMA8_PV(o[3], pf, vf[3]); EXP8(C1, 8); if (GL) { kload2(kf, kp0 + sl_next * KSLOT, 3); } ATT_SBAR(); \
    } while (0)
    int t = 1;
#undef CMASK
#define CMASK(P0, P1, t) do {} while (0)
    for (; t + 5 < NT; t += 2) {
        STEP(pB0, pB1, pA0, pA1, t, true, true, true);       if (MODE == 3) { asm volatile("s_waitcnt lgkmcnt(0)" ::: "memory"); } else { ATT_WAIT_BAR(2); } RESC(); ROT();
        STEP(pA0, pA1, pB0, pB1, t + 1, true, true, true);   if (MODE == 3) { asm volatile("s_waitcnt lgkmcnt(0)" ::: "memory"); } else { ATT_WAIT_BAR(2); } RESC(); ROT();
    }
#undef CMASK
#define CMASK(P0, P1, t) do { const int jb_ = (t) - (NT - 4); if (jb_ >= 0) cmask(P0, P1, jb_, qrel, hi); } while (0)
#define ENDW(tt) do { if ((tt) + 3 < NT) { ATT_WAIT_BAR(2); } else if ((tt) + 2 < NT) { ATT_WAIT_BAR(1); } else { ATT_WAIT_BAR(0); } } while (0)
    for (; t + 1 < NT; t += 2) {
        STEP(pB0, pB1, pA0, pA1, t, (t + 3 < NT), (t + 1 < NT), (t + 1 < NT));       ENDW(t);     RESC(); ROT();
        STEP(pA0, pA1, pB0, pB1, t + 1, (t + 4 < NT), (t + 2 < NT), (t + 2 < NT));   ENDW(t + 1); RESC(); ROT();
    }
    STEP(pB0, pB1, pA0, pA1, NT - 1, false, false, false); RESC();
    { float sacc = 0.f;
#pragma unroll
      for (int r = 0; r < 16; ++r) sacc += pB0[r] + pB1[r];
      l_reg += sacc;
      pf[0] = PK4(pB0, 0); pf[1] = PK4(pB0, 4); pf[2] = PK4(pB0, 8); pf[3] = PK4(pB0, 12); pf[4] = PK4(pB1, 0); pf[5] = PK4(pB1, 4); pf[6] = PK4(pB1, 8); pf[7] = PK4(pB1, 12);
      const LAS char* vp_ = vp0 + sl_cur * VSLOT;
      vf[0] = frag32(vp_, vc0); vf[1] = frag32(vp_ + 32 * 64, vc0); vf[2] = frag32(vp_ + 64 * 64, vc0); vf[3] = frag32(vp_ + 96 * 64, vc0);
      asm volatile("s_nop 3" : "+v"(pf));
      MFMA8_PV(o[0], pf, vf[0]); MFMA8_PV(o[1], pf, vf[1]); MFMA8_PV(o[2], pf, vf[2]); MFMA8_PV(o[3], pf, vf[3]);
      asm volatile("s_nop 15\n\ts_nop 15\n\ts_nop 7" : "+v"(o[0]), "+v"(o[1]), "+v"(o[2]), "+v"(o[3])); }
#undef PK4
#undef PIN
#undef GAPA
#undef EXP8
#undef STEP
#undef ENDW
#undef CMASK
#undef RESC
#undef ROT
    { auto rr = __builtin_amdgcn_permlane32_swap(__float_as_uint(l_reg), __float_as_uint(l_reg), false, false); l_reg = __uint_as_float(rr[0]) + __uint_as_float(rr[1]); }
    if (hi == 0) wsf[32 + r32] = l_reg;
    asm volatile("s_waitcnt lgkmcnt(0)" ::: "memory");
#pragma unroll
    for (int r = 0; r < 16; ++r) { const float rl = fast_rcp(wsf[32 + crow(r, hi)]);
#pragma unroll
        for (int d0 = 0; d0 < 4; ++d0) o[d0][r] *= rl; }
    asm volatile("s_waitcnt lgkmcnt(0)" ::: "memory");
#undef DMA_K
#undef DMA_V
}

constexpr int KSLOT8 = 4096, QP8 = 256  ;
constexpr int L_V8 = NSLOT * KSLOT8, L_WS8 = L_V8 + NSLOT * VSLOT;
static_assert(L_WS8 + NWAVES * 256 <= L_OST, "fp8 pass LDS");
#define MFMA8_QK(C, A, B) asm volatile("v_mfma_scale_f32_32x32x64_f8f6f4 %0, %1, %2, %3, %4, %5 op_sel_hi:[0,0,0]" : "=&v"(C) : "v"(A), "v"(B), "v"(negm), "v"(sc_k), "v"(sc_q))
#define MFMA8_PV8(O, A, B) asm volatile("v_mfma_scale_f32_32x32x64_f8f6f4 %0, %1, %2, %0, %3, %3 op_sel_hi:[0,0,0]" : "+v"(O) : "v"(A), "v"(B), "v"(sc_k))
template <int MODE> __device__ __forceinline__ void attn_pass8(f32x16 (&o)[4], int b, int hm, int h, int qb, const unsigned char* Q8, const unsigned char* __restrict__ K8, const unsigned char* __restrict__ V8T, LAS char* shm) {
    const int tid = opaque_tid(), lane = tid & 63, r32 = lane & 31, hi = lane >> 5; const int wid = __builtin_amdgcn_readfirstlane(tid >> 6);
    const long rowbase = (long)b * SEQ; const int q0 = qb * QB, NT = (q0 + QB) / KVB;
    const unsigned lds0 = (unsigned)(uintptr_t)shm;
    LAS float* wsf = (LAS float*)(shm + L_WS8) + wid * 64;
    const int kkey = (wid & 3) * 16 + (lane >> 2);
    const unsigned char* ksrc = K8 + (rowbase + kkey) * QP8 + h * 64 + (((lane & 3) ^ ((kkey >> 2) & 3)) * 16);
    const unsigned char* vsrc = V8T + ((size_t)(b * 4 + h) * (SEQ / KVB)) * VSLOT + wid * 1024 + lane * 16;
    const unsigned kdst = lds0 + L_K + (wid & 3) * 1024, vdst = lds0 + L_V8 + wid * 1024;
#define DMA_K(t, s) glds16(ksrc + (long)(t) * KVB * QP8, (unsigned)__builtin_amdgcn_readfirstlane(kdst + (unsigned)(s) * KSLOT8))
#define DMA_V(t, s) glds16(vsrc + (long)(t) * VSLOT, (unsigned)__builtin_amdgcn_readfirstlane(vdst + (unsigned)(s) * VSLOT))
    const int sw = (r32 >> 2) & 3;
    const LAS char* kp0 = shm + L_K + r32 * 64;  const int kc0 = (2 * hi) ^ sw;
    const LAS char* vp0 = shm + L_V8 + r32 * 64;  const int vc0 = (2 * hi) ^ sw;
    DMA_K(0, 0); DMA_V(0, 0); DMA_K(1, 1);
    i32x8 qf;
    { const unsigned char* qp = Q8 + (rowbase + q0 + wid * 32 + r32) * QP8 + h * 64 + hi * 32; const i32x4 lo = *(const i32x4*)qp, hi4 = *(const i32x4*)(qp + 16); qf = __builtin_shufflevector(lo, hi4, 0, 1, 2, 3, 4, 5, 6, 7); }
    float mhat = 0.f;
    f32x16 ol;
    float zf = 0.f; asm volatile("" : "+v"(zf));
    int sc_k = 0x7f7f7f7f, sc_q = 0x7c7c7c7c; asm volatile("" : "+v"(sc_k), "+v"(sc_q));
    f32x16 negm;
#pragma unroll
    for (int r = 0; r < 16; ++r) { negm[r] = zf;
#pragma unroll
        for (int d0 = 0; d0 < 4; ++d0) o[d0][r] = zf;
        ol[r] = zf; }
    i32x8 ones8; { int o1 = 0x38383838; asm volatile("" : "+v"(o1)); ones8 = (i32x8){o1, o1, o1, o1, o1, o1, o1, o1}; }
    asm volatile("" : "+v"(negm));
    const int qrel = wid * 32 + r32;
    asm volatile("" : "+v"(qf));
    DMA_K(2, 2);
    ATT_WAIT_BAR(1);
    bool resc = false;
#define CMASK(P0, P1, t) do { const int jb_ = (t) - (NT - 4); if (jb_ >= 0) cmask(P0, P1, jb_, qrel, hi); } while (0)
#define RESC() do { if (resc) { asm volatile("s_waitcnt lgkmcnt(0)\n\ts_nop 15\n\ts_nop 7" ::: "memory"); \
        _Pragma("unroll") for (int r = 0; r < 16; ++r) { const float fr_ = wsf[crow(r, hi)]; _Pragma("unroll") for (int d_ = 0; d_ < 4; ++d_) asm volatile("v_mul_f32 %0, %0, %1" : "+v"(o[d_][r]) : "v"(fr_)); asm volatile("v_mul_f32 %0, %0, %1" : "+v"(ol[r]) : "v"(fr_)); } } } while (0)
    f32x16 pA0, pA1, pB0, pB1;
    int sl_prev = 0, sl_cur = 0, sl_next = 1;
#define ROT() do { sl_prev = sl_cur; sl_cur = sl_next; sl_next = (sl_next == NSLOT - 1) ? 0 : sl_next + 1; } while (0)
    i32x8 kf0, kf1;
    kf0 = frag32(kp0, kc0); kf1 = frag32(kp0 + 32 * 64, kc0);
    MFMA8_QK(pA0, kf0, qf); MFMA8_QK(pA1, kf1, qf);
    asm volatile("s_nop 15\n\ts_nop 15\n\ts_nop 7" : "+v"(pA0), "+v"(pA1));
    CMASK(pA0, pA1, 0);
    { const float rm = rowmax(pA0, pA1) - ATT_REF_OFF; mhat = rm;
#pragma unroll
      for (int r = 0; r < 16; ++r) { pA0[r] -= rm; pA1[r] -= rm; negm[r] = -rm; }
      asm volatile("" : "+v"(negm));
#pragma unroll
      for (int r = 0; r < 16; ++r) { pA0[r] = fast_exp2(pA0[r]); pA1[r] = fast_exp2(pA1[r]); } }
    ATT_WAIT_BAR(0);
    DMA_K(3, 0); DMA_V(1, 1);
    ROT();
    kf0 = frag32(kp0 + sl_cur * KSLOT8, kc0); kf1 = frag32(kp0 + sl_cur * KSLOT8 + 32 * 64, kc0);
    ATT_WAIT_BAR(2);
    i32x8 vf[4], pf;
#define PK4(P, B) cvt_pk4_fp8(P[B], P[(B) + 1], P[(B) + 2], P[(B) + 3])
#define PIN(x) asm volatile("" : "+v"(x))
#define SUM8(P, B) do { sacc += P[B]; sacc += P[(B) + 1]; sacc += P[(B) + 2]; sacc += P[(B) + 3]; sacc += P[(B) + 4]; sacc += P[(B) + 5]; sacc += P[(B) + 6]; sacc += P[(B) + 7]; PIN(sacc); } while (0)
#define EXP8(X, B) do { X[B] = fast_exp2(X[B]); X[(B) + 1] = fast_exp2(X[(B) + 1]); X[(B) + 2] = fast_exp2(X[(B) + 2]); X[(B) + 3] = fast_exp2(X[(B) + 3]); \
        X[(B) + 4] = fast_exp2(X[(B) + 4]); X[(B) + 5] = fast_exp2(X[(B) + 5]); X[(B) + 6] = fast_exp2(X[(B) + 6]); X[(B) + 7] = fast_exp2(X[(B) + 7]); PIN(X); } while (0)
#define STEP(C0, C1, P0, P1, t, GK, GV, GL) do { ATT_SBAR(); \
    const LAS char* vp_ = vp0 + sl_prev * VSLOT; \
    const bool det_ = (((t) & 3) == 1);            \
    float sacc = 0.f; \
    MFMA8_QK(C0, kf0, qf); \
    if (det_) { SUM8(P0, 0); SUM8(P0, 8); } \
    pf[0] = PK4(P0, 0); pf[1] = PK4(P0, 4); pf[2] = PK4(P0, 8); pf[3] = PK4(P0, 12); PIN(pf); \
    vf[0] = frag32(vp_, vc0); vf[1] = frag32(vp_ + 32 * 64, vc0); ATT_SBAR(); \
    MFMA8_QK(C1, kf1, qf); \
    if (det_) { SUM8(P1, 0); SUM8(P1, 8); } \
    pf[4] = PK4(P1, 0); pf[5] = PK4(P1, 4); pf[6] = PK4(P1, 8); pf[7] = PK4(P1, 12); PIN(pf); \
    vf[2] = frag32(vp_ + 64 * 64, vc0); vf[3] = frag32(vp_ + 96 * 64, vc0); ATT_SBAR(); \
    if (GK) { DMA_K((t) + 3, sl_cur); } if (GV) { DMA_V((t) + 1, sl_next); } \
    {   \
      float st_; { auto rr = __builtin_amdgcn_permlane32_swap(__float_as_uint(sacc), __float_as_uint(sacc), false, false); st_ = __uint_as_float(rr[0]) + __uint_as_float(rr[1]); } \
      resc = false; \
      if (__builtin_expect(det_ && __any(st_ > ATT_RESC_THR), 0)) { const float dl = (st_ > ATT_RESC_MIN) ? __builtin_fmaxf(__builtin_floorf(__builtin_amdgcn_logf(st_)) - 6.f, ATT_RESC_LO) : 0.f; mhat += dl; \
        asm volatile("s_nop 15\n\ts_nop 15" ::: "memory"); \
        _Pragma("unroll") for (int r = 0; r < 16; ++r) { asm volatile("v_sub_f32 %0, %0, %1" : "+v"(C0[r]) : "v"(dl)); asm volatile("v_sub_f32 %0, %0, %1" : "+v"(C1[r]) : "v"(dl)); } \
        _Pragma("unroll") for (int r = 0; r < 16; ++r) negm[r] = -mhat; asm volatile("" : "+v"(negm)); \
        const float f = fast_exp2(-dl); if (hi == 0) wsf[r32] = f; resc = true; } } \
    asm volatile("s_nop 7" : "+v"(C0), "+v"(C1)); CMASK(C0, C1, t); \
    ATT_SBAR(); \
    MFMA8_PV8(o[0], pf, vf[0]); EXP8(C0, 0); if (GL) kf0 = frag32(kp0 + sl_next * KSLOT8, kc0); ATT_SBAR(); \
    MFMA8_PV8(o[1], pf, vf[1]); EXP8(C0, 8); ATT_SBAR(); \
    MFMA8_PV8(o[2], pf, vf[2]); EXP8(C1, 0); if (GL) kf1 = frag32(kp0 + sl_next * KSLOT8 + 32 * 64, kc0); ATT_SBAR(); \
    MFMA8_PV8(o[3], pf, vf[3]); EXP8(C1, 8); ATT_SBAR(); \
    MFMA8_PV8(ol, pf, ones8); ATT_SBAR(); \
    } while (0)
    int t = 1;
#undef CMASK
#define CMASK(P0, P1, t) do {} while (0)
    for (; t + 5 < NT; t += 2) {
        STEP(pB0, pB1, pA0, pA1, t, true, true, true);       ATT_WAIT_BAR(2); RESC(); ROT();
        STEP(pA0, pA1, pB0, pB1, t + 1, true, true, true);   ATT_WAIT_BAR(2); RESC(); ROT();
    }
#undef CMASK
#define CMASK(P0, P1, t) do { const int jb_ = (t) - (NT - 4); if (jb_ >= 0) cmask(P0, P1, jb_, qrel, hi); } while (0)
#define ENDW(tt) do { if ((tt) + 3 < NT) { ATT_WAIT_BAR(2); } else if ((tt) + 2 < NT) { ATT_WAIT_BAR(1); } else { ATT_WAIT_BAR(0); } } while (0)
    for (; t + 1 < NT; t += 2) {
        STEP(pB0, pB1, pA0, pA1, t, (t + 3 < NT), (t + 1 < NT), (t + 1 < NT));       ENDW(t);     RESC(); ROT();
        STEP(pA0, pA1, pB0, pB1, t + 1, (t + 4 < NT), (t + 2 < NT), (t + 2 < NT));   ENDW(t + 1); RESC(); ROT();
    }
    STEP(pB0, pB1, pA0, pA1, NT - 1, false, false, false); RESC();
    {
      pf[0] = PK4(pB0, 0); pf[1] = PK4(pB0, 4); pf[2] = PK4(pB0, 8); pf[3] = PK4(pB0, 12); pf[4] = PK4(pB1, 0); pf[5] = PK4(pB1, 4); pf[6] = PK4(pB1, 8); pf[7] = PK4(pB1, 12);
      const LAS char* vp_ = vp0 + sl_cur * VSLOT;
      vf[0] = frag32(vp_, vc0); vf[1] = frag32(vp_ + 32 * 64, vc0); vf[2] = frag32(vp_ + 64 * 64, vc0); vf[3] = frag32(vp_ + 96 * 64, vc0);
      asm volatile("s_nop 3" : "+v"(pf));
      MFMA8_PV8(o[0], pf, vf[0]); MFMA8_PV8(o[1], pf, vf[1]); MFMA8_PV8(o[2], pf, vf[2]); MFMA8_PV8(o[3], pf, vf[3]); MFMA8_PV8(ol, pf, ones8);
      asm volatile("s_nop 15\n\ts_nop 15\n\ts_nop 7" : "+v"(o[0]), "+v"(o[1]), "+v"(o[2]), "+v"(o[3]), "+v"(ol)); }
#undef PK4
#undef PIN
#undef SUM8
#undef EXP8
#undef STEP
#undef ENDW
#undef CMASK
#undef RESC
#undef ROT
#pragma unroll
    for (int r = 0; r < 16; ++r) { const float rl = fast_rcp(ol[r]);
#pragma unroll
        for (int d0 = 0; d0 < 4; ++d0) o[d0][r] *= rl; }
#undef DMA_K
#undef DMA_V
}

template <int MODE> __device__ __forceinline__ void attn_unit(int b, int h, int qb, const bf16_t* Q, const bf16_t* K, const unsigned char* Q8, const unsigned char* K8, const unsigned char* V, bf16_t* YAB, float* park, float lam, const float* subg, LAS char* shm) {
    const int tid = opaque_tid(), lane = tid & 63, r32 = lane & 31, hi = lane >> 5; const int wid = __builtin_amdgcn_readfirstlane(tid >> 6);
    for (int m = 0; m < 2; ++m) {
        f32x16 o[4];
        if (m == 0) attn_pass<MODE>(o, b, 2 * h, h, qb, Q, K, V, shm);
        else attn_pass8<MODE>(o, b, 2 * h + 1, h, qb, Q8, K8, V, shm);
        int lo_ = lane; asm volatile("" : "+v"(lo_));
        f32x4* pk = (f32x4*)park + (size_t)wid * 1024 + lo_;
        if (m == 0) {
#pragma unroll
            for (int d0 = 0; d0 < 4; ++d0)
#pragma unroll
                for (int j = 0; j < 4; ++j) pk[(d0 * 4 + j) * 64] = (f32x4){o[d0][4 * j], o[d0][4 * j + 1], o[d0][4 * j + 2], o[d0][4 * j + 3]};
        } else {
            float ss[16];
#pragma unroll
            for (int r = 0; r < 16; ++r) ss[r] = 0.f;
            f32x4 pa[16];
#pragma unroll
            for (int i = 0; i < 16; ++i) pa[i] = pk[i * 64];
#pragma unroll
            for (int i = 0; i < 16; i += 4) asm volatile("" : "+v"(pa[i]), "+v"(pa[i + 1]), "+v"(pa[i + 2]), "+v"(pa[i + 3]));
#pragma unroll
            for (int d0 = 0; d0 < 4; ++d0)
#pragma unroll
                for (int j = 0; j < 4; ++j) { const f32x4 a = pa[d0 * 4 + j];
#pragma unroll
                    for (int e = 0; e < 4; ++e) { const float v = a[e] - lam * o[d0][4 * j + e]; o[d0][4 * j + e] = v; ss[4 * j + e] += v * v; } }
#pragma unroll
            for (int r = 0; r < 16; ++r) { float s = ss[r]; s += __shfl_xor(s, 1); s += __shfl_xor(s, 2); s += __shfl_xor(s, 4); s += __shfl_xor(s, 8); s += __shfl_xor(s, 16); ss[r] = 0.8f / sqrtf(s * (1.0f / 128.0f) + EPS); }
            float gd[4];
#pragma unroll
            for (int d0 = 0; d0 < 4; ++d0) gd[d0] = subg[d0 * 32 + r32];
            LAS bf16_t* stg = (LAS bf16_t*)(shm + L_OST) + wid * 4096;
#pragma unroll
            for (int r = 0; r < 16; ++r) { const int orow = crow(r, hi);
#pragma unroll
                for (int d0 = 0; d0 < 4; ++d0) { float y = o[d0][r] * ss[r] * gd[d0];
#if PROBE_PHASE == 51
                    if (!(__builtin_fabsf(y) < 1e30f)) y = 0.f;
#endif
                    stg[orow * 128 + d0 * 32 + r32] = (bf16_t)(cvt_pk_bf16(y, 0.f) & 0xffffu); } }
            asm volatile("s_waitcnt lgkmcnt(0)" ::: "memory");
            bf16_t* Ow = YAB + ((long)b * SEQ + qb * QB + wid * 32) * 1024 + 512 + h * 128;
#pragma unroll
            for (int i = 0; i < 8; ++i) { const int row = i * 4 + (lo_ >> 4), ch = lo_ & 15; const u32x4 v = *(const LAS u32x4*)(stg + row * 128 + ch * 8); *(u32x4*)(Ow + (long)row * 1024 + ch * 8) = v; }
        }
        asm volatile("s_waitcnt lgkmcnt(0)\n\ts_barrier" ::: "memory");
    }
}
#undef ATT_WAIT_BAR
#undef MX3
#undef ATT_SBAR
#undef ATT_MFMA
#undef MFMA8_PV
#undef MFMA8_QK
#undef MFMA8_PV8
}

#define XB_TMO      128
#define XB_XCNT(j)  (256  + 64 * (j))
#define XB_XSUB(j)  (1280 + 64 * (j))
#define XB_XGEN(j)  (2304 + 64 * (j))
#define XB_TOP      3328
#define XB_TOPGEN   3392
#define XCD_BAR_WORDS 3456
#define XB_SPIN_CAP (1u << 18)
__device__ __forceinline__ unsigned xb_ld(unsigned* p)              { return __hip_atomic_load(p, __ATOMIC_RELAXED, __HIP_MEMORY_SCOPE_AGENT); }
__device__ __forceinline__ unsigned xb_add(unsigned* p, unsigned v) { return __hip_atomic_fetch_add(p, v, __ATOMIC_RELAXED, __HIP_MEMORY_SCOPE_AGENT); }
__device__ __forceinline__ unsigned xb_xcc_id() { return (unsigned)__builtin_amdgcn_s_getreg((3 << 11) | 20) & 0xFu; }
#define XB_SPIN(cond, bar) do { unsigned _sp = 0; while (cond) { __builtin_amdgcn_s_sleep(1); \
    if ((++_sp & 255u) == 0u) { if (xb_ld(&(bar)[XB_TMO])) break; if (_sp > XB_SPIN_CAP) { atomicAdd(&(bar)[XB_TMO], 1u); break; } } } } while (0)
struct XcdBarrier { unsigned* bar; unsigned x; volatile LAS unsigned* st; };
__device__ __forceinline__ XcdBarrier xcd_barrier_post(unsigned* bar, volatile LAS unsigned* st) {
    XcdBarrier b; b.bar = bar; b.x = xb_xcc_id(); b.st = st;
    if (threadIdx.x == 0) (void)xb_add(&bar[XB_XCNT(b.x)], 1u);
    return b;
}
__device__ __forceinline__ void xcd_barrier_complete(unsigned* bar, unsigned x, unsigned& nloc, unsigned& nx) {
    const unsigned G = gridDim.x * gridDim.y * gridDim.z;
    unsigned sum, cnt, mine, sp = 0u;
    for (;;) {
        sum = 0u; cnt = 0u; mine = 0u;
#pragma unroll
        for (unsigned j = 0; j < 16; ++j) { const unsigned c = xb_ld(&bar[XB_XCNT(j)]); sum += c; cnt += (c > 0u) ? 1u : 0u; mine = (j == x) ? c : mine; }
        if (sum == G) break;
        __builtin_amdgcn_s_sleep(1);
        if ((++sp & 255u) == 0u) { if (xb_ld(&bar[XB_TMO])) break; if (sp > XB_SPIN_CAP) { atomicAdd(&bar[XB_TMO], 1u); break; } }
    }
    nloc = mine > 0u ? mine : 1u; nx = cnt > 0u ? cnt : 1u;
}
__device__ __forceinline__ void xcd_barrier(const XcdBarrier& b) {
    asm volatile("s_waitcnt vmcnt(0)" ::: "memory");
    __syncthreads();
    if (threadIdx.x == 0) {
        unsigned* bar = b.bar;
        __builtin_amdgcn_s_waitcnt(0);
        unsigned nloc = b.st[0], nx = b.st[1];
        if (nloc == 0u) { xcd_barrier_complete(bar, b.x, nloc, nx); b.st[0] = nloc; b.st[1] = nx; }
        const unsigned old = xb_add(&bar[XB_XSUB(b.x)], 1u);
        const unsigned gen = old / nloc;
        if (old + 1u == (gen + 1u) * nloc) {
            __builtin_amdgcn_fence(__ATOMIC_RELEASE, "agent");
            asm volatile("s_waitcnt vmcnt(0)" ::: "memory");
            const unsigned og = xb_add(&bar[XB_TOP], 1u);
            const unsigned tg = og / nx;
            if (og + 1u == (tg + 1u) * nx) xb_add(&bar[XB_TOPGEN], 1u);
            else XB_SPIN(xb_ld(&bar[XB_TOPGEN]) == tg, bar);
            __builtin_amdgcn_fence(__ATOMIC_ACQUIRE, "agent");
            xb_add(&bar[XB_XGEN(b.x)], 1u);
            asm volatile("s_waitcnt vmcnt(0)" ::: "memory");
        } else {
            XB_SPIN(xb_ld(&bar[XB_XGEN(b.x)]) == gen, bar);
            __builtin_amdgcn_fence(__ATOMIC_ACQUIRE, "agent");
            asm volatile("s_waitcnt vmcnt(0)" ::: "memory");
        }
    }
    __syncthreads();
}

#define GRID_BAR() xcd_barrier(bar)

__device__ __forceinline__ void phase_stagger(int cls, unsigned ticks) {
    const unsigned long long t0 = __builtin_amdgcn_s_memrealtime(); const unsigned long long want = (unsigned long long)cls * ticks;
    while (__builtin_amdgcn_s_memrealtime() - t0 < want) __builtin_amdgcn_s_sleep(8);
}

struct Args {
    const float* x; const int* pos; const float* norm_mix_g; const float* w_in; const float* gm_ln_g; const float* gm_ln_b; const float* gm_w_s; const float* gm_b_s;
    const float* lam_q1; const float* lam_k1; const float* lam_q2; const float* lam_k2; const float* subln_g; const float* w_br_a; const float* w_br_b; const float* w_out;
    const float* norm_ffn_g; const float* w_rg; const float* b_rg; const float* w_re; const float* b_re; const float* w_gate; const float* w_up; const float* w_down; const float* final_g;
    float* out; unsigned char* ws;
};

__device__ __forceinline__ int wrow_map(int rmode, int n) { return rmode == 0 ? n : rmode == 1 ? ((n >> 5) * 128 + (n & 31)) : (((n >> 3) & 1) * 128 + (n >> 4) * 8 + (n & 7)); }
__device__ __forceinline__ void transpose_item(const float* W, int ldw, int k0, int n0, bf16_t* WT, int ldt, int drow0, int dk0, const float* gk, LAS float* scr, int lane, float sc = 1.0f, int rmode = 0) {
    f32x4 v[16];
    const int kr = lane >> 4, nc = (lane & 15) * 4;
#pragma unroll
    for (int i = 0; i < 16; ++i) v[i] = *(const f32x4*)(W + (size_t)(k0 + 4 * i + kr) * ldw + n0 + nc);
    if (gk) {
#pragma unroll
        for (int i = 0; i < 16; ++i) v[i] = v[i] * gk[k0 + 4 * i + kr];
    }
    if (sc != 1.0f) {
#pragma unroll
        for (int i = 0; i < 16; ++i) v[i] = v[i] * sc;
    }
#pragma unroll
    for (int i = 0; i < 16; ++i) { LAS float* d = scr + (4 * i + kr) * 65 + nc; d[0] = v[i][0]; d[1] = v[i][1]; d[2] = v[i][2]; d[3] = v[i][3]; }
    LDS_WAIT(); asm volatile("" ::: "memory");
    const int c = lane & 7;
#pragma unroll
    for (int j = 0; j < 8; ++j) { const int n = (lane >> 3) + 8 * j; const LAS float* s = scr + (8 * c) * 65 + n;
        u32x4 o; o.x = cvt_pk_bf16(s[0 * 65], s[1 * 65]); o.y = cvt_pk_bf16(s[2 * 65], s[3 * 65]); o.z = cvt_pk_bf16(s[4 * 65], s[5 * 65]); o.w = cvt_pk_bf16(s[6 * 65], s[7 * 65]);
        *(u32x4*)(WT + (size_t)(drow0 + wrow_map(rmode, n)) * ldt + dk0 + k0 + 8 * c) = o; }
    LDS_WAIT(); asm volatile("" ::: "memory");
}
__device__ __forceinline__ void transpose_item8(const float* W, int ldw, int k0, int n0, unsigned char* WT, int ldt, int drow0, const float* gk, float sc, LAS float* scr, int lane, int rmode = 0) {
    f32x4 v[16];
    const int kr = lane >> 4, nc = (lane & 15) * 4;
#pragma unroll
    for (int i = 0; i < 16; ++i) v[i] = *(const f32x4*)(W + (size_t)(k0 + 4 * i + kr) * ldw + n0 + nc);
    float gs[16];
    if (gk) {
#pragma unroll
        for (int i = 0; i < 16; ++i) gs[i] = gk[k0 + 4 * i + kr];
#pragma unroll
        for (int i = 0; i < 16; ++i) gs[i] *= sc;
    } else {
#pragma unroll
        for (int i = 0; i < 16; ++i) gs[i] = sc;
    }
#pragma unroll
    for (int i = 0; i < 16; ++i) v[i] = v[i] * gs[i];
#pragma unroll
    for (int i = 0; i < 16; ++i) { LAS float* d = scr + (4 * i + kr) * 65 + nc; d[0] = v[i][0]; d[1] = v[i][1]; d[2] = v[i][2]; d[3] = v[i][3]; }
    LDS_WAIT(); asm volatile("" ::: "memory");
    const int c = lane & 7;
#pragma unroll
    for (int j = 0; j < 8; ++j) { const int n = (lane >> 3) + 8 * j; const LAS float* s = scr + (8 * c) * 65 + n;
        u32x2 o; o.x = cvt_pk4_fp8(s[0 * 65], s[1 * 65], s[2 * 65], s[3 * 65]); o.y = cvt_pk4_fp8(s[4 * 65], s[5 * 65], s[6 * 65], s[7 * 65]);
        *(u32x2*)(WT + (size_t)(drow0 + wrow_map(rmode, n)) * ldt + k0 + 8 * c) = o; }
    LDS_WAIT(); asm volatile("" ::: "memory");
}
__device__ __forceinline__ void expert_item(int r, const float* w_gate, const float* w_up, const float* w_down, const float* gffn, unsigned char* W13, unsigned char* W2, LAS float* scr, int lane) {
    constexpr int I_G = 32 * 128;
    if (r < 2 * I_G) { const int up = r >= I_G; if (up) r -= I_G; const int e = r / 128, q = r % 128, kb = q / 8, nb = q % 8;
        const int n0 = 64 * nb, drow = e * 1024 + (n0 >> 7) * 256 + up * 128 + (n0 & 127);
        transpose_item8((up ? w_up : w_gate) + (size_t)e * 1024 * 512, 512, 64 * kb, n0, W13, 1024, drow, gffn, 64.f, scr, lane); return; }
    r -= 2 * I_G;
    { const int e = r / 128, q = r % 128, kb = q / 16, nb = q % 16;
        transpose_item8(w_down + (size_t)e * 512 * 1024, 1024, 64 * kb, 64 * nb, W2, 512, e * 1024 + (nb >> 2) * 256 + (nb & 3) * 32, nullptr, 32.f, scr, lane, 2); }
}
__device__ __forceinline__ void rms_row_to_bf16(const float* xrow, const float* g, bf16_t* orow, int lane) {
    const f32x4* xr = (const f32x4*)xrow + lane; const f32x4* gr = (const f32x4*)g + lane;
    f32x4 v[4]; float s = 0.f;
#pragma unroll
    for (int j = 0; j < 4; ++j) { v[j] = xr[64 * j]; s += (v[j].x * v[j].x + v[j].y * v[j].y) + (v[j].z * v[j].z + v[j].w * v[j].w); }
    const float rstd = 1.f / sqrtf(wave_sum(s) * (1.f / D) + EPS);
    u32x2* o8 = (u32x2*)orow + lane;
#pragma unroll
    for (int j = 0; j < 4; ++j) { const f32x4 gg = gr[64 * j]; u32x2 w; w.x = cvt_pk_bf16(v[j].x * rstd * gg.x, v[j].y * rstd * gg.y); w.y = cvt_pk_bf16(v[j].z * rstd * gg.z, v[j].w * rstd * gg.w); o8[64 * j] = w; }
}

__global__ void __launch_bounds__(NTHREADS, 2) fwd_kernel(Args a) {
    extern __shared__ __attribute__((aligned(16))) unsigned char lds_raw[];
    LAS unsigned char* lds = (LAS unsigned char*)lds_raw;
    volatile LAS unsigned* LCTL = (volatile LAS unsigned*)(lds + LDSCTL_OFF);
    const int tid0 = threadIdx.x;
    const int G = gridDim.x, bx = blockIdx.x;
    const int vcu = (G % 8 == 0) ? (bx % 8) * (G / 8) + bx / 8 : bx;
    unsigned char* ws = a.ws;
    unsigned* ctl = (unsigned*)(ws + WS_CTL);
    __builtin_amdgcn_s_setreg((23 << 6) | 1, 1);
    for (int u = tid0; u < (LDS_BYTES - LDSCTL_OFF) / 4; u += NTHREADS) LCTL[u] = 0u;
    __syncthreads();
    XcdBarrier bar = xcd_barrier_post(ctl + CW_BAR, LCTL);
    const int NGW = G * NWAVES;
#define PHASE_IDS() const int tid = opaque_tid(), lane = tid & 63, wave = __builtin_amdgcn_readfirstlane(tid >> 6), gw = vcu * NWAVES + wave; (void)lane; (void)gw

    bf16_t* WIN = (bf16_t*)(ws + WS_WIN); bf16_t* WBR = (bf16_t*)(ws + WS_WBR); bf16_t* WO = (bf16_t*)(ws + WS_WO); unsigned char* W13 = ws + WS_W13; unsigned char* W2 = ws + WS_W2;
    bf16_t* WRH = (bf16_t*)(ws + WS_WRH); bf16_t* WRL = (bf16_t*)(ws + WS_WRL); float* CS = (float*)(ws + WS_CS); float* SSQ = (float*)(ws + WS_SSQ); float* RSTD = (float*)(ws + WS_RSTD); float* WTS = (float*)(ws + WS_WTS);
    int* LIST = (int*)(ws + WS_LIST);
    float* PARK = (float*)(ws + WS_PARK);
    bf16_t* XN = (bf16_t*)(ws + WS_RA); bf16_t* YAB = (bf16_t*)(ws + WS_RA); unsigned char* YB8 = ws + WS_RA;
    bf16_t* UV = (bf16_t*)(ws + WS_RB); bf16_t* MG = (bf16_t*)(ws + WS_RB);
    bf16_t* Qb = (bf16_t*)(ws + WS_RC); bf16_t* Kb = Qb + (size_t)T * 512; bf16_t* XB = (bf16_t*)(ws + WS_RC); unsigned char* V8T = ws + WS_RE + 128 * MiB; unsigned char* Q8 = V8T + 32 * MiB; unsigned char* K8 = Q8 + 16 * MiB;
    bf16_t* Vb = (bf16_t*)(ws + WS_RD);
    unsigned char* G8 = ws + WS_RE; unsigned char* H8 = ws + WS_RE; unsigned char* XB8 = ws + WS_RD;

    for (int rep = 0; rep < REPS(0); ++rep) {
        PHASE_IDS();
        LAS float* scr = (LAS float*)(lds + wave * 16896);
#if LEVEL >= 1
        constexpr int I_IN = 16 * 72, I_BA = 8 * 16, I_BB = 8 * 16, I_O = 16 * 16;
        constexpr int NITEMS = I_IN + I_BA + I_BB + I_O;
        for (int it = gw; it < NITEMS; it += NGW) {
            int r = it;
            if (r < I_IN) { const int kb = r / 72, nb = r % 72; transpose_item(a.w_in, IN_COLS, 64 * kb, 64 * nb, WIN, 1024, (nb >> 2) * 256 + (nb & 3) * 32, 0, nullptr, scr, lane, (64 * nb >= 2560) ? -LOG2E : 1.0f, (64 * nb >= 2560) ? 2 : 1); continue; } r -= I_IN;
            if (r < I_BA) { const int kb = r / 16, nb = r % 16; transpose_item(a.w_br_a, 1024, 64 * kb, 64 * nb, WBR, 1024, (nb >> 2) * 256 + (nb & 3) * 32, 0, nullptr, scr, lane, 1.0f, 1); continue; } r -= I_BA;
            if (r < I_BB) { const int kb = r / 16, nb = r % 16; transpose_item(a.w_br_b, 1024, 64 * kb, 64 * nb, WBR, 1024, (nb >> 2) * 256 + (nb & 3) * 32, 512, nullptr, scr, lane, 1.0f, 1); continue; } r -= I_BB;
            { const int kb = r / 16, nb = r % 16; transpose_item(a.w_out, 1024, 64 * kb, 64 * nb, WO, 1024, (nb >> 2) * 256 + (nb & 3) * 32, 0, nullptr, scr, lane, 1.0f, 1); }
        }
#if LEVEL >= 3
        for (int i = bx * NTHREADS + tid; i < 64 * 1024; i += G * NTHREADS) { const int n = i >> 10, k = i & 1023; float v = 0.f; if (n < 4) v = a.w_rg[k * 4 + n]; else if (n < 36) v = a.w_re[k * 32 + (n - 4)];
            v *= a.norm_ffn_g[k]; const unsigned h = cvt_pk_bf16(v, 0.f) & 0xffffu; const float r = v - __uint_as_float(h << 16); WRH[i] = (bf16_t)h; WRL[i] = (bf16_t)(cvt_pk_bf16(r, 0.f) & 0xffffu); }
#endif
        for (int i = bx * NTHREADS + tid; i < T * 8; i += G * NTHREADS) { const int t = i >> 3, j = i & 7;
            const double invf = exp2(-(double)j * (18.931568569324174 / 8.0));
            const double ang = (double)a.pos[t] * invf; const double kk = rint(ang * 0.15915494309189535); const float rr = (float)(ang - kk * 6.283185307179586);
            CS[t * 16 + j] = cosf(rr); CS[t * 16 + 8 + j] = sinf(rr); }
        for (int m = gw; m < T; m += NGW) rms_row_to_bf16(a.x + (size_t)m * D, a.norm_mix_g, XN + (size_t)m * D, lane);
#endif
    }
    GRID_BAR();

#if LEVEL >= 1 && !defined(NO_P1)
#if PROBE_PHASE >= 71 && PROBE_PHASE <= 73
    {
        pg8::DenseProb P; P.init(XN, WIN, T, IN_COLS, 1024, G, bx);
        pg8::EpiInProjT<(PROBE_PHASE == 73 ? 4 : PROBE_PHASE - 70)> E{UV, Qb, Kb, Vb, G8, CS, Q8, K8, lds};
        pg8::gemm_core<false>(lds, P, E, pg8::NoHook{});
    }
#endif
#if PROBE_PHASE == 66 || PROBE_PHASE == 67
    {
        pg8::DenseProb P; P.init(XN, WIN, T, IN_COLS, 1024, G, bx);
        pg8::EpiInProjT<PROBE_PHASE - 65> E{UV, Qb, Kb, Vb, G8, CS, Q8, K8, lds};
        pg8::gemm_core<false, pg8::DenseProb, pg8::EpiInProjT<PROBE_PHASE - 65>, pg8::NoHook, 4>(lds, P, E, pg8::NoHook{});
    }
#endif
#if PROBE_PHASE == 64
    {
        pg8::DenseProb P; P.init(XN, WIN, T, IN_COLS, 1024, G, bx);
        pg8::EpiInProj E{UV, Qb, Kb, Vb, G8, CS, Q8, K8, lds};
        pg8::gemm_core<false, pg8::DenseProb, pg8::EpiInProj, pg8::NoHook, 4>(lds, P, E, pg8::NoHook{});
    }
#endif
    for (int rep = 0; rep < REPS(1); ++rep) {
#ifdef STAG1
        phase_stagger(((bx >> 3) & 7) >> 1, STAG1);
#endif
        pg8::DenseProb P; P.init(XN, WIN, T, IN_COLS, 1024, G, bx);
        pg8::EpiInProj E{UV, Qb, Kb, Vb, G8, CS, Q8, K8, lds};
        pg8::gemm_core<false>(lds, P, E, pg8::NoHook{});
    }
#if PROBE_PHASE == 11
    {
        pg8::DenseProb P; P.init(XN, WIN, T, IN_COLS, 1024, G, bx);
        pg8::gemm_core<false>(lds, P, pg8::EpiNull{}, pg8::NoHook{});
    }
#endif
#if PROBE_PHASE >= 61 && PROBE_PHASE <= 63
    {
        pg8::DenseProb P; P.init(XN, WIN, T, IN_COLS, 1024, G, bx);
        pg8::gemm_core<false, pg8::DenseProb, pg8::EpiNull, pg8::NoHook, PROBE_PHASE - 60>(lds, P, pg8::EpiNull{}, pg8::NoHook{});
    }
#endif
#if PROBE_PHASE == 31
    {
        pg8::DenseProb P; P.init(XN, WIN, T, IN_COLS, 1024, G, bx);
        pg8::gemm_core<false>(lds, P, pg8::EpiStoreOnly{(bf16_t*)(ws + WS_END)}, pg8::NoHook{});
    }
#endif
#if PROBE_PHASE == 12
    {
        pg8::DenseProbSame P; P.init(XN, WIN, T, IN_COLS, 1024, G, bx);
        pg8::gemm_core<false>(lds, P, pg8::EpiNull{}, pg8::NoHook{});
    }
#endif
#endif
    GRID_BAR();

#if LEVEL >= 1 && !defined(NO_P2A)
    for (int rep = 0; rep < REPS(2); ++rep) {
        PHASE_IDS();
        LAS bf16_t* VT = (LAS bf16_t*)lds;
        LAS float* SV = (LAS float*)(lds + 36864);
        const int r32 = lane & 31, hi = lane >> 5;
        for (int un = vcu; un < 2048; un += G) {
            const int ch = un >> 2, g = un & 3; const size_t row0 = (size_t)ch * 128;
            {
                const int s = tid >> 2, qd = tid & 3;
                const u32x4* vp = (const u32x4*)(UV + (row0 + s) * 1024 + 512 + g * 128 + qd * 32);
                float v[32]; float sm = 0.f;
#pragma unroll
                for (int j = 0; j < 4; ++j) { const u32x4 w = vp[j]; f32x4 x0, x1; pg8::unpack8(w, x0, x1);
#pragma unroll
                    for (int e = 0; e < 4; ++e) { v[8 * j + e] = x0[e]; v[8 * j + 4 + e] = x1[e]; sm += x0[e] + x1[e]; } }
                sm += __shfl_xor(sm, 1); sm += __shfl_xor(sm, 2);
                const float mu = sm * (1.0f / 128.0f); float sq = 0.f;
#pragma unroll
                for (int i = 0; i < 32; ++i) { v[i] -= mu; sq += v[i] * v[i]; }
                sq += __shfl_xor(sq, 1); sq += __shfl_xor(sq, 2);
                const float rstd = 1.0f / sqrtf(sq * (1.0f / 128.0f) + EPS);
                const float* lg = a.gm_ln_g + g * 128 + qd * 32; const float* lb = a.gm_ln_b + g * 128 + qd * 32;
#pragma unroll
                for (int i = 0; i < 32; ++i) { const float y = v[i] * rstd * lg[i] + lb[i]; VT[(qd * 32 + i) * 136 + s] = (bf16_t)(cvt_pk_bf16(y, 0.f) & 0xffffu); }
            }
            LDS_WAIT(); __syncthreads();
            {
                const int tb = wave >> 1, db0 = 2 * (wave & 1);
                f32x16 c0 = f32x16{}, c1 = f32x16{};
                const float* wrow = a.gm_w_s + ((size_t)g * 128 + tb * 32 + r32) * 128;
                const int trow = tb * 32 + r32;
                for (int ks = 0; ks <= 2 * tb + 1; ++ks) {
                    const int s0 = 16 * ks + 8 * hi;
                    const f32x4 wa = *(const f32x4*)(wrow + s0), wb = *(const f32x4*)(wrow + s0 + 4);
                    float w8[8] = {wa[0], wa[1], wa[2], wa[3], wb[0], wb[1], wb[2], wb[3]};
#pragma unroll
                    for (int j = 0; j < 8; ++j) if (s0 + j > trow) w8[j] = 0.f;
                    u32x4 aw; aw.x = cvt_pk_bf16(w8[0], w8[1]); aw.y = cvt_pk_bf16(w8[2], w8[3]); aw.z = cvt_pk_bf16(w8[4], w8[5]); aw.w = cvt_pk_bf16(w8[6], w8[7]);
                    const bf16x8 af = __builtin_bit_cast(bf16x8, aw);
                    const bf16x8 b0 = *(const LAS bf16x8*)(VT + ((db0 + 0) * 32 + r32) * 136 + s0);
                    const bf16x8 b1 = *(const LAS bf16x8*)(VT + ((db0 + 1) * 32 + r32) * 136 + s0);
                    c0 = __builtin_amdgcn_mfma_f32_32x32x16_bf16(af, b0, c0, 0, 0, 0);
                    c1 = __builtin_amdgcn_mfma_f32_32x32x16_bf16(af, b1, c1, 0, 0, 0);
                }
#pragma unroll
                for (int r = 0; r < 16; ++r) { const int t = tb * 32 + att::crow(r, hi); const float bs = a.gm_b_s[g * 128 + t];
                    SV[t * 132 + db0 * 32 + r32] = c0[r] + bs; SV[t * 132 + db0 * 32 + 32 + r32] = c1[r] + bs; }
            }
            LDS_WAIT(); __syncthreads();
            {
#pragma unroll
                for (int i = 0; i < 4; ++i) { const int t = i * 32 + (tid >> 4), dc = (tid & 15) * 8;
                    const size_t ro = (row0 + t) * 1024 + g * 128 + dc;
                    const u32x4 uw = *(const u32x4*)(UV + ro); f32x4 u0, u1; pg8::unpack8(uw, u0, u1);
                    const f32x4 s0 = *(const LAS f32x4*)(SV + t * 132 + dc), s1 = *(const LAS f32x4*)(SV + t * 132 + dc + 4);
                    *(u32x4*)(YAB + ro) = pg8::pack8(u0 * s0, u1 * s1); }
            }
            LDS_WAIT(); __syncthreads();
        }
    }
#endif
#if LEVEL >= 2
    {
        PHASE_IDS();
        LAS unsigned char* TB = (LAS unsigned char*)lds + wave * 8192;
        for (int tl = gw; tl < BATCH * 4 * (SEQ / 64); tl += NGW) {
            const int bh = tl >> 7, tt = tl & 127, b = bh >> 2, h = bh & 3;
            const bf16_t* vsrc = Vb + ((size_t)b * SEQ + tt * 64) * 512 + h * 128;
            u32x4 w[16];
#pragma unroll
            for (int i = 0; i < 16; ++i) w[i] = *(const u32x4*)(vsrc + (size_t)(i * 4 + (lane >> 4)) * 512 + (lane & 15) * 8);
#pragma unroll
            for (int i = 0; i < 16; ++i) { const int key = i * 4 + (lane >> 4), kk = key & 31, khi = (kk >> 2) & 1, j = (kk & 3) + 4 * (kk >> 3) + 16 * (key >> 5), cc = khi * 2 + (j >> 4);
                f32x4 x0, x1; pg8::unpack8(w[i], x0, x1); const unsigned q0_ = cvt_pk4_fp8(x0[0], x0[1], x0[2], x0[3]), q1_ = cvt_pk4_fp8(x1[0], x1[1], x1[2], x1[3]);
#pragma unroll
                for (int e = 0; e < 8; ++e) { const int d = (lane & 15) * 8 + e; const unsigned byte = ((e < 4 ? q0_ : q1_) >> (8 * (e & 3))) & 0xffu;
                    TB[d * 64 + ((cc ^ ((d >> 2) & 3)) * 16) + (j & 15)] = (unsigned char)byte; } }
            LDS_WAIT(); asm volatile("" ::: "memory");
            unsigned char* dst = V8T + (size_t)tl * 8192;
#pragma unroll
            for (int i = 0; i < 8; ++i) *(u32x4*)(dst + (i * 64 + lane) * 16) = *(const LAS u32x4*)(TB + (i * 64 + lane) * 16);
            LDS_WAIT(); asm volatile("" ::: "memory");
        }
    }
    GRID_BAR();
#endif
#if LEVEL >= 2 && !defined(NO_P2B)
    {
        PHASE_IDS();
        float lam;
        { const float p1 = wave_sum(a.lam_q1[lane] * a.lam_k1[lane]), p2 = wave_sum(a.lam_q2[lane] * a.lam_k2[lane]); lam = expf(p1) - expf(p2) + 0.2f; }
        const int bh = vcu >> 3, s = vcu & 7, b = bh >> 2, h = bh & 3;
        float* park = PARK + (size_t)bx * 32768;
        if (G == 256) {
            for (int ii = 0; ii < 4 * REPS(3); ++ii) { const int i = ii & 3; const int qb = (i == 0) ? s : (i == 1) ? 15 - s : (i == 2) ? 16 + s : 31 - s;
                att::attn_unit<0>(b, h, qb, Qb, Kb, Q8, K8, V8T, YAB, park, lam, a.subln_g, (LAS char*)lds);
#if LEVEL >= 3
                if (ii < 4) {
                    LAS float* scr = (LAS float*)(lds + wave * 16896);
                    for (int k = wave; k < 12; k += NWAVES) expert_item((bx * 4 + ii) * 12 + k, a.w_gate, a.w_up, a.w_down, a.norm_ffn_g, W13, W2, scr, lane);
                    LDS_WAIT(); __syncthreads();
                }
#endif
            }
#if PROBE_PHASE == 13 || PROBE_PHASE == 14 || PROBE_PHASE == 15 || PROBE_PHASE == 16
            for (int i = 0; i < 4; ++i) { const int qb = (i == 0) ? s : (i == 1) ? 15 - s : (i == 2) ? 16 + s : 31 - s;
                att::attn_unit<PROBE_PHASE - 13>(0, 0, qb, Qb, Kb, Q8, K8, V8T, (bf16_t*)(ws + WS_END), park, lam, a.subln_g, (LAS char*)lds); }
#endif
        }
    }
#elif LEVEL >= 1
    {
        PHASE_IDS();
        for (int i = bx * NTHREADS + tid; i < T * 64; i += G * NTHREADS) { const int row = i >> 6, c = i & 63; *(u32x4*)(YAB + (size_t)row * 1024 + 512 + c * 8) = (u32x4){0u, 0u, 0u, 0u}; }
    }
#endif
    GRID_BAR();

#if LEVEL >= 1 && !defined(NO_P3)
    for (int rep = 0; rep < REPS(4); ++rep) {
        pg8::PanelProb P; P.init(YAB, WBR, T, 1024, 1024, G, bx);
        pg8::EpiMerge E{G8, MG};
        pg8::gemm_core<false>(lds, P, E, pg8::HookMerge{G8});
    }
#endif
    asm volatile("s_waitcnt vmcnt(0)" ::: "memory"); __syncthreads();
#if LEVEL >= 1 && !defined(NO_P4)
    for (int rep = 0; rep < REPS(5); ++rep) {
        pg8::PanelProb P; P.init(MG, WO, T, 1024, 1024, G, bx);
        pg8::EpiX1 E{a.x, XB, XB8, SSQ};
        pg8::gemm_core<false>(lds, P, E, pg8::NoHook{});
    }
#endif
    asm volatile("s_waitcnt vmcnt(0)" ::: "memory"); __syncthreads();

#if LEVEL >= 3 && !defined(NO_P5)
    {
        PHASE_IDS();
        LAS float* LG = (LAS float*)lds;
        volatile LAS int* LCNT = (volatile LAS int*)(LCTL + 96); volatile LAS int* LBASE = (volatile LAS int*)(LCTL + 128);
        const int r32 = lane & 31, hi = lane >> 5;
        for (int tb = bx; tb < T / 256; tb += G) {
            const size_t tok0 = (size_t)tb * 256 + wave * 32;
            const bf16_t* xa = XB + (tok0 + r32) * 1024 + hi * 8;
            const bf16_t* wh0 = WRH + (size_t)r32 * 1024 + hi * 8; const bf16_t* wh1 = wh0 + 32 * 1024;
            const bf16_t* wl0 = WRL + (size_t)r32 * 1024 + hi * 8; const bf16_t* wl1 = wl0 + 32 * 1024;
            f32x16 c0 = f32x16{}, c1 = f32x16{};
#pragma unroll 4
            for (int ks = 0; ks < 64; ++ks) {
                const bf16x8 av = *(const bf16x8*)(xa + ks * 16);
                const bf16x8 h0 = *(const bf16x8*)(wh0 + ks * 16), h1 = *(const bf16x8*)(wh1 + ks * 16), l0 = *(const bf16x8*)(wl0 + ks * 16), l1 = *(const bf16x8*)(wl1 + ks * 16);
                c0 = __builtin_amdgcn_mfma_f32_32x32x16_bf16(av, h0, c0, 0, 0, 0); c1 = __builtin_amdgcn_mfma_f32_32x32x16_bf16(av, h1, c1, 0, 0, 0);
                c0 = __builtin_amdgcn_mfma_f32_32x32x16_bf16(av, l0, c0, 0, 0, 0); c1 = __builtin_amdgcn_mfma_f32_32x32x16_bf16(av, l1, c1, 0, 0, 0);
            }
#pragma unroll
            for (int r = 0; r < 16; ++r) { const int tl = wave * 32 + att::crow(r, hi); LG[tl * 37 + r32] = c0[r]; if (r32 < 4) LG[tl * 37 + 32 + r32] = c1[r]; }
            if (tid < 32) LCNT[tid] = 0;
            LDS_WAIT(); __syncthreads();
            int eid0 = 0, eid1 = 0, rk0 = 0, rk1 = 0; float w0 = 0.f, w1 = 0.f; const size_t tok = (size_t)tb * 256 + tid;
            if (tid < 256) {
                float ssq = 0.f;
#pragma unroll
                for (int j = 0; j < 16; ++j) ssq += SSQ[tok * 16 + j];
                const float rstd = 1.0f / sqrtf(ssq * (1.0f / 1024.0f) + EPS);
                RSTD[tok] = rstd;
                const LAS float* p0 = LG + tid * 37;
                float gl[4]; int grp = 0;
#pragma unroll
                for (int j = 0; j < 4; ++j) gl[j] = p0[j] * rstd + a.b_rg[j];
                float gmx = gl[0];
#pragma unroll
                for (int j = 1; j < 4; ++j) if (gl[j] > gmx) { gmx = gl[j]; grp = j; }
                float gs = 0.f;
#pragma unroll
                for (int j = 0; j < 4; ++j) gs += expf(gl[j] - gmx);
                const float gwt = 1.0f / gs;
                float el[8];
#pragma unroll
                for (int j = 0; j < 8; ++j) el[j] = p0[4 + grp * 8 + j] * rstd + a.b_re[grp * 8 + j];
                int i0 = 0; float v0 = el[0];
#pragma unroll
                for (int j = 1; j < 8; ++j) if (el[j] > v0) { v0 = el[j]; i0 = j; }
                int i1 = -1; float v1 = -INFINITY;
#pragma unroll
                for (int j = 0; j < 8; ++j) if (j != i0 && el[j] > v1) { v1 = el[j]; i1 = j; }
                const float e1 = expf(v1 - v0); w0 = gwt / (1.0f + e1); w1 = gwt * e1 / (1.0f + e1);
                eid0 = grp * 8 + i0; eid1 = grp * 8 + i1;
                rk0 = atomicAdd((int*)(LCNT + eid0), 1); rk1 = atomicAdd((int*)(LCNT + eid1), 1);
            }
            LDS_WAIT(); __syncthreads();
            if (tid < 32) LBASE[tid] = (int)__hip_atomic_fetch_add(ctl + CW_CNT + tid, (unsigned)LCNT[tid], RLX_AGENT);
            LDS_WAIT(); __syncthreads();
            if (tid < 256) {
                const int s0_ = eid0 * LISTCAP + LBASE[eid0] + rk0, s1_ = eid1 * LISTCAP + LBASE[eid1] + rk1;
                LIST[s0_] = (int)(((unsigned)(tok * 2) << 15) | (cvt_pk_bf16(w0, 0.f) & 0x7fffu)); LIST[s1_] = (int)(((unsigned)(tok * 2 + 1) << 15) | (cvt_pk_bf16(w1, 0.f) & 0x7fffu));
            }
            LDS_WAIT(); __syncthreads();
        }
    }
#endif
    GRID_BAR();
#if LEVEL >= 3
    {
        PHASE_IDS();
        volatile LAS int* BST = (volatile LAS int*)(LCTL + 16); volatile LAS int* CNT = (volatile LAS int*)(LCTL + 64);
        if (tid < NEXP) CNT[tid] = (int)__hip_atomic_load(ctl + CW_CNT + tid, RLX_AGENT);
        LDS_WAIT(); __syncthreads();
        if (tid == 0) { int accb = 0; for (int e = 0; e < NEXP; ++e) { BST[e] = accb; accb += (CNT[e] + 255) >> 8; } BST[NEXP] = accb; }
        LDS_WAIT(); __syncthreads();
    }
#if !defined(NO_P6)
    for (int rep = 0; rep < REPS(6); ++rep) {
        pg8::MoeUpProb P; P.init((const LAS int*)(LCTL + 16), (const LAS int*)(LCTL + 64), G, bx); P.A = (const char*)XB8; P.Bt = (const char*)W13; P.pitch = 1024; P.list = LIST;
        pg8::EpiMoeUp E{LIST, RSTD, H8, {}};
        pg8::gemm_core<true>(lds, P, E, pg8::HookPin<pg8::EpiMoeUp>{&E});
    }
#endif
#endif
    GRID_BAR();
#if LEVEL >= 3 && !defined(NO_P7)
    for (int rep = 0; rep < REPS(7); ++rep) {
        pg8::MoeDownProb P; P.init((const LAS int*)(LCTL + 16), (const LAS int*)(LCTL + 64), G, bx); P.A = (const char*)H8; P.Bt = (const char*)W2; P.pitch = 512;
        pg8::EpiMoeDown E{LIST, YB8, {}};
        pg8::gemm_core<true>(lds, P, E, pg8::HookPin<pg8::EpiMoeDown>{&E});
    }
#endif
    GRID_BAR();

    {
        PHASE_IDS();
        const bool tmo = (__hip_atomic_load(ctl + CW_BAR + XB_TMO, RLX_AGENT) != 0u);
        for (int m = gw; m < T; m += NGW) {
            const f32x4* gr = (const f32x4*)a.final_g + lane;
            f32x4 v[4]; float s = 0.f;
#pragma unroll
            for (int j = 0; j < 4; ++j) {
#if LEVEL >= 1
                { const u32x2 xw = *((const u32x2*)(XB + (size_t)m * D) + lane + 64 * j); v[j] = (f32x4){bf_lo(xw.x), bf_hi(xw.x), bf_lo(xw.y), bf_hi(xw.y)}; }
#else
                v[j] = ((const f32x4*)(a.x + (size_t)m * D) + lane)[64 * j];
#endif
#if LEVEL >= 3
                const unsigned y0 = *((const unsigned*)(YB8 + (size_t)(2 * m) * D) + lane + 64 * j), y1 = *((const unsigned*)(YB8 + (size_t)(2 * m + 1) * D) + lane + 64 * j);
                v[j] = v[j] + (fp8x4_to_f32(y0) + fp8x4_to_f32(y1)) * 0.0625f;
#endif
                s += (v[j].x * v[j].x + v[j].y * v[j].y) + (v[j].z * v[j].z + v[j].w * v[j].w); }
            float rstd = 1.f / sqrtf(wave_sum(s) * (1.f / D) + EPS);
            if (tmo) rstd = __builtin_nanf("");
            f32x4* o = (f32x4*)(a.out + (size_t)m * D) + lane;
#pragma unroll
            for (int j = 0; j < 4; ++j) { f32x4 ov = v[j] * rstd * gr[64 * j];
#if PROBE_PHASE == 50
#pragma unroll
                for (int e = 0; e < 4; ++e) if (!(__builtin_fabsf(ov[e]) < 1e30f)) ov[e] = 0.f;
#endif
                o[64 * j] = ov; }
        }
    }
}

extern "C" void kernel_launch(void* const* d_in, const int* in_sizes, int n_in, void* d_out, int out_size, void* d_ws, size_t ws_size, hipStream_t stream) {
    static int grid = 0;
    if (grid == 0) {
        if (n_in != 25 || in_sizes[0] != T * D || out_size != T * D || ws_size < WS_END + 64 * MiB) { fprintf(stderr, "kernel_launch: unexpected shapes (n_in %d, in0 %d, out %d, ws %zu); nothing launched\n", n_in, n_in > 0 ? in_sizes[0] : -1, out_size, ws_size); grid = -1; return; }
        int dev = 0, cus = 0, per_cu = 0;
        if (hipGetDevice(&dev) != hipSuccess || hipDeviceGetAttribute(&cus, hipDeviceAttributeMultiprocessorCount, dev) != hipSuccess) { grid = -1; return; }
        if (hipFuncSetAttribute((const void*)fwd_kernel, hipFuncAttributeMaxDynamicSharedMemorySize, LDS_BYTES) != hipSuccess) { fprintf(stderr, "kernel_launch: hipFuncSetAttribute failed\n"); grid = -1; return; }
        if (hipOccupancyMaxActiveBlocksPerMultiprocessor(&per_cu, (const void*)fwd_kernel, NTHREADS, LDS_BYTES) != hipSuccess || per_cu < 1) fprintf(stderr, "kernel_launch: occupancy query reports %d\n", per_cu);
        (void)hipGetLastError();
        grid = cus;
        if (grid != 256) fprintf(stderr, "kernel_launch: %d CUs (built for 256)\n", grid);
    }
    if (grid < 0) return;
    if (hipMemsetAsync((char*)d_ws + WS_CTL, 0, CTL_ZERO_BYTES, stream) != hipSuccess) return;
    Args a{};
    a.x = (const float*)d_in[0]; a.pos = (const int*)d_in[1]; a.norm_mix_g = (const float*)d_in[2]; a.w_in = (const float*)d_in[3]; a.gm_ln_g = (const float*)d_in[4]; a.gm_ln_b = (const float*)d_in[5];
    a.gm_w_s = (const float*)d_in[6]; a.gm_b_s = (const float*)d_in[7]; a.lam_q1 = (const float*)d_in[8]; a.lam_k1 = (const float*)d_in[9]; a.lam_q2 = (const float*)d_in[10]; a.lam_k2 = (const float*)d_in[11];
    a.subln_g = (const float*)d_in[12]; a.w_br_a = (const float*)d_in[13]; a.w_br_b = (const float*)d_in[14]; a.w_out = (const float*)d_in[15]; a.norm_ffn_g = (const float*)d_in[16];
    a.w_rg = (const float*)d_in[17]; a.b_rg = (const float*)d_in[18]; a.w_re = (const float*)d_in[19]; a.b_re = (const float*)d_in[20]; a.w_gate = (const float*)d_in[21]; a.w_up = (const float*)d_in[22];
    a.w_down = (const float*)d_in[23]; a.final_g = (const float*)d_in[24];
    a.out = (float*)d_out; a.ws = (unsigned char*)d_ws;
    hipLaunchKernelGGL(fwd_kernel, dim3(grid), dim3(NTHREADS), LDS_BYTES, stream, a);
    const hipError_t le = hipPeekAtLastError();
    if (le != hipSuccess) fprintf(stderr, "kernel_launch: launch failed: %s\n", hipGetErrorName(le));
}
```
